# Optimizing an MI355X kernel written in HIP

```python
import jax, jax.numpy as jnp
from jax import lax
import numpy as np

D_MODEL = 1024
BATCH = 8
SEQ = 2048
DEPTH = 2

GRID_W = 64
D_MIX = D_MODEL
HG_DIM = D_MIX // 2
HG_EXPAND = 128
HG_HEADS = HG_DIM // HG_EXPAND
HG_HEAD_DIM = HG_DIM // HG_HEADS
HG_CHUNK = 32
NA_DIM = D_MIX // 4
NA_HEAD_DIM = 64
NA_HEADS = NA_DIM // NA_HEAD_DIM
NA_KH = 8
NA_KW = 16
NA_QB_W = 16
NA_KB_W = NA_QB_W + NA_KW
NA_NCB = GRID_W // NA_QB_W
CONV_DIM = D_MIX - HG_DIM - NA_DIM
CONV_WIDTH = 31
IN_SPLITS = (HG_DIM, HG_DIM, HG_DIM, HG_DIM, HG_DIM,
             NA_DIM, NA_DIM, NA_DIM,
             CONV_DIM, CONV_DIM)
D_IN = sum(IN_SPLITS)
FFN_DIM = -(-8 * D_MODEL // (3 * 256)) * 256
EPS = 1e-6
NEG_INF = -1e30

kernel_name = "hymba_style_hgrn2_natten_conformer_encoder"


def _rmsnorm(x, g):
    xf = x.astype(jnp.float32)
    y = xf * lax.rsqrt(jnp.mean(xf * xf, axis=-1, keepdims=True) + EPS)
    return (y * g.astype(jnp.float32)).astype(x.dtype)


def _chunk_gated_recurrence(q, k, v, g):
    B, H, T, dk = q.shape
    dv = v.shape[-1]
    n = T // HG_CHUNK
    cs = lambda t: t.reshape(B, H, n, HG_CHUNK, t.shape[-1])
    q, k, v, g = cs(q), cs(k), cs(v), cs(g)
    b = jnp.cumsum(g, axis=3)
    q_in = q * jnp.exp(b)
    k_in = k * jnp.exp(-b)
    scores = jnp.einsum('bhncd,bhnsd->bhncs', q_in, k_in)
    mask = np.tril(np.ones((HG_CHUNK, HG_CHUNK), dtype=bool))
    scores = jnp.where(mask, scores, 0.0)
    o_intra = jnp.einsum('bhncs,bhnsv->bhncv', scores, v)
    b_last = b[:, :, :, -1:, :]
    d_state = jnp.einsum('bhncd,bhncv->bhndv', k * jnp.exp(b_last - b), v)
    decay = jnp.exp(b_last[:, :, :, 0, :])

    def step(S, inp):
        ds_n, dec_n, q_n = inp
        o_n = jnp.einsum('bhcd,bhdv->bhcv', q_n, S)
        return dec_n[..., None] * S + ds_n, o_n

    S0 = jnp.zeros((B, H, dk, dv), jnp.float32)
    _, o_inter = lax.scan(step, S0, (jnp.moveaxis(d_state, 2, 0), jnp.moveaxis(decay, 2, 0),
                                     jnp.moveaxis(q_in, 2, 0)))
    o = o_intra + jnp.moveaxis(o_inter, 0, 2)
    return o.reshape(B, H, T, dv)


def _hgrn2(q_raw, f_fwd_raw, f_bwd_raw, i_raw, g_raw, lb, norm_g):
    B, T, _ = q_raw.shape
    heads = lambda t: t.reshape(B, T, HG_HEADS, -1).transpose(0, 2, 1, 3)
    q = heads(jax.nn.silu(q_raw.astype(jnp.float32)))
    v = heads(i_raw.astype(jnp.float32))

    def gates(z, lb_d):
        z = z.astype(jnp.float32)
        f = lb_d + (1.0 - lb_d) * jax.nn.sigmoid(z)
        k = (1.0 - lb_d) * jax.nn.sigmoid(-z)
        return heads(k), heads(jnp.log(f))

    k_f, g_f = gates(f_fwd_raw, lb[0])
    k_b, g_b = gates(f_bwd_raw, lb[1])
    flip = lambda t: jnp.flip(t, axis=2)
    o = _chunk_gated_recurrence(q, k_f, v, g_f) + \
        flip(_chunk_gated_recurrence(flip(q), flip(k_b), flip(v), flip(g_b)))
    o = o * lax.rsqrt(jnp.mean(o * o, axis=-1, keepdims=True) + EPS) * norm_g.astype(jnp.float32)
    o = o.transpose(0, 2, 1, 3).reshape(B, T, HG_DIM)
    return o * jax.nn.silu(g_raw.astype(jnp.float32))


def _neighbourhood_attention(q_raw, k_raw, v_raw, rpb):
    B, T, _ = q_raw.shape
    rows = T // GRID_W
    kh = min(NA_KH, rows)
    nk = kh * NA_KB_W
    heads = lambda t: t.astype(jnp.float32).reshape(B, T, NA_HEADS, NA_HEAD_DIM).transpose(0, 2, 1, 3)
    q, k, v = heads(q_raw), heads(k_raw), heads(v_raw)

    r = np.arange(rows)
    key_rows = np.clip(r - kh // 2, 0, rows - kh)[:, None] + np.arange(kh)[None, :]
    c0 = np.arange(NA_NCB) * NA_QB_W
    key_cols = np.clip(c0 - NA_KW // 2, 0, GRID_W - NA_KB_W)[:, None] + np.arange(NA_KB_W)[None, :]
    tok = (key_rows[:, None, :, None] * GRID_W + key_cols[None, :, None, :]).reshape(rows, NA_NCB, nk)
    kg = k[:, :, tok]
    vg = v[:, :, tok]

    q_col = c0[:, None] + np.arange(NA_QB_W)[None, :]
    q_start = np.clip(q_col - NA_KW // 2, 0, GRID_W - NA_KW)
    k_col = np.tile(key_cols, (1, kh))
    valid = (k_col[:, None, :] >= q_start[:, :, None]) & (k_col[:, None, :] < q_start[:, :, None] + NA_KW)
    col_idx = np.clip(k_col[:, None, :] - q_col[:, :, None] + NA_KW - 1, 0, 2 * NA_KW - 2)
    row_idx = np.repeat(key_rows - r[:, None], NA_KB_W, axis=1) + NA_KH - 1
    bias = rpb.astype(jnp.float32)[:, row_idx[:, None, None, :], col_idx[None, :, :, :]]

    qb = q.reshape(B, NA_HEADS, rows, NA_NCB, NA_QB_W, NA_HEAD_DIM)
    s = jnp.einsum('bhrjqd,bhrjkd->bhrjqk', qb, kg) * (NA_HEAD_DIM ** -0.5) + bias[None]
    s = jnp.where(valid, s, NEG_INF)
    p = jax.nn.softmax(s, axis=-1)
    o = jnp.einsum('bhrjqk,bhrjkd->bhrjqd', p, vg)
    return o.reshape(B, NA_HEADS, T, NA_HEAD_DIM).transpose(0, 2, 1, 3).reshape(B, T, NA_DIM)


def _conformer_conv(a, gate, w_dw, b_dw, ln_g, ln_b):
    u = a.astype(jnp.float32) * jax.nn.sigmoid(gate.astype(jnp.float32))
    u = lax.conv_general_dilated(u, w_dw.astype(jnp.float32)[:, None, :], window_strides=(1,),
                                 padding=[(CONV_WIDTH // 2, CONV_WIDTH // 2)],
                                 dimension_numbers=('NWC', 'WIO', 'NWC'),
                                 feature_group_count=CONV_DIM) + b_dw.astype(jnp.float32)
    mu = jnp.mean(u, axis=-1, keepdims=True)
    var = jnp.mean(jnp.square(u - mu), axis=-1, keepdims=True)
    u = (u - mu) * lax.rsqrt(var + EPS) * ln_g.astype(jnp.float32) + ln_b.astype(jnp.float32)
    return jax.nn.silu(u)


def setup_inputs(seed: int = 0) -> dict:
    key = jax.random.key(seed)
    ks = jax.random.split(key, 16)
    nrm = lambda k, shape, scale: jax.random.normal(k, shape, jnp.float32) * scale
    return {
        "x": nrm(ks[0], (BATCH, SEQ, D_MODEL), 1.0),
        "mix_norm_g": 1.0 + nrm(ks[1], (DEPTH, D_MODEL), 0.02),
        "w_in": nrm(ks[2], (DEPTH, D_MODEL, D_IN), D_MODEL ** -0.5),
        "hg_lower_bounds": nrm(ks[3], (DEPTH, 2, HG_DIM), 0.1),
        "hg_norm_g": 1.0 + nrm(ks[4], (DEPTH, HG_HEAD_DIM), 0.02),
        "na_rpb": nrm(ks[5], (DEPTH, NA_HEADS, 2 * NA_KH - 1, 2 * NA_KW - 1), 0.02),
        "conv_w": nrm(ks[6], (DEPTH, CONV_WIDTH, CONV_DIM), CONV_WIDTH ** -0.5),
        "conv_b": nrm(ks[7], (DEPTH, CONV_DIM), 0.02),
        "conv_ln_g": 1.0 + nrm(ks[8], (DEPTH, CONV_DIM), 0.02),
        "conv_ln_b": nrm(ks[9], (DEPTH, CONV_DIM), 0.02),
        "w_out": nrm(ks[10], (DEPTH, D_MIX, D_MODEL), D_MIX ** -0.5),
        "ffn_norm_g": 1.0 + nrm(ks[11], (DEPTH, D_MODEL), 0.02),
        "w_gate_up": nrm(ks[12], (DEPTH, D_MODEL, 2 * FFN_DIM), D_MODEL ** -0.5),
        "w_down": nrm(ks[13], (DEPTH, FFN_DIM, D_MODEL), FFN_DIM ** -0.5),
        "final_norm_g": 1.0 + nrm(ks[14], (D_MODEL,), 0.02),
    }


def reference(x, mix_norm_g, w_in, hg_lower_bounds, hg_norm_g, na_rpb, conv_w, conv_b,
              conv_ln_g, conv_ln_b, w_out, ffn_norm_g, w_gate_up, w_down, final_norm_g):
    lbs = jax.nn.softmax(hg_lower_bounds.astype(jnp.float32), axis=0)
    lbs = jnp.cumsum(lbs, axis=0) - lbs[0:1]
    split_idx = []
    acc = 0
    for s in IN_SPLITS[:-1]:
        acc += s
        split_idx.append(acc)
    for l in range(DEPTH):
        h = _rmsnorm(x, mix_norm_g[l])
        p = h @ w_in[l]
        hq, hff, hfb, hi, hg, nq, nk, nv, ca, cg = jnp.split(p, split_idx, axis=-1)
        y_hg = _hgrn2(hq, hff, hfb, hi, hg, lbs[l], hg_norm_g[l])
        y_na = _neighbourhood_attention(nq, nk, nv, na_rpb[l])
        y_cv = _conformer_conv(ca, cg, conv_w[l], conv_b[l], conv_ln_g[l], conv_ln_b[l])
        mixed = jnp.concatenate([y_hg, y_na, y_cv], axis=-1).astype(x.dtype)
        x = x + mixed @ w_out[l]
        h = _rmsnorm(x, ffn_norm_g[l])
        gt, up = jnp.split(h @ w_gate_up[l], 2, axis=-1)
        x = x + (jax.nn.silu(gt) * up) @ w_down[l]
    return _rmsnorm(x, final_norm_g)
```

```cpp
#include <hip/hip_runtime.h>
#include <hip/hip_cooperative_groups.h>
#include <cstdio>
#include <cstdint>
namespace cg = cooperative_groups;

namespace pg8 {
#define PG8_LAS __attribute__((address_space(3)))
typedef unsigned short bf16_t;
typedef short bf16x8 __attribute__((ext_vector_type(8)));
typedef float f32x4 __attribute__((ext_vector_type(4)));
typedef unsigned u32x4 __attribute__((ext_vector_type(4)));
constexpr int BM = 256, BK = 64, HALF = 128, HTB = HALF * BK * 2  , STAGE_BYTES = 8 * HTB, NXCD = 8, WGM = 8;

__host__ __device__ __forceinline__ int lds_byte(int r, int c) { const int st = (r >> 4) * 2 + (c >> 5), rr = r & 15, cc = c & 31, ob = rr * 64 + cc * 2; return st * 1024 + (ob ^ (((ob >> 9) & 1) << 5)); }
__host__ __device__ __forceinline__ void stage_rc(int b, int& R, int& C) { const int st = b / 1024, sb = b % 1024, swz = sb ^ (((sb >> 9) & 1) << 5); R = (st >> 1) * 16 + swz / 64; C = (st & 1) * 32 + (swz % 64) / 2; }
__host__ __device__ __forceinline__ int perm32(int rho) { const int n = rho >> 4, i = rho & 15; return 8 * (i >> 2) + 4 * n + (i & 3); }

struct Unit { int pm, pn; };
struct Gemm { const bf16_t* A; const bf16_t* Bt; int M, N, K; };

struct StaticOrder {
    int nM, nN, nwg, G, c;
    __host__ __device__ void init(int M, int N, int G_, int c_) { nM = M / BM; nN = N / BM; nwg = nM * nN; G = G_; c = c_; }
    __host__ __device__ bool next(int i, Unit& u) const {
        const long L = (long)i * G + c; if (L >= nwg) return false;
        int wgid = (int)L; { const int q = nwg / NXCD, r = nwg % NXCD, xcd = wgid % NXCD, off = wgid / NXCD; wgid = (xcd < r ? xcd * (q + 1) : r * (q + 1) + (xcd - r) * q) + off; }
        const int nig = WGM * nN, gid = wgid / nig, fm = gid * WGM, gsz = (nM - fm) < WGM ? (nM - fm) : WGM;
        u.pm = fm + ((wgid % nig) % gsz); u.pn = (wgid % nig) / gsz; return true;
    }
    __device__ __forceinline__ void a_ready(const Unit&) const {}
    __device__ __forceinline__ void done(const Unit&) const {}
};
__device__ __forceinline__ unsigned cvt_pk_bf16(float lo, float hi) { unsigned r; asm volatile("v_cvt_pk_bf16_f32 %0, %1, %2" : "=v"(r) : "v"(lo), "v"(hi)); return r; }
typedef float f32x2 __attribute__((ext_vector_type(2)));
constexpr int MROWS = 16384, DMODEL = 1024, NPART = 16;
constexpr float NORM_EPS = 1e-6f;
__device__ __forceinline__ float row_rstd(const float* ssq, int row) {
    float s = 0.f;
#pragma unroll
    for (int p = 0; p < NPART; ++p) s += ssq[(size_t)p * MROWS + row];
    return __builtin_amdgcn_rsqf(s * (1.f / DMODEL) + NORM_EPS);
}
__device__ __forceinline__ float silu_f(float x) { return x * __builtin_amdgcn_rcpf(1.f + __expf(-x)); }

struct EpiScale {
    static constexpr bool PERM = true, AFTER_DRAIN = false;
    bf16_t* O; int ldc; const PG8_LAS float* RS;
    __device__ __forceinline__ void operator()(const f32x4 (&acc)[2][2][4][2], const Unit& u, int ui, int wr, int wc, int fr, int fq) const {
        const int row0 = u.pm * BM + wr * 64 + fr, col0 = u.pn * BM + wc * 32 + 8 * fq;
#pragma unroll
        for (int ai = 0; ai < 2; ++ai)
#pragma unroll
            for (int m = 0; m < 4; ++m) { const int row = row0 + ai * HALF + m * 16; const float rs = RS[ui * BM + wr * 64 + fr + ai * HALF + m * 16]; bf16_t* rowp = O + (size_t)row * ldc + col0;
#pragma unroll
                for (int bj = 0; bj < 2; ++bj) { const f32x4 v0 = acc[ai][bj][m][0] * rs, v1 = acc[ai][bj][m][1] * rs;
                    u32x4 w; w.x = cvt_pk_bf16(v0[0], v0[1]); w.y = cvt_pk_bf16(v0[2], v0[3]); w.z = cvt_pk_bf16(v1[0], v1[1]); w.w = cvt_pk_bf16(v1[2], v1[3]);
                    *(u32x4*)(rowp + bj * HALF) = w; } __builtin_amdgcn_sched_barrier(0); }
    }
};
struct EpiRes {
    static constexpr bool PERM = true, AFTER_DRAIN = false;
    const float* R; float* X; bf16_t* XB; float* ssq;
    __device__ __forceinline__ void operator()(const f32x4 (&acc)[2][2][4][2], const Unit& u, int ui, int wr, int wc, int fr, int fq) const {
        const int row0 = u.pm * BM + wr * 64 + fr, col0 = u.pn * BM + wc * 32 + 8 * fq;
#pragma unroll
        for (int ai = 0; ai < 2; ++ai)
#pragma unroll
            for (int m = 0; m < 4; ++m) { const int row = row0 + ai * HALF + m * 16; const size_t o = (size_t)row * DMODEL + col0; float sq = 0.f;
#pragma unroll
                for (int bj = 0; bj < 2; ++bj) { const f32x4 r0 = *(const f32x4*)(R + o + bj * HALF), r1 = *(const f32x4*)(R + o + bj * HALF + 4);
                    const f32x4 v0 = acc[ai][bj][m][0] + r0, v1 = acc[ai][bj][m][1] + r1;
                    *(f32x4*)(X + o + bj * HALF) = v0; *(f32x4*)(X + o + bj * HALF + 4) = v1;
                    u32x4 w; w.x = cvt_pk_bf16(v0[0], v0[1]); w.y = cvt_pk_bf16(v0[2], v0[3]); w.z = cvt_pk_bf16(v1[0], v1[1]); w.w = cvt_pk_bf16(v1[2], v1[3]);
                    *(u32x4*)(XB + o + bj * HALF) = w;
                    sq += (v0[0] * v0[0] + v0[1] * v0[1]) + (v0[2] * v0[2] + v0[3] * v0[3]) + (v1[0] * v1[0] + v1[1] * v1[1]) + (v1[2] * v1[2] + v1[3] * v1[3]); }
                sq += __shfl_xor(sq, 16); sq += __shfl_xor(sq, 32);
                if (fq == 0) ssq[(size_t)(u.pn * 4 + wc) * MROWS + row] = sq; __builtin_amdgcn_sched_barrier(0); }
    }
};
struct EpiSwiGLU {
    static constexpr bool PERM = true, AFTER_DRAIN = false;
    bf16_t* O; int ldc; const PG8_LAS float* RS;
    __device__ __forceinline__ void operator()(const f32x4 (&acc)[2][2][4][2], const Unit& u, int ui, int wr, int wc, int fr, int fq) const {
        const int row0 = u.pm * BM + wr * 64 + fr, col0 = u.pn * HALF + wc * 32 + 8 * fq;
#pragma unroll
        for (int ai = 0; ai < 2; ++ai)
#pragma unroll
            for (int m = 0; m < 4; ++m) { const int row = row0 + ai * HALF + m * 16; const float rs = RS[ui * BM + wr * 64 + fr + ai * HALF + m * 16];
                const f32x4 g0 = acc[ai][0][m][0] * rs, g1 = acc[ai][0][m][1] * rs, u0 = acc[ai][1][m][0] * rs, u1 = acc[ai][1][m][1] * rs;
                u32x4 w; w.x = cvt_pk_bf16(silu_f(g0[0]) * u0[0], silu_f(g0[1]) * u0[1]); w.y = cvt_pk_bf16(silu_f(g0[2]) * u0[2], silu_f(g0[3]) * u0[3]);
                w.z = cvt_pk_bf16(silu_f(g1[0]) * u1[0], silu_f(g1[1]) * u1[1]); w.w = cvt_pk_bf16(silu_f(g1[2]) * u1[2], silu_f(g1[3]) * u1[3]);
                *(u32x4*)(O + (size_t)row * ldc + col0) = w; __builtin_amdgcn_sched_barrier(0); }
    }
};
template <class Sched> __device__ __forceinline__ void rstd_table(PG8_LAS float* RS, const float* ssq, const Sched& S) {
    Unit u;
    for (int i = 0; S.next(i, u); ++i) if (threadIdx.x < BM) RS[i * BM + threadIdx.x] = row_rstd(ssq, u.pm * BM + threadIdx.x);
    __syncthreads();
}
template <class Epi, class Sched, bool ALIGN_EPI = false, bool SP2 = false>
__device__ __forceinline__ void gemm_phase(PG8_LAS unsigned char* lds, const Gemm g, const Sched& S, const Epi& E) {
    int tid_ = threadIdx.x; asm volatile("" : "+v"(tid_));
    const int tid = tid_, wid = __builtin_amdgcn_readfirstlane(tid >> 6), lane = tid & 63, wr = wid >> 2, wc = wid & 3, fr = lane & 15, fq = lane >> 4;
    const int K = g.K, nt = K / BK;
    unsigned voffA[2], voffB[2];
#pragma unroll
    for (int i = 0; i < 2; ++i) { int R, C; stage_rc(tid * 16 + i * 8192, R, C); const int Rb = Epi::PERM ? ((R & ~31) + perm32(R & 31)) : R;
        voffA[i] = (unsigned)(R * K + C) * 2u; voffB[i] = (unsigned)(Rb * K + C) * 2u; }
    const size_t kstep = (size_t)(BK * 2);
    const size_t hstep = (size_t)HALF * K * 2;
    const size_t tstep = 2 * hstep;
    const unsigned ldsw = (unsigned)wid * 1024u;
    const int aoff = lds_byte(wr * 64 + fr, fq * 8), boff = lds_byte(wc * 32 + fr, fq * 8);
#define PG8_SA(b, h) (((b) * 2 + (h)) * HTB)
#define PG8_SB(b, h) ((4 + (b) * 2 + (h)) * HTB)
#define PG8_STAGE(bufoff, gbase, voff) do { _Pragma("unroll") for (int _i = 0; _i < 2; ++_i) \
        __builtin_amdgcn_global_load_lds((const unsigned*)((const char*)(gbase) + (voff)[_i]), (PG8_LAS unsigned*)(lds + (bufoff) + ldsw + _i * 8192), 16, 0, 0); } while (0)
#define PG8_LDA(dst, b, h) do { _Pragma("unroll") for (int m = 0; m < 4; ++m) _Pragma("unroll") for (int k = 0; k < 2; ++k) dst[m][k] = *(const PG8_LAS bf16x8*)(lds + PG8_SA(b, h) + aoff + m * 2048 + k * 1024); } while (0)
#define PG8_LDB(dst, b, h) do { _Pragma("unroll") for (int n = 0; n < 2; ++n) _Pragma("unroll") for (int k = 0; k < 2; ++k) dst[n][k] = *(const PG8_LAS bf16x8*)(lds + PG8_SB(b, h) + boff + n * 2048 + k * 1024); } while (0)
#define PG8_MMA(ai, bj, At, Bt) do { __builtin_amdgcn_s_setprio(1); _Pragma("unroll") for (int m = 0; m < 4; ++m) _Pragma("unroll") for (int n = 0; n < 2; ++n) _Pragma("unroll") for (int k = 0; k < 2; ++k) \
        acc[ai][bj][m][n] = __builtin_amdgcn_mfma_f32_16x16x32_bf16(Bt[n][k], At[m][k], acc[ai][bj][m][n], 0, 0, 0); __builtin_amdgcn_s_setprio(0); } while (0)
#define PG8_WAIT_V(n) asm volatile("s_waitcnt vmcnt(" #n ")" ::: "memory")
#define PG8_WAIT_L(n) asm volatile("s_waitcnt lgkmcnt(" #n ")" ::: "memory")
#define PG8_BAR __builtin_amdgcn_s_barrier()
#define PG8_SCHED __builtin_amdgcn_sched_barrier(0)
    Unit cur, nxt; int ui = 0;
    if (!S.next(0, cur)) return;
    f32x4 acc[2][2][4][2];
#pragma unroll
    for (int a = 0; a < 2; ++a)
#pragma unroll
        for (int b = 0; b < 2; ++b)
#pragma unroll
            for (int m = 0; m < 4; ++m)
#pragma unroll
                for (int n = 0; n < 2; ++n) acc[a][b][m][n] = (f32x4){0.f, 0.f, 0.f, 0.f};
    bf16x8 At[4][2], B0[2][2], B1[2][2];
    const char* cA = (const char*)g.A + (size_t)cur.pm * tstep; const char* cB = (const char*)g.Bt + (size_t)cur.pn * tstep;
    S.a_ready(cur);
    if constexpr (SP2) {
        PG8_STAGE(PG8_SB(0, 0), cB, voffB); PG8_STAGE(PG8_SB(0, 1), cB + hstep, voffB); PG8_STAGE(PG8_SA(0, 0), cA, voffA); PG8_STAGE(PG8_SA(0, 1), cA + hstep, voffA);
        if (wr == 1) PG8_BAR;
        PG8_WAIT_V(2); PG8_BAR;
        PG8_STAGE(PG8_SB(1, 0), cB + kstep, voffB); PG8_STAGE(PG8_SA(1, 0), cA + kstep, voffA); PG8_STAGE(PG8_SB(1, 1), cB + hstep + kstep, voffB);
        PG8_WAIT_V(6); PG8_BAR;
    } else {
        PG8_STAGE(PG8_SB(0, 0), cB, voffB); PG8_STAGE(PG8_SA(0, 0), cA, voffA); PG8_STAGE(PG8_SB(0, 1), cB + hstep, voffB); PG8_STAGE(PG8_SA(0, 1), cA + hstep, voffA);
        if (wr == 1) PG8_BAR;
        PG8_WAIT_V(4); PG8_BAR;
        PG8_STAGE(PG8_SB(1, 0), cB + kstep, voffB); PG8_STAGE(PG8_SA(1, 0), cA + kstep, voffA); PG8_STAGE(PG8_SB(1, 1), cB + hstep + kstep, voffB);
        PG8_WAIT_V(6); PG8_BAR;
    }
    for (;;) {
        const bool has_next = S.next(ui + 1, nxt);
        const char* nA = has_next ? (const char*)g.A + (size_t)nxt.pm * tstep : cA; const char* nB = has_next ? (const char*)g.Bt + (size_t)nxt.pn * tstep : cB;
        for (int t = 0; t < nt; t += 2) {
            const bool last = (t == nt - 2);
            const char* a1 = cA + (size_t)(t + 1) * kstep;
            const char* a2 = last ? nA : cA + (size_t)(t + 2) * kstep; const char* b2 = last ? nB : cB + (size_t)(t + 2) * kstep;
            const char* a3 = a2 + kstep; const char* b3 = b2 + kstep;
            if (last && has_next) S.a_ready(nxt);
            if constexpr (SP2) {
            PG8_LDB(B0, 0, 0); PG8_LDB(B1, 0, 1); PG8_SCHED; PG8_LDA(At, 0, 0); PG8_STAGE(PG8_SA(1, 1), a1 + hstep, voffA);
            PG8_WAIT_V(8); PG8_WAIT_L(0); PG8_BAR; PG8_MMA(0, 0, At, B0); PG8_MMA(0, 1, At, B1); PG8_BAR; PG8_SCHED;
            PG8_LDA(At, 0, 1); PG8_STAGE(PG8_SB(0, 0), b2, voffB); PG8_STAGE(PG8_SB(0, 1), b2 + hstep, voffB); PG8_STAGE(PG8_SA(0, 0), a2, voffA);
            PG8_WAIT_V(8); PG8_WAIT_L(0); PG8_BAR; PG8_MMA(1, 0, At, B0); PG8_MMA(1, 1, At, B1); PG8_BAR; PG8_SCHED;
            PG8_LDB(B0, 1, 0); PG8_LDB(B1, 1, 1); PG8_SCHED; PG8_LDA(At, 1, 0); PG8_STAGE(PG8_SA(0, 1), a2 + hstep, voffA);
            PG8_WAIT_V(8); PG8_WAIT_L(0); PG8_BAR; PG8_MMA(0, 0, At, B0); PG8_MMA(0, 1, At, B1); PG8_BAR; PG8_SCHED;
            PG8_LDA(At, 1, 1); PG8_STAGE(PG8_SB(1, 0), b3, voffB); PG8_STAGE(PG8_SB(1, 1), b3 + hstep, voffB); PG8_STAGE(PG8_SA(1, 0), a3, voffA);
            PG8_WAIT_V(8); PG8_WAIT_L(0); PG8_BAR; PG8_MMA(1, 0, At, B0); PG8_MMA(1, 1, At, B1); PG8_BAR; PG8_SCHED;
            } else {
            PG8_LDB(B0, 0, 0); PG8_SCHED; PG8_LDA(At, 0, 0); PG8_STAGE(PG8_SA(1, 1), a1 + hstep, voffA);
            PG8_WAIT_L(8); PG8_BAR; PG8_WAIT_L(0); PG8_MMA(0, 0, At, B0); PG8_BAR; PG8_SCHED;
            PG8_LDB(B1, 0, 1); PG8_STAGE(PG8_SB(0, 0), b2, voffB);
            PG8_BAR; PG8_WAIT_L(0); PG8_MMA(0, 1, At, B1); PG8_BAR;
            PG8_LDA(At, 0, 1); PG8_STAGE(PG8_SA(0, 0), a2, voffA);
            PG8_BAR; PG8_WAIT_L(0); PG8_MMA(1, 0, At, B0); PG8_BAR; PG8_SCHED;
            PG8_STAGE(PG8_SB(0, 1), b2 + hstep, voffB);
            PG8_WAIT_V(6); PG8_BAR; PG8_MMA(1, 1, At, B1); PG8_BAR;
            PG8_LDB(B0, 1, 0); PG8_SCHED; PG8_LDA(At, 1, 0); PG8_STAGE(PG8_SA(0, 1), a2 + hstep, voffA);
            PG8_WAIT_L(8); PG8_BAR; PG8_WAIT_L(0); PG8_MMA(0, 0, At, B0); PG8_BAR; PG8_SCHED;
            PG8_LDB(B1, 1, 1); PG8_STAGE(PG8_SB(1, 0), b3, voffB);
            PG8_BAR; PG8_WAIT_L(0); PG8_MMA(0, 1, At, B1); PG8_BAR;
            PG8_LDA(At, 1, 1); PG8_STAGE(PG8_SA(1, 0), a3, voffA);
            PG8_BAR; PG8_WAIT_L(0); PG8_MMA(1, 0, At, B0); PG8_BAR; PG8_SCHED;
            PG8_STAGE(PG8_SB(1, 1), b3 + hstep, voffB);
            PG8_WAIT_V(6); PG8_BAR; PG8_MMA(1, 1, At, B1); PG8_BAR;
            }
        }
        if constexpr (ALIGN_EPI) { if (wr == 0) PG8_BAR; }
        if constexpr (!Epi::AFTER_DRAIN) { E(acc, cur, ui, wr, wc, fr, fq); S.done(cur); }
        if (!has_next) break;
#pragma unroll
        for (int a = 0; a < 2; ++a)
#pragma unroll
            for (int b = 0; b < 2; ++b)
#pragma unroll
                for (int m = 0; m < 4; ++m)
#pragma unroll
                    for (int n = 0; n < 2; ++n) acc[a][b][m][n] = (f32x4){0.f, 0.f, 0.f, 0.f};
        cur = nxt; cA = nA; cB = nB; ++ui;
        if constexpr (ALIGN_EPI) { if (wr == 1) PG8_BAR; }
    }
    PG8_WAIT_V(0);
    if constexpr (!ALIGN_EPI) { if (wr == 0) PG8_BAR; }
    PG8_BAR;
    if constexpr (Epi::AFTER_DRAIN) { E.fused(acc, cur, wr, wc, fr, fq, lds, wid, lane); S.done(cur); }
#undef PG8_SA
#undef PG8_SB
#undef PG8_STAGE
#undef PG8_LDA
#undef PG8_LDB
#undef PG8_MMA
#undef PG8_WAIT_V
#undef PG8_WAIT_L
#undef PG8_BAR
#undef PG8_SCHED
}
}
#define LAS __attribute__((address_space(3)))
typedef unsigned short bf16;
typedef float f32x4 __attribute__((ext_vector_type(4)));
typedef short bf16x8 __attribute__((ext_vector_type(8)));
typedef unsigned u32x4 __attribute__((ext_vector_type(4)));
typedef unsigned u32x2 __attribute__((ext_vector_type(2)));
constexpr int NWAVES = 8, NTHR = 512;
constexpr int BATCH = 8, SEQ = 2048, DM = 1024, M = BATCH * SEQ, DIN = 3840, FFN = 2816, DEPTH = 2;
constexpr int C_HQ = 0, C_HFF = 512, C_HI = 1536, C_HG = 2048, C_NQ = 2560, C_NK = 2816, C_NV = 3072, C_CA = 3328, C_CG = 3584;
constexpr int NSEG = 8, SEGLEN = SEQ / NSEG, CHS = SEGLEN / 32;
constexpr float EPS = 1e-6f;
constexpr size_t MiB = 1u << 20;
constexpr size_t WS_SSQ = 1 * MiB;
constexpr size_t WS_WIN = 2 * MiB, WS_WIN_L = (size_t)DIN * DM * 2;
constexpr size_t WS_WOUT = 17 * MiB, WS_WOUT_L = (size_t)DM * DM * 2;
constexpr size_t WS_WGU = 21 * MiB, WS_WGU_L = (size_t)2 * FFN * DM * 2;
constexpr size_t WS_WDN = 43 * MiB, WS_WDN_L = (size_t)DM * FFN * 2;
constexpr size_t WS_P = 54 * MiB;
constexpr size_t WS_MIX = 174 * MiB;
constexpr size_t WS_XB = 206 * MiB;
constexpr size_t WS_SLOC = 238 * MiB;
constexpr size_t WS_DSEG = 254 * MiB;
constexpr size_t WS_END = 255 * MiB;

__device__ __forceinline__ float bf2f(unsigned short h) { return __builtin_bit_cast(float, (unsigned)h << 16); }
__device__ __forceinline__ float bflo(unsigned w) { return __builtin_bit_cast(float, w << 16); }
__device__ __forceinline__ float bfhi(unsigned w) { return __builtin_bit_cast(float, w & 0xffff0000u); }
__device__ __forceinline__ unsigned pk2(float lo, float hi) { return pg8::cvt_pk_bf16(lo, hi); }
__device__ __forceinline__ unsigned short f2bf(float v) { return (unsigned short)(pg8::cvt_pk_bf16(v, 0.f) & 0xffffu); }
__device__ __forceinline__ float wave_sum(float v) {
#pragma unroll
    for (int o = 1; o < 64; o <<= 1) v += __shfl_xor(v, o);
    return v;
}
__device__ __forceinline__ float sigm(float x) { return __builtin_amdgcn_rcpf(1.f + __expf(-x)); }
__device__ __forceinline__ float silu_f0(float x) { return x * sigm(x); }
__device__ __forceinline__ f32x4 mfma16(bf16x8 a, bf16x8 b, f32x4 c) { return __builtin_amdgcn_mfma_f32_16x16x32_bf16(a, b, c, 0, 0, 0); }
#define LDS_WAIT() asm volatile("s_waitcnt lgkmcnt(0)" ::: "memory")

struct Params {
    const float *x, *mix_g, *w_in, *hg_lb, *hg_ng, *rpb, *cw, *cb, *lng, *lnb, *w_out, *ffn_g, *w_gu, *w_dn, *fin_g;
    float* out; unsigned char* ws;
};

__device__ __forceinline__ void transpose_item(const float* W, int K, int N, bf16* WT, const float* gk, bool gu, LAS float* scr, int item, int lane) {
    const int nblk = N / 32, kb = item / nblk, nb = item % nblk, k0 = 64 * kb, n0 = 32 * nb;
#pragma unroll 8
    for (int i = 0; i < 32; ++i) { const int kk = 2 * i + (lane >> 5); float v = W[(size_t)(k0 + kk) * N + n0 + (lane & 31)]; if (gk) v *= gk[k0 + kk]; scr[kk * 33 + (lane & 31)] = v; }
    LDS_WAIT(); asm volatile("" ::: "memory");
    const int c = lane & 7;
    int r0 = n0;
    if (gu) { const int up = n0 >= FFN ? 1 : 0, cc = n0 - up * FFN; r0 = 256 * (cc >> 7) + (cc & 127) + up * 128; }
#pragma unroll
    for (int j = 0; j < 4; ++j) { const int n = (lane >> 3) + 8 * j; const LAS float* s = scr + (8 * c) * 33 + n;
        u32x4 o; o.x = pk2(s[0 * 33], s[1 * 33]); o.y = pk2(s[2 * 33], s[3 * 33]); o.z = pk2(s[4 * 33], s[5 * 33]); o.w = pk2(s[6 * 33], s[7 * 33]);
        *(u32x4*)(WT + (size_t)(r0 + n) * K + k0 + 8 * c) = o; }
    LDS_WAIT(); asm volatile("" ::: "memory");
}
__device__ __forceinline__ void prologue(const Params& p, LAS unsigned char* lds, int gw, int NGW, int wave, int lane) {
    LAS float* scr = (LAS float*)(lds + wave * 16384);
    constexpr int I_IN = (DM / 64) * (DIN / 32), I_OUT = (DM / 64) * (DM / 32), I_GU = (DM / 64) * (2 * FFN / 32), I_DN = (FFN / 64) * (DM / 32), I_L = I_IN + I_OUT + I_GU + I_DN;
    for (int it = gw; it < DEPTH * I_L; it += NGW) {
        const int l = it / I_L; int r = it % I_L;
        if (r < I_IN) { transpose_item(p.w_in + (size_t)l * DM * DIN, DM, DIN, (bf16*)(p.ws + WS_WIN + l * WS_WIN_L), p.mix_g + l * DM, false, scr, r, lane); continue; } r -= I_IN;
        if (r < I_OUT) { transpose_item(p.w_out + (size_t)l * DM * DM, DM, DM, (bf16*)(p.ws + WS_WOUT + l * WS_WOUT_L), nullptr, false, scr, r, lane); continue; } r -= I_OUT;
        if (r < I_GU) { transpose_item(p.w_gu + (size_t)l * DM * 2 * FFN, DM, 2 * FFN, (bf16*)(p.ws + WS_WGU + l * WS_WGU_L), p.ffn_g + l * DM, true, scr, r, lane); continue; } r -= I_GU;
        transpose_item(p.w_dn + (size_t)l * FFN * DM, FFN, DM, (bf16*)(p.ws + WS_WDN + l * WS_WDN_L), nullptr, false, scr, r, lane);
    }
    bf16* XB = (bf16*)(p.ws + WS_XB); float* ssq = (float*)(p.ws + WS_SSQ);
    for (int m = gw; m < M; m += NGW) {
        const f32x4* xr = (const f32x4*)(p.x + (size_t)m * DM) + lane; float s = 0.f;
        unsigned long long* o8 = (unsigned long long*)(XB + (size_t)m * DM) + lane;
#pragma unroll
        for (int j = 0; j < 4; ++j) { const f32x4 v = xr[64 * j]; s += (v.x * v.x + v.y * v.y) + (v.z * v.z + v.w * v.w);
            o8[64 * j] = (unsigned long long)pk2(v.x, v.y) | ((unsigned long long)pk2(v.z, v.w) << 32); }
        s = wave_sum(s);
        if (lane < 16) ssq[(size_t)lane * M + m] = lane == 0 ? s : 0.f;
    }
}

constexpr int HQ_OFF = 0, HK_OFF = 8704, HKH_OFF = 17408, HV_OFF = 27648, HP_OFF = 37888, HST_OFF = 40448, HOS_OFF = 75264, HGS_OFF = 92160, HDEC_OFF = 94208;
template <bool FULL, bool SECOND>
__device__ __forceinline__ void hg_segment(LAS unsigned char* lds, const bf16* P, int b, int h, int dir, int seg, float lb, f32x4 (&S)[8], float& bsum,
                                           float* OP, bf16* MIXED, const float* norm_g) {
    int tid_ = threadIdx.x; asm volatile("" : "+v"(tid_)); const int tid = tid_, w = __builtin_amdgcn_readfirstlane(tid >> 6), lane = tid & 63, fr = lane & 15, fq = lane >> 4;
    const int d = tid & 127, grp = tid >> 7;
    LAS bf16* QT = (LAS bf16*)(lds + HQ_OFF); LAS bf16* KT = (LAS bf16*)(lds + HK_OFF); LAS bf16* KHT = (LAS bf16*)(lds + HKH_OFF); LAS bf16* VT = (LAS bf16*)(lds + HV_OFF);
    LAS bf16* PS = (LAS bf16*)(lds + HP_OFF); LAS bf16* ST = (LAS bf16*)(lds + HST_OFF); LAS float* OS = (LAS float*)(lds + HOS_OFF); LAS float* GS = (LAS float*)(lds + HGS_OFF); LAS float* DEC = (LAS float*)(lds + HDEC_OFF);
    const int zcol = C_HFF + dir * 512 + h * 128 + d, qcol = C_HQ + h * 128 + d, vcol = C_HI + h * 128 + d;
    const float oml = 1.f - lb;
    for (int n = 0; n < CHS; ++n) {
        const int tb = dir == 0 ? (seg * SEGLEN + 32 * n) : (seg * SEGLEN + SEGLEN - 1 - 32 * n); const int ts = dir == 0 ? 1 : -1;
        const bf16* rowp = P + (size_t)(b * SEQ + tb + ts * 8 * grp) * DIN; const long rstep = (long)ts * DIN;
        float bl[8], kv[8], qv[8]; unsigned short vv[8]; float run = 0.f;
#pragma unroll
        for (int e = 0; e < 8; ++e) { const bf16* r = rowp + rstep * e; float z = bf2f(r[zcol]); z = fminf(fmaxf(z, -40.f), 40.f);
            const float ez = __expf(-z), inv = __builtin_amdgcn_rcpf(1.f + ez), sg = inv, sgn = ez * inv;
            const float f = lb + oml * sg; run += __logf(f); bl[e] = run; kv[e] = oml * sgn;
            if (FULL) qv[e] = silu_f0(bf2f(r[qcol])); else qv[e] = 0.f;
            vv[e] = r[vcol]; }
        GS[grp * 128 + d] = run;
        __syncthreads();
        float pre = 0.f, tot = 0.f;
#pragma unroll
        for (int g2 = 0; g2 < 4; ++g2) { const float t = GS[g2 * 128 + d]; tot += t; if (g2 < grp) pre += t; }
        unsigned khp[4], vvp[4];
#pragma unroll
        for (int e = 0; e < 8; e += 2) { const float b0 = pre + bl[e], b1 = pre + bl[e + 1];
            if (FULL) { const int c0 = 8 * grp + e; QT[c0 * 136 + d] = f2bf(qv[e] * __expf(b0)); QT[(c0 + 1) * 136 + d] = f2bf(qv[e + 1] * __expf(b1));
                KT[c0 * 136 + d] = f2bf(kv[e] * __expf(-b0)); KT[(c0 + 1) * 136 + d] = f2bf(kv[e + 1] * __expf(-b1)); }
            khp[e >> 1] = pk2(kv[e] * __expf(tot - b0), kv[e + 1] * __expf(tot - b1)); vvp[e >> 1] = (unsigned)vv[e] | ((unsigned)vv[e + 1] << 16); }
        *(LAS u32x4*)(KHT + d * 40 + 8 * grp) = (u32x4){khp[0], khp[1], khp[2], khp[3]};
        *(LAS u32x4*)(VT + d * 40 + 8 * grp) = (u32x4){vvp[0], vvp[1], vvp[2], vvp[3]};
        if (grp == 0) { DEC[d] = __expf(tot); bsum += tot; }
        __syncthreads();
        f32x4 o[2] = {(f32x4){0.f, 0.f, 0.f, 0.f}, (f32x4){0.f, 0.f, 0.f, 0.f}};
        if (FULL) {
            if (w < 4) { const int ct = w >> 1, st = w & 1; f32x4 a = (f32x4){0.f, 0.f, 0.f, 0.f};
                if (!(ct == 0 && st == 1)) {
#pragma unroll
                    for (int ks = 0; ks < 4; ++ks) a = mfma16(*(const LAS bf16x8*)(QT + (16 * ct + fr) * 136 + 32 * ks + 8 * fq), *(const LAS bf16x8*)(KT + (16 * st + fr) * 136 + 32 * ks + 8 * fq), a); }
#pragma unroll
                for (int i = 0; i < 4; ++i) { const int c = 16 * ct + 4 * fq + i, s = 16 * st + fr; PS[c * 40 + s] = f2bf(s <= c ? a[i] : 0.f); } }
#pragma unroll
            for (int ct = 0; ct < 2; ++ct)
#pragma unroll
                for (int ks = 0; ks < 4; ++ks) o[ct] = mfma16(*(const LAS bf16x8*)(QT + (16 * ct + fr) * 136 + 32 * ks + 8 * fq), *(const LAS bf16x8*)(ST + (16 * w + fr) * 136 + 32 * ks + 8 * fq), o[ct]);
            __syncthreads();
        }
        const bf16x8 vfr = *(const LAS bf16x8*)(VT + (16 * w + fr) * 40 + 8 * fq);
        if (FULL) {
#pragma unroll
            for (int ct = 0; ct < 2; ++ct) { o[ct] = mfma16(*(const LAS bf16x8*)(PS + (16 * ct + fr) * 40 + 8 * fq), vfr, o[ct]);
#pragma unroll
                for (int i = 0; i < 4; ++i) OS[(16 * ct + 4 * fq + i) * 132 + 16 * w + fr] = o[ct][i]; }
        }
#pragma unroll
        for (int i = 0; i < 8; ++i) { const f32x4 dv4 = *(const LAS f32x4*)(DEC + 16 * i + 4 * fq); S[i] = S[i] * dv4;
            S[i] = mfma16(*(const LAS bf16x8*)(KHT + (16 * i + fr) * 40 + 8 * fq), vfr, S[i]); }
        if (FULL) {
#pragma unroll
            for (int i = 0; i < 8; ++i) *(LAS u32x2*)(ST + (16 * w + fr) * 136 + 16 * i + 4 * fq) = (u32x2){pk2(S[i][0], S[i][1]), pk2(S[i][2], S[i][3])};
            __syncthreads();
            const int c = tid >> 4, dvg = tid & 15, tok = tb + ts * c;
            f32x4 o0 = *(const LAS f32x4*)(OS + c * 132 + 8 * dvg), o1 = *(const LAS f32x4*)(OS + c * 132 + 8 * dvg + 4);
            float* op = OP + ((size_t)((b * 4 + h) * SEQ + tok)) * 128 + 8 * dvg;
            if (!SECOND) { *(f32x4*)op = o0; *(f32x4*)(op + 4) = o1; }
            else { o0 = o0 + *(const f32x4*)op; o1 = o1 + *(const f32x4*)(op + 4);
                float sq = (o0[0] * o0[0] + o0[1] * o0[1]) + (o0[2] * o0[2] + o0[3] * o0[3]) + (o1[0] * o1[0] + o1[1] * o1[1]) + (o1[2] * o1[2] + o1[3] * o1[3]);
                sq += __shfl_xor(sq, 1); sq += __shfl_xor(sq, 2); sq += __shfl_xor(sq, 4); sq += __shfl_xor(sq, 8);
                const float rs = __builtin_amdgcn_rsqf(sq * (1.f / 128.f) + EPS);
                const u32x4 gw4 = *(const u32x4*)(P + (size_t)(b * SEQ + tok) * DIN + C_HG + h * 128 + 8 * dvg);
                const f32x4 n0 = *(const f32x4*)(norm_g + 8 * dvg), n1 = *(const f32x4*)(norm_g + 8 * dvg + 4);
                u32x4 ow; ow.x = pk2(o0[0] * rs * n0[0] * silu_f0(bflo(gw4.x)), o0[1] * rs * n0[1] * silu_f0(bfhi(gw4.x)));
                ow.y = pk2(o0[2] * rs * n0[2] * silu_f0(bflo(gw4.y)), o0[3] * rs * n0[3] * silu_f0(bfhi(gw4.y)));
                ow.z = pk2(o1[0] * rs * n1[0] * silu_f0(bflo(gw4.z)), o1[1] * rs * n1[1] * silu_f0(bfhi(gw4.z)));
                ow.w = pk2(o1[2] * rs * n1[2] * silu_f0(bflo(gw4.w)), o1[3] * rs * n1[3] * silu_f0(bfhi(gw4.w)));
                *(u32x4*)(MIXED + (size_t)(b * SEQ + tok) * DM + h * 128 + 8 * dvg) = ow; }
        }
    }
}
__device__ __forceinline__ float hg_lb(const float* hg_lb_all, int layer, int dir, int ch) {
    if (layer == 0) return 0.f;
    const float a0 = hg_lb_all[(0 * 2 + dir) * 512 + ch], a1 = hg_lb_all[(1 * 2 + dir) * 512 + ch], mx = fmaxf(a0, a1), e0 = __expf(a0 - mx), e1 = __expf(a1 - mx);
    return e1 / (e0 + e1);
}
__device__ __forceinline__ void hg_passA_item(LAS unsigned char* lds, const Params& p, int layer, int item) {
    const int dir = item & 1, seg = (item >> 1) & (NSEG - 1), h = (item >> 4) & 3, b = item >> 6;
    if ((dir == 0 && seg == NSEG - 1) || (dir == 1 && seg == 0)) return;
    int tid_ = threadIdx.x; asm volatile("" : "+v"(tid_)); const int tid = tid_, w = __builtin_amdgcn_readfirstlane(tid >> 6), lane = tid & 63;
    const float lb = hg_lb(p.hg_lb, layer, dir, h * 128 + (tid & 127));
    f32x4 S[8];
#pragma unroll
    for (int i = 0; i < 8; ++i) S[i] = (f32x4){0.f, 0.f, 0.f, 0.f};
    float bsum = 0.f;
    hg_segment<false, false>(lds, (const bf16*)(p.ws + WS_P), b, h, dir, seg, lb, S, bsum, nullptr, nullptr, nullptr);
    u32x2* sl = (u32x2*)(p.ws + WS_SLOC) + (size_t)item * 4096;
#pragma unroll
    for (int i = 0; i < 8; ++i) sl[(w * 8 + i) * 64 + lane] = (u32x2){pk2(S[i][0], S[i][1]), pk2(S[i][2], S[i][3])};
    if (tid < 128) ((float*)(p.ws + WS_DSEG))[(size_t)item * 128 + tid] = __expf(bsum);
    __syncthreads();
}
__device__ __forceinline__ void hg_passB_item(LAS unsigned char* lds, const Params& p, int layer, int item) {
    const int seg = item & (NSEG - 1), h = (item >> 3) & 3, b = item >> 5;
    int tid_ = threadIdx.x; asm volatile("" : "+v"(tid_)); const int tid = tid_, w = __builtin_amdgcn_readfirstlane(tid >> 6), lane = tid & 63, fr = lane & 15, fq = lane >> 4;
    LAS bf16* ST = (LAS bf16*)(lds + HST_OFF);
    const u32x2* slb = (const u32x2*)(p.ws + WS_SLOC); const float* dsg = (const float*)(p.ws + WS_DSEG);
    float* OP = (float*)(p.ws + WS_XB); bf16* MIXED = (bf16*)(p.ws + WS_MIX); const bf16* P = (const bf16*)(p.ws + WS_P);
#pragma unroll 1
    for (int dir = 0; dir < 2; ++dir) {
        const float lb = hg_lb(p.hg_lb, layer, dir, h * 128 + (tid & 127));
        f32x4 S[8];
#pragma unroll
        for (int i = 0; i < 8; ++i) S[i] = (f32x4){0.f, 0.f, 0.f, 0.f};
        const int nprev = dir == 0 ? seg : (NSEG - 1 - seg);
#pragma unroll 1
        for (int q = 0; q < nprev; ++q) { const int s2 = dir == 0 ? q : (NSEG - 1 - q); const int it2 = ((b * 4 + h) * NSEG + s2) * 2 + dir;
            const u32x2* sl = slb + (size_t)it2 * 4096; const float* dc = dsg + (size_t)it2 * 128;
#pragma unroll
            for (int i = 0; i < 8; ++i) { const f32x4 dv4 = *(const f32x4*)(dc + 16 * i + 4 * fq); const u32x2 sv = sl[(w * 8 + i) * 64 + lane];
                S[i] = S[i] * dv4 + (f32x4){bflo(sv.x), bfhi(sv.x), bflo(sv.y), bfhi(sv.y)}; } }
#pragma unroll
        for (int i = 0; i < 8; ++i) *(LAS u32x2*)(ST + (16 * w + fr) * 136 + 16 * i + 4 * fq) = (u32x2){pk2(S[i][0], S[i][1]), pk2(S[i][2], S[i][3])};
        float bsum = 0.f;
        if (dir == 0) hg_segment<true, false>(lds, P, b, h, 0, seg, lb, S, bsum, OP, MIXED, p.hg_ng + layer * 128);
        else hg_segment<true, true>(lds, P, b, h, 1, seg, lb, S, bsum, OP, MIXED, p.hg_ng + layer * 128);
        __threadfence(); __syncthreads();
    }
}

constexpr int NA_KS = 584, NA_RPB_OFF = 64 * NA_KS * 2;
__device__ __forceinline__ int clampi(int v, int lo, int hi) { return v < lo ? lo : (v > hi ? hi : v); }
__device__ __forceinline__ void na_item(LAS unsigned char* lds, const Params& p, int layer, int item) {
    const int rp = item & 15, h = (item >> 4) & 3, b = item >> 6, r0 = 2 * rp, kbase = clampi(r0 - 4, 0, 24);
    int tid_ = threadIdx.x; asm volatile("" : "+v"(tid_)); const int tid = tid_, w = __builtin_amdgcn_readfirstlane(tid >> 6), lane = tid & 63, fr = lane & 15, fq = lane >> 4;
    const bf16* P = (const bf16*)(p.ws + WS_P); bf16* MIXED = (bf16*)(p.ws + WS_MIX);
    LAS bf16* VT = (LAS bf16*)lds; LAS float* RPB = (LAS float*)(lds + NA_RPB_OFF);
#pragma unroll 3
    for (int it = 0; it < 9; ++it) { const int u = it * NTHR + tid, key = u >> 3, dg = u & 7; int trow = kbase * 64 + key; trow = trow > SEQ - 1 ? SEQ - 1 : trow;
        const u32x4 v = *(const u32x4*)(P + (size_t)(b * SEQ + trow) * DIN + C_NV + h * 64 + 8 * dg);
        LAS bf16* dst = VT + (8 * dg) * NA_KS + key;
        dst[0 * NA_KS] = (bf16)(v.x & 0xffffu); dst[1 * NA_KS] = (bf16)(v.x >> 16); dst[2 * NA_KS] = (bf16)(v.y & 0xffffu); dst[3 * NA_KS] = (bf16)(v.y >> 16);
        dst[4 * NA_KS] = (bf16)(v.z & 0xffffu); dst[5 * NA_KS] = (bf16)(v.z >> 16); dst[6 * NA_KS] = (bf16)(v.w & 0xffffu); dst[7 * NA_KS] = (bf16)(v.w >> 16); }
    for (int i = tid; i < 465; i += NTHR) RPB[i] = p.rpb[(size_t)(layer * 4 + h) * 465 + i];
    __syncthreads();
    const int rl = w >> 2, j = w & 3, r = r0 + rl, kr0 = clampi(r - 4, 0, 24), kc0 = clampi(16 * j - 8, 0, 32);
    const size_t qtok = (size_t)b * SEQ + r * 64 + 16 * j + fr;
    bf16x8 qf[2];
#pragma unroll
    for (int ks = 0; ks < 2; ++ks) qf[ks] = *(const bf16x8*)(P + qtok * DIN + C_NQ + h * 64 + 32 * ks + 8 * fq);
    f32x4 s[16];
#pragma unroll
    for (int kt = 0; kt < 16; ++kt) { const int krl = kt >> 1, half = kt & 1; const size_t ktok = (size_t)b * SEQ + (kr0 + krl) * 64 + kc0 + 16 * half + fr;
        f32x4 a = (f32x4){0.f, 0.f, 0.f, 0.f};
#pragma unroll
        for (int ks = 0; ks < 2; ++ks) a = mfma16(*(const bf16x8*)(P + ktok * DIN + C_NK + h * 64 + 32 * ks + 8 * fq), qf[ks], a);
        s[kt] = a; }
    const int qc = 16 * j + fr, qs = clampi(qc - 8, 0, 48);
    float mx = -1e30f;
#pragma unroll
    for (int kt = 0; kt < 16; ++kt) { const int krl = kt >> 1, half = kt & 1; const int ridx = kr0 + krl - r + 7;
#pragma unroll
        for (int i = 0; i < 4; ++i) { const int kc = kc0 + 16 * half + 4 * fq + i; const bool valid = kc >= qs && kc < qs + 16; const int cidx = clampi(kc - qc + 15, 0, 30);
            const float v = valid ? s[kt][i] * 0.125f + RPB[ridx * 31 + cidx] : -1e30f; s[kt][i] = v; mx = fmaxf(mx, v); } }
    mx = fmaxf(mx, __shfl_xor(mx, 16)); mx = fmaxf(mx, __shfl_xor(mx, 32));
    float sum = 0.f;
#pragma unroll
    for (int kt = 0; kt < 16; ++kt)
#pragma unroll
        for (int i = 0; i < 4; ++i) { const float e = __expf(s[kt][i] - mx); s[kt][i] = e; sum += e; }
    sum += __shfl_xor(sum, 16); sum += __shfl_xor(sum, 32);
    f32x4 o[4];
#pragma unroll
    for (int dt = 0; dt < 4; ++dt) o[dt] = (f32x4){0.f, 0.f, 0.f, 0.f};
#pragma unroll
    for (int kk = 0; kk < 8; ++kk) {
        const u32x4 pw = (u32x4){pk2(s[2 * kk][0], s[2 * kk][1]), pk2(s[2 * kk][2], s[2 * kk][3]), pk2(s[2 * kk + 1][0], s[2 * kk + 1][1]), pk2(s[2 * kk + 1][2], s[2 * kk + 1][3])};
        const bf16x8 pf = __builtin_bit_cast(bf16x8, pw);
        const int keyoff = (kr0 + kk - kbase) * 64 + kc0 + 4 * fq;
#pragma unroll
        for (int dt = 0; dt < 4; ++dt) { const u32x2 lo = *(const LAS u32x2*)(VT + (16 * dt + fr) * NA_KS + keyoff), hi = *(const LAS u32x2*)(VT + (16 * dt + fr) * NA_KS + keyoff + 16);
            const bf16x8 vf = __builtin_bit_cast(bf16x8, (u32x4){lo.x, lo.y, hi.x, hi.y});
            o[dt] = mfma16(vf, pf, o[dt]); } }
    const float inv = 1.f / sum;
#pragma unroll
    for (int dt = 0; dt < 4; ++dt) *(u32x2*)(MIXED + qtok * DM + 512 + h * 64 + 16 * dt + 4 * fq) = (u32x2){pk2(o[dt][0] * inv, o[dt][1] * inv), pk2(o[dt][2] * inv, o[dt][3] * inv)};
    __syncthreads();
}

__device__ __forceinline__ void conv_item(LAS unsigned char* lds, const Params& p, int layer, int item) {
    const int b = item >> 6, t0 = (item & 63) * 32;
    int tid_ = threadIdx.x; asm volatile("" : "+v"(tid_)); const int tid = tid_, w = __builtin_amdgcn_readfirstlane(tid >> 6), lane = tid & 63;
    const bf16* P = (const bf16*)(p.ws + WS_P); bf16* MIXED = (bf16*)(p.ws + WS_MIX);
    LAS float* U = (LAS float*)lds; LAS float* CO = U + 62 * 256;
#pragma unroll
    for (int it = 0; it < 4; ++it) { const int u = it * NTHR + tid;
        if (u < 62 * 32) { const int tt = u >> 5, c8 = u & 31, t = t0 - 15 + tt; f32x4 u0 = (f32x4){0.f, 0.f, 0.f, 0.f}, u1 = u0;
            if (t >= 0 && t < SEQ) { const bf16* rp = P + (size_t)(b * SEQ + t) * DIN; const u32x4 a = *(const u32x4*)(rp + C_CA + 8 * c8), g = *(const u32x4*)(rp + C_CG + 8 * c8);
                u0 = (f32x4){bflo(a.x) * sigm(bflo(g.x)), bfhi(a.x) * sigm(bfhi(g.x)), bflo(a.y) * sigm(bflo(g.y)), bfhi(a.y) * sigm(bfhi(g.y))};
                u1 = (f32x4){bflo(a.z) * sigm(bflo(g.z)), bfhi(a.z) * sigm(bfhi(g.z)), bflo(a.w) * sigm(bflo(g.w)), bfhi(a.w) * sigm(bfhi(g.w))}; }
            *(LAS f32x4*)(U + tt * 256 + 8 * c8) = u0; *(LAS f32x4*)(U + tt * 256 + 8 * c8 + 4) = u1; } }
    __syncthreads();
    const int c = tid & 255, half = tid >> 8;
    float wk[31];
#pragma unroll
    for (int k = 0; k < 31; ++k) wk[k] = p.cw[(size_t)(layer * 31 + k) * 256 + c];
    const float bias = p.cb[layer * 256 + c];
#pragma unroll 1
    for (int g = 0; g < 2; ++g) { const int base = 16 * half + 8 * g; float win[38];
#pragma unroll
        for (int i = 0; i < 38; ++i) win[i] = U[(base + i) * 256 + c];
#pragma unroll
        for (int o = 0; o < 8; ++o) { float a = bias;
#pragma unroll
            for (int k = 0; k < 31; ++k) a += wk[k] * win[o + k];
            CO[(base + o) * 256 + c] = a; } }
    __syncthreads();
    const f32x4 lg = *(const f32x4*)(p.lng + layer * 256 + 4 * lane), lbv = *(const f32x4*)(p.lnb + layer * 256 + 4 * lane);
#pragma unroll
    for (int q = 0; q < 4; ++q) { const int tl = 4 * w + q; const f32x4 v = *(const LAS f32x4*)(CO + tl * 256 + 4 * lane);
        const float mean = wave_sum((v.x + v.y) + (v.z + v.w)) * (1.f / 256.f); const f32x4 dd = v - mean;
        const float var = wave_sum((dd.x * dd.x + dd.y * dd.y) + (dd.z * dd.z + dd.w * dd.w)) * (1.f / 256.f); const float rs = __builtin_amdgcn_rsqf(var + EPS);
        f32x4 y = dd * rs * lg + lbv; y = (f32x4){silu_f0(y.x), silu_f0(y.y), silu_f0(y.z), silu_f0(y.w)};
        *(u32x2*)(MIXED + (size_t)(b * SEQ + t0 + tl) * DM + 768 + 4 * lane) = (u32x2){pk2(y.x, y.y), pk2(y.z, y.w)}; }
    __syncthreads();
}

constexpr int RS_OFF = 131072;
constexpr int LDS_BYTES = 147456;
__global__ void __launch_bounds__(NTHR, 2) fwd_megakernel(Params p) {
    extern __shared__ __attribute__((aligned(16))) unsigned char lds_raw[];
    cg::grid_group grid = cg::this_grid();
    LAS unsigned char* lds = (LAS unsigned char*)lds_raw;
    int tid_ = threadIdx.x; asm volatile("" : "+v"(tid_)); const int tid = tid_, lane = tid & 63, wave = __builtin_amdgcn_readfirstlane(tid >> 6);
    const int G = gridDim.x, bid = blockIdx.x, gw = bid * NWAVES + wave, NGW = G * NWAVES;
    unsigned char* ws = p.ws;
    float* ssq = (float*)(ws + WS_SSQ); bf16* XB = (bf16*)(ws + WS_XB); bf16* PB = (bf16*)(ws + WS_P); bf16* MIXED = (bf16*)(ws + WS_MIX);

    prologue(p, lds, gw, NGW, wave, lane);
    grid.sync();
#pragma unroll 1
    for (int l = 0; l < DEPTH; ++l) {
        {
            pg8::Gemm g{XB, (const bf16*)(ws + WS_WIN + l * WS_WIN_L), M, DIN, DM}; pg8::StaticOrder S; S.init(M, DIN, G, bid);
            pg8::rstd_table((LAS float*)(lds + RS_OFF), ssq, S); pg8::EpiScale E{PB, DIN, (LAS float*)(lds + RS_OFF)};
            pg8::gemm_phase<pg8::EpiScale, pg8::StaticOrder, true, true>(lds, g, S, E);
        }
        grid.sync();
        for (int it = bid; it < BATCH * 4 * NSEG * 2; it += G) hg_passA_item(lds, p, l, it);
        for (int it = bid; it < BATCH * 4 * 16; it += G) na_item(lds, p, l, it);
        for (int it = bid; it < BATCH * 64; it += G) conv_item(lds, p, l, it);
        grid.sync();
        for (int it = bid; it < BATCH * 4 * NSEG; it += G) hg_passB_item(lds, p, l, it);
        grid.sync();
        {
            pg8::Gemm g{MIXED, (const bf16*)(ws + WS_WOUT + l * WS_WOUT_L), M, DM, DM}; pg8::StaticOrder S; S.init(M, DM, G, bid);
            pg8::EpiRes E{l == 0 ? p.x : p.out, p.out, XB, ssq};
            pg8::gemm_phase<pg8::EpiRes, pg8::StaticOrder, true, true>(lds, g, S, E);
        }
        grid.sync();
        {
            pg8::Gemm g{XB, (const bf16*)(ws + WS_WGU + l * WS_WGU_L), M, 2 * FFN, DM}; pg8::StaticOrder S; S.init(M, 2 * FFN, G, bid);
            pg8::rstd_table((LAS float*)(lds + RS_OFF), ssq, S); pg8::EpiSwiGLU E{PB, FFN, (LAS float*)(lds + RS_OFF)};
            pg8::gemm_phase<pg8::EpiSwiGLU, pg8::StaticOrder, true, true>(lds, g, S, E);
        }
        grid.sync();
        {
            pg8::Gemm g{PB, (const bf16*)(ws + WS_WDN + l * WS_WDN_L), M, DM, FFN}; pg8::StaticOrder S; S.init(M, DM, G, bid);
            pg8::EpiRes E{p.out, p.out, XB, ssq};
            pg8::gemm_phase<pg8::EpiRes, pg8::StaticOrder, true, true>(lds, g, S, E);
        }
        grid.sync();
    }
    for (int m = gw; m < M; m += NGW) {
        const float rs = pg8::row_rstd(ssq, m);
        f32x4* xr = (f32x4*)(p.out + (size_t)m * DM) + lane; const f32x4* gr = (const f32x4*)p.fin_g + lane;
#pragma unroll
        for (int j = 0; j < 4; ++j) xr[64 * j] = xr[64 * j] * rs * gr[64 * j];
    }
}

extern "C" void kernel_launch(void* const* d_in, const int* in_sizes, int n_in, void* d_out, int out_size, void* d_ws, size_t ws_size, hipStream_t stream) {
    static int grid_blocks = 0;
    if (grid_blocks == 0) {
        if (n_in != 15 || out_size != M * DM || ws_size < WS_END) { fprintf(stderr, "kernel_launch: unexpected shapes (n_in %d out %d ws %zu)\n", n_in, out_size, ws_size); grid_blocks = -1; return; }
        int dev = 0, cus = 0, per_cu = 0;
        hipGetDevice(&dev); hipDeviceGetAttribute(&cus, hipDeviceAttributeMultiprocessorCount, dev);
        hipFuncSetAttribute((const void*)fwd_megakernel, hipFuncAttributeMaxDynamicSharedMemorySize, LDS_BYTES);
        hipOccupancyMaxActiveBlocksPerMultiprocessor(&per_cu, (const void*)fwd_megakernel, NTHR, LDS_BYTES);
        if (per_cu < 1) { fprintf(stderr, "kernel_launch: occupancy query says %d blocks per CU\n", per_cu); per_cu = 1; }
        (void)hipGetLastError();
        grid_blocks = cus * 1;
    }
    if (grid_blocks < 0) return;
    Params p{};
    p.x = (const float*)d_in[0]; p.mix_g = (const float*)d_in[1]; p.w_in = (const float*)d_in[2]; p.hg_lb = (const float*)d_in[3]; p.hg_ng = (const float*)d_in[4];
    p.rpb = (const float*)d_in[5]; p.cw = (const float*)d_in[6]; p.cb = (const float*)d_in[7]; p.lng = (const float*)d_in[8]; p.lnb = (const float*)d_in[9];
    p.w_out = (const float*)d_in[10]; p.ffn_g = (const float*)d_in[11]; p.w_gu = (const float*)d_in[12]; p.w_dn = (const float*)d_in[13]; p.fin_g = (const float*)d_in[14];
    p.out = (float*)d_out; p.ws = (unsigned char*)d_ws;
    void* args[] = {&p};
    hipError_t e = hipLaunchCooperativeKernel((const void*)fwd_megakernel, dim3(grid_blocks), dim3(NTHR), args, LDS_BYTES, stream);
    if (e != hipSuccess) fprintf(stderr, "cooperative launch failed: %s (grid %d)\n", hipGetErrorString(e), grid_blocks);
}
```

```cpp
#include <hip/hip_runtime.h>
#include <hip/hip_cooperative_groups.h>
#include <cstdio>
#include <cstdint>
namespace cg = cooperative_groups;

namespace pg8 {
#define PG8_LAS __attribute__((address_space(3)))
typedef unsigned short bf16_t;
typedef short bf16x8 __attribute__((ext_vector_type(8)));
typedef float f32x4 __attribute__((ext_vector_type(4)));
typedef unsigned u32x4 __attribute__((ext_vector_type(4)));
constexpr int BM = 256, BK = 64, HALF = 128, HTB = HALF * BK * 2  , STAGE_BYTES = 8 * HTB, NXCD = 8, WGM = 8;

__host__ __device__ __forceinline__ int lds_byte(int r, int c) { const int st = (r >> 4) * 2 + (c >> 5), rr = r & 15, cc = c & 31, ob = rr * 64 + cc * 2; return st * 1024 + (ob ^ (((ob >> 9) & 1) << 5)); }
__host__ __device__ __forceinline__ void stage_rc(int b, int& R, int& C) { const int st = b / 1024, sb = b % 1024, swz = sb ^ (((sb >> 9) & 1) << 5); R = (st >> 1) * 16 + swz / 64; C = (st & 1) * 32 + (swz % 64) / 2; }
__host__ __device__ __forceinline__ int perm32(int rho) { const int n = rho >> 4, i = rho & 15; return 8 * (i >> 2) + 4 * n + (i & 3); }

struct Unit { int pm, pn; };
struct Gemm { const bf16_t* A; const bf16_t* Bt; int M, N, K; };

struct StaticOrder {
    int nM, nN, nwg, G, c;
    __host__ __device__ void init(int M, int N, int G_, int c_) { nM = M / BM; nN = N / BM; nwg = nM * nN; G = G_; c = c_; }
    __host__ __device__ bool next(int i, Unit& u) const {
        const long L = (long)i * G + c; if (L >= nwg) return false;
        int wgid = (int)L; { const int q = nwg / NXCD, r = nwg % NXCD, xcd = wgid % NXCD, off = wgid / NXCD; wgid = (xcd < r ? xcd * (q + 1) : r * (q + 1) + (xcd - r) * q) + off; }
        const int nig = WGM * nN, gid = wgid / nig, fm = gid * WGM, gsz = (nM - fm) < WGM ? (nM - fm) : WGM;
        u.pm = fm + ((wgid % nig) % gsz); u.pn = (wgid % nig) / gsz; return true;
    }
    __device__ __forceinline__ void a_ready(const Unit&) const {}
    __device__ __forceinline__ void done(const Unit&) const {}
};
__device__ __forceinline__ unsigned cvt_pk_bf16(float lo, float hi) { unsigned r; asm volatile("v_cvt_pk_bf16_f32 %0, %1, %2" : "=v"(r) : "v"(lo), "v"(hi)); return r; }
typedef float f32x2 __attribute__((ext_vector_type(2)));
constexpr int MROWS = 16384, DMODEL = 1024, NPART = 16;
constexpr float NORM_EPS = 1e-6f;
__device__ __forceinline__ float row_rstd(const float* ssq, int row) {
    float s = 0.f;
#pragma unroll
    for (int p = 0; p < NPART; ++p) s += ssq[(size_t)p * MROWS + row];
    return __builtin_amdgcn_rsqf(s * (1.f / DMODEL) + NORM_EPS);
}
__device__ __forceinline__ float silu_f(float x) { return x * __builtin_amdgcn_rcpf(1.f + __expf(-x)); }

struct EpiScale {
    static constexpr bool PERM = true, AFTER_DRAIN = false;
    bf16_t* O; int ldc; const PG8_LAS float* RS; unsigned silu_mask;
    __device__ __forceinline__ void operator()(const f32x4 (&acc)[2][2][4][2], const Unit& u, int ui, int wr, int wc, int fr, int fq) const {
        const int row0 = u.pm * BM + wr * 64 + fr, col0 = u.pn * BM + wc * 32 + 8 * fq; const bool act = (silu_mask >> u.pn) & 1u;
#pragma unroll
        for (int ai = 0; ai < 2; ++ai)
#pragma unroll
            for (int m = 0; m < 4; ++m) { const int row = row0 + ai * HALF + m * 16; const float rs = RS[ui * BM + wr * 64 + fr + ai * HALF + m * 16]; bf16_t* rowp = O + (size_t)row * ldc + col0;
#pragma unroll
                for (int bj = 0; bj < 2; ++bj) { f32x4 v0 = acc[ai][bj][m][0] * rs, v1 = acc[ai][bj][m][1] * rs;
                    if (act) { v0 = (f32x4){silu_f(v0[0]), silu_f(v0[1]), silu_f(v0[2]), silu_f(v0[3])}; v1 = (f32x4){silu_f(v1[0]), silu_f(v1[1]), silu_f(v1[2]), silu_f(v1[3])}; }
                    u32x4 w; w.x = cvt_pk_bf16(v0[0], v0[1]); w.y = cvt_pk_bf16(v0[2], v0[3]); w.z = cvt_pk_bf16(v1[0], v1[1]); w.w = cvt_pk_bf16(v1[2], v1[3]);
                    *(u32x4*)(rowp + bj * HALF) = w; } __builtin_amdgcn_sched_barrier(0); }
    }
};
struct EpiRes {
    static constexpr bool PERM = true, AFTER_DRAIN = false;
    bf16_t* XB; float* ssq;
    __device__ __forceinline__ void operator()(const f32x4 (&acc)[2][2][4][2], const Unit& u, int ui, int wr, int wc, int fr, int fq) const {
        const int row0 = u.pm * BM + wr * 64 + fr, col0 = u.pn * BM + wc * 32 + 8 * fq;
#pragma unroll
        for (int ai = 0; ai < 2; ++ai)
#pragma unroll
            for (int mm = 0; mm < 4; mm += 2) {
                u32x4 rr[2][2];
#pragma unroll
                for (int q = 0; q < 2; ++q)
#pragma unroll
                    for (int bj = 0; bj < 2; ++bj) rr[q][bj] = *(const u32x4*)(XB + (size_t)(row0 + ai * HALF + (mm + q) * 16) * DMODEL + col0 + bj * HALF);
                __builtin_amdgcn_sched_barrier(0);
#pragma unroll
                for (int q = 0; q < 2; ++q) { const int m = mm + q, row = row0 + ai * HALF + m * 16; const size_t o = (size_t)row * DMODEL + col0; float sq = 0.f;
#pragma unroll
                    for (int bj = 0; bj < 2; ++bj) { const u32x4 r = rr[q][bj];
                        const f32x4 r0 = (f32x4){__builtin_bit_cast(float, r.x << 16), __builtin_bit_cast(float, r.x & 0xffff0000u), __builtin_bit_cast(float, r.y << 16), __builtin_bit_cast(float, r.y & 0xffff0000u)};
                        const f32x4 r1 = (f32x4){__builtin_bit_cast(float, r.z << 16), __builtin_bit_cast(float, r.z & 0xffff0000u), __builtin_bit_cast(float, r.w << 16), __builtin_bit_cast(float, r.w & 0xffff0000u)};
                        const f32x4 v0 = acc[ai][bj][m][0] + r0, v1 = acc[ai][bj][m][1] + r1;
                        u32x4 w; w.x = cvt_pk_bf16(v0[0], v0[1]); w.y = cvt_pk_bf16(v0[2], v0[3]); w.z = cvt_pk_bf16(v1[0], v1[1]); w.w = cvt_pk_bf16(v1[2], v1[3]);
                        *(u32x4*)(XB + o + bj * HALF) = w;
                        sq += (v0[0] * v0[0] + v0[1] * v0[1]) + (v0[2] * v0[2] + v0[3] * v0[3]) + (v1[0] * v1[0] + v1[1] * v1[1]) + (v1[2] * v1[2] + v1[3] * v1[3]); }
                    sq += __shfl_xor(sq, 16); sq += __shfl_xor(sq, 32);
                    if (fq == 0) ssq[(size_t)(u.pn * 4 + wc) * MROWS + row] = sq; }
                __builtin_amdgcn_sched_barrier(0); }
    }
};
struct EpiSwiGLU {
    static constexpr bool PERM = true, AFTER_DRAIN = false;
    bf16_t* O; int ldc; const PG8_LAS float* RS;
    __device__ __forceinline__ void operator()(const f32x4 (&acc)[2][2][4][2], const Unit& u, int ui, int wr, int wc, int fr, int fq) const {
        const int row0 = u.pm * BM + wr * 64 + fr, col0 = u.pn * HALF + wc * 32 + 8 * fq;
#pragma unroll
        for (int ai = 0; ai < 2; ++ai)
#pragma unroll
            for (int m = 0; m < 4; ++m) { const int row = row0 + ai * HALF + m * 16; const float rs = RS[ui * BM + wr * 64 + fr + ai * HALF + m * 16];
                const f32x4 g0 = acc[ai][0][m][0] * rs, g1 = acc[ai][0][m][1] * rs, u0 = acc[ai][1][m][0] * rs, u1 = acc[ai][1][m][1] * rs;
                u32x4 w; w.x = cvt_pk_bf16(silu_f(g0[0]) * u0[0], silu_f(g0[1]) * u0[1]); w.y = cvt_pk_bf16(silu_f(g0[2]) * u0[2], silu_f(g0[3]) * u0[3]);
                w.z = cvt_pk_bf16(silu_f(g1[0]) * u1[0], silu_f(g1[1]) * u1[1]); w.w = cvt_pk_bf16(silu_f(g1[2]) * u1[2], silu_f(g1[3]) * u1[3]);
                *(u32x4*)(O + (size_t)row * ldc + col0) = w; __builtin_amdgcn_sched_barrier(0); }
    }
};
template <class Sched> __device__ __forceinline__ void rstd_table(PG8_LAS float* RS, const float* ssq, const Sched& S) {
    Unit u; const int t = threadIdx.x & (BM - 1);
    for (int i = threadIdx.x >> 8; S.next(i, u); i += 2) {
        float v[NPART];
#pragma unroll
        for (int p = 0; p < NPART; ++p) v[p] = ssq[(size_t)p * MROWS + u.pm * BM + t];
        __builtin_amdgcn_sched_barrier(0);
        const float s = (((v[0] + v[1]) + (v[2] + v[3])) + ((v[4] + v[5]) + (v[6] + v[7]))) + (((v[8] + v[9]) + (v[10] + v[11])) + ((v[12] + v[13]) + (v[14] + v[15])));
        RS[i * BM + t] = __builtin_amdgcn_rsqf(s * (1.f / DMODEL) + NORM_EPS);
    }
    __syncthreads();
}
template <class Epi, class Sched, bool ALIGN_EPI = false, bool SP2 = false>
__device__ __forceinline__ void gemm_phase(PG8_LAS unsigned char* lds, const Gemm g, const Sched& S, const Epi& E) {
    int tid_ = threadIdx.x; asm volatile("" : "+v"(tid_));
    const int tid = tid_, wid = __builtin_amdgcn_readfirstlane(tid >> 6), lane = tid & 63, wr = wid >> 2, wc = wid & 3, fr = lane & 15, fq = lane >> 4;
    const int K = g.K, nt = K / BK;
    unsigned voffA[2], voffB[2];
#pragma unroll
    for (int i = 0; i < 2; ++i) { int R, C; stage_rc(tid * 16 + i * 8192, R, C); const int Rb = Epi::PERM ? ((R & ~31) + perm32(R & 31)) : R;
        voffA[i] = (unsigned)(R * K + C) * 2u; voffB[i] = (unsigned)(Rb * K + C) * 2u; }
    const size_t kstep = (size_t)(BK * 2);
    const size_t hstep = (size_t)HALF * K * 2;
    const size_t tstep = 2 * hstep;
    const unsigned ldsw = (unsigned)wid * 1024u;
    const int aoff = lds_byte(wr * 64 + fr, fq * 8), boff = lds_byte(wc * 32 + fr, fq * 8);
#define PG8_SA(b, h) (((b) * 2 + (h)) * HTB)
#define PG8_SB(b, h) ((4 + (b) * 2 + (h)) * HTB)
#define PG8_STAGE(bufoff, gbase, voff) do { _Pragma("unroll") for (int _i = 0; _i < 2; ++_i) \
        __builtin_amdgcn_global_load_lds((const unsigned*)((const char*)(gbase) + (voff)[_i]), (PG8_LAS unsigned*)(lds + (bufoff) + ldsw + _i * 8192), 16, 0, 0); } while (0)
#define PG8_LDA(dst, b, h) do { _Pragma("unroll") for (int m = 0; m < 4; ++m) _Pragma("unroll") for (int k = 0; k < 2; ++k) dst[m][k] = *(const PG8_LAS bf16x8*)(lds + PG8_SA(b, h) + aoff + m * 2048 + k * 1024); } while (0)
#define PG8_LDB(dst, b, h) do { _Pragma("unroll") for (int n = 0; n < 2; ++n) _Pragma("unroll") for (int k = 0; k < 2; ++k) dst[n][k] = *(const PG8_LAS bf16x8*)(lds + PG8_SB(b, h) + boff + n * 2048 + k * 1024); } while (0)
#define PG8_MMA(ai, bj, At, Bt) do { __builtin_amdgcn_s_setprio(1); _Pragma("unroll") for (int m = 0; m < 4; ++m) _Pragma("unroll") for (int n = 0; n < 2; ++n) _Pragma("unroll") for (int k = 0; k < 2; ++k) \
        acc[ai][bj][m][n] = __builtin_amdgcn_mfma_f32_16x16x32_bf16(Bt[n][k], At[m][k], acc[ai][bj][m][n], 0, 0, 0); __builtin_amdgcn_s_setprio(0); } while (0)
#define PG8_WAIT_V(n) asm volatile("s_waitcnt vmcnt(" #n ")" ::: "memory")
#define PG8_WAIT_L(n) asm volatile("s_waitcnt lgkmcnt(" #n ")" ::: "memory")
#define PG8_BAR __builtin_amdgcn_s_barrier()
#define PG8_SCHED __builtin_amdgcn_sched_barrier(0)
    Unit cur, nxt; int ui = 0;
    if (!S.next(0, cur)) return;
    f32x4 acc[2][2][4][2];
#pragma unroll
    for (int a = 0; a < 2; ++a)
#pragma unroll
        for (int b = 0; b < 2; ++b)
#pragma unroll
            for (int m = 0; m < 4; ++m)
#pragma unroll
                for (int n = 0; n < 2; ++n) acc[a][b][m][n] = (f32x4){0.f, 0.f, 0.f, 0.f};
    bf16x8 At[4][2], B0[2][2], B1[2][2];
    const char* cA = (const char*)g.A + (size_t)cur.pm * tstep; const char* cB = (const char*)g.Bt + (size_t)cur.pn * tstep;
    S.a_ready(cur);
    if constexpr (SP2) {
        PG8_STAGE(PG8_SB(0, 0), cB, voffB); PG8_STAGE(PG8_SB(0, 1), cB + hstep, voffB); PG8_STAGE(PG8_SA(0, 0), cA, voffA); PG8_STAGE(PG8_SA(0, 1), cA + hstep, voffA);
        if (wr == 1) PG8_BAR;
        PG8_WAIT_V(2); PG8_BAR;
        PG8_STAGE(PG8_SB(1, 0), cB + kstep, voffB); PG8_STAGE(PG8_SA(1, 0), cA + kstep, voffA); PG8_STAGE(PG8_SB(1, 1), cB + hstep + kstep, voffB);
        PG8_WAIT_V(6); PG8_BAR;
    } else {
        PG8_STAGE(PG8_SB(0, 0), cB, voffB); PG8_STAGE(PG8_SA(0, 0), cA, voffA); PG8_STAGE(PG8_SB(0, 1), cB + hstep, voffB); PG8_STAGE(PG8_SA(0, 1), cA + hstep, voffA);
        if (wr == 1) PG8_BAR;
        PG8_WAIT_V(4); PG8_BAR;
        PG8_STAGE(PG8_SB(1, 0), cB + kstep, voffB); PG8_STAGE(PG8_SA(1, 0), cA + kstep, voffA); PG8_STAGE(PG8_SB(1, 1), cB + hstep + kstep, voffB);
        PG8_WAIT_V(6); PG8_BAR;
    }
    for (;;) {
        const bool has_next = S.next(ui + 1, nxt);
        const char* nA = has_next ? (const char*)g.A + (size_t)nxt.pm * tstep : cA; const char* nB = has_next ? (const char*)g.Bt + (size_t)nxt.pn * tstep : cB;
        for (int t = 0; t < nt; t += 2) {
            const bool last = (t == nt - 2);
            const char* a1 = cA + (size_t)(t + 1) * kstep;
            const char* a2 = last ? nA : cA + (size_t)(t + 2) * kstep; const char* b2 = last ? nB : cB + (size_t)(t + 2) * kstep;
            const char* a3 = a2 + kstep; const char* b3 = b2 + kstep;
            if (last && has_next) S.a_ready(nxt);
            if constexpr (SP2) {
            PG8_LDB(B0, 0, 0); PG8_LDB(B1, 0, 1); PG8_SCHED; PG8_LDA(At, 0, 0); PG8_STAGE(PG8_SA(1, 1), a1 + hstep, voffA);
            PG8_WAIT_V(8); PG8_WAIT_L(0); PG8_BAR; PG8_MMA(0, 0, At, B0); PG8_MMA(0, 1, At, B1); PG8_BAR; PG8_SCHED;
            PG8_LDA(At, 0, 1); PG8_STAGE(PG8_SB(0, 0), b2, voffB); PG8_STAGE(PG8_SB(0, 1), b2 + hstep, voffB); PG8_STAGE(PG8_SA(0, 0), a2, voffA);
            PG8_WAIT_V(8); PG8_WAIT_L(0); PG8_BAR; PG8_MMA(1, 0, At, B0); PG8_MMA(1, 1, At, B1); PG8_BAR; PG8_SCHED;
            PG8_LDB(B0, 1, 0); PG8_LDB(B1, 1, 1); PG8_SCHED; PG8_LDA(At, 1, 0); PG8_STAGE(PG8_SA(0, 1), a2 + hstep, voffA);
            PG8_WAIT_V(8); PG8_WAIT_L(0); PG8_BAR; PG8_MMA(0, 0, At, B0); PG8_MMA(0, 1, At, B1); PG8_BAR; PG8_SCHED;
            PG8_LDA(At, 1, 1); PG8_STAGE(PG8_SB(1, 0), b3, voffB); PG8_STAGE(PG8_SB(1, 1), b3 + hstep, voffB); PG8_STAGE(PG8_SA(1, 0), a3, voffA);
            PG8_WAIT_V(8); PG8_WAIT_L(0); PG8_BAR; PG8_MMA(1, 0, At, B0); PG8_MMA(1, 1, At, B1); PG8_BAR; PG8_SCHED;
            } else {
            PG8_LDB(B0, 0, 0); PG8_SCHED; PG8_LDA(At, 0, 0); PG8_STAGE(PG8_SA(1, 1), a1 + hstep, voffA);
            PG8_WAIT_L(8); PG8_BAR; PG8_WAIT_L(0); PG8_MMA(0, 0, At, B0); PG8_BAR; PG8_SCHED;
            PG8_LDB(B1, 0, 1); PG8_STAGE(PG8_SB(0, 0), b2, voffB);
            PG8_BAR; PG8_WAIT_L(0); PG8_MMA(0, 1, At, B1); PG8_BAR;
            PG8_LDA(At, 0, 1); PG8_STAGE(PG8_SA(0, 0), a2, voffA);
            PG8_BAR; PG8_WAIT_L(0); PG8_MMA(1, 0, At, B0); PG8_BAR; PG8_SCHED;
            PG8_STAGE(PG8_SB(0, 1), b2 + hstep, voffB);
            PG8_WAIT_V(6); PG8_BAR; PG8_MMA(1, 1, At, B1); PG8_BAR;
            PG8_LDB(B0, 1, 0); PG8_SCHED; PG8_LDA(At, 1, 0); PG8_STAGE(PG8_SA(0, 1), a2 + hstep, voffA);
            PG8_WAIT_L(8); PG8_BAR; PG8_WAIT_L(0); PG8_MMA(0, 0, At, B0); PG8_BAR; PG8_SCHED;
            PG8_LDB(B1, 1, 1); PG8_STAGE(PG8_SB(1, 0), b3, voffB);
            PG8_BAR; PG8_WAIT_L(0); PG8_MMA(0, 1, At, B1); PG8_BAR;
            PG8_LDA(At, 1, 1); PG8_STAGE(PG8_SA(1, 0), a3, voffA);
            PG8_BAR; PG8_WAIT_L(0); PG8_MMA(1, 0, At, B0); PG8_BAR; PG8_SCHED;
            PG8_STAGE(PG8_SB(1, 1), b3 + hstep, voffB);
            PG8_WAIT_V(6); PG8_BAR; PG8_MMA(1, 1, At, B1); PG8_BAR;
            }
        }
        if constexpr (ALIGN_EPI) { if (wr == 0) PG8_BAR; }
        if constexpr (!Epi::AFTER_DRAIN) { E(acc, cur, ui, wr, wc, fr, fq); S.done(cur); }
        if (!has_next) break;
#pragma unroll
        for (int a = 0; a < 2; ++a)
#pragma unroll
            for (int b = 0; b < 2; ++b)
#pragma unroll
                for (int m = 0; m < 4; ++m)
#pragma unroll
                    for (int n = 0; n < 2; ++n) acc[a][b][m][n] = (f32x4){0.f, 0.f, 0.f, 0.f};
        cur = nxt; cA = nA; cB = nB; ++ui;
        if constexpr (ALIGN_EPI) { if (wr == 1) PG8_BAR; }
    }
    PG8_WAIT_V(0);
    if constexpr (!ALIGN_EPI) { if (wr == 0) PG8_BAR; }
    PG8_BAR;
    if constexpr (Epi::AFTER_DRAIN) { E.fused(acc, cur, wr, wc, fr, fq, lds, wid, lane); S.done(cur); }
#undef PG8_SA
#undef PG8_SB
#undef PG8_STAGE
#undef PG8_LDA
#undef PG8_LDB
#undef PG8_MMA
#undef PG8_WAIT_V
#undef PG8_WAIT_L
#undef PG8_BAR
#undef PG8_SCHED
}
}
#define LAS __attribute__((address_space(3)))
typedef unsigned short bf16;
typedef float f32x4 __attribute__((ext_vector_type(4)));
typedef short bf16x8 __attribute__((ext_vector_type(8)));
typedef unsigned u32x4 __attribute__((ext_vector_type(4)));
typedef unsigned u32x2 __attribute__((ext_vector_type(2)));
constexpr int NWAVES = 8, NTHR = 512;
constexpr int BATCH = 8, SEQ = 2048, DM = 1024, M = BATCH * SEQ, DIN = 3840, FFN = 2816, DEPTH = 2;
constexpr int C_HQ = 0, C_HFF = 512, C_HI = 1536, C_HG = 2048, C_NQ = 2560, C_NK = 2816, C_NV = 3072, C_CA = 3328, C_CG = 3584;
constexpr int NSEG = 8, SEGLEN = SEQ / NSEG, CHS = SEGLEN / 32;
constexpr float EPS = 1e-6f;
constexpr size_t MiB = 1u << 20;
constexpr size_t WS_SSQ = 1 * MiB;
constexpr size_t WS_WIN = 2 * MiB, WS_WIN_L = (size_t)DIN * DM * 2;
constexpr size_t WS_WOUT = 17 * MiB, WS_WOUT_L = (size_t)DM * DM * 2;
constexpr size_t WS_WGU = 21 * MiB, WS_WGU_L = (size_t)2 * FFN * DM * 2;
constexpr size_t WS_WDN = 43 * MiB, WS_WDN_L = (size_t)DM * FFN * 2;
constexpr size_t WS_P = 54 * MiB;
constexpr size_t WS_MIX = 174 * MiB;
constexpr size_t WS_XB = 206 * MiB;
constexpr size_t WS_SLOC = 238 * MiB;
constexpr size_t WS_DSEG = 254 * MiB;
constexpr size_t WS_END = 255 * MiB;

__device__ __forceinline__ float bf2f(unsigned short h) { return __builtin_bit_cast(float, (unsigned)h << 16); }
__device__ __forceinline__ float bflo(unsigned w) { return __builtin_bit_cast(float, w << 16); }
__device__ __forceinline__ float bfhi(unsigned w) { return __builtin_bit_cast(float, w & 0xffff0000u); }
__device__ __forceinline__ unsigned pk2(float lo, float hi) { return pg8::cvt_pk_bf16(lo, hi); }
__device__ __forceinline__ unsigned short f2bf(float v) { return (unsigned short)(pg8::cvt_pk_bf16(v, 0.f) & 0xffffu); }
__device__ __forceinline__ float wave_sum(float v) {
#pragma unroll
    for (int o = 1; o < 64; o <<= 1) v += __shfl_xor(v, o);
    return v;
}
__device__ __forceinline__ float sigm(float x) { return __builtin_amdgcn_rcpf(1.f + __expf(-x)); }
__device__ __forceinline__ float silu_f0(float x) { return x * sigm(x); }
__device__ __forceinline__ f32x4 mfma16(bf16x8 a, bf16x8 b, f32x4 c) { return __builtin_amdgcn_mfma_f32_16x16x32_bf16(a, b, c, 0, 0, 0); }
#define LDS_WAIT() asm volatile("s_waitcnt lgkmcnt(0)" ::: "memory")

struct Params {
    const float *x, *mix_g, *w_in, *hg_lb, *hg_ng, *rpb, *cw, *cb, *lng, *lnb, *w_out, *ffn_g, *w_gu, *w_dn, *fin_g;
    float* out; unsigned char* ws;
};

__device__ __forceinline__ void transpose_item(const float* W, int K, int N, bf16* WT, const float* gk, bool gu, LAS float* scr, int item, int lane) {
    const int nblk = N / 32, kb = item / nblk, nb = item % nblk, k0 = 64 * kb, n0 = 32 * nb;
    float wv[32];
#pragma unroll
    for (int i = 0; i < 32; ++i) { const int kk = 2 * i + (lane >> 5); wv[i] = W[(size_t)(k0 + kk) * N + n0 + (lane & 31)]; }
    const float gs = gk ? gk[k0 + lane] : 1.f;
    __builtin_amdgcn_sched_barrier(0);
#pragma unroll
    for (int i = 0; i < 32; ++i) { const int kk = 2 * i + (lane >> 5); scr[kk * 33 + (lane & 31)] = wv[i] * __shfl(gs, kk); }
    LDS_WAIT(); asm volatile("" ::: "memory");
    const int c = lane & 7;
    int r0 = n0;
    if (gu) { const int up = n0 >= FFN ? 1 : 0, cc = n0 - up * FFN; r0 = 256 * (cc >> 7) + (cc & 127) + up * 128; }
#pragma unroll
    for (int j = 0; j < 4; ++j) { const int n = (lane >> 3) + 8 * j; const LAS float* s = scr + (8 * c) * 33 + n;
        u32x4 o; o.x = pk2(s[0 * 33], s[1 * 33]); o.y = pk2(s[2 * 33], s[3 * 33]); o.z = pk2(s[4 * 33], s[5 * 33]); o.w = pk2(s[6 * 33], s[7 * 33]);
        *(u32x4*)(WT + (size_t)(r0 + n) * K + k0 + 8 * c) = o; }
    LDS_WAIT(); asm volatile("" ::: "memory");
}
__device__ __forceinline__ void prologue(const Params& p, LAS unsigned char* lds, int gw, int NGW, int wave, int lane) {
    LAS float* scr = (LAS float*)(lds + wave * 16384);
    constexpr int I_IN = (DM / 64) * (DIN / 32), I_OUT = (DM / 64) * (DM / 32), I_GU = (DM / 64) * (2 * FFN / 32), I_DN = (FFN / 64) * (DM / 32), I_L = I_IN + I_OUT + I_GU + I_DN;
    for (int it = gw; it < DEPTH * I_L; it += NGW) {
        const int l = it / I_L; int r = it % I_L;
        if (r < I_IN) { transpose_item(p.w_in + (size_t)l * DM * DIN, DM, DIN, (bf16*)(p.ws + WS_WIN + l * WS_WIN_L), p.mix_g + l * DM, false, scr, r, lane); continue; } r -= I_IN;
        if (r < I_OUT) { transpose_item(p.w_out + (size_t)l * DM * DM, DM, DM, (bf16*)(p.ws + WS_WOUT + l * WS_WOUT_L), nullptr, false, scr, r, lane); continue; } r -= I_OUT;
        if (r < I_GU) { transpose_item(p.w_gu + (size_t)l * DM * 2 * FFN, DM, 2 * FFN, (bf16*)(p.ws + WS_WGU + l * WS_WGU_L), p.ffn_g + l * DM, true, scr, r, lane); continue; } r -= I_GU;
        transpose_item(p.w_dn + (size_t)l * FFN * DM, FFN, DM, (bf16*)(p.ws + WS_WDN + l * WS_WDN_L), nullptr, false, scr, r, lane);
    }
    bf16* XB = (bf16*)(p.ws + WS_XB); float* ssq = (float*)(p.ws + WS_SSQ);
    for (int m = gw; m < M; m += 2 * NGW) {
        const int m2 = m + NGW;
        const f32x4* xa = (const f32x4*)(p.x + (size_t)m * DM) + lane; const f32x4* xc = (const f32x4*)(p.x + (size_t)(m2 < M ? m2 : m) * DM) + lane;
        f32x4 va[4], vc[4];
#pragma unroll
        for (int j = 0; j < 4; ++j) { va[j] = xa[64 * j]; vc[j] = xc[64 * j]; }
        __builtin_amdgcn_sched_barrier(0);
        float sa = 0.f, sc = 0.f;
        unsigned long long* oa = (unsigned long long*)(XB + (size_t)m * DM) + lane; unsigned long long* oc = (unsigned long long*)(XB + (size_t)m2 * DM) + lane;
#pragma unroll
        for (int j = 0; j < 4; ++j) { sa += (va[j].x * va[j].x + va[j].y * va[j].y) + (va[j].z * va[j].z + va[j].w * va[j].w); sc += (vc[j].x * vc[j].x + vc[j].y * vc[j].y) + (vc[j].z * vc[j].z + vc[j].w * vc[j].w);
            oa[64 * j] = (unsigned long long)pk2(va[j].x, va[j].y) | ((unsigned long long)pk2(va[j].z, va[j].w) << 32);
            if (m2 < M) oc[64 * j] = (unsigned long long)pk2(vc[j].x, vc[j].y) | ((unsigned long long)pk2(vc[j].z, vc[j].w) << 32); }
        sa = wave_sum(sa); sc = wave_sum(sc);
        if (lane < 16) { ssq[(size_t)lane * M + m] = lane == 0 ? sa : 0.f; if (m2 < M) ssq[(size_t)lane * M + m2] = lane == 0 ? sc : 0.f; }
    }
}

constexpr int HQ_OFF = 0, HK_OFF = 8704, HKH_OFF = 17408, HV_OFF = 27648, HP_OFF = 37888, HST_OFF = 40448, HOS_OFF = 75264, HGS_OFF = 92160, HDEC_OFF = 94208;
#define WG_BAR() asm volatile("s_waitcnt lgkmcnt(0)\n\ts_barrier" ::: "memory")
template <bool FULL, bool SECOND>
__device__ __forceinline__ void hg_segment(LAS unsigned char* lds, const bf16* P, int b, int h, int dir, int seg, float lb, f32x4 (&S)[8], float& bsum,
                                           float* OP, bf16* MIXED, const float* norm_g) {
    int tid_ = threadIdx.x; asm volatile("" : "+v"(tid_)); const int tid = tid_, w = __builtin_amdgcn_readfirstlane(tid >> 6), lane = tid & 63, fr = lane & 15, fq = lane >> 4;
    const int d = 16 * w + (lane & 15), grp = lane >> 4;
    LAS bf16* QT = (LAS bf16*)(lds + HQ_OFF); LAS bf16* KT = (LAS bf16*)(lds + HK_OFF); LAS bf16* KHT = (LAS bf16*)(lds + HKH_OFF); LAS bf16* VT = (LAS bf16*)(lds + HV_OFF);
    LAS bf16* PS = (LAS bf16*)(lds + HP_OFF); LAS bf16* ST = (LAS bf16*)(lds + HST_OFF); LAS float* OS = (LAS float*)(lds + HOS_OFF); LAS float* GS = (LAS float*)(lds + HGS_OFF); LAS float* DEC = (LAS float*)(lds + HDEC_OFF);
    const int zcol = C_HFF + dir * 512 + h * 128 + d, qcol = C_HQ + h * 128 + d, vcol = C_HI + h * 128 + d;
    const float oml = 1.f - lb;
    const int ts = dir == 0 ? 1 : -1, tb0 = dir == 0 ? seg * SEGLEN : (seg * SEGLEN + SEGLEN - 1);
    const long rstep = (long)ts * DIN;
    const int fc = tid >> 4, dvg = tid & 15;
    f32x4 ng0 = (f32x4){0.f, 0.f, 0.f, 0.f}, ng1 = ng0;
    if (FULL && SECOND) { ng0 = *(const f32x4*)(norm_g + 8 * dvg); ng1 = *(const f32x4*)(norm_g + 8 * dvg + 4); }
    unsigned short zn[8], qn[8], vn[8];
#define HG_LOAD(n_) do { const bf16* rowp_ = P + (size_t)(b * SEQ + tb0 + ts * (32 * (n_) + 8 * grp)) * DIN; \
        _Pragma("unroll") for (int e = 0; e < 8; ++e) { const bf16* r_ = rowp_ + rstep * e; zn[e] = r_[zcol]; if (FULL) qn[e] = r_[qcol]; else qn[e] = 0; vn[e] = r_[vcol]; } } while (0)
    HG_LOAD(0);
#pragma unroll 1
    for (int n = 0; n < CHS; ++n) {
        const int tb = tb0 + ts * 32 * n;
        unsigned short zc[8], qc[8], vv[8];
#pragma unroll
        for (int e = 0; e < 8; ++e) { zc[e] = zn[e]; qc[e] = qn[e]; vv[e] = vn[e]; }
        if (n + 1 < CHS) HG_LOAD(n + 1);
        const int ftok = tb + ts * fc;
        f32x4 op0 = (f32x4){0.f, 0.f, 0.f, 0.f}, op1 = op0; u32x4 gw4 = (u32x4){0u, 0u, 0u, 0u};
        float* op = OP + ((size_t)((b * 4 + h) * SEQ + ftok)) * 128 + 8 * dvg;
        if (FULL && SECOND) { op0 = *(const f32x4*)op; op1 = *(const f32x4*)(op + 4); gw4 = *(const u32x4*)(P + (size_t)(b * SEQ + ftok) * DIN + C_HG + h * 128 + 8 * dvg); }
        __builtin_amdgcn_sched_barrier(0);
        float El[8], kv[8]; float run = 1.f;
#pragma unroll
        for (int e = 0; e < 8; ++e) { float z = bf2f(zc[e]); z = fminf(fmaxf(z, -40.f), 40.f);
            const float ez = __expf(-z), inv = __builtin_amdgcn_rcpf(1.f + ez);
            run *= lb + oml * inv; El[e] = run; kv[e] = oml * (ez * inv); }
        float pre = 1.f, tot = 1.f;
#pragma unroll
        for (int g2 = 0; g2 < 4; ++g2) { const float t = __shfl(run, (g2 << 4) | (lane & 15)); tot *= t; if (g2 < grp) pre *= t; }
        unsigned khp[4], vvp[4];
#pragma unroll
        for (int e = 0; e < 8; e += 2) { const float E0 = pre * El[e], E1 = pre * El[e + 1], r0 = __builtin_amdgcn_rcpf(E0), r1 = __builtin_amdgcn_rcpf(E1);
            if (FULL) { const int c0 = 8 * grp + e; QT[c0 * 136 + d] = f2bf(bf2f(qc[e]) * E0); QT[(c0 + 1) * 136 + d] = f2bf(bf2f(qc[e + 1]) * E1);
                KT[c0 * 136 + d] = f2bf(kv[e] * r0); KT[(c0 + 1) * 136 + d] = f2bf(kv[e + 1] * r1); }
            khp[e >> 1] = pk2(kv[e] * (tot * r0), kv[e + 1] * (tot * r1)); vvp[e >> 1] = (unsigned)vv[e] | ((unsigned)vv[e + 1] << 16); }
        *(LAS u32x4*)(KHT + d * 40 + 8 * grp) = (u32x4){khp[0], khp[1], khp[2], khp[3]};
        *(LAS u32x4*)(VT + d * 40 + 8 * grp) = (u32x4){vvp[0], vvp[1], vvp[2], vvp[3]};
        if (grp == 0) { DEC[d] = tot; bsum *= tot; }
        WG_BAR();
        f32x4 o[2] = {(f32x4){0.f, 0.f, 0.f, 0.f}, (f32x4){0.f, 0.f, 0.f, 0.f}};
        if (FULL) {
            if (w < 4) { const int ct = w >> 1, st = w & 1; f32x4 a = (f32x4){0.f, 0.f, 0.f, 0.f};
                if (!(ct == 0 && st == 1)) {
#pragma unroll
                    for (int ks = 0; ks < 4; ++ks) a = mfma16(*(const LAS bf16x8*)(QT + (16 * ct + fr) * 136 + 32 * ks + 8 * fq), *(const LAS bf16x8*)(KT + (16 * st + fr) * 136 + 32 * ks + 8 * fq), a); }
#pragma unroll
                for (int i = 0; i < 4; ++i) { const int c = 16 * ct + 4 * fq + i, s = 16 * st + fr; PS[c * 40 + s] = f2bf(s <= c ? a[i] : 0.f); } }
#pragma unroll
            for (int ct = 0; ct < 2; ++ct)
#pragma unroll
                for (int ks = 0; ks < 4; ++ks) o[ct] = mfma16(*(const LAS bf16x8*)(QT + (16 * ct + fr) * 136 + 32 * ks + 8 * fq), *(const LAS bf16x8*)(ST + (16 * w + fr) * 136 + 32 * ks + 8 * fq), o[ct]);
            WG_BAR();
        }
        const bf16x8 vfr = *(const LAS bf16x8*)(VT + (16 * w + fr) * 40 + 8 * fq);
        if (FULL) {
#pragma unroll
            for (int ct = 0; ct < 2; ++ct) { o[ct] = mfma16(*(const LAS bf16x8*)(PS + (16 * ct + fr) * 40 + 8 * fq), vfr, o[ct]);
#pragma unroll
                for (int i = 0; i < 4; ++i) OS[(16 * ct + 4 * fq + i) * 132 + 16 * w + fr] = o[ct][i]; }
        }
#pragma unroll
        for (int i = 0; i < 8; ++i) { const f32x4 dv4 = *(const LAS f32x4*)(DEC + 16 * i + 4 * fq); S[i] = S[i] * dv4;
            S[i] = mfma16(*(const LAS bf16x8*)(KHT + (16 * i + fr) * 40 + 8 * fq), vfr, S[i]); }
        if (!FULL) WG_BAR();
        if (FULL) {
#pragma unroll
            for (int i = 0; i < 8; ++i) *(LAS u32x2*)(ST + (16 * w + fr) * 136 + 16 * i + 4 * fq) = (u32x2){pk2(S[i][0], S[i][1]), pk2(S[i][2], S[i][3])};
            WG_BAR();
            f32x4 o0 = *(const LAS f32x4*)(OS + fc * 132 + 8 * dvg), o1 = *(const LAS f32x4*)(OS + fc * 132 + 8 * dvg + 4);
            if (!SECOND) { *(f32x4*)op = o0; *(f32x4*)(op + 4) = o1; }
            else { o0 = o0 + op0; o1 = o1 + op1;
                float sq = (o0[0] * o0[0] + o0[1] * o0[1]) + (o0[2] * o0[2] + o0[3] * o0[3]) + (o1[0] * o1[0] + o1[1] * o1[1]) + (o1[2] * o1[2] + o1[3] * o1[3]);
                sq += __shfl_xor(sq, 1); sq += __shfl_xor(sq, 2); sq += __shfl_xor(sq, 4); sq += __shfl_xor(sq, 8);
                const float rs = __builtin_amdgcn_rsqf(sq * (1.f / 128.f) + EPS);
                u32x4 ow; ow.x = pk2(o0[0] * rs * ng0[0] * bflo(gw4.x), o0[1] * rs * ng0[1] * bfhi(gw4.x));
                ow.y = pk2(o0[2] * rs * ng0[2] * bflo(gw4.y), o0[3] * rs * ng0[3] * bfhi(gw4.y));
                ow.z = pk2(o1[0] * rs * ng1[0] * bflo(gw4.z), o1[1] * rs * ng1[1] * bfhi(gw4.z));
                ow.w = pk2(o1[2] * rs * ng1[2] * bflo(gw4.w), o1[3] * rs * ng1[3] * bfhi(gw4.w));
                *(u32x4*)(MIXED + (size_t)(b * SEQ + ftok) * DM + h * 128 + 8 * dvg) = ow; }
        }
    }
#undef HG_LOAD
}
__device__ __forceinline__ float hg_lb(const float* hg_lb_all, int layer, int dir, int ch) {
    if (layer == 0) return 0.f;
    const float a0 = hg_lb_all[(0 * 2 + dir) * 512 + ch], a1 = hg_lb_all[(1 * 2 + dir) * 512 + ch], mx = fmaxf(a0, a1), e0 = __expf(a0 - mx), e1 = __expf(a1 - mx);
    return e1 / (e0 + e1);
}
__device__ __forceinline__ void hg_passA_item(LAS unsigned char* lds, const Params& p, int layer, int item) {
    const int dir = item & 1, seg = (item >> 1) & (NSEG - 1), h = (item >> 4) & 3, b = item >> 6;
    if ((dir == 0 && seg == NSEG - 1) || (dir == 1 && seg == 0)) return;
    int tid_ = threadIdx.x; asm volatile("" : "+v"(tid_)); const int tid = tid_, w = __builtin_amdgcn_readfirstlane(tid >> 6), lane = tid & 63;
    const float lb = hg_lb(p.hg_lb, layer, dir, h * 128 + 16 * w + (lane & 15));
    f32x4 S[8];
#pragma unroll
    for (int i = 0; i < 8; ++i) S[i] = (f32x4){0.f, 0.f, 0.f, 0.f};
    float bsum = 1.f;
    hg_segment<false, false>(lds, (const bf16*)(p.ws + WS_P), b, h, dir, seg, lb, S, bsum, nullptr, nullptr, nullptr);
    u32x2* sl = (u32x2*)(p.ws + WS_SLOC) + (size_t)item * 4096;
#pragma unroll
    for (int i = 0; i < 8; ++i) sl[(w * 8 + i) * 64 + lane] = (u32x2){pk2(S[i][0], S[i][1]), pk2(S[i][2], S[i][3])};
    if (lane < 16) ((float*)(p.ws + WS_DSEG))[(size_t)item * 128 + 16 * w + (lane & 15)] = bsum;
    __syncthreads();
}
__device__ __forceinline__ void hg_passB_item(LAS unsigned char* lds, const Params& p, int layer, int item) {
    const int seg = item & (NSEG - 1), h = (item >> 3) & 3, b = item >> 5;
    int tid_ = threadIdx.x; asm volatile("" : "+v"(tid_)); const int tid = tid_, w = __builtin_amdgcn_readfirstlane(tid >> 6), lane = tid & 63, fr = lane & 15, fq = lane >> 4;
    LAS bf16* ST = (LAS bf16*)(lds + HST_OFF);
    const u32x2* slb = (const u32x2*)(p.ws + WS_SLOC); const float* dsg = (const float*)(p.ws + WS_DSEG);
    float* OP = p.out;   bf16* MIXED = (bf16*)(p.ws + WS_MIX); const bf16* P = (const bf16*)(p.ws + WS_P);
#pragma unroll 1
    for (int dir = 0; dir < 2; ++dir) {
        const float lb = hg_lb(p.hg_lb, layer, dir, h * 128 + 16 * w + (lane & 15));
        f32x4 S[8];
#pragma unroll
        for (int i = 0; i < 8; ++i) S[i] = (f32x4){0.f, 0.f, 0.f, 0.f};
        const int nprev = dir == 0 ? seg : (NSEG - 1 - seg);
#pragma unroll 1
        for (int q = 0; q < nprev; ++q) { const int s2 = dir == 0 ? q : (NSEG - 1 - q); const int it2 = ((b * 4 + h) * NSEG + s2) * 2 + dir;
            const u32x2* sl = slb + (size_t)it2 * 4096; const float* dc = dsg + (size_t)it2 * 128;
            f32x4 dvb[8]; u32x2 svb[8];
#pragma unroll
            for (int i = 0; i < 8; ++i) { dvb[i] = *(const f32x4*)(dc + 16 * i + 4 * fq); svb[i] = sl[(w * 8 + i) * 64 + lane]; }
            __builtin_amdgcn_sched_barrier(0);
#pragma unroll
            for (int i = 0; i < 8; ++i) S[i] = S[i] * dvb[i] + (f32x4){bflo(svb[i].x), bfhi(svb[i].x), bflo(svb[i].y), bfhi(svb[i].y)}; }
#pragma unroll
        for (int i = 0; i < 8; ++i) *(LAS u32x2*)(ST + (16 * w + fr) * 136 + 16 * i + 4 * fq) = (u32x2){pk2(S[i][0], S[i][1]), pk2(S[i][2], S[i][3])};
        float bsum = 1.f;
        if (dir == 0) hg_segment<true, false>(lds, P, b, h, 0, seg, lb, S, bsum, OP, MIXED, p.hg_ng + layer * 128);
        else hg_segment<true, true>(lds, P, b, h, 1, seg, lb, S, bsum, OP, MIXED, p.hg_ng + layer * 128);
        __threadfence(); __syncthreads();
    }
}

constexpr int NA_KS = 584, NA_RPB_OFF = 64 * NA_KS * 2;
__device__ __forceinline__ int clampi(int v, int lo, int hi) { return v < lo ? lo : (v > hi ? hi : v); }
__device__ __forceinline__ void na_item(LAS unsigned char* lds, const Params& p, int layer, int item) {
    const int rp = item & 15, h = (item >> 4) & 3, b = item >> 6, r0 = 2 * rp, kbase = clampi(r0 - 4, 0, 24);
    int tid_ = threadIdx.x; asm volatile("" : "+v"(tid_)); const int tid = tid_, w = __builtin_amdgcn_readfirstlane(tid >> 6), lane = tid & 63, fr = lane & 15, fq = lane >> 4;
    const bf16* P = (const bf16*)(p.ws + WS_P); bf16* MIXED = (bf16*)(p.ws + WS_MIX);
    LAS bf16* VT = (LAS bf16*)lds; LAS float* RPB = (LAS float*)(lds + NA_RPB_OFF);
    const int rl = w >> 2, j = w & 3, r = r0 + rl, kr0 = clampi(r - 4, 0, 24), kc0 = clampi(16 * j - 8, 0, 32);
    const size_t qtok = (size_t)b * SEQ + r * 64 + 16 * j + fr;
    u32x4 vbuf[9];
#pragma unroll
    for (int it = 0; it < 9; ++it) { const int u = it * NTHR + tid, key = u >> 3, dg = u & 7; int trow = kbase * 64 + key; trow = trow > SEQ - 1 ? SEQ - 1 : trow;
        vbuf[it] = *(const u32x4*)(P + (size_t)(b * SEQ + trow) * DIN + C_NV + h * 64 + 8 * dg); }
    bf16x8 qf[2], kfa[16], kfb[16];
#pragma unroll
    for (int ks = 0; ks < 2; ++ks) qf[ks] = *(const bf16x8*)(P + qtok * DIN + C_NQ + h * 64 + 32 * ks + 8 * fq);
#define NA_KLOAD(dst, hh) do { _Pragma("unroll") for (int k8 = 0; k8 < 8; ++k8) { const int kt = (hh) * 8 + k8, krl = kt >> 1, half = kt & 1; \
        const size_t ktok = (size_t)b * SEQ + (kr0 + krl) * 64 + kc0 + 16 * half + fr; \
        _Pragma("unroll") for (int ks = 0; ks < 2; ++ks) dst[k8 * 2 + ks] = *(const bf16x8*)(P + ktok * DIN + C_NK + h * 64 + 32 * ks + 8 * fq); } } while (0)
    NA_KLOAD(kfa, 0);
    __builtin_amdgcn_sched_barrier(0);
#pragma unroll
    for (int it = 0; it < 9; ++it) { const int u = it * NTHR + tid, key = u >> 3, dg = u & 7; const u32x4 v = vbuf[it];
        LAS bf16* dst = VT + (8 * dg) * NA_KS + key;
        dst[0 * NA_KS] = (bf16)(v.x & 0xffffu); dst[1 * NA_KS] = (bf16)(v.x >> 16); dst[2 * NA_KS] = (bf16)(v.y & 0xffffu); dst[3 * NA_KS] = (bf16)(v.y >> 16);
        dst[4 * NA_KS] = (bf16)(v.z & 0xffffu); dst[5 * NA_KS] = (bf16)(v.z >> 16); dst[6 * NA_KS] = (bf16)(v.w & 0xffffu); dst[7 * NA_KS] = (bf16)(v.w >> 16); }
    for (int i = tid; i < 465; i += NTHR) RPB[i] = p.rpb[(size_t)(layer * 4 + h) * 465 + i];
    NA_KLOAD(kfb, 1);
    __builtin_amdgcn_sched_barrier(0);
    WG_BAR();
    f32x4 s[16];
#pragma unroll
    for (int k8 = 0; k8 < 8; ++k8) { f32x4 a = (f32x4){0.f, 0.f, 0.f, 0.f};
#pragma unroll
        for (int ks = 0; ks < 2; ++ks) a = mfma16(kfa[k8 * 2 + ks], qf[ks], a);
        s[k8] = a; }
#pragma unroll
    for (int k8 = 0; k8 < 8; ++k8) { f32x4 a = (f32x4){0.f, 0.f, 0.f, 0.f};
#pragma unroll
        for (int ks = 0; ks < 2; ++ks) a = mfma16(kfb[k8 * 2 + ks], qf[ks], a);
        s[8 + k8] = a; }
#undef NA_KLOAD
    const int qc = 16 * j + fr, qs = clampi(qc - 8, 0, 48);
    float mx = -1e30f;
#pragma unroll
    for (int kt = 0; kt < 16; ++kt) { const int krl = kt >> 1, half = kt & 1; const int ridx = kr0 + krl - r + 7;
#pragma unroll
        for (int i = 0; i < 4; ++i) { const int kc = kc0 + 16 * half + 4 * fq + i; const bool valid = kc >= qs && kc < qs + 16; const int cidx = clampi(kc - qc + 15, 0, 30);
            const float v = valid ? s[kt][i] * 0.125f + RPB[ridx * 31 + cidx] : -1e30f; s[kt][i] = v; mx = fmaxf(mx, v); } }
    mx = fmaxf(mx, __shfl_xor(mx, 16)); mx = fmaxf(mx, __shfl_xor(mx, 32));
    float sum = 0.f;
#pragma unroll
    for (int kt = 0; kt < 16; ++kt)
#pragma unroll
        for (int i = 0; i < 4; ++i) { const float e = __expf(s[kt][i] - mx); s[kt][i] = e; sum += e; }
    sum += __shfl_xor(sum, 16); sum += __shfl_xor(sum, 32);
    f32x4 o[4];
#pragma unroll
    for (int dt = 0; dt < 4; ++dt) o[dt] = (f32x4){0.f, 0.f, 0.f, 0.f};
#pragma unroll
    for (int kk = 0; kk < 8; ++kk) {
        const u32x4 pw = (u32x4){pk2(s[2 * kk][0], s[2 * kk][1]), pk2(s[2 * kk][2], s[2 * kk][3]), pk2(s[2 * kk + 1][0], s[2 * kk + 1][1]), pk2(s[2 * kk + 1][2], s[2 * kk + 1][3])};
        const bf16x8 pf = __builtin_bit_cast(bf16x8, pw);
        const int keyoff = (kr0 + kk - kbase) * 64 + kc0 + 4 * fq;
#pragma unroll
        for (int dt = 0; dt < 4; ++dt) { const u32x2 lo = *(const LAS u32x2*)(VT + (16 * dt + fr) * NA_KS + keyoff), hi = *(const LAS u32x2*)(VT + (16 * dt + fr) * NA_KS + keyoff + 16);
            const bf16x8 vf = __builtin_bit_cast(bf16x8, (u32x4){lo.x, lo.y, hi.x, hi.y});
            o[dt] = mfma16(vf, pf, o[dt]); } }
    const float inv = 1.f / sum;
#pragma unroll
    for (int dt = 0; dt < 4; ++dt) *(u32x2*)(MIXED + qtok * DM + 512 + h * 64 + 16 * dt + 4 * fq) = (u32x2){pk2(o[dt][0] * inv, o[dt][1] * inv), pk2(o[dt][2] * inv, o[dt][3] * inv)};
    WG_BAR();
}

__device__ __forceinline__ void conv_item(LAS unsigned char* lds, const Params& p, int layer, int item) {
    const int b = item >> 6, t0 = (item & 63) * 32;
    int tid_ = threadIdx.x; asm volatile("" : "+v"(tid_)); const int tid = tid_, w = __builtin_amdgcn_readfirstlane(tid >> 6), lane = tid & 63;
    const bf16* P = (const bf16*)(p.ws + WS_P); bf16* MIXED = (bf16*)(p.ws + WS_MIX);
    LAS float* U = (LAS float*)lds; LAS float* CO = U + 62 * 256;
    u32x4 ca4[4], cg4[4];
#pragma unroll
    for (int it = 0; it < 4; ++it) { const int u = it * NTHR + tid, tt = u >> 5, c8 = u & 31, t = t0 - 15 + tt; ca4[it] = (u32x4){0u, 0u, 0u, 0u}; cg4[it] = ca4[it];
        if (u < 62 * 32 && t >= 0 && t < SEQ) { const bf16* rp = P + (size_t)(b * SEQ + t) * DIN; ca4[it] = *(const u32x4*)(rp + C_CA + 8 * c8); cg4[it] = *(const u32x4*)(rp + C_CG + 8 * c8); } }
    const int c = tid & 255, half = tid >> 8;
    float wk[31];
#pragma unroll
    for (int k = 0; k < 31; ++k) wk[k] = p.cw[(size_t)(layer * 31 + k) * 256 + c];
    const float bias = p.cb[layer * 256 + c];
    __builtin_amdgcn_sched_barrier(0);
#pragma unroll
    for (int it = 0; it < 4; ++it) { const int u = it * NTHR + tid, tt = u >> 5, c8 = u & 31; const u32x4 a = ca4[it], g = cg4[it];
        if (u < 62 * 32) {
            const f32x4 u0 = (f32x4){bflo(a.x) * sigm(bflo(g.x)), bfhi(a.x) * sigm(bfhi(g.x)), bflo(a.y) * sigm(bflo(g.y)), bfhi(a.y) * sigm(bfhi(g.y))};
            const f32x4 u1 = (f32x4){bflo(a.z) * sigm(bflo(g.z)), bfhi(a.z) * sigm(bfhi(g.z)), bflo(a.w) * sigm(bflo(g.w)), bfhi(a.w) * sigm(bfhi(g.w))};
            *(LAS f32x4*)(U + tt * 256 + 8 * c8) = u0; *(LAS f32x4*)(U + tt * 256 + 8 * c8 + 4) = u1; } }
    WG_BAR();
#pragma unroll 1
    for (int g = 0; g < 2; ++g) { const int base = 16 * half + 8 * g; float win[38];
#pragma unroll
        for (int i = 0; i < 38; ++i) win[i] = U[(base + i) * 256 + c];
#pragma unroll
        for (int o = 0; o < 8; ++o) { float a = bias;
#pragma unroll
            for (int k = 0; k < 31; ++k) a += wk[k] * win[o + k];
            CO[(base + o) * 256 + c] = a; } }
    __syncthreads();
    const f32x4 lg = *(const f32x4*)(p.lng + layer * 256 + 4 * lane), lbv = *(const f32x4*)(p.lnb + layer * 256 + 4 * lane);
#pragma unroll
    for (int q = 0; q < 4; ++q) { const int tl = 4 * w + q; const f32x4 v = *(const LAS f32x4*)(CO + tl * 256 + 4 * lane);
        const float mean = wave_sum((v.x + v.y) + (v.z + v.w)) * (1.f / 256.f); const f32x4 dd = v - mean;
        const float var = wave_sum((dd.x * dd.x + dd.y * dd.y) + (dd.z * dd.z + dd.w * dd.w)) * (1.f / 256.f); const float rs = __builtin_amdgcn_rsqf(var + EPS);
        f32x4 y = dd * rs * lg + lbv; y = (f32x4){silu_f0(y.x), silu_f0(y.y), silu_f0(y.z), silu_f0(y.w)};
        *(u32x2*)(MIXED + (size_t)(b * SEQ + t0 + tl) * DM + 768 + 4 * lane) = (u32x2){pk2(y.x, y.y), pk2(y.z, y.w)}; }
    __syncthreads();
}

#ifndef PROBE_SEL
#define PROBE_SEL (-1)
#endif
#ifndef REP_A
#define REP_A 1
#endif
#ifndef REP_B
#define REP_B 1
#endif
#define PHASE_END(kind) do { grid.sync(); if (PROBE_SEL >= 0) { const unsigned long long t_ = __builtin_amdgcn_s_memrealtime(); if ((kind) == PROBE_SEL) tacc += t_ - tprev; tprev = t_; } } while (0)
constexpr int RS_OFF = 131072;
constexpr int LDS_BYTES = 147456;
__global__ void __launch_bounds__(NTHR, 2) fwd_megakernel(Params p) {
    extern __shared__ __attribute__((aligned(16))) unsigned char lds_raw[];
    cg::grid_group grid = cg::this_grid();
    LAS unsigned char* lds = (LAS unsigned char*)lds_raw;
    int tid_ = threadIdx.x; asm volatile("" : "+v"(tid_)); const int tid = tid_, lane = tid & 63, wave = __builtin_amdgcn_readfirstlane(tid >> 6);
    const int G = gridDim.x, bid = blockIdx.x, gw = bid * NWAVES + wave, NGW = G * NWAVES;
    unsigned char* ws = p.ws;
    float* ssq = (float*)(ws + WS_SSQ); bf16* XB = (bf16*)(ws + WS_XB); bf16* PB = (bf16*)(ws + WS_P); bf16* MIXED = (bf16*)(ws + WS_MIX);

    unsigned long long tprev = 0, tacc = 0; if (PROBE_SEL >= 0) tprev = __builtin_amdgcn_s_memrealtime();
    prologue(p, lds, gw, NGW, wave, lane);
    PHASE_END(0);
#pragma unroll 1
    for (int l = 0; l < DEPTH; ++l) {
        {
            pg8::Gemm g{XB, (const bf16*)(ws + WS_WIN + l * WS_WIN_L), M, DIN, DM}; pg8::StaticOrder S; S.init(M, DIN, G, bid);
            pg8::rstd_table((LAS float*)(lds + RS_OFF), ssq, S); pg8::EpiScale E{PB, DIN, (LAS float*)(lds + RS_OFF), 0x303u};
            pg8::gemm_phase<pg8::EpiScale, pg8::StaticOrder, true, true>(lds, g, S, E);
        }
        PHASE_END(1);
#pragma unroll 1
        for (int rep = 0; rep < REP_A; ++rep) {
        for (int it = bid; it < BATCH * 4 * NSEG * 2; it += G) hg_passA_item(lds, p, l, it);
        for (int it = bid; it < BATCH * 4 * 16; it += G) na_item(lds, p, l, it);
        for (int it = bid; it < BATCH * 64; it += G) conv_item(lds, p, l, it);
        }
        PHASE_END(2);
#pragma unroll 1
        for (int rep = 0; rep < REP_B; ++rep)
        for (int it = bid; it < BATCH * 4 * NSEG; it += G) hg_passB_item(lds, p, l, it);
        PHASE_END(3);
        {
            pg8::Gemm g{MIXED, (const bf16*)(ws + WS_WOUT + l * WS_WOUT_L), M, DM, DM}; pg8::StaticOrder S; S.init(M, DM, G, bid);
            pg8::EpiRes E{XB, ssq};
            pg8::gemm_phase<pg8::EpiRes, pg8::StaticOrder, true, true>(lds, g, S, E);
        }
        PHASE_END(4);
        {
            pg8::Gemm g{XB, (const bf16*)(ws + WS_WGU + l * WS_WGU_L), M, 2 * FFN, DM}; pg8::StaticOrder S; S.init(M, 2 * FFN, G, bid);
            pg8::rstd_table((LAS float*)(lds + RS_OFF), ssq, S); pg8::EpiSwiGLU E{PB, FFN, (LAS float*)(lds + RS_OFF)};
            pg8::gemm_phase<pg8::EpiSwiGLU, pg8::StaticOrder, true, true>(lds, g, S, E);
        }
        PHASE_END(5);
        {
            pg8::Gemm g{PB, (const bf16*)(ws + WS_WDN + l * WS_WDN_L), M, DM, FFN}; pg8::StaticOrder S; S.init(M, DM, G, bid);
            pg8::EpiRes E{XB, ssq};
            pg8::gemm_phase<pg8::EpiRes, pg8::StaticOrder, true, true>(lds, g, S, E);
        }
        PHASE_END(6);
    }
    float pdelta = 0.f;
    if (PROBE_SEL >= 0) {
        unsigned* tw = (unsigned*)(ws + 64);
        if (bid == 0 && tid == 0) __hip_atomic_store(tw, (unsigned)tacc, __ATOMIC_RELAXED, __HIP_MEMORY_SCOPE_AGENT);
        grid.sync();
        pdelta = (float)__hip_atomic_load(tw, __ATOMIC_RELAXED, __HIP_MEMORY_SCOPE_AGENT) * 1e-6f;
    }
    for (int m = gw; m < M; m += 2 * NGW) {
        const int m2 = (m + NGW < M) ? m + NGW : m;
        float pa = lane < 16 ? ssq[(size_t)(lane & 15) * M + m] : 0.f, pc = lane < 16 ? ssq[(size_t)(lane & 15) * M + m2] : 0.f;
        const u32x4* xa = (const u32x4*)(XB + (size_t)m * DM) + lane; const u32x4* xc = (const u32x4*)(XB + (size_t)m2 * DM) + lane;
        u32x4 va[2], vc[2]; f32x4 gg[4];
#pragma unroll
        for (int j = 0; j < 2; ++j) { va[j] = xa[64 * j]; vc[j] = xc[64 * j]; gg[2 * j] = *(const f32x4*)(p.fin_g + 512 * j + 8 * lane); gg[2 * j + 1] = *(const f32x4*)(p.fin_g + 512 * j + 8 * lane + 4); }
        __builtin_amdgcn_sched_barrier(0);
        pa = wave_sum(pa); pc = wave_sum(pc);
        const float ra = __builtin_amdgcn_rsqf(pa * (1.f / DM) + EPS), rc = __builtin_amdgcn_rsqf(pc * (1.f / DM) + EPS);
        const f32x4 pd = (PROBE_SEL >= 0) ? (f32x4){pdelta, -pdelta, pdelta, -pdelta} : (f32x4){0.f, 0.f, 0.f, 0.f};
#pragma unroll
        for (int j = 0; j < 2; ++j) {
            { const u32x4 r = va[j]; float* o = p.out + (size_t)m * DM + 512 * j + 8 * lane;
              f32x4 v0 = (f32x4){bflo(r.x), bfhi(r.x), bflo(r.y), bfhi(r.y)} * ra * gg[2 * j], v1 = (f32x4){bflo(r.z), bfhi(r.z), bflo(r.w), bfhi(r.w)} * ra * gg[2 * j + 1];
              if (PROBE_SEL >= 0 && m < 256) { v0 = v0 + pd; v1 = v1 + pd; }
              *(f32x4*)o = v0; *(f32x4*)(o + 4) = v1; }
            if (m2 != m) { const u32x4 r = vc[j]; float* o = p.out + (size_t)m2 * DM + 512 * j + 8 * lane;
              f32x4 v0 = (f32x4){bflo(r.x), bfhi(r.x), bflo(r.y), bfhi(r.y)} * rc * gg[2 * j], v1 = (f32x4){bflo(r.z), bfhi(r.z), bflo(r.w), bfhi(r.w)} * rc * gg[2 * j + 1];
              if (PROBE_SEL >= 0 && m2 < 256) { v0 = v0 + pd; v1 = v1 + pd; }
              *(f32x4*)o = v0; *(f32x4*)(o + 4) = v1; } }
    }
}

extern "C" void kernel_launch(void* const* d_in, const int* in_sizes, int n_in, void* d_out, int out_size, void* d_ws, size_t ws_size, hipStream_t stream) {
    static int grid_blocks = 0;
    if (grid_blocks == 0) {
        if (n_in != 15 || out_size != M * DM || ws_size < WS_END) { fprintf(stderr, "kernel_launch: unexpected shapes (n_in %d out %d ws %zu)\n", n_in, out_size, ws_size); grid_blocks = -1; return; }
        int dev = 0, cus = 0, per_cu = 0;
        hipGetDevice(&dev); hipDeviceGetAttribute(&cus, hipDeviceAttributeMultiprocessorCount, dev);
        hipFuncSetAttribute((const void*)fwd_megakernel, hipFuncAttributeMaxDynamicSharedMemorySize, LDS_BYTES);
        hipOccupancyMaxActiveBlocksPerMultiprocessor(&per_cu, (const void*)fwd_megakernel, NTHR, LDS_BYTES);
        if (per_cu < 1) { fprintf(stderr, "kernel_launch: occupancy query says %d blocks per CU\n", per_cu); per_cu = 1; }
        (void)hipGetLastError();
        grid_blocks = cus * 1;
    }
    if (grid_blocks < 0) return;
    Params p{};
    p.x = (const float*)d_in[0]; p.mix_g = (const float*)d_in[1]; p.w_in = (const float*)d_in[2]; p.hg_lb = (const float*)d_in[3]; p.hg_ng = (const float*)d_in[4];
    p.rpb = (const float*)d_in[5]; p.cw = (const float*)d_in[6]; p.cb = (const float*)d_in[7]; p.lng = (const float*)d_in[8]; p.lnb = (const float*)d_in[9];
    p.w_out = (const float*)d_in[10]; p.ffn_g = (const float*)d_in[11]; p.w_gu = (const float*)d_in[12]; p.w_dn = (const float*)d_in[13]; p.fin_g = (const float*)d_in[14];
    p.out = (float*)d_out; p.ws = (unsigned char*)d_ws;
    void* args[] = {&p};
    hipError_t e = hipLaunchCooperativeKernel((const void*)fwd_megakernel, dim3(grid_blocks), dim3(NTHR), args, LDS_BYTES, stream);
    if (e != hipSuccess) fprintf(stderr, "cooperative launch failed: %s (grid %d)\n", hipGetErrorString(e), grid_blocks);
}
```

```cpp
#include <hip/hip_runtime.h>
#include <hip/hip_cooperative_groups.h>
#include <cstdio>
#include <cstdint>
namespace cg = cooperative_groups;

namespace pg8 {
#define PG8_LAS __attribute__((address_space(3)))
typedef unsigned short bf16_t;
typedef short bf16x8 __attribute__((ext_vector_type(8)));
typedef float f32x4 __attribute__((ext_vector_type(4)));
typedef unsigned u32x4 __attribute__((ext_vector_type(4)));
constexpr int BM = 256, BK = 64, HALF = 128, HTB = HALF * BK * 2  , STAGE_BYTES = 8 * HTB, NXCD = 8, WGM = 8;

__host__ __device__ __forceinline__ int lds_byte(int r, int c) { const int st = (r >> 4) * 2 + (c >> 5), rr = r & 15, cc = c & 31, ob = rr * 64 + cc * 2; return st * 1024 + (ob ^ (((ob >> 9) & 1) << 5)); }
__host__ __device__ __forceinline__ void stage_rc(int b, int& R, int& C) { const int st = b / 1024, sb = b % 1024, swz = sb ^ (((sb >> 9) & 1) << 5); R = (st >> 1) * 16 + swz / 64; C = (st & 1) * 32 + (swz % 64) / 2; }
__host__ __device__ __forceinline__ int perm32(int rho) { const int n = rho >> 4, i = rho & 15; return 8 * (i >> 2) + 4 * n + (i & 3); }

struct Unit { int pm, pn; };
struct Gemm { const bf16_t* A; const bf16_t* Bt; int M, N, K; };

struct StaticOrder {
    int nM, nN, nwg, G, c;
    __host__ __device__ void init(int M, int N, int G_, int c_) { nM = M / BM; nN = N / BM; nwg = nM * nN; G = G_; c = c_; }
    __host__ __device__ bool next(int i, Unit& u) const {
        const long L = (long)i * G + c; if (L >= nwg) return false;
        int wgid = (int)L; { const int q = nwg / NXCD, r = nwg % NXCD, xcd = wgid % NXCD, off = wgid / NXCD; wgid = (xcd < r ? xcd * (q + 1) : r * (q + 1) + (xcd - r) * q) + off; }
        const int nig = WGM * nN, gid = wgid / nig, fm = gid * WGM, gsz = (nM - fm) < WGM ? (nM - fm) : WGM;
        u.pm = fm + ((wgid % nig) % gsz); u.pn = (wgid % nig) / gsz; return true;
    }
    __device__ __forceinline__ void a_ready(const Unit&) const {}
    __device__ __forceinline__ void done(const Unit&) const {}
};
__device__ __forceinline__ unsigned cvt_pk_bf16(float lo, float hi) { unsigned r; asm volatile("v_cvt_pk_bf16_f32 %0, %1, %2" : "=v"(r) : "v"(lo), "v"(hi)); return r; }
typedef float f32x2 __attribute__((ext_vector_type(2)));
constexpr int MROWS = 16384, DMODEL = 1024, NPART = 16;
constexpr float NORM_EPS = 1e-6f;
__device__ __forceinline__ float row_rstd(const float* ssq, int row) {
    float s = 0.f;
#pragma unroll
    for (int p = 0; p < NPART; ++p) s += ssq[(size_t)p * MROWS + row];
    return __builtin_amdgcn_rsqf(s * (1.f / DMODEL) + NORM_EPS);
}
__device__ __forceinline__ float silu_f(float x) { return x * __builtin_amdgcn_rcpf(1.f + __expf(-x)); }

struct EpiScale {
    static constexpr bool PERM = true, AFTER_DRAIN = false;
    bf16_t* O; int ldc; const PG8_LAS float* RS; unsigned silu_mask;
    __device__ __forceinline__ void operator()(const f32x4 (&acc)[2][2][4][2], const Unit& u, int ui, int wr, int wc, int fr, int fq) const {
        const int row0 = u.pm * BM + wr * 64 + fr, col0 = u.pn * BM + wc * 32 + 8 * fq; const bool act = (silu_mask >> u.pn) & 1u;
#pragma unroll
        for (int ai = 0; ai < 2; ++ai)
#pragma unroll
            for (int m = 0; m < 4; ++m) { const int row = row0 + ai * HALF + m * 16; const float rs = RS[ui * BM + wr * 64 + fr + ai * HALF + m * 16]; bf16_t* rowp = O + (size_t)row * ldc + col0;
#pragma unroll
                for (int bj = 0; bj < 2; ++bj) { f32x4 v0 = acc[ai][bj][m][0] * rs, v1 = acc[ai][bj][m][1] * rs;
                    if (act) { v0 = (f32x4){silu_f(v0[0]), silu_f(v0[1]), silu_f(v0[2]), silu_f(v0[3])}; v1 = (f32x4){silu_f(v1[0]), silu_f(v1[1]), silu_f(v1[2]), silu_f(v1[3])}; }
                    u32x4 w; w.x = cvt_pk_bf16(v0[0], v0[1]); w.y = cvt_pk_bf16(v0[2], v0[3]); w.z = cvt_pk_bf16(v1[0], v1[1]); w.w = cvt_pk_bf16(v1[2], v1[3]);
                    *(u32x4*)(rowp + bj * HALF) = w; } __builtin_amdgcn_sched_barrier(0); }
    }
};
struct EpiRes {
    static constexpr bool PERM = true, AFTER_DRAIN = false;
    bf16_t* XB; float* ssq;
    __device__ __forceinline__ void operator()(const f32x4 (&acc)[2][2][4][2], const Unit& u, int ui, int wr, int wc, int fr, int fq) const {
        const int row0 = u.pm * BM + wr * 64 + fr, col0 = u.pn * BM + wc * 32 + 8 * fq;
#pragma unroll
        for (int ai = 0; ai < 2; ++ai)
#pragma unroll
            for (int mm = 0; mm < 4; mm += 2) {
                u32x4 rr[2][2];
#pragma unroll
                for (int q = 0; q < 2; ++q)
#pragma unroll
                    for (int bj = 0; bj < 2; ++bj) rr[q][bj] = *(const u32x4*)(XB + (size_t)(row0 + ai * HALF + (mm + q) * 16) * DMODEL + col0 + bj * HALF);
                __builtin_amdgcn_sched_barrier(0);
#pragma unroll
                for (int q = 0; q < 2; ++q) { const int m = mm + q, row = row0 + ai * HALF + m * 16; const size_t o = (size_t)row * DMODEL + col0; float sq = 0.f;
#pragma unroll
                    for (int bj = 0; bj < 2; ++bj) { const u32x4 r = rr[q][bj];
                        const f32x4 r0 = (f32x4){__builtin_bit_cast(float, r.x << 16), __builtin_bit_cast(float, r.x & 0xffff0000u), __builtin_bit_cast(float, r.y << 16), __builtin_bit_cast(float, r.y & 0xffff0000u)};
                        const f32x4 r1 = (f32x4){__builtin_bit_cast(float, r.z << 16), __builtin_bit_cast(float, r.z & 0xffff0000u), __builtin_bit_cast(float, r.w << 16), __builtin_bit_cast(float, r.w & 0xffff0000u)};
                        const f32x4 v0 = acc[ai][bj][m][0] + r0, v1 = acc[ai][bj][m][1] + r1;
                        u32x4 w; w.x = cvt_pk_bf16(v0[0], v0[1]); w.y = cvt_pk_bf16(v0[2], v0[3]); w.z = cvt_pk_bf16(v1[0], v1[1]); w.w = cvt_pk_bf16(v1[2], v1[3]);
                        *(u32x4*)(XB + o + bj * HALF) = w;
                        sq += (v0[0] * v0[0] + v0[1] * v0[1]) + (v0[2] * v0[2] + v0[3] * v0[3]) + (v1[0] * v1[0] + v1[1] * v1[1]) + (v1[2] * v1[2] + v1[3] * v1[3]); }
                    sq += __shfl_xor(sq, 16); sq += __shfl_xor(sq, 32);
                    if (fq == 0) ssq[(size_t)(u.pn * 4 + wc) * MROWS + row] = sq; }
                __builtin_amdgcn_sched_barrier(0); }
    }
};
struct EpiSwiGLU {
    static constexpr bool PERM = true, AFTER_DRAIN = false;
    bf16_t* O; int ldc; const PG8_LAS float* RS;
    __device__ __forceinline__ void operator()(const f32x4 (&acc)[2][2][4][2], const Unit& u, int ui, int wr, int wc, int fr, int fq) const {
        const int row0 = u.pm * BM + wr * 64 + fr, col0 = u.pn * HALF + wc * 32 + 8 * fq;
#pragma unroll
        for (int ai = 0; ai < 2; ++ai)
#pragma unroll
            for (int m = 0; m < 4; ++m) { const int row = row0 + ai * HALF + m * 16; const float rs = RS[ui * BM + wr * 64 + fr + ai * HALF + m * 16];
                const f32x4 g0 = acc[ai][0][m][0] * rs, g1 = acc[ai][0][m][1] * rs, u0 = acc[ai][1][m][0] * rs, u1 = acc[ai][1][m][1] * rs;
                u32x4 w; w.x = cvt_pk_bf16(silu_f(g0[0]) * u0[0], silu_f(g0[1]) * u0[1]); w.y = cvt_pk_bf16(silu_f(g0[2]) * u0[2], silu_f(g0[3]) * u0[3]);
                w.z = cvt_pk_bf16(silu_f(g1[0]) * u1[0], silu_f(g1[1]) * u1[1]); w.w = cvt_pk_bf16(silu_f(g1[2]) * u1[2], silu_f(g1[3]) * u1[3]);
                *(u32x4*)(O + (size_t)row * ldc + col0) = w; __builtin_amdgcn_sched_barrier(0); }
    }
};
template <class Sched> __device__ __forceinline__ void rstd_table(PG8_LAS float* RS, const float* ssq, const Sched& S) {
    Unit u; const int t = threadIdx.x & (BM - 1);
    for (int i = threadIdx.x >> 8; S.next(i, u); i += 2) {
        float v[NPART];
#pragma unroll
        for (int p = 0; p < NPART; ++p) v[p] = ssq[(size_t)p * MROWS + u.pm * BM + t];
        __builtin_amdgcn_sched_barrier(0);
        const float s = (((v[0] + v[1]) + (v[2] + v[3])) + ((v[4] + v[5]) + (v[6] + v[7]))) + (((v[8] + v[9]) + (v[10] + v[11])) + ((v[12] + v[13]) + (v[14] + v[15])));
        RS[i * BM + t] = __builtin_amdgcn_rsqf(s * (1.f / DMODEL) + NORM_EPS);
    }
    __syncthreads();
}
template <class Epi, class Sched, bool ALIGN_EPI = false, bool SP2 = false>
__device__ __forceinline__ void gemm_phase(PG8_LAS unsigned char* lds, const Gemm g, const Sched& S, const Epi& E) {
    int tid_ = threadIdx.x; asm volatile("" : "+v"(tid_));
    const int tid = tid_, wid = __builtin_amdgcn_readfirstlane(tid >> 6), lane = tid & 63, wr = wid >> 2, wc = wid & 3, fr = lane & 15, fq = lane >> 4;
    const int K = g.K, nt = K / BK;
    unsigned voffA[2], voffB[2];
#pragma unroll
    for (int i = 0; i < 2; ++i) { int R, C; stage_rc(tid * 16 + i * 8192, R, C); const int Rb = Epi::PERM ? ((R & ~31) + perm32(R & 31)) : R;
        voffA[i] = (unsigned)(R * K + C) * 2u; voffB[i] = (unsigned)(Rb * K + C) * 2u; }
    const size_t kstep = (size_t)(BK * 2);
    const size_t hstep = (size_t)HALF * K * 2;
    const size_t tstep = 2 * hstep;
    const unsigned ldsw = (unsigned)wid * 1024u;
    const int aoff = lds_byte(wr * 64 + fr, fq * 8), boff = lds_byte(wc * 32 + fr, fq * 8);
#define PG8_SA(b, h) (((b) * 2 + (h)) * HTB)
#define PG8_SB(b, h) ((4 + (b) * 2 + (h)) * HTB)
#define PG8_STAGE(bufoff, gbase, voff) do { _Pragma("unroll") for (int _i = 0; _i < 2; ++_i) \
        __builtin_amdgcn_global_load_lds((const unsigned*)((const char*)(gbase) + (voff)[_i]), (PG8_LAS unsigned*)(lds + (bufoff) + ldsw + _i * 8192), 16, 0, 0); } while (0)
#define PG8_LDA(dst, b, h) do { _Pragma("unroll") for (int m = 0; m < 4; ++m) _Pragma("unroll") for (int k = 0; k < 2; ++k) dst[m][k] = *(const PG8_LAS bf16x8*)(lds + PG8_SA(b, h) + aoff + m * 2048 + k * 1024); } while (0)
#define PG8_LDB(dst, b, h) do { _Pragma("unroll") for (int n = 0; n < 2; ++n) _Pragma("unroll") for (int k = 0; k < 2; ++k) dst[n][k] = *(const PG8_LAS bf16x8*)(lds + PG8_SB(b, h) + boff + n * 2048 + k * 1024); } while (0)
#define PG8_MMA(ai, bj, At, Bt) do { __builtin_amdgcn_s_setprio(1); _Pragma("unroll") for (int m = 0; m < 4; ++m) _Pragma("unroll") for (int n = 0; n < 2; ++n) _Pragma("unroll") for (int k = 0; k < 2; ++k) \
        acc[ai][bj][m][n] = __builtin_amdgcn_mfma_f32_16x16x32_bf16(Bt[n][k], At[m][k], acc[ai][bj][m][n], 0, 0, 0); __builtin_amdgcn_s_setprio(0); } while (0)
#define PG8_WAIT_V(n) asm volatile("s_waitcnt vmcnt(" #n ")" ::: "memory")
#define PG8_WAIT_L(n) asm volatile("s_waitcnt lgkmcnt(" #n ")" ::: "memory")
#define PG8_BAR __builtin_amdgcn_s_barrier()
#define PG8_SCHED __builtin_amdgcn_sched_barrier(0)
    Unit cur, nxt; int ui = 0;
    if (!S.next(0, cur)) return;
    f32x4 acc[2][2][4][2];
#pragma unroll
    for (int a = 0; a < 2; ++a)
#pragma unroll
        for (int b = 0; b < 2; ++b)
#pragma unroll
            for (int m = 0; m < 4; ++m)
#pragma unroll
                for (int n = 0; n < 2; ++n) acc[a][b][m][n] = (f32x4){0.f, 0.f, 0.f, 0.f};
    bf16x8 At[4][2], B0[2][2], B1[2][2];
    const char* cA = (const char*)g.A + (size_t)cur.pm * tstep; const char* cB = (const char*)g.Bt + (size_t)cur.pn * tstep;
    S.a_ready(cur);
    if constexpr (SP2) {
        PG8_STAGE(PG8_SB(0, 0), cB, voffB); PG8_STAGE(PG8_SB(0, 1), cB + hstep, voffB); PG8_STAGE(PG8_SA(0, 0), cA, voffA); PG8_STAGE(PG8_SA(0, 1), cA + hstep, voffA);
        if (wr == 1) PG8_BAR;
        PG8_WAIT_V(2); PG8_BAR;
        PG8_STAGE(PG8_SB(1, 0), cB + kstep, voffB); PG8_STAGE(PG8_SA(1, 0), cA + kstep, voffA); PG8_STAGE(PG8_SB(1, 1), cB + hstep + kstep, voffB);
        PG8_WAIT_V(6); PG8_BAR;
    } else {
        PG8_STAGE(PG8_SB(0, 0), cB, voffB); PG8_STAGE(PG8_SA(0, 0), cA, voffA); PG8_STAGE(PG8_SB(0, 1), cB + hstep, voffB); PG8_STAGE(PG8_SA(0, 1), cA + hstep, voffA);
        if (wr == 1) PG8_BAR;
        PG8_WAIT_V(4); PG8_BAR;
        PG8_STAGE(PG8_SB(1, 0), cB + kstep, voffB); PG8_STAGE(PG8_SA(1, 0), cA + kstep, voffA); PG8_STAGE(PG8_SB(1, 1), cB + hstep + kstep, voffB);
        PG8_WAIT_V(6); PG8_BAR;
    }
    for (;;) {
        const bool has_next = S.next(ui + 1, nxt);
        const char* nA = has_next ? (const char*)g.A + (size_t)nxt.pm * tstep : cA; const char* nB = has_next ? (const char*)g.Bt + (size_t)nxt.pn * tstep : cB;
        for (int t = 0; t < nt; t += 2) {
            const bool last = (t == nt - 2);
            const char* a1 = cA + (size_t)(t + 1) * kstep;
            const char* a2 = last ? nA : cA + (size_t)(t + 2) * kstep; const char* b2 = last ? nB : cB + (size_t)(t + 2) * kstep;
            const char* a3 = a2 + kstep; const char* b3 = b2 + kstep;
            if (last && has_next) S.a_ready(nxt);
            if constexpr (SP2) {
            PG8_LDB(B0, 0, 0); PG8_LDB(B1, 0, 1); PG8_SCHED; PG8_LDA(At, 0, 0); PG8_STAGE(PG8_SA(1, 1), a1 + hstep, voffA);
            PG8_WAIT_V(8); PG8_WAIT_L(0); PG8_BAR; PG8_MMA(0, 0, At, B0); PG8_MMA(0, 1, At, B1); PG8_BAR; PG8_SCHED;
            PG8_LDA(At, 0, 1); PG8_STAGE(PG8_SB(0, 0), b2, voffB); PG8_STAGE(PG8_SB(0, 1), b2 + hstep, voffB); PG8_STAGE(PG8_SA(0, 0), a2, voffA);
            PG8_WAIT_V(8); PG8_WAIT_L(0); PG8_BAR; PG8_MMA(1, 0, At, B0); PG8_MMA(1, 1, At, B1); PG8_BAR; PG8_SCHED;
            PG8_LDB(B0, 1, 0); PG8_LDB(B1, 1, 1); PG8_SCHED; PG8_LDA(At, 1, 0); PG8_STAGE(PG8_SA(0, 1), a2 + hstep, voffA);
            PG8_WAIT_V(8); PG8_WAIT_L(0); PG8_BAR; PG8_MMA(0, 0, At, B0); PG8_MMA(0, 1, At, B1); PG8_BAR; PG8_SCHED;
            PG8_LDA(At, 1, 1); PG8_STAGE(PG8_SB(1, 0), b3, voffB); PG8_STAGE(PG8_SB(1, 1), b3 + hstep, voffB); PG8_STAGE(PG8_SA(1, 0), a3, voffA);
            PG8_WAIT_V(8); PG8_WAIT_L(0); PG8_BAR; PG8_MMA(1, 0, At, B0); PG8_MMA(1, 1, At, B1); PG8_BAR; PG8_SCHED;
            } else {
            PG8_LDB(B0, 0, 0); PG8_SCHED; PG8_LDA(At, 0, 0); PG8_STAGE(PG8_SA(1, 1), a1 + hstep, voffA);
            PG8_WAIT_L(8); PG8_BAR; PG8_WAIT_L(0); PG8_MMA(0, 0, At, B0); PG8_BAR; PG8_SCHED;
            PG8_LDB(B1, 0, 1); PG8_STAGE(PG8_SB(0, 0), b2, voffB);
            PG8_BAR; PG8_WAIT_L(0); PG8_MMA(0, 1, At, B1); PG8_BAR;
            PG8_LDA(At, 0, 1); PG8_STAGE(PG8_SA(0, 0), a2, voffA);
            PG8_BAR; PG8_WAIT_L(0); PG8_MMA(1, 0, At, B0); PG8_BAR; PG8_SCHED;
            PG8_STAGE(PG8_SB(0, 1), b2 + hstep, voffB);
            PG8_WAIT_V(6); PG8_BAR; PG8_MMA(1, 1, At, B1); PG8_BAR;
            PG8_LDB(B0, 1, 0); PG8_SCHED; PG8_LDA(At, 1, 0); PG8_STAGE(PG8_SA(0, 1), a2 + hstep, voffA);
            PG8_WAIT_L(8); PG8_BAR; PG8_WAIT_L(0); PG8_MMA(0, 0, At, B0); PG8_BAR; PG8_SCHED;
            PG8_LDB(B1, 1, 1); PG8_STAGE(PG8_SB(1, 0), b3, voffB);
            PG8_BAR; PG8_WAIT_L(0); PG8_MMA(0, 1, At, B1); PG8_BAR;
            PG8_LDA(At, 1, 1); PG8_STAGE(PG8_SA(1, 0), a3, voffA);
            PG8_BAR; PG8_WAIT_L(0); PG8_MMA(1, 0, At, B0); PG8_BAR; PG8_SCHED;
            PG8_STAGE(PG8_SB(1, 1), b3 + hstep, voffB);
            PG8_WAIT_V(6); PG8_BAR; PG8_MMA(1, 1, At, B1); PG8_BAR;
            }
        }
        if constexpr (ALIGN_EPI) { if (wr == 0) PG8_BAR; }
        if constexpr (!Epi::AFTER_DRAIN) { E(acc, cur, ui, wr, wc, fr, fq); S.done(cur); }
        if (!has_next) break;
#pragma unroll
        for (int a = 0; a < 2; ++a)
#pragma unroll
            for (int b = 0; b < 2; ++b)
#pragma unroll
                for (int m = 0; m < 4; ++m)
#pragma unroll
                    for (int n = 0; n < 2; ++n) acc[a][b][m][n] = (f32x4){0.f, 0.f, 0.f, 0.f};
        cur = nxt; cA = nA; cB = nB; ++ui;
        if constexpr (ALIGN_EPI) { if (wr == 1) PG8_BAR; }
    }
    PG8_WAIT_V(0);
    if constexpr (!ALIGN_EPI) { if (wr == 0) PG8_BAR; }
    PG8_BAR;
    if constexpr (Epi::AFTER_DRAIN) { E.fused(acc, cur, wr, wc, fr, fq, lds, wid, lane); S.done(cur); }
#undef PG8_SA
#undef PG8_SB
#undef PG8_STAGE
#undef PG8_LDA
#undef PG8_LDB
#undef PG8_MMA
#undef PG8_WAIT_V
#undef PG8_WAIT_L
#undef PG8_BAR
#undef PG8_SCHED
}
}
#ifndef PROBE_SEL
#define PROBE_SEL (-1)
#endif
#define PT_NOW() __builtin_amdgcn_s_memrealtime()
#define LAS __attribute__((address_space(3)))
typedef unsigned short bf16;
typedef float f32x4 __attribute__((ext_vector_type(4)));
typedef short bf16x8 __attribute__((ext_vector_type(8)));
typedef unsigned u32x4 __attribute__((ext_vector_type(4)));
typedef unsigned u32x2 __attribute__((ext_vector_type(2)));
constexpr int NWAVES = 8, NTHR = 512;
constexpr int BATCH = 8, SEQ = 2048, DM = 1024, M = BATCH * SEQ, DIN = 3840, FFN = 2816, DEPTH = 2;
constexpr int C_HQ = 0, C_HFF = 512, C_HI = 1536, C_HG = 2048, C_NQ = 2560, C_NK = 2816, C_NV = 3072, C_CA = 3328, C_CG = 3584;
constexpr int NSEG = 8, SEGLEN = SEQ / NSEG, CHS = SEGLEN / 32;
constexpr float EPS = 1e-6f;
constexpr size_t MiB = 1u << 20;
constexpr size_t WS_SSQ = 1 * MiB;
constexpr size_t WS_WIN = 2 * MiB, WS_WIN_L = (size_t)DIN * DM * 2;
constexpr size_t WS_WOUT = 17 * MiB, WS_WOUT_L = (size_t)DM * DM * 2;
constexpr size_t WS_WGU = 21 * MiB, WS_WGU_L = (size_t)2 * FFN * DM * 2;
constexpr size_t WS_WDN = 43 * MiB, WS_WDN_L = (size_t)DM * FFN * 2;
constexpr size_t WS_P = 54 * MiB;
constexpr size_t WS_MIX = 174 * MiB;
constexpr size_t WS_XB = 206 * MiB;
constexpr size_t WS_SLOC = 238 * MiB;
constexpr size_t WS_DSEG = 254 * MiB;
constexpr size_t WS_END = 255 * MiB;

__device__ __forceinline__ float bf2f(unsigned short h) { return __builtin_bit_cast(float, (unsigned)h << 16); }
__device__ __forceinline__ float bflo(unsigned w) { return __builtin_bit_cast(float, w << 16); }
__device__ __forceinline__ float bfhi(unsigned w) { return __builtin_bit_cast(float, w & 0xffff0000u); }
typedef float f32x2_t __attribute__((ext_vector_type(2)));
typedef __bf16 bf16x2_t __attribute__((ext_vector_type(2)));
__device__ __forceinline__ unsigned pk2(float lo, float hi) { const f32x2_t v = {lo, hi}; const bf16x2_t b = __builtin_convertvector(v, bf16x2_t); return __builtin_bit_cast(unsigned, b); }
__device__ __forceinline__ unsigned short f2bf(float v) { return (unsigned short)(pk2(v, 0.f) & 0xffffu); }
__device__ __forceinline__ float wave_sum(float v) {
#pragma unroll
    for (int o = 1; o < 64; o <<= 1) v += __shfl_xor(v, o);
    return v;
}
__device__ __forceinline__ float sigm(float x) { return __builtin_amdgcn_rcpf(1.f + __expf(-x)); }
__device__ __forceinline__ float silu_f0(float x) { return x * sigm(x); }
__device__ __forceinline__ f32x4 mfma16(bf16x8 a, bf16x8 b, f32x4 c) { return __builtin_amdgcn_mfma_f32_16x16x32_bf16(a, b, c, 0, 0, 0); }
#define LDS_WAIT() asm volatile("s_waitcnt lgkmcnt(0)" ::: "memory")

struct Params {
    const float *x, *mix_g, *w_in, *hg_lb, *hg_ng, *rpb, *cw, *cb, *lng, *lnb, *w_out, *ffn_g, *w_gu, *w_dn, *fin_g;
    float* out; unsigned char* ws;
};

__device__ __forceinline__ void transpose_item(const float* W, int K, int N, bf16* WT, const float* gk, bool gu, LAS float* scr, int item, int lane) {
    const int nblk = N / 32, kb = item / nblk, nb = item % nblk, k0 = 64 * kb, n0 = 32 * nb;
    float wv[32];
#pragma unroll
    for (int i = 0; i < 32; ++i) { const int kk = 2 * i + (lane >> 5); wv[i] = W[(size_t)(k0 + kk) * N + n0 + (lane & 31)]; }
    const float gs = gk ? gk[k0 + lane] : 1.f;
    __builtin_amdgcn_sched_barrier(0);
#pragma unroll
    for (int i = 0; i < 32; ++i) { const int kk = 2 * i + (lane >> 5); scr[kk * 33 + (lane & 31)] = wv[i] * __shfl(gs, kk); }
    LDS_WAIT(); asm volatile("" ::: "memory");
    const int c = lane & 7;
    int r0 = n0;
    if (gu) { const int up = n0 >= FFN ? 1 : 0, cc = n0 - up * FFN; r0 = 256 * (cc >> 7) + (cc & 127) + up * 128; }
#pragma unroll
    for (int j = 0; j < 4; ++j) { const int n = (lane >> 3) + 8 * j; const LAS float* s = scr + (8 * c) * 33 + n;
        u32x4 o; o.x = pk2(s[0 * 33], s[1 * 33]); o.y = pk2(s[2 * 33], s[3 * 33]); o.z = pk2(s[4 * 33], s[5 * 33]); o.w = pk2(s[6 * 33], s[7 * 33]);
        *(u32x4*)(WT + (size_t)(r0 + n) * K + k0 + 8 * c) = o; }
    LDS_WAIT(); asm volatile("" ::: "memory");
}
__device__ __forceinline__ void prologue(const Params& p, LAS unsigned char* lds, int gw, int NGW, int wave, int lane) {
    LAS float* scr = (LAS float*)(lds + wave * 16384);
    constexpr int I_IN = (DM / 64) * (DIN / 32), I_OUT = (DM / 64) * (DM / 32), I_GU = (DM / 64) * (2 * FFN / 32), I_DN = (FFN / 64) * (DM / 32), I_L = I_IN + I_OUT + I_GU + I_DN;
    for (int it = gw; it < DEPTH * I_L; it += NGW) {
        const int l = it / I_L; int r = it % I_L;
        if (r < I_IN) { transpose_item(p.w_in + (size_t)l * DM * DIN, DM, DIN, (bf16*)(p.ws + WS_WIN + l * WS_WIN_L), p.mix_g + l * DM, false, scr, r, lane); continue; } r -= I_IN;
        if (r < I_OUT) { transpose_item(p.w_out + (size_t)l * DM * DM, DM, DM, (bf16*)(p.ws + WS_WOUT + l * WS_WOUT_L), nullptr, false, scr, r, lane); continue; } r -= I_OUT;
        if (r < I_GU) { transpose_item(p.w_gu + (size_t)l * DM * 2 * FFN, DM, 2 * FFN, (bf16*)(p.ws + WS_WGU + l * WS_WGU_L), p.ffn_g + l * DM, true, scr, r, lane); continue; } r -= I_GU;
        transpose_item(p.w_dn + (size_t)l * FFN * DM, FFN, DM, (bf16*)(p.ws + WS_WDN + l * WS_WDN_L), nullptr, false, scr, r, lane);
    }
    bf16* XB = (bf16*)(p.ws + WS_XB); float* ssq = (float*)(p.ws + WS_SSQ);
    for (int m = gw; m < M; m += 2 * NGW) {
        const int m2 = m + NGW;
        const f32x4* xa = (const f32x4*)(p.x + (size_t)m * DM) + lane; const f32x4* xc = (const f32x4*)(p.x + (size_t)(m2 < M ? m2 : m) * DM) + lane;
        f32x4 va[4], vc[4];
#pragma unroll
        for (int j = 0; j < 4; ++j) { va[j] = xa[64 * j]; vc[j] = xc[64 * j]; }
        __builtin_amdgcn_sched_barrier(0);
        float sa = 0.f, sc = 0.f;
        unsigned long long* oa = (unsigned long long*)(XB + (size_t)m * DM) + lane; unsigned long long* oc = (unsigned long long*)(XB + (size_t)m2 * DM) + lane;
#pragma unroll
        for (int j = 0; j < 4; ++j) { sa += (va[j].x * va[j].x + va[j].y * va[j].y) + (va[j].z * va[j].z + va[j].w * va[j].w); sc += (vc[j].x * vc[j].x + vc[j].y * vc[j].y) + (vc[j].z * vc[j].z + vc[j].w * vc[j].w);
            oa[64 * j] = (unsigned long long)pk2(va[j].x, va[j].y) | ((unsigned long long)pk2(va[j].z, va[j].w) << 32);
            if (m2 < M) oc[64 * j] = (unsigned long long)pk2(vc[j].x, vc[j].y) | ((unsigned long long)pk2(vc[j].z, vc[j].w) << 32); }
        sa = wave_sum(sa); sc = wave_sum(sc);
        if (lane < 16) { ssq[(size_t)lane * M + m] = lane == 0 ? sa : 0.f; if (m2 < M) ssq[(size_t)lane * M + m2] = lane == 0 ? sc : 0.f; }
    }
}

constexpr int HS_SET = 37888, HQ_OFF = 0, HK_OFF = 8704, HKH_OFF = 17408, HV_OFF = 27648;
constexpr int HOS_OFF = 2 * HS_SET, HOS_SZ = 16896, HDEC_OFF = HOS_OFF + 2 * HOS_SZ;
#define WG_BAR() asm volatile("s_waitcnt lgkmcnt(0)\n\ts_barrier" ::: "memory")
template <bool FULL, bool SECOND>
__device__ __forceinline__ void hg_segment(LAS unsigned char* lds, const bf16* P, int b, int h, int dir, int seg, float lb, f32x4 (&S)[8], float& bsum,
                                           float* OP, bf16* MIXED, const float* norm_g) {
    int tid_ = threadIdx.x; asm volatile("" : "+v"(tid_)); const int tid = tid_, w = __builtin_amdgcn_readfirstlane(tid >> 6), lane = tid & 63, fr = lane & 15, fq = lane >> 4;
    const int d = 16 * w + (lane & 15), grp = lane >> 4;
    const int zcol = C_HFF + dir * 512 + h * 128 + d, qcol = C_HQ + h * 128 + d, vcol = C_HI + h * 128 + d;
    const float oml = 1.f - lb;
    const int ts = dir == 0 ? 1 : -1, tb0 = dir == 0 ? seg * SEGLEN : (seg * SEGLEN + SEGLEN - 1);
    const long rstep = (long)ts * DIN;
    const int fc = tid >> 4, dvg = tid & 15;
    f32x4 ng0 = (f32x4){0.f, 0.f, 0.f, 0.f}, ng1 = ng0;
    if (FULL && SECOND) { ng0 = *(const f32x4*)(norm_g + 8 * dvg); ng1 = *(const f32x4*)(norm_g + 8 * dvg + 4); }
    unsigned short zn[8], qn[8], vn[8];
#define HG_LOAD(n_) do { const bf16* rowp_ = P + (size_t)(b * SEQ + tb0 + ts * (32 * (n_) + 8 * grp)) * DIN; \
        _Pragma("unroll") for (int e = 0; e < 8; ++e) { const bf16* r_ = rowp_ + rstep * e; zn[e] = r_[zcol]; if (FULL) qn[e] = r_[qcol]; else qn[e] = 0; vn[e] = r_[vcol]; } } while (0)
#define HG_PREP(s_) do { LAS unsigned char* set_ = lds + (s_) * HS_SET; LAS bf16* QT_ = (LAS bf16*)(set_ + HQ_OFF); LAS bf16* KT_ = (LAS bf16*)(set_ + HK_OFF); \
        float El[8], kv[8]; float run = 1.f; \
        _Pragma("unroll") for (int e = 0; e < 8; ++e) { float z = bf2f(zn[e]); z = fminf(fmaxf(z, -40.f), 40.f); \
            const float ez = __expf(-z), inv = __builtin_amdgcn_rcpf(1.f + ez); run *= lb + oml * inv; El[e] = run; kv[e] = oml * (ez * inv); } \
        float pre = 1.f, tot = 1.f; \
        _Pragma("unroll") for (int g2 = 0; g2 < 4; ++g2) { const float t = __shfl(run, (g2 << 4) | (lane & 15)); tot *= t; if (g2 < grp) pre *= t; } \
        unsigned khp[4], vvp[4]; \
        _Pragma("unroll") for (int e = 0; e < 8; e += 2) { const float E0 = pre * El[e], E1 = pre * El[e + 1], r0 = __builtin_amdgcn_rcpf(E0), r1 = __builtin_amdgcn_rcpf(E1); \
            if (FULL) { const int c0 = 8 * grp + e; QT_[c0 * 136 + d] = f2bf(bf2f(qn[e]) * E0); QT_[(c0 + 1) * 136 + d] = f2bf(bf2f(qn[e + 1]) * E1); \
                KT_[c0 * 136 + d] = f2bf(kv[e] * r0); KT_[(c0 + 1) * 136 + d] = f2bf(kv[e + 1] * r1); } \
            khp[e >> 1] = pk2(kv[e] * (tot * r0), kv[e + 1] * (tot * r1)); vvp[e >> 1] = (unsigned)vn[e] | ((unsigned)vn[e + 1] << 16); } \
        *(LAS u32x4*)((LAS bf16*)(set_ + HKH_OFF) + d * 40 + 8 * grp) = (u32x4){khp[0], khp[1], khp[2], khp[3]}; \
        *(LAS u32x4*)((LAS bf16*)(set_ + HV_OFF) + d * 40 + 8 * grp) = (u32x4){vvp[0], vvp[1], vvp[2], vvp[3]}; \
        if (grp == 0) { ((LAS float*)(lds + HDEC_OFF))[(s_) * 128 + d] = tot; bsum *= tot; } } while (0)
    HG_LOAD(0);
    __builtin_amdgcn_sched_barrier(0);
    HG_PREP(0);
    __builtin_amdgcn_sched_barrier(0);
    if (CHS > 1) HG_LOAD(1);
    WG_BAR();
#pragma unroll 1
    for (int n = 0; n < CHS; ++n) {
        const int tb = tb0 + ts * 32 * n, cs = n & 1;
        const int ftok = tb + ts * fc;
        f32x4 op0 = (f32x4){0.f, 0.f, 0.f, 0.f}, op1 = op0; u32x4 gw4 = (u32x4){0u, 0u, 0u, 0u};
        float* op = OP + ((size_t)((b * 4 + h) * SEQ + ftok)) * 128 + 8 * dvg;
        if (FULL && SECOND) { op0 = *(const f32x4*)op; op1 = *(const f32x4*)(op + 4); gw4 = *(const u32x4*)(P + (size_t)(b * SEQ + ftok) * DIN + C_HG + h * 128 + 8 * dvg); }
        __builtin_amdgcn_sched_barrier(0);
        if (n + 1 < CHS) { HG_PREP(cs ^ 1); __builtin_amdgcn_sched_barrier(0); if (n + 2 < CHS) HG_LOAD(n + 2); }
        LAS unsigned char* set = lds + cs * HS_SET;
        LAS bf16* QT = (LAS bf16*)(set + HQ_OFF); LAS bf16* KT = (LAS bf16*)(set + HK_OFF); LAS bf16* KHT = (LAS bf16*)(set + HKH_OFF); LAS bf16* VT = (LAS bf16*)(set + HV_OFF);
        LAS float* OS = (LAS float*)(lds + HOS_OFF + cs * HOS_SZ); LAS float* DEC = (LAS float*)(lds + HDEC_OFF) + cs * 128;
        if (FULL) {
            f32x4 p00 = (f32x4){0.f, 0.f, 0.f, 0.f}, p01 = p00, p11 = p00;
#pragma unroll
            for (int ks = 0; ks < 4; ++ks) {
                const bf16x8 k0 = *(const LAS bf16x8*)(KT + fr * 136 + 32 * ks + 8 * fq), k1 = *(const LAS bf16x8*)(KT + (16 + fr) * 136 + 32 * ks + 8 * fq);
                const bf16x8 q0 = *(const LAS bf16x8*)(QT + fr * 136 + 32 * ks + 8 * fq), q1 = *(const LAS bf16x8*)(QT + (16 + fr) * 136 + 32 * ks + 8 * fq);
                p00 = mfma16(k0, q0, p00); p01 = mfma16(k0, q1, p01); p11 = mfma16(k1, q1, p11); }
#pragma unroll
            for (int i = 0; i < 4; ++i) { const bool keep = 4 * fq + i <= fr; p00[i] = keep ? p00[i] : 0.f; p11[i] = keep ? p11[i] : 0.f; }
            const bf16x8 pf0 = __builtin_bit_cast(bf16x8, (u32x4){pk2(p00[0], p00[1]), pk2(p00[2], p00[3]), 0u, 0u});
            const bf16x8 pf1 = __builtin_bit_cast(bf16x8, (u32x4){pk2(p01[0], p01[1]), pk2(p01[2], p01[3]), pk2(p11[0], p11[1]), pk2(p11[2], p11[3])});
            f32x4 o0 = (f32x4){0.f, 0.f, 0.f, 0.f}, o1 = o0;
#pragma unroll
            for (int ks = 0; ks < 4; ++ks) {
                const bf16x8 sa = __builtin_bit_cast(bf16x8, (u32x4){pk2(S[2 * ks][0], S[2 * ks][1]), pk2(S[2 * ks][2], S[2 * ks][3]), pk2(S[2 * ks + 1][0], S[2 * ks + 1][1]), pk2(S[2 * ks + 1][2], S[2 * ks + 1][3])});
                const u32x2 a0 = *(const LAS u32x2*)(QT + fr * 136 + 32 * ks + 4 * fq), a1 = *(const LAS u32x2*)(QT + fr * 136 + 32 * ks + 16 + 4 * fq);
                const u32x2 c0 = *(const LAS u32x2*)(QT + (16 + fr) * 136 + 32 * ks + 4 * fq), c1 = *(const LAS u32x2*)(QT + (16 + fr) * 136 + 32 * ks + 16 + 4 * fq);
                o0 = mfma16(sa, __builtin_bit_cast(bf16x8, (u32x4){a0.x, a0.y, a1.x, a1.y}), o0);
                o1 = mfma16(sa, __builtin_bit_cast(bf16x8, (u32x4){c0.x, c0.y, c1.x, c1.y}), o1); }
            { const u32x2 v0 = *(const LAS u32x2*)(VT + (16 * w + fr) * 40 + 4 * fq), v1 = *(const LAS u32x2*)(VT + (16 * w + fr) * 40 + 16 + 4 * fq);
              const bf16x8 va = __builtin_bit_cast(bf16x8, (u32x4){v0.x, v0.y, v1.x, v1.y});
              o0 = mfma16(va, pf0, o0); o1 = mfma16(va, pf1, o1); }
            *(LAS f32x4*)(OS + fr * 132 + 16 * w + 4 * fq) = o0; *(LAS f32x4*)(OS + (16 + fr) * 132 + 16 * w + 4 * fq) = o1;
        }
        { const bf16x8 vfr = *(const LAS bf16x8*)(VT + (16 * w + fr) * 40 + 8 * fq);
#pragma unroll
          for (int i = 0; i < 8; ++i) { const f32x4 dv4 = *(const LAS f32x4*)(DEC + 16 * i + 4 * fq); S[i] = S[i] * dv4;
              S[i] = mfma16(*(const LAS bf16x8*)(KHT + (16 * i + fr) * 40 + 8 * fq), vfr, S[i]); } }
        WG_BAR();
        if (FULL) {
            f32x4 o0 = *(const LAS f32x4*)(OS + fc * 132 + 8 * dvg), o1 = *(const LAS f32x4*)(OS + fc * 132 + 8 * dvg + 4);
            if (!SECOND) { *(f32x4*)op = o0; *(f32x4*)(op + 4) = o1; }
            else { o0 = o0 + op0; o1 = o1 + op1;
                float sq = (o0[0] * o0[0] + o0[1] * o0[1]) + (o0[2] * o0[2] + o0[3] * o0[3]) + (o1[0] * o1[0] + o1[1] * o1[1]) + (o1[2] * o1[2] + o1[3] * o1[3]);
                sq += __shfl_xor(sq, 1); sq += __shfl_xor(sq, 2); sq += __shfl_xor(sq, 4); sq += __shfl_xor(sq, 8);
                const float rs = __builtin_amdgcn_rsqf(sq * (1.f / 128.f) + EPS);
                u32x4 ow; ow.x = pk2(o0[0] * rs * ng0[0] * bflo(gw4.x), o0[1] * rs * ng0[1] * bfhi(gw4.x));
                ow.y = pk2(o0[2] * rs * ng0[2] * bflo(gw4.y), o0[3] * rs * ng0[3] * bfhi(gw4.y));
                ow.z = pk2(o1[0] * rs * ng1[0] * bflo(gw4.z), o1[1] * rs * ng1[1] * bfhi(gw4.z));
                ow.w = pk2(o1[2] * rs * ng1[2] * bflo(gw4.w), o1[3] * rs * ng1[3] * bfhi(gw4.w));
                *(u32x4*)(MIXED + (size_t)(b * SEQ + ftok) * DM + h * 128 + 8 * dvg) = ow; }
        }
    }
    WG_BAR();
#undef HG_LOAD
#undef HG_PREP
}
__device__ __forceinline__ float hg_lb(const float* hg_lb_all, int layer, int dir, int ch) {
    if (layer == 0) return 0.f;
    const float a0 = hg_lb_all[(0 * 2 + dir) * 512 + ch], a1 = hg_lb_all[(1 * 2 + dir) * 512 + ch], mx = fmaxf(a0, a1), e0 = __expf(a0 - mx), e1 = __expf(a1 - mx);
    return e1 / (e0 + e1);
}
__device__ __forceinline__ void hg_passA_item(LAS unsigned char* lds, const Params& p, int layer, int item) {
    const int dir = item & 1, seg = (item >> 1) & (NSEG - 1), h = (item >> 4) & 3, b = item >> 6;
    if ((dir == 0 && seg == NSEG - 1) || (dir == 1 && seg == 0)) return;
    int tid_ = threadIdx.x; asm volatile("" : "+v"(tid_)); const int tid = tid_, w = __builtin_amdgcn_readfirstlane(tid >> 6), lane = tid & 63;
    const float lb = hg_lb(p.hg_lb, layer, dir, h * 128 + 16 * w + (lane & 15));
    f32x4 S[8];
#pragma unroll
    for (int i = 0; i < 8; ++i) S[i] = (f32x4){0.f, 0.f, 0.f, 0.f};
    float bsum = 1.f;
    hg_segment<false, false>(lds, (const bf16*)(p.ws + WS_P), b, h, dir, seg, lb, S, bsum, nullptr, nullptr, nullptr);
    u32x2* sl = (u32x2*)(p.ws + WS_SLOC) + (size_t)item * 4096;
#pragma unroll
    for (int i = 0; i < 8; ++i) sl[(w * 8 + i) * 64 + lane] = (u32x2){pk2(S[i][0], S[i][1]), pk2(S[i][2], S[i][3])};
    if (lane < 16) ((float*)(p.ws + WS_DSEG))[(size_t)item * 128 + 16 * w + (lane & 15)] = bsum;
    __syncthreads();
}
__device__ __forceinline__ unsigned long long hg_passB_item(LAS unsigned char* lds, const Params& p, int layer, int item) {
    unsigned long long tsub = 0, t0_ = 0;
    const int seg = item & (NSEG - 1), h = (item >> 3) & 3, b = item >> 5;
    int tid_ = threadIdx.x; asm volatile("" : "+v"(tid_)); const int tid = tid_, w = __builtin_amdgcn_readfirstlane(tid >> 6), lane = tid & 63, fr = lane & 15, fq = lane >> 4;
    const u32x2* slb = (const u32x2*)(p.ws + WS_SLOC); const float* dsg = (const float*)(p.ws + WS_DSEG);
    float* OP = p.out;   bf16* MIXED = (bf16*)(p.ws + WS_MIX); const bf16* P = (const bf16*)(p.ws + WS_P);
#pragma unroll 1
    for (int dir = 0; dir < 2; ++dir) {
        const float lb = hg_lb(p.hg_lb, layer, dir, h * 128 + 16 * w + (lane & 15));
        f32x4 S[8];
#pragma unroll
        for (int i = 0; i < 8; ++i) S[i] = (f32x4){0.f, 0.f, 0.f, 0.f};
        const int nprev = dir == 0 ? seg : (NSEG - 1 - seg);
        if (PROBE_SEL == 11) t0_ = PT_NOW();
#pragma unroll 1
        for (int q = 0; q < nprev; q += 2) {
            const bool two = q + 1 < nprev; const int sA = dir == 0 ? q : (NSEG - 1 - q), sB = two ? (dir == 0 ? q + 1 : (NSEG - 2 - q)) : sA;
            const int itA = ((b * 4 + h) * NSEG + sA) * 2 + dir, itB = ((b * 4 + h) * NSEG + sB) * 2 + dir;
            const u32x2* slA = slb + (size_t)itA * 4096; const float* dcA = dsg + (size_t)itA * 128; const u32x2* slB = slb + (size_t)itB * 4096; const float* dcB = dsg + (size_t)itB * 128;
            f32x4 dvA[8], dvB[8]; u32x2 svA[8], svB[8];
#pragma unroll
            for (int i = 0; i < 8; ++i) { dvA[i] = *(const f32x4*)(dcA + 16 * i + 4 * fq); svA[i] = slA[(w * 8 + i) * 64 + lane]; dvB[i] = *(const f32x4*)(dcB + 16 * i + 4 * fq); svB[i] = slB[(w * 8 + i) * 64 + lane]; }
            __builtin_amdgcn_sched_barrier(0);
#pragma unroll
            for (int i = 0; i < 8; ++i) { S[i] = S[i] * dvA[i] + (f32x4){bflo(svA[i].x), bfhi(svA[i].x), bflo(svA[i].y), bfhi(svA[i].y)};
                if (two) S[i] = S[i] * dvB[i] + (f32x4){bflo(svB[i].x), bfhi(svB[i].x), bflo(svB[i].y), bfhi(svB[i].y)}; } }
        if (PROBE_SEL == 11) tsub += PT_NOW() - t0_;
        if (PROBE_SEL == 10) t0_ = PT_NOW();
        float bsum = 1.f;
        if (dir == 0) hg_segment<true, false>(lds, P, b, h, 0, seg, lb, S, bsum, OP, MIXED, p.hg_ng + layer * 128);
        else hg_segment<true, true>(lds, P, b, h, 1, seg, lb, S, bsum, OP, MIXED, p.hg_ng + layer * 128);
        if (PROBE_SEL == 10) tsub += PT_NOW() - t0_;
        if (PROBE_SEL == 12) t0_ = PT_NOW();
        __syncthreads();
        if (PROBE_SEL == 12) tsub += PT_NOW() - t0_;
    }
    return tsub;
}

constexpr int NA_KS = 584, NA_RPB_OFF = 64 * NA_KS * 2;
__device__ __forceinline__ int clampi(int v, int lo, int hi) { return v < lo ? lo : (v > hi ? hi : v); }
__device__ __forceinline__ void na_item(LAS unsigned char* lds, const Params& p, int layer, int item) {
    const int rp = item & 15, h = (item >> 4) & 3, b = item >> 6, r0 = 2 * rp, kbase = clampi(r0 - 4, 0, 24);
    int tid_ = threadIdx.x; asm volatile("" : "+v"(tid_)); const int tid = tid_, w = __builtin_amdgcn_readfirstlane(tid >> 6), lane = tid & 63, fr = lane & 15, fq = lane >> 4;
    const bf16* P = (const bf16*)(p.ws + WS_P); bf16* MIXED = (bf16*)(p.ws + WS_MIX);
    LAS bf16* VT = (LAS bf16*)lds; LAS float* RPB = (LAS float*)(lds + NA_RPB_OFF);
    const int rl = w >> 2, j = w & 3, r = r0 + rl, kr0 = clampi(r - 4, 0, 24), kc0 = clampi(16 * j - 8, 0, 32);
    const size_t qtok = (size_t)b * SEQ + r * 64 + 16 * j + fr;
    u32x4 vbuf[9];
#pragma unroll
    for (int it = 0; it < 9; ++it) { const int u = it * NTHR + tid, key = u >> 3, dg = u & 7; int trow = kbase * 64 + key; trow = trow > SEQ - 1 ? SEQ - 1 : trow;
        vbuf[it] = *(const u32x4*)(P + (size_t)(b * SEQ + trow) * DIN + C_NV + h * 64 + 8 * dg); }
    bf16x8 qf[2], kfa[16], kfb[16];
#pragma unroll
    for (int ks = 0; ks < 2; ++ks) qf[ks] = *(const bf16x8*)(P + qtok * DIN + C_NQ + h * 64 + 32 * ks + 8 * fq);
#define NA_KLOAD(dst, hh) do { _Pragma("unroll") for (int k8 = 0; k8 < 8; ++k8) { const int kt = (hh) * 8 + k8, krl = kt >> 1, half = kt & 1; \
        const size_t ktok = (size_t)b * SEQ + (kr0 + krl) * 64 + kc0 + 16 * half + fr; \
        _Pragma("unroll") for (int ks = 0; ks < 2; ++ks) dst[k8 * 2 + ks] = *(const bf16x8*)(P + ktok * DIN + C_NK + h * 64 + 32 * ks + 8 * fq); } } while (0)
    NA_KLOAD(kfa, 0);
    __builtin_amdgcn_sched_barrier(0);
#pragma unroll
    for (int it = 0; it < 9; ++it) { const int u = it * NTHR + tid, key = u >> 3, dg = u & 7; const u32x4 v = vbuf[it];
        LAS bf16* dst = VT + (8 * dg) * NA_KS + key;
        dst[0 * NA_KS] = (bf16)(v.x & 0xffffu); dst[1 * NA_KS] = (bf16)(v.x >> 16); dst[2 * NA_KS] = (bf16)(v.y & 0xffffu); dst[3 * NA_KS] = (bf16)(v.y >> 16);
        dst[4 * NA_KS] = (bf16)(v.z & 0xffffu); dst[5 * NA_KS] = (bf16)(v.z >> 16); dst[6 * NA_KS] = (bf16)(v.w & 0xffffu); dst[7 * NA_KS] = (bf16)(v.w >> 16); }
    for (int i = tid; i < 465; i += NTHR) RPB[i] = p.rpb[(size_t)(layer * 4 + h) * 465 + i];
    NA_KLOAD(kfb, 1);
    __builtin_amdgcn_sched_barrier(0);
    WG_BAR();
    f32x4 s[16];
#pragma unroll
    for (int k8 = 0; k8 < 8; ++k8) { f32x4 a = (f32x4){0.f, 0.f, 0.f, 0.f};
#pragma unroll
        for (int ks = 0; ks < 2; ++ks) a = mfma16(kfa[k8 * 2 + ks], qf[ks], a);
        s[k8] = a; }
#pragma unroll
    for (int k8 = 0; k8 < 8; ++k8) { f32x4 a = (f32x4){0.f, 0.f, 0.f, 0.f};
#pragma unroll
        for (int ks = 0; ks < 2; ++ks) a = mfma16(kfb[k8 * 2 + ks], qf[ks], a);
        s[8 + k8] = a; }
#undef NA_KLOAD
    const int qc = 16 * j + fr, qs = clampi(qc - 8, 0, 48);
    float mx = -1e30f;
#pragma unroll
    for (int kt = 0; kt < 16; ++kt) { const int krl = kt >> 1, half = kt & 1; const int ridx = kr0 + krl - r + 7;
#pragma unroll
        for (int i = 0; i < 4; ++i) { const int kc = kc0 + 16 * half + 4 * fq + i; const bool valid = kc >= qs && kc < qs + 16; const int cidx = clampi(kc - qc + 15, 0, 30);
            const float v = valid ? s[kt][i] * 0.125f + RPB[ridx * 31 + cidx] : -1e30f; s[kt][i] = v; mx = fmaxf(mx, v); } }
    mx = fmaxf(mx, __shfl_xor(mx, 16)); mx = fmaxf(mx, __shfl_xor(mx, 32));
    float sum = 0.f;
#pragma unroll
    for (int kt = 0; kt < 16; ++kt)
#pragma unroll
        for (int i = 0; i < 4; ++i) { const float e = __expf(s[kt][i] - mx); s[kt][i] = e; sum += e; }
    sum += __shfl_xor(sum, 16); sum += __shfl_xor(sum, 32);
    f32x4 o[4];
#pragma unroll
    for (int dt = 0; dt < 4; ++dt) o[dt] = (f32x4){0.f, 0.f, 0.f, 0.f};
#pragma unroll
    for (int kk = 0; kk < 8; ++kk) {
        const u32x4 pw = (u32x4){pk2(s[2 * kk][0], s[2 * kk][1]), pk2(s[2 * kk][2], s[2 * kk][3]), pk2(s[2 * kk + 1][0], s[2 * kk + 1][1]), pk2(s[2 * kk + 1][2], s[2 * kk + 1][3])};
        const bf16x8 pf = __builtin_bit_cast(bf16x8, pw);
        const int keyoff = (kr0 + kk - kbase) * 64 + kc0 + 4 * fq;
#pragma unroll
        for (int dt = 0; dt < 4; ++dt) { const u32x2 lo = *(const LAS u32x2*)(VT + (16 * dt + fr) * NA_KS + keyoff), hi = *(const LAS u32x2*)(VT + (16 * dt + fr) * NA_KS + keyoff + 16);
            const bf16x8 vf = __builtin_bit_cast(bf16x8, (u32x4){lo.x, lo.y, hi.x, hi.y});
            o[dt] = mfma16(vf, pf, o[dt]); } }
    const float inv = 1.f / sum;
#pragma unroll
    for (int dt = 0; dt < 4; ++dt) *(u32x2*)(MIXED + qtok * DM + 512 + h * 64 + 16 * dt + 4 * fq) = (u32x2){pk2(o[dt][0] * inv, o[dt][1] * inv), pk2(o[dt][2] * inv, o[dt][3] * inv)};
    WG_BAR();
}

__device__ __forceinline__ void conv_item(LAS unsigned char* lds, const Params& p, int layer, int item) {
    const int b = item >> 6, t0 = (item & 63) * 32;
    int tid_ = threadIdx.x; asm volatile("" : "+v"(tid_)); const int tid = tid_, w = __builtin_amdgcn_readfirstlane(tid >> 6), lane = tid & 63;
    const bf16* P = (const bf16*)(p.ws + WS_P); bf16* MIXED = (bf16*)(p.ws + WS_MIX);
    LAS float* U = (LAS float*)lds; LAS float* CO = U + 62 * 256;
    u32x4 ca4[4], cg4[4];
#pragma unroll
    for (int it = 0; it < 4; ++it) { const int u = it * NTHR + tid, tt = u >> 5, c8 = u & 31, t = t0 - 15 + tt; ca4[it] = (u32x4){0u, 0u, 0u, 0u}; cg4[it] = ca4[it];
        if (u < 62 * 32 && t >= 0 && t < SEQ) { const bf16* rp = P + (size_t)(b * SEQ + t) * DIN; ca4[it] = *(const u32x4*)(rp + C_CA + 8 * c8); cg4[it] = *(const u32x4*)(rp + C_CG + 8 * c8); } }
    const int c = tid & 255, half = tid >> 8;
    float wk[31];
#pragma unroll
    for (int k = 0; k < 31; ++k) wk[k] = p.cw[(size_t)(layer * 31 + k) * 256 + c];
    const float bias = p.cb[layer * 256 + c];
    __builtin_amdgcn_sched_barrier(0);
#pragma unroll
    for (int it = 0; it < 4; ++it) { const int u = it * NTHR + tid, tt = u >> 5, c8 = u & 31; const u32x4 a = ca4[it], g = cg4[it];
        if (u < 62 * 32) {
            const f32x4 u0 = (f32x4){bflo(a.x) * sigm(bflo(g.x)), bfhi(a.x) * sigm(bfhi(g.x)), bflo(a.y) * sigm(bflo(g.y)), bfhi(a.y) * sigm(bfhi(g.y))};
            const f32x4 u1 = (f32x4){bflo(a.z) * sigm(bflo(g.z)), bfhi(a.z) * sigm(bfhi(g.z)), bflo(a.w) * sigm(bflo(g.w)), bfhi(a.w) * sigm(bfhi(g.w))};
            *(LAS f32x4*)(U + tt * 256 + 8 * c8) = u0; *(LAS f32x4*)(U + tt * 256 + 8 * c8 + 4) = u1; } }
    WG_BAR();
#pragma unroll 1
    for (int g = 0; g < 2; ++g) { const int base = 16 * half + 8 * g; float win[38];
#pragma unroll
        for (int i = 0; i < 38; ++i) win[i] = U[(base + i) * 256 + c];
#pragma unroll
        for (int o = 0; o < 8; ++o) { float a = bias;
#pragma unroll
            for (int k = 0; k < 31; ++k) a += wk[k] * win[o + k];
            CO[(base + o) * 256 + c] = a; } }
    __syncthreads();
    const f32x4 lg = *(const f32x4*)(p.lng + layer * 256 + 4 * lane), lbv = *(const f32x4*)(p.lnb + layer * 256 + 4 * lane);
#pragma unroll
    for (int q = 0; q < 4; ++q) { const int tl = 4 * w + q; const f32x4 v = *(const LAS f32x4*)(CO + tl * 256 + 4 * lane);
        const float mean = wave_sum((v.x + v.y) + (v.z + v.w)) * (1.f / 256.f); const f32x4 dd = v - mean;
        const float var = wave_sum((dd.x * dd.x + dd.y * dd.y) + (dd.z * dd.z + dd.w * dd.w)) * (1.f / 256.f); const float rs = __builtin_amdgcn_rsqf(var + EPS);
        f32x4 y = dd * rs * lg + lbv; y = (f32x4){silu_f0(y.x), silu_f0(y.y), silu_f0(y.z), silu_f0(y.w)};
        *(u32x2*)(MIXED + (size_t)(b * SEQ + t0 + tl) * DM + 768 + 4 * lane) = (u32x2){pk2(y.x, y.y), pk2(y.z, y.w)}; }
    __syncthreads();
}

#define XB_TMO      128
#define XB_XCNT(j)  (256  + 64 * (j))
#define XB_XSUB(j)  (1280 + 64 * (j))
#define XB_XGEN(j)  (2304 + 64 * (j))
#define XB_TOP      3328
#define XB_TOPGEN   3392
#define XCD_BAR_WORDS 3456
#define XB_SPIN_CAP (1u << 18)

__device__ __forceinline__ unsigned xb_ld(unsigned* p)              { return __hip_atomic_load(p, __ATOMIC_RELAXED, __HIP_MEMORY_SCOPE_AGENT); }
__device__ __forceinline__ unsigned xb_add(unsigned* p, unsigned v) { return __hip_atomic_fetch_add(p, v, __ATOMIC_RELAXED, __HIP_MEMORY_SCOPE_AGENT); }
__device__ __forceinline__ unsigned xb_xcc_id() { return (unsigned)__builtin_amdgcn_s_getreg((3 << 11) | 20) & 0xFu; }
#define XB_SPIN(cond, bar) do { unsigned _sp = 0; while (cond) { __builtin_amdgcn_s_sleep(1); \
    if ((++_sp & 255u) == 0u) { if (xb_ld(&(bar)[XB_TMO])) break; if (_sp > XB_SPIN_CAP) { atomicAdd(&(bar)[XB_TMO], 1u); break; } } } } while (0)

struct XcdBarrier {
    unsigned* bar; unsigned x;
    volatile LAS unsigned* st;
};

__device__ __forceinline__ XcdBarrier xcd_barrier_post(unsigned* bar, volatile LAS unsigned* st) {
    XcdBarrier b; b.bar = bar; b.x = xb_xcc_id(); b.st = st;
    if (threadIdx.x == 0) (void)xb_add(&bar[XB_XCNT(b.x)], 1u);
    return b;
}
__device__ __forceinline__ void xcd_barrier_complete(unsigned* bar, unsigned x, unsigned& nloc, unsigned& nx) {
    const unsigned G = gridDim.x * gridDim.y * gridDim.z;
    unsigned sum, cnt, mine, sp = 0u;
    for (;;) {
        sum = 0u; cnt = 0u; mine = 0u;
#pragma unroll
        for (unsigned j = 0; j < 16; ++j) { const unsigned c = xb_ld(&bar[XB_XCNT(j)]); sum += c; cnt += (c > 0u) ? 1u : 0u; mine = (j == x) ? c : mine; }
        if (sum == G) break;
        __builtin_amdgcn_s_sleep(1);
        if ((++sp & 255u) == 0u) { if (xb_ld(&bar[XB_TMO])) break; if (sp > XB_SPIN_CAP) { atomicAdd(&bar[XB_TMO], 1u); break; } }
    }
    nloc = mine > 0u ? mine : 1u; nx = cnt > 0u ? cnt : 1u;
}

__device__ __forceinline__ void xcd_barrier(const XcdBarrier& b) {
    asm volatile("s_waitcnt vmcnt(0)" ::: "memory");
    __syncthreads();
    if (threadIdx.x == 0) {
        unsigned* bar = b.bar;
        __builtin_amdgcn_s_waitcnt(0);
        unsigned nloc = b.st[0], nx = b.st[1];
        if (nloc == 0u) { xcd_barrier_complete(bar, b.x, nloc, nx); b.st[0] = nloc; b.st[1] = nx; }
        const unsigned old = xb_add(&bar[XB_XSUB(b.x)], 1u);
        const unsigned gen = old / nloc;
        if (old + 1u == (gen + 1u) * nloc) {
            __builtin_amdgcn_fence(__ATOMIC_RELEASE, "agent");
            asm volatile("s_waitcnt vmcnt(0)" ::: "memory");
            const unsigned og = xb_add(&bar[XB_TOP], 1u);
            const unsigned tg = og / nx;
            if (og + 1u == (tg + 1u) * nx) xb_add(&bar[XB_TOPGEN], 1u);
            else XB_SPIN(xb_ld(&bar[XB_TOPGEN]) == tg, bar);
            __builtin_amdgcn_fence(__ATOMIC_ACQUIRE, "agent");
            xb_add(&bar[XB_XGEN(b.x)], 1u);
            asm volatile("s_waitcnt vmcnt(0)" ::: "memory");
        } else {
            XB_SPIN(xb_ld(&bar[XB_XGEN(b.x)]) == gen, bar);
            __builtin_amdgcn_fence(__ATOMIC_ACQUIRE, "agent");
            asm volatile("s_waitcnt vmcnt(0)" ::: "memory");
        }
    }
    __syncthreads();
}

#if 0
#define PROBE_SEL_UNUSED (-1)
#endif
#ifndef REP_A
#define REP_A 1
#endif
#ifndef REP_B
#define REP_B 1
#endif
#define PHASE_END(kind) do { if ((kind) == 0) grid.sync(); else xcd_barrier(xbar); if (PROBE_SEL >= 0) { const unsigned long long t_ = __builtin_amdgcn_s_memrealtime(); if ((kind) == PROBE_SEL) tacc += t_ - tprev; tprev = t_; } } while (0)
constexpr size_t WS_BAR = 4096, WS_CTL_BYTES = 65536;
constexpr int XB_ST_OFF = 140288;
constexpr int RS_OFF = 131072;
constexpr int LDS_BYTES = 147456;
__global__ void __launch_bounds__(NTHR, 2) fwd_megakernel(Params p) {
    extern __shared__ __attribute__((aligned(16))) unsigned char lds_raw[];
    cg::grid_group grid = cg::this_grid();
    LAS unsigned char* lds = (LAS unsigned char*)lds_raw;
    int tid_ = threadIdx.x; asm volatile("" : "+v"(tid_)); const int tid = tid_, lane = tid & 63, wave = __builtin_amdgcn_readfirstlane(tid >> 6);
    const int G = gridDim.x, bid = blockIdx.x, gw = bid * NWAVES + wave, NGW = G * NWAVES;
    unsigned char* ws = p.ws;
    float* ssq = (float*)(ws + WS_SSQ); bf16* XB = (bf16*)(ws + WS_XB); bf16* PB = (bf16*)(ws + WS_P); bf16* MIXED = (bf16*)(ws + WS_MIX);

    if (tid < 2) ((volatile LAS unsigned*)(lds + XB_ST_OFF))[tid] = 0u;
    __syncthreads();
    const XcdBarrier xbar = xcd_barrier_post((unsigned*)(ws + WS_BAR), (volatile LAS unsigned*)(lds + XB_ST_OFF));
    unsigned long long tprev = 0, tacc = 0; if (PROBE_SEL >= 0) tprev = __builtin_amdgcn_s_memrealtime();
    prologue(p, lds, gw, NGW, wave, lane);
    PHASE_END(0);
    if (PROBE_SEL == 8) { PHASE_END(9); PHASE_END(8); }
#pragma unroll 1
    for (int l = 0; l < DEPTH; ++l) {
        {
            pg8::Gemm g{XB, (const bf16*)(ws + WS_WIN + l * WS_WIN_L), M, DIN, DM}; pg8::StaticOrder S; S.init(M, DIN, G, bid);
            pg8::rstd_table((LAS float*)(lds + RS_OFF), ssq, S); pg8::EpiScale E{PB, DIN, (LAS float*)(lds + RS_OFF), 0x303u};
            pg8::gemm_phase<pg8::EpiScale, pg8::StaticOrder, true, true>(lds, g, S, E);
        }
        PHASE_END(1);
#pragma unroll 1
        for (int rep = 0; rep < REP_A; ++rep) {
        for (int it = bid; it < BATCH * 4 * NSEG * 2; it += G) hg_passA_item(lds, p, l, it);
        for (int it = bid; it < BATCH * 4 * 16; it += G) na_item(lds, p, l, it);
        for (int it = bid; it < BATCH * 64; it += G) conv_item(lds, p, l, it);
        }
        PHASE_END(2);
#pragma unroll 1
        for (int rep = 0; rep < REP_B; ++rep)
        for (int it = bid; it < BATCH * 4 * NSEG; it += G) { const unsigned long long ts_ = hg_passB_item(lds, p, l, it); if (PROBE_SEL >= 10) tacc += ts_; }
        PHASE_END(3);
        {
            pg8::Gemm g{MIXED, (const bf16*)(ws + WS_WOUT + l * WS_WOUT_L), M, DM, DM}; pg8::StaticOrder S; S.init(M, DM, G, bid);
            pg8::EpiRes E{XB, ssq};
            pg8::gemm_phase<pg8::EpiRes, pg8::StaticOrder, true, true>(lds, g, S, E);
        }
        PHASE_END(4);
        {
            pg8::Gemm g{XB, (const bf16*)(ws + WS_WGU + l * WS_WGU_L), M, 2 * FFN, DM}; pg8::StaticOrder S; S.init(M, 2 * FFN, G, bid);
            pg8::rstd_table((LAS float*)(lds + RS_OFF), ssq, S); pg8::EpiSwiGLU E{PB, FFN, (LAS float*)(lds + RS_OFF)};
            pg8::gemm_phase<pg8::EpiSwiGLU, pg8::StaticOrder, true, true>(lds, g, S, E);
        }
        PHASE_END(5);
        {
            pg8::Gemm g{PB, (const bf16*)(ws + WS_WDN + l * WS_WDN_L), M, DM, FFN}; pg8::StaticOrder S; S.init(M, DM, G, bid);
            pg8::EpiRes E{XB, ssq};
            pg8::gemm_phase<pg8::EpiRes, pg8::StaticOrder, true, true>(lds, g, S, E);
        }
        PHASE_END(6);
    }
    float pdelta = 0.f;
    if (PROBE_SEL >= 0) {
        unsigned* tw = (unsigned*)(ws + 64);
        if (bid == 0 && tid == 0) __hip_atomic_store(tw, (unsigned)tacc, __ATOMIC_RELAXED, __HIP_MEMORY_SCOPE_AGENT);
        xcd_barrier(xbar);
        pdelta = (float)__hip_atomic_load(tw, __ATOMIC_RELAXED, __HIP_MEMORY_SCOPE_AGENT) * 1e-6f;
    }
    for (int m = gw; m < M; m += 2 * NGW) {
        const int m2 = (m + NGW < M) ? m + NGW : m;
        float pa = lane < 16 ? ssq[(size_t)(lane & 15) * M + m] : 0.f, pc = lane < 16 ? ssq[(size_t)(lane & 15) * M + m2] : 0.f;
        const u32x4* xa = (const u32x4*)(XB + (size_t)m * DM) + lane; const u32x4* xc = (const u32x4*)(XB + (size_t)m2 * DM) + lane;
        u32x4 va[2], vc[2]; f32x4 gg[4];
#pragma unroll
        for (int j = 0; j < 2; ++j) { va[j] = xa[64 * j]; vc[j] = xc[64 * j]; gg[2 * j] = *(const f32x4*)(p.fin_g + 512 * j + 8 * lane); gg[2 * j + 1] = *(const f32x4*)(p.fin_g + 512 * j + 8 * lane + 4); }
        __builtin_amdgcn_sched_barrier(0);
        pa = wave_sum(pa); pc = wave_sum(pc);
        const float ra = __builtin_amdgcn_rsqf(pa * (1.f / DM) + EPS), rc = __builtin_amdgcn_rsqf(pc * (1.f / DM) + EPS);
        const f32x4 pd = (PROBE_SEL >= 0) ? (f32x4){pdelta, -pdelta, pdelta, -pdelta} : (f32x4){0.f, 0.f, 0.f, 0.f};
#pragma unroll
        for (int j = 0; j < 2; ++j) {
            { const u32x4 r = va[j]; float* o = p.out + (size_t)m * DM + 512 * j + 8 * lane;
              f32x4 v0 = (f32x4){bflo(r.x), bfhi(r.x), bflo(r.y), bfhi(r.y)} * ra * gg[2 * j], v1 = (f32x4){bflo(r.z), bfhi(r.z), bflo(r.w), bfhi(r.w)} * ra * gg[2 * j + 1];
              if (PROBE_SEL >= 0 && m < 256) { v0 = v0 + pd; v1 = v1 + pd; }
              *(f32x4*)o = v0; *(f32x4*)(o + 4) = v1; }
            if (m2 != m) { const u32x4 r = vc[j]; float* o = p.out + (size_t)m2 * DM + 512 * j + 8 * lane;
              f32x4 v0 = (f32x4){bflo(r.x), bfhi(r.x), bflo(r.y), bfhi(r.y)} * rc * gg[2 * j], v1 = (f32x4){bflo(r.z), bfhi(r.z), bflo(r.w), bfhi(r.w)} * rc * gg[2 * j + 1];
              if (PROBE_SEL >= 0 && m2 < 256) { v0 = v0 + pd; v1 = v1 + pd; }
              *(f32x4*)o = v0; *(f32x4*)(o + 4) = v1; } }
    }
}

extern "C" void kernel_launch(void* const* d_in, const int* in_sizes, int n_in, void* d_out, int out_size, void* d_ws, size_t ws_size, hipStream_t stream) {
    static int grid_blocks = 0;
    if (grid_blocks == 0) {
        if (n_in != 15 || out_size != M * DM || ws_size < WS_END) { fprintf(stderr, "kernel_launch: unexpected shapes (n_in %d out %d ws %zu)\n", n_in, out_size, ws_size); grid_blocks = -1; return; }
        int dev = 0, cus = 0, per_cu = 0;
        hipGetDevice(&dev); hipDeviceGetAttribute(&cus, hipDeviceAttributeMultiprocessorCount, dev);
        hipFuncSetAttribute((const void*)fwd_megakernel, hipFuncAttributeMaxDynamicSharedMemorySize, LDS_BYTES);
        hipOccupancyMaxActiveBlocksPerMultiprocessor(&per_cu, (const void*)fwd_megakernel, NTHR, LDS_BYTES);
        if (per_cu < 1) { fprintf(stderr, "kernel_launch: occupancy query says %d blocks per CU\n", per_cu); per_cu = 1; }
        (void)hipGetLastError();
        grid_blocks = cus * 1;
    }
    if (grid_blocks < 0) return;
    Params p{};
    p.x = (const float*)d_in[0]; p.mix_g = (const float*)d_in[1]; p.w_in = (const float*)d_in[2]; p.hg_lb = (const float*)d_in[3]; p.hg_ng = (const float*)d_in[4];
    p.rpb = (const float*)d_in[5]; p.cw = (const float*)d_in[6]; p.cb = (const float*)d_in[7]; p.lng = (const float*)d_in[8]; p.lnb = (const float*)d_in[9];
    p.w_out = (const float*)d_in[10]; p.ffn_g = (const float*)d_in[11]; p.w_gu = (const float*)d_in[12]; p.w_dn = (const float*)d_in[13]; p.fin_g = (const float*)d_in[14];
    p.out = (float*)d_out; p.ws = (unsigned char*)d_ws;
    if (hipMemsetAsync(d_ws, 0, WS_CTL_BYTES, stream) != hipSuccess) { fprintf(stderr, "kernel_launch: hipMemsetAsync failed\n"); return; }
    void* args[] = {&p};
    hipError_t e = hipLaunchCooperativeKernel((const void*)fwd_megakernel, dim3(grid_blocks), dim3(NTHR), args, LDS_BYTES, stream);
    if (e != hipSuccess) fprintf(stderr, "cooperative launch failed: %s (grid %d)\n", hipGetErrorString(e), grid_blocks);
}
```

```cpp
#include <hip/hip_runtime.h>
#include <hip/hip_cooperative_groups.h>
#include <cstdio>
#include <cstdint>
namespace cg = cooperative_groups;

namespace pg8 {
#define PG8_LAS __attribute__((address_space(3)))
typedef unsigned short bf16_t;
typedef short bf16x8 __attribute__((ext_vector_type(8)));
typedef float f32x4 __attribute__((ext_vector_type(4)));
typedef unsigned u32x4 __attribute__((ext_vector_type(4)));
constexpr int BM = 256, BK = 64, HALF = 128, HTB = HALF * BK * 2  , STAGE_BYTES = 8 * HTB, NXCD = 8, WGM = 8;

__host__ __device__ __forceinline__ int lds_byte(int r, int c) { const int st = (r >> 4) * 2 + (c >> 5), rr = r & 15, cc = c & 31, ob = rr * 64 + cc * 2; return st * 1024 + (ob ^ (((ob >> 9) & 1) << 5)); }
__host__ __device__ __forceinline__ void stage_rc(int b, int& R, int& C) { const int st = b / 1024, sb = b % 1024, swz = sb ^ (((sb >> 9) & 1) << 5); R = (st >> 1) * 16 + swz / 64; C = (st & 1) * 32 + (swz % 64) / 2; }
__host__ __device__ __forceinline__ int perm32(int rho) { const int n = rho >> 4, i = rho & 15; return 8 * (i >> 2) + 4 * n + (i & 3); }

struct Unit { int pm, pn; };
struct Gemm { const bf16_t* A; const bf16_t* Bt; int M, N, K; };

struct StaticOrder {
    int nM, nN, nwg, G, c;
    __host__ __device__ void init(int M, int N, int G_, int c_) { nM = M / BM; nN = N / BM; nwg = nM * nN; G = G_; c = c_; }
    __host__ __device__ bool next(int i, Unit& u) const {
        const long L = (long)i * G + c; if (L >= nwg) return false;
        int wgid = (int)L; { const int q = nwg / NXCD, r = nwg % NXCD, xcd = wgid % NXCD, off = wgid / NXCD; wgid = (xcd < r ? xcd * (q + 1) : r * (q + 1) + (xcd - r) * q) + off; }
        const int nig = WGM * nN, gid = wgid / nig, fm = gid * WGM, gsz = (nM - fm) < WGM ? (nM - fm) : WGM;
        u.pm = fm + ((wgid % nig) % gsz); u.pn = (wgid % nig) / gsz; return true;
    }
    __device__ __forceinline__ void a_ready(const Unit&) const {}
    __device__ __forceinline__ void done(const Unit&) const {}
};
__device__ __forceinline__ unsigned cvt_pk_bf16(float lo, float hi) { unsigned r; asm volatile("v_cvt_pk_bf16_f32 %0, %1, %2" : "=v"(r) : "v"(lo), "v"(hi)); return r; }
typedef float f32x2 __attribute__((ext_vector_type(2)));
constexpr int MROWS = 16384, DMODEL = 1024, NPART = 16;
constexpr float NORM_EPS = 1e-6f;
__device__ __forceinline__ float row_rstd(const float* ssq, int row) {
    float s = 0.f;
#pragma unroll
    for (int p = 0; p < NPART; ++p) s += ssq[(size_t)p * MROWS + row];
    return __builtin_amdgcn_rsqf(s * (1.f / DMODEL) + NORM_EPS);
}
__device__ __forceinline__ float silu_f(float x) { return x * __builtin_amdgcn_rcpf(1.f + __expf(-x)); }

struct EpiScale {
    static constexpr bool PERM = true, AFTER_DRAIN = false;
    bf16_t* O; int ldc; const PG8_LAS float* RS; unsigned silu_mask;
    __device__ __forceinline__ void operator()(const f32x4 (&acc)[2][2][4][2], const Unit& u, int ui, int wr, int wc, int fr, int fq) const {
        const int row0 = u.pm * BM + wr * 64 + fr, col0 = u.pn * BM + wc * 32 + 8 * fq; const bool act = (silu_mask >> u.pn) & 1u;
#pragma unroll
        for (int ai = 0; ai < 2; ++ai)
#pragma unroll
            for (int m = 0; m < 4; ++m) { const int row = row0 + ai * HALF + m * 16; const float rs = RS[ui * BM + wr * 64 + fr + ai * HALF + m * 16]; bf16_t* rowp = O + (size_t)row * ldc + col0;
#pragma unroll
                for (int bj = 0; bj < 2; ++bj) { f32x4 v0 = acc[ai][bj][m][0] * rs, v1 = acc[ai][bj][m][1] * rs;
                    if (act) { v0 = (f32x4){silu_f(v0[0]), silu_f(v0[1]), silu_f(v0[2]), silu_f(v0[3])}; v1 = (f32x4){silu_f(v1[0]), silu_f(v1[1]), silu_f(v1[2]), silu_f(v1[3])}; }
                    u32x4 w; w.x = cvt_pk_bf16(v0[0], v0[1]); w.y = cvt_pk_bf16(v0[2], v0[3]); w.z = cvt_pk_bf16(v1[0], v1[1]); w.w = cvt_pk_bf16(v1[2], v1[3]);
                    *(u32x4*)(rowp + bj * HALF) = w; } __builtin_amdgcn_sched_barrier(0); }
    }
};
struct EpiRes {
    static constexpr bool PERM = true, AFTER_DRAIN = false;
    bf16_t* XB; float* ssq;
    __device__ __forceinline__ void operator()(const f32x4 (&acc)[2][2][4][2], const Unit& u, int ui, int wr, int wc, int fr, int fq) const {
        const int row0 = u.pm * BM + wr * 64 + fr, col0 = u.pn * BM + wc * 32 + 8 * fq;
#pragma unroll
        for (int ai = 0; ai < 2; ++ai)
#pragma unroll
            for (int mm = 0; mm < 4; mm += 2) {
                u32x4 rr[2][2];
#pragma unroll
                for (int q = 0; q < 2; ++q)
#pragma unroll
                    for (int bj = 0; bj < 2; ++bj) rr[q][bj] = *(const u32x4*)(XB + (size_t)(row0 + ai * HALF + (mm + q) * 16) * DMODEL + col0 + bj * HALF);
                __builtin_amdgcn_sched_barrier(0);
#pragma unroll
                for (int q = 0; q < 2; ++q) { const int m = mm + q, row = row0 + ai * HALF + m * 16; const size_t o = (size_t)row * DMODEL + col0; float sq = 0.f;
#pragma unroll
                    for (int bj = 0; bj < 2; ++bj) { const u32x4 r = rr[q][bj];
                        const f32x4 r0 = (f32x4){__builtin_bit_cast(float, r.x << 16), __builtin_bit_cast(float, r.x & 0xffff0000u), __builtin_bit_cast(float, r.y << 16), __builtin_bit_cast(float, r.y & 0xffff0000u)};
                        const f32x4 r1 = (f32x4){__builtin_bit_cast(float, r.z << 16), __builtin_bit_cast(float, r.z & 0xffff0000u), __builtin_bit_cast(float, r.w << 16), __builtin_bit_cast(float, r.w & 0xffff0000u)};
                        const f32x4 v0 = acc[ai][bj][m][0] + r0, v1 = acc[ai][bj][m][1] + r1;
                        u32x4 w; w.x = cvt_pk_bf16(v0[0], v0[1]); w.y = cvt_pk_bf16(v0[2], v0[3]); w.z = cvt_pk_bf16(v1[0], v1[1]); w.w = cvt_pk_bf16(v1[2], v1[3]);
                        *(u32x4*)(XB + o + bj * HALF) = w;
                        sq += (v0[0] * v0[0] + v0[1] * v0[1]) + (v0[2] * v0[2] + v0[3] * v0[3]) + (v1[0] * v1[0] + v1[1] * v1[1]) + (v1[2] * v1[2] + v1[3] * v1[3]); }
                    sq += __shfl_xor(sq, 16); sq += __shfl_xor(sq, 32);
                    if (fq == 0) ssq[(size_t)(u.pn * 4 + wc) * MROWS + row] = sq; }
                __builtin_amdgcn_sched_barrier(0); }
    }
};
struct EpiSwiGLU {
    static constexpr bool PERM = true, AFTER_DRAIN = false;
    bf16_t* O; int ldc; const PG8_LAS float* RS;
    __device__ __forceinline__ void operator()(const f32x4 (&acc)[2][2][4][2], const Unit& u, int ui, int wr, int wc, int fr, int fq) const {
        const int row0 = u.pm * BM + wr * 64 + fr, col0 = u.pn * HALF + wc * 32 + 8 * fq;
#pragma unroll
        for (int ai = 0; ai < 2; ++ai)
#pragma unroll
            for (int m = 0; m < 4; ++m) { const int row = row0 + ai * HALF + m * 16; const float rs = RS[ui * BM + wr * 64 + fr + ai * HALF + m * 16];
                const f32x4 g0 = acc[ai][0][m][0] * rs, g1 = acc[ai][0][m][1] * rs, u0 = acc[ai][1][m][0] * rs, u1 = acc[ai][1][m][1] * rs;
                u32x4 w; w.x = cvt_pk_bf16(silu_f(g0[0]) * u0[0], silu_f(g0[1]) * u0[1]); w.y = cvt_pk_bf16(silu_f(g0[2]) * u0[2], silu_f(g0[3]) * u0[3]);
                w.z = cvt_pk_bf16(silu_f(g1[0]) * u1[0], silu_f(g1[1]) * u1[1]); w.w = cvt_pk_bf16(silu_f(g1[2]) * u1[2], silu_f(g1[3]) * u1[3]);
                *(u32x4*)(O + (size_t)row * ldc + col0) = w; __builtin_amdgcn_sched_barrier(0); }
    }
};
template <class Sched> __device__ __forceinline__ void rstd_table(PG8_LAS float* RS, const float* ssq, const Sched& S) {
    int tx_ = threadIdx.x; asm volatile("" : "+v"(tx_));
    Unit u; const int t = tx_ & (BM - 1);
    for (int i = __builtin_amdgcn_readfirstlane(tx_ >> 8); S.next(i, u); i += 2) {
        float v[NPART];
#pragma unroll
        for (int p = 0; p < NPART; ++p) v[p] = ssq[(size_t)p * MROWS + u.pm * BM + t];
        __builtin_amdgcn_sched_barrier(0);
        const float s = (((v[0] + v[1]) + (v[2] + v[3])) + ((v[4] + v[5]) + (v[6] + v[7]))) + (((v[8] + v[9]) + (v[10] + v[11])) + ((v[12] + v[13]) + (v[14] + v[15])));
        RS[i * BM + t] = __builtin_amdgcn_rsqf(s * (1.f / DMODEL) + NORM_EPS);
    }
    __syncthreads();
}
template <class Epi, class Sched, bool ALIGN_EPI = false, bool SP2 = false>
__device__ __forceinline__ void gemm_phase(PG8_LAS unsigned char* lds, const Gemm g, const Sched& S, const Epi& E) {
    int tid_ = threadIdx.x; asm volatile("" : "+v"(tid_));
    const int tid = tid_, wid = __builtin_amdgcn_readfirstlane(tid >> 6), lane = tid & 63, wr = wid >> 2, wc = wid & 3, fr = lane & 15, fq = lane >> 4;
    const int K = g.K, nt = K / BK;
    unsigned voffA[2], voffB[2];
#pragma unroll
    for (int i = 0; i < 2; ++i) { int R, C; stage_rc(tid * 16 + i * 8192, R, C); const int Rb = Epi::PERM ? ((R & ~31) + perm32(R & 31)) : R;
        voffA[i] = (unsigned)(R * K + C) * 2u; voffB[i] = (unsigned)(Rb * K + C) * 2u; }
    const size_t kstep = (size_t)(BK * 2);
    const size_t hstep = (size_t)HALF * K * 2;
    const size_t tstep = 2 * hstep;
    const unsigned ldsw = (unsigned)wid * 1024u;
    const int aoff = lds_byte(wr * 64 + fr, fq * 8), boff = lds_byte(wc * 32 + fr, fq * 8);
#define PG8_SA(b, h) (((b) * 2 + (h)) * HTB)
#define PG8_SB(b, h) ((4 + (b) * 2 + (h)) * HTB)
#define PG8_STAGE(bufoff, gbase, voff) do { _Pragma("unroll") for (int _i = 0; _i < 2; ++_i) \
        __builtin_amdgcn_global_load_lds((const unsigned*)((const char*)(gbase) + (voff)[_i]), (PG8_LAS unsigned*)(lds + (bufoff) + ldsw + _i * 8192), 16, 0, 0); } while (0)
#define PG8_LDA(dst, b, h) do { _Pragma("unroll") for (int m = 0; m < 4; ++m) _Pragma("unroll") for (int k = 0; k < 2; ++k) dst[m][k] = *(const PG8_LAS bf16x8*)(lds + PG8_SA(b, h) + aoff + m * 2048 + k * 1024); } while (0)
#define PG8_LDB(dst, b, h) do { _Pragma("unroll") for (int n = 0; n < 2; ++n) _Pragma("unroll") for (int k = 0; k < 2; ++k) dst[n][k] = *(const PG8_LAS bf16x8*)(lds + PG8_SB(b, h) + boff + n * 2048 + k * 1024); } while (0)
#define PG8_MMA(ai, bj, At, Bt) do { __builtin_amdgcn_s_setprio(1); _Pragma("unroll") for (int m = 0; m < 4; ++m) _Pragma("unroll") for (int n = 0; n < 2; ++n) _Pragma("unroll") for (int k = 0; k < 2; ++k) \
        acc[ai][bj][m][n] = __builtin_amdgcn_mfma_f32_16x16x32_bf16(Bt[n][k], At[m][k], acc[ai][bj][m][n], 0, 0, 0); __builtin_amdgcn_s_setprio(0); } while (0)
#define PG8_WAIT_V(n) asm volatile("s_waitcnt vmcnt(" #n ")" ::: "memory")
#define PG8_WAIT_L(n) asm volatile("s_waitcnt lgkmcnt(" #n ")" ::: "memory")
#define PG8_BAR __builtin_amdgcn_s_barrier()
#define PG8_SCHED __builtin_amdgcn_sched_barrier(0)
    Unit cur, nxt; int ui = 0;
    if (!S.next(0, cur)) return;
    f32x4 acc[2][2][4][2];
#pragma unroll
    for (int a = 0; a < 2; ++a)
#pragma unroll
        for (int b = 0; b < 2; ++b)
#pragma unroll
            for (int m = 0; m < 4; ++m)
#pragma unroll
                for (int n = 0; n < 2; ++n) acc[a][b][m][n] = (f32x4){0.f, 0.f, 0.f, 0.f};
    bf16x8 At[4][2], B0[2][2], B1[2][2];
    const char* cA = (const char*)g.A + (size_t)cur.pm * tstep; const char* cB = (const char*)g.Bt + (size_t)cur.pn * tstep;
    S.a_ready(cur);
    if constexpr (SP2) {
        PG8_STAGE(PG8_SB(0, 0), cB, voffB); PG8_STAGE(PG8_SB(0, 1), cB + hstep, voffB); PG8_STAGE(PG8_SA(0, 0), cA, voffA); PG8_STAGE(PG8_SA(0, 1), cA + hstep, voffA);
        if (wr == 1) PG8_BAR;
        PG8_WAIT_V(2); PG8_BAR;
        PG8_STAGE(PG8_SB(1, 0), cB + kstep, voffB); PG8_STAGE(PG8_SA(1, 0), cA + kstep, voffA); PG8_STAGE(PG8_SB(1, 1), cB + hstep + kstep, voffB);
        PG8_WAIT_V(6); PG8_BAR;
    } else {
        PG8_STAGE(PG8_SB(0, 0), cB, voffB); PG8_STAGE(PG8_SA(0, 0), cA, voffA); PG8_STAGE(PG8_SB(0, 1), cB + hstep, voffB); PG8_STAGE(PG8_SA(0, 1), cA + hstep, voffA);
        if (wr == 1) PG8_BAR;
        PG8_WAIT_V(4); PG8_BAR;
        PG8_STAGE(PG8_SB(1, 0), cB + kstep, voffB); PG8_STAGE(PG8_SA(1, 0), cA + kstep, voffA); PG8_STAGE(PG8_SB(1, 1), cB + hstep + kstep, voffB);
        PG8_WAIT_V(6); PG8_BAR;
    }
    for (;;) {
        const bool has_next = S.next(ui + 1, nxt);
        const char* nA = has_next ? (const char*)g.A + (size_t)nxt.pm * tstep : cA; const char* nB = has_next ? (const char*)g.Bt + (size_t)nxt.pn * tstep : cB;
        for (int t = 0; t < nt; t += 2) {
            const bool last = (t == nt - 2);
            const char* a1 = cA + (size_t)(t + 1) * kstep;
            const char* a2 = last ? nA : cA + (size_t)(t + 2) * kstep; const char* b2 = last ? nB : cB + (size_t)(t + 2) * kstep;
            const char* a3 = a2 + kstep; const char* b3 = b2 + kstep;
            if (last && has_next) S.a_ready(nxt);
            if constexpr (SP2) {
            PG8_LDB(B0, 0, 0); PG8_LDB(B1, 0, 1); PG8_SCHED; PG8_LDA(At, 0, 0); PG8_STAGE(PG8_SA(1, 1), a1 + hstep, voffA);
            PG8_WAIT_V(8); PG8_WAIT_L(0); PG8_BAR; PG8_MMA(0, 0, At, B0); PG8_MMA(0, 1, At, B1); PG8_BAR; PG8_SCHED;
            PG8_LDA(At, 0, 1); PG8_STAGE(PG8_SB(0, 0), b2, voffB); PG8_STAGE(PG8_SB(0, 1), b2 + hstep, voffB); PG8_STAGE(PG8_SA(0, 0), a2, voffA);
            PG8_WAIT_V(8); PG8_WAIT_L(0); PG8_BAR; PG8_MMA(1, 0, At, B0); PG8_MMA(1, 1, At, B1); PG8_BAR; PG8_SCHED;
            PG8_LDB(B0, 1, 0); PG8_LDB(B1, 1, 1); PG8_SCHED; PG8_LDA(At, 1, 0); PG8_STAGE(PG8_SA(0, 1), a2 + hstep, voffA);
            PG8_WAIT_V(8); PG8_WAIT_L(0); PG8_BAR; PG8_MMA(0, 0, At, B0); PG8_MMA(0, 1, At, B1); PG8_BAR; PG8_SCHED;
            PG8_LDA(At, 1, 1); PG8_STAGE(PG8_SB(1, 0), b3, voffB); PG8_STAGE(PG8_SB(1, 1), b3 + hstep, voffB); PG8_STAGE(PG8_SA(1, 0), a3, voffA);
            PG8_WAIT_V(8); PG8_WAIT_L(0); PG8_BAR; PG8_MMA(1, 0, At, B0); PG8_MMA(1, 1, At, B1); PG8_BAR; PG8_SCHED;
            } else {
            PG8_LDB(B0, 0, 0); PG8_SCHED; PG8_LDA(At, 0, 0); PG8_STAGE(PG8_SA(1, 1), a1 + hstep, voffA);
            PG8_WAIT_L(8); PG8_BAR; PG8_WAIT_L(0); PG8_MMA(0, 0, At, B0); PG8_BAR; PG8_SCHED;
            PG8_LDB(B1, 0, 1); PG8_STAGE(PG8_SB(0, 0), b2, voffB);
            PG8_BAR; PG8_WAIT_L(0); PG8_MMA(0, 1, At, B1); PG8_BAR;
            PG8_LDA(At, 0, 1); PG8_STAGE(PG8_SA(0, 0), a2, voffA);
            PG8_BAR; PG8_WAIT_L(0); PG8_MMA(1, 0, At, B0); PG8_BAR; PG8_SCHED;
            PG8_STAGE(PG8_SB(0, 1), b2 + hstep, voffB);
            PG8_WAIT_V(6); PG8_BAR; PG8_MMA(1, 1, At, B1); PG8_BAR;
            PG8_LDB(B0, 1, 0); PG8_SCHED; PG8_LDA(At, 1, 0); PG8_STAGE(PG8_SA(0, 1), a2 + hstep, voffA);
            PG8_WAIT_L(8); PG8_BAR; PG8_WAIT_L(0); PG8_MMA(0, 0, At, B0); PG8_BAR; PG8_SCHED;
            PG8_LDB(B1, 1, 1); PG8_STAGE(PG8_SB(1, 0), b3, voffB);
            PG8_BAR; PG8_WAIT_L(0); PG8_MMA(0, 1, At, B1); PG8_BAR;
            PG8_LDA(At, 1, 1); PG8_STAGE(PG8_SA(1, 0), a3, voffA);
            PG8_BAR; PG8_WAIT_L(0); PG8_MMA(1, 0, At, B0); PG8_BAR; PG8_SCHED;
            PG8_STAGE(PG8_SB(1, 1), b3 + hstep, voffB);
            PG8_WAIT_V(6); PG8_BAR; PG8_MMA(1, 1, At, B1); PG8_BAR;
            }
        }
        if constexpr (ALIGN_EPI) { if (wr == 0) PG8_BAR; }
        if constexpr (!Epi::AFTER_DRAIN) { E(acc, cur, ui, wr, wc, fr, fq); S.done(cur); }
        if (!has_next) break;
#pragma unroll
        for (int a = 0; a < 2; ++a)
#pragma unroll
            for (int b = 0; b < 2; ++b)
#pragma unroll
                for (int m = 0; m < 4; ++m)
#pragma unroll
                    for (int n = 0; n < 2; ++n) acc[a][b][m][n] = (f32x4){0.f, 0.f, 0.f, 0.f};
        cur = nxt; cA = nA; cB = nB; ++ui;
        if constexpr (ALIGN_EPI) { if (wr == 1) PG8_BAR; }
    }
    PG8_WAIT_V(0);
    if constexpr (!ALIGN_EPI) { if (wr == 0) PG8_BAR; }
    PG8_BAR;
    if constexpr (Epi::AFTER_DRAIN) { E.fused(acc, cur, wr, wc, fr, fq, lds, wid, lane); S.done(cur); }
#undef PG8_SA
#undef PG8_SB
#undef PG8_STAGE
#undef PG8_LDA
#undef PG8_LDB
#undef PG8_MMA
#undef PG8_WAIT_V
#undef PG8_WAIT_L
#undef PG8_BAR
#undef PG8_SCHED
}
}
#ifndef PROBE_SEL
#define PROBE_SEL (-1)
#endif
#define PT_NOW() __builtin_amdgcn_s_memrealtime()
#define PT_WORDS_OFF 140304
#define PT_ACC(lds_, dt_) do { if (threadIdx.x == 0) { volatile __attribute__((address_space(3))) unsigned* a_ = (volatile __attribute__((address_space(3))) unsigned*)((lds_) + PT_WORDS_OFF); a_[0] = a_[0] + (unsigned)(dt_); } } while (0)
#define LAS __attribute__((address_space(3)))
typedef unsigned short bf16;
typedef float f32x4 __attribute__((ext_vector_type(4)));
typedef short bf16x8 __attribute__((ext_vector_type(8)));
typedef unsigned u32x4 __attribute__((ext_vector_type(4)));
typedef unsigned u32x2 __attribute__((ext_vector_type(2)));
constexpr int NWAVES = 8, NTHR = 512;
constexpr int BATCH = 8, SEQ = 2048, DM = 1024, M = BATCH * SEQ, DIN = 3840, FFN = 2816, DEPTH = 2;
constexpr int C_HQ = 0, C_HFF = 512, C_HI = 1536, C_HG = 2048, C_NQ = 2560, C_NK = 2816, C_NV = 3072, C_CA = 3328, C_CG = 3584;
constexpr int NSEG = 8, SEGLEN = SEQ / NSEG, CHS = SEGLEN / 32;
constexpr float EPS = 1e-6f;
constexpr size_t MiB = 1u << 20;
constexpr size_t WS_SSQ = 1 * MiB;
constexpr size_t WS_WIN = 2 * MiB, WS_WIN_L = (size_t)DIN * DM * 2;
constexpr size_t WS_WOUT = 17 * MiB, WS_WOUT_L = (size_t)DM * DM * 2;
constexpr size_t WS_WGU = 21 * MiB, WS_WGU_L = (size_t)2 * FFN * DM * 2;
constexpr size_t WS_WDN = 43 * MiB, WS_WDN_L = (size_t)DM * FFN * 2;
constexpr size_t WS_P = 54 * MiB;
constexpr size_t WS_MIX = 174 * MiB;
constexpr size_t WS_XB = 206 * MiB;
constexpr size_t WS_SLOC = 238 * MiB;
constexpr size_t WS_DSEG = 254 * MiB;
constexpr size_t WS_END = 255 * MiB;

__device__ __forceinline__ float bf2f(unsigned short h) { return __builtin_bit_cast(float, (unsigned)h << 16); }
__device__ __forceinline__ float bflo(unsigned w) { return __builtin_bit_cast(float, w << 16); }
__device__ __forceinline__ float bfhi(unsigned w) { return __builtin_bit_cast(float, w & 0xffff0000u); }
typedef float f32x2_t __attribute__((ext_vector_type(2)));
typedef __bf16 bf16x2_t __attribute__((ext_vector_type(2)));
__device__ __forceinline__ unsigned pk2(float lo, float hi) { const f32x2_t v = {lo, hi}; const bf16x2_t b = __builtin_convertvector(v, bf16x2_t); return __builtin_bit_cast(unsigned, b); }
__device__ __forceinline__ unsigned short f2bf(float v) { return (unsigned short)(pk2(v, 0.f) & 0xffffu); }
__device__ __forceinline__ float wave_sum(float v) {
#pragma unroll
    for (int o = 1; o < 64; o <<= 1) v += __shfl_xor(v, o);
    return v;
}
__device__ __forceinline__ float sigm(float x) { return __builtin_amdgcn_rcpf(1.f + __expf(-x)); }
__device__ __forceinline__ float silu_f0(float x) { return x * sigm(x); }
__device__ __forceinline__ f32x4 mfma16(bf16x8 a, bf16x8 b, f32x4 c) { return __builtin_amdgcn_mfma_f32_16x16x32_bf16(a, b, c, 0, 0, 0); }
#define LDS_WAIT() asm volatile("s_waitcnt lgkmcnt(0)" ::: "memory")

struct Params {
    const float *x, *mix_g, *w_in, *hg_lb, *hg_ng, *rpb, *cw, *cb, *lng, *lnb, *w_out, *ffn_g, *w_gu, *w_dn, *fin_g;
    float* out; unsigned char* ws;
};

__device__ __forceinline__ void transpose_item(const float* W, int K, int N, bf16* WT, const float* gk, bool gu, LAS float* scr, int item, int lane) {
    const int nblk = N / 32, kb = item / nblk, nb = item % nblk, k0 = 64 * kb, n0 = 32 * nb;
    float wv[32];
#pragma unroll
    for (int i = 0; i < 32; ++i) { const int kk = 2 * i + (lane >> 5); wv[i] = W[(size_t)(k0 + kk) * N + n0 + (lane & 31)]; }
    const float gs = gk ? gk[k0 + lane] : 1.f;
    __builtin_amdgcn_sched_barrier(0);
#pragma unroll
    for (int i = 0; i < 32; ++i) { const int kk = 2 * i + (lane >> 5); scr[kk * 33 + (lane & 31)] = wv[i] * __shfl(gs, kk); }
    LDS_WAIT(); asm volatile("" ::: "memory");
    const int c = lane & 7;
    int r0 = n0;
    if (gu) { const int up = n0 >= FFN ? 1 : 0, cc = n0 - up * FFN; r0 = 256 * (cc >> 7) + (cc & 127) + up * 128; }
#pragma unroll
    for (int j = 0; j < 4; ++j) { const int n = (lane >> 3) + 8 * j; const LAS float* s = scr + (8 * c) * 33 + n;
        u32x4 o; o.x = pk2(s[0 * 33], s[1 * 33]); o.y = pk2(s[2 * 33], s[3 * 33]); o.z = pk2(s[4 * 33], s[5 * 33]); o.w = pk2(s[6 * 33], s[7 * 33]);
        *(u32x4*)(WT + (size_t)(r0 + n) * K + k0 + 8 * c) = o; }
    LDS_WAIT(); asm volatile("" ::: "memory");
}
__device__ __forceinline__ void prologue(const Params& p, LAS unsigned char* lds, int gw, int NGW, int wave, int lane) {
    LAS float* scr = (LAS float*)(lds + wave * 16384);
    constexpr int I_IN = (DM / 64) * (DIN / 32), I_OUT = (DM / 64) * (DM / 32), I_GU = (DM / 64) * (2 * FFN / 32), I_DN = (FFN / 64) * (DM / 32), I_L = I_IN + I_OUT + I_GU + I_DN;
    for (int it = gw; it < DEPTH * I_L; it += NGW) {
        const int l = it / I_L; int r = it % I_L;
        if (r < I_IN) { transpose_item(p.w_in + (size_t)l * DM * DIN, DM, DIN, (bf16*)(p.ws + WS_WIN + l * WS_WIN_L), p.mix_g + l * DM, false, scr, r, lane); continue; } r -= I_IN;
        if (r < I_OUT) { transpose_item(p.w_out + (size_t)l * DM * DM, DM, DM, (bf16*)(p.ws + WS_WOUT + l * WS_WOUT_L), nullptr, false, scr, r, lane); continue; } r -= I_OUT;
        if (r < I_GU) { transpose_item(p.w_gu + (size_t)l * DM * 2 * FFN, DM, 2 * FFN, (bf16*)(p.ws + WS_WGU + l * WS_WGU_L), p.ffn_g + l * DM, true, scr, r, lane); continue; } r -= I_GU;
        transpose_item(p.w_dn + (size_t)l * FFN * DM, FFN, DM, (bf16*)(p.ws + WS_WDN + l * WS_WDN_L), nullptr, false, scr, r, lane);
    }
    bf16* XB = (bf16*)(p.ws + WS_XB); float* ssq = (float*)(p.ws + WS_SSQ);
    for (int m = gw; m < M; m += 2 * NGW) {
        const int m2 = m + NGW;
        const f32x4* xa = (const f32x4*)(p.x + (size_t)m * DM) + lane; const f32x4* xc = (const f32x4*)(p.x + (size_t)(m2 < M ? m2 : m) * DM) + lane;
        f32x4 va[4], vc[4];
#pragma unroll
        for (int j = 0; j < 4; ++j) { va[j] = xa[64 * j]; vc[j] = xc[64 * j]; }
        __builtin_amdgcn_sched_barrier(0);
        float sa = 0.f, sc = 0.f;
        unsigned long long* oa = (unsigned long long*)(XB + (size_t)m * DM) + lane; unsigned long long* oc = (unsigned long long*)(XB + (size_t)m2 * DM) + lane;
#pragma unroll
        for (int j = 0; j < 4; ++j) { sa += (va[j].x * va[j].x + va[j].y * va[j].y) + (va[j].z * va[j].z + va[j].w * va[j].w); sc += (vc[j].x * vc[j].x + vc[j].y * vc[j].y) + (vc[j].z * vc[j].z + vc[j].w * vc[j].w);
            oa[64 * j] = (unsigned long long)pk2(va[j].x, va[j].y) | ((unsigned long long)pk2(va[j].z, va[j].w) << 32);
            if (m2 < M) oc[64 * j] = (unsigned long long)pk2(vc[j].x, vc[j].y) | ((unsigned long long)pk2(vc[j].z, vc[j].w) << 32); }
        sa = wave_sum(sa); sc = wave_sum(sc);
        if (lane < 16) { ssq[(size_t)lane * M + m] = lane == 0 ? sa : 0.f; if (m2 < M) ssq[(size_t)lane * M + m2] = lane == 0 ? sc : 0.f; }
    }
}

constexpr int HS_SET = 37888, HQ_OFF = 0, HK_OFF = 8704, HKH_OFF = 17408, HV_OFF = 27648;
constexpr int HOS_OFF = 2 * HS_SET, HOS_SZ = 16896, HDEC_OFF = HOS_OFF + 2 * HOS_SZ;
#define WG_BAR() asm volatile("s_waitcnt lgkmcnt(0)\n\ts_barrier" ::: "memory")
template <bool FULL, bool SECOND>
__device__ __forceinline__ void hg_segment(LAS unsigned char* lds, const bf16* P, int b, int h, int dir, int seg, float lb, f32x4 (&S)[8], float& bsum,
                                           float* OP, bf16* MIXED, const float* norm_g) {
    int tid_ = threadIdx.x; asm volatile("" : "+v"(tid_)); const int tid = tid_, w = __builtin_amdgcn_readfirstlane(tid >> 6), lane = tid & 63, fr = lane & 15, fq = lane >> 4;
    unsigned long long tk0 = 0;
    const int d = 16 * w + (lane & 15), grp = lane >> 4;
    const int zcol = C_HFF + dir * 512 + h * 128 + d, qcol = C_HQ + h * 128 + d, vcol = C_HI + h * 128 + d;
    const float oml = 1.f - lb;
    const int ts = dir == 0 ? 1 : -1, tb0 = dir == 0 ? seg * SEGLEN : (seg * SEGLEN + SEGLEN - 1);
    const long rstep = (long)ts * DIN;
    const int fc = tid >> 4, dvg = tid & 15;
    f32x4 ng0 = (f32x4){0.f, 0.f, 0.f, 0.f}, ng1 = ng0;
    if (FULL && SECOND) { ng0 = *(const f32x4*)(norm_g + 8 * dvg); ng1 = *(const f32x4*)(norm_g + 8 * dvg + 4); }
    unsigned short zn[8], qn[8], vn[8];
#define HG_LOAD(n_) do { const bf16* rowp_ = P + (size_t)(b * SEQ + tb0 + ts * (32 * (n_) + 8 * grp)) * DIN; \
        _Pragma("unroll") for (int e = 0; e < 8; ++e) { const bf16* r_ = rowp_ + rstep * e; zn[e] = r_[zcol]; if (FULL) qn[e] = r_[qcol]; else qn[e] = 0; vn[e] = r_[vcol]; } } while (0)
#define HG_PREP(s_) do { LAS unsigned char* set_ = lds + (s_) * HS_SET; LAS bf16* QT_ = (LAS bf16*)(set_ + HQ_OFF); LAS bf16* KT_ = (LAS bf16*)(set_ + HK_OFF); \
        float El[8], kv[8]; float run = 1.f; \
        _Pragma("unroll") for (int e = 0; e < 8; ++e) { float z = bf2f(zn[e]); z = fminf(fmaxf(z, -40.f), 40.f); \
            const float ez = __expf(-z), inv = __builtin_amdgcn_rcpf(1.f + ez); run *= lb + oml * inv; El[e] = run; kv[e] = oml * (ez * inv); } \
        float pre = 1.f, tot = 1.f; \
        _Pragma("unroll") for (int g2 = 0; g2 < 4; ++g2) { const float t = __shfl(run, (g2 << 4) | (lane & 15)); tot *= t; if (g2 < grp) pre *= t; } \
        unsigned khp[4], vvp[4]; \
        _Pragma("unroll") for (int e = 0; e < 8; e += 2) { const float E0 = pre * El[e], E1 = pre * El[e + 1], r0 = __builtin_amdgcn_rcpf(E0), r1 = __builtin_amdgcn_rcpf(E1); \
            if (FULL) { const int c0 = 8 * grp + e; QT_[c0 * 136 + d] = f2bf(bf2f(qn[e]) * E0); QT_[(c0 + 1) * 136 + d] = f2bf(bf2f(qn[e + 1]) * E1); \
                KT_[c0 * 136 + d] = f2bf(kv[e] * r0); KT_[(c0 + 1) * 136 + d] = f2bf(kv[e + 1] * r1); } \
            khp[e >> 1] = pk2(kv[e] * (tot * r0), kv[e + 1] * (tot * r1)); vvp[e >> 1] = (unsigned)vn[e] | ((unsigned)vn[e + 1] << 16); } \
        *(LAS u32x4*)((LAS bf16*)(set_ + HKH_OFF) + d * 40 + 8 * grp) = (u32x4){khp[0], khp[1], khp[2], khp[3]}; \
        *(LAS u32x4*)((LAS bf16*)(set_ + HV_OFF) + d * 40 + 8 * grp) = (u32x4){vvp[0], vvp[1], vvp[2], vvp[3]}; \
        if (grp == 0) { ((LAS float*)(lds + HDEC_OFF))[(s_) * 128 + d] = tot; bsum *= tot; } } while (0)
    HG_LOAD(0);
    __builtin_amdgcn_sched_barrier(0);
    HG_PREP(0);
    __builtin_amdgcn_sched_barrier(0);
    if (CHS > 1) HG_LOAD(1);
    WG_BAR();
#pragma unroll 1
    for (int n = 0; n < CHS; ++n) {
        const int tb = tb0 + ts * 32 * n, cs = n & 1;
        const int ftok = tb + ts * fc;
        f32x4 op0 = (f32x4){0.f, 0.f, 0.f, 0.f}, op1 = op0; u32x4 gw4 = (u32x4){0u, 0u, 0u, 0u};
        float* op = OP + ((size_t)((b * 4 + h) * SEQ + ftok)) * 128 + 8 * dvg;
        if (FULL && SECOND) { op0 = *(const f32x4*)op; op1 = *(const f32x4*)(op + 4); gw4 = *(const u32x4*)(P + (size_t)(b * SEQ + ftok) * DIN + C_HG + h * 128 + 8 * dvg); }
        __builtin_amdgcn_sched_barrier(0);
#pragma unroll 1
        for (int ph = 0; ph < 2; ++ph) {
        if ((ph == 0) == (w < 4)) { if (PROBE_SEL == 13) tk0 = PT_NOW(); if (n + 1 < CHS) { HG_PREP(cs ^ 1); __builtin_amdgcn_sched_barrier(0); if (n + 2 < CHS) HG_LOAD(n + 2); } if (PROBE_SEL == 13) PT_ACC(lds, PT_NOW() - tk0); }
        else {
        if (PROBE_SEL == 14) tk0 = PT_NOW();
        LAS unsigned char* set = lds + cs * HS_SET;
        LAS bf16* QT = (LAS bf16*)(set + HQ_OFF); LAS bf16* KT = (LAS bf16*)(set + HK_OFF); LAS bf16* KHT = (LAS bf16*)(set + HKH_OFF); LAS bf16* VT = (LAS bf16*)(set + HV_OFF);
        LAS float* OS = (LAS float*)(lds + HOS_OFF + cs * HOS_SZ); LAS float* DEC = (LAS float*)(lds + HDEC_OFF) + cs * 128;
        if (FULL) {
            f32x4 p00 = (f32x4){0.f, 0.f, 0.f, 0.f}, p01 = p00, p11 = p00;
#pragma unroll
            for (int ks = 0; ks < 4; ++ks) {
                const bf16x8 k0 = *(const LAS bf16x8*)(KT + fr * 136 + 32 * ks + 8 * fq), k1 = *(const LAS bf16x8*)(KT + (16 + fr) * 136 + 32 * ks + 8 * fq);
                const bf16x8 q0 = *(const LAS bf16x8*)(QT + fr * 136 + 32 * ks + 8 * fq), q1 = *(const LAS bf16x8*)(QT + (16 + fr) * 136 + 32 * ks + 8 * fq);
                p00 = mfma16(k0, q0, p00); p01 = mfma16(k0, q1, p01); p11 = mfma16(k1, q1, p11); }
#pragma unroll
            for (int i = 0; i < 4; ++i) { const bool keep = 4 * fq + i <= fr; p00[i] = keep ? p00[i] : 0.f; p11[i] = keep ? p11[i] : 0.f; }
            const bf16x8 pf0 = __builtin_bit_cast(bf16x8, (u32x4){pk2(p00[0], p00[1]), pk2(p00[2], p00[3]), 0u, 0u});
            const bf16x8 pf1 = __builtin_bit_cast(bf16x8, (u32x4){pk2(p01[0], p01[1]), pk2(p01[2], p01[3]), pk2(p11[0], p11[1]), pk2(p11[2], p11[3])});
            f32x4 o0 = (f32x4){0.f, 0.f, 0.f, 0.f}, o1 = o0;
#pragma unroll
            for (int ks = 0; ks < 4; ++ks) {
                const bf16x8 sa = __builtin_bit_cast(bf16x8, (u32x4){pk2(S[2 * ks][0], S[2 * ks][1]), pk2(S[2 * ks][2], S[2 * ks][3]), pk2(S[2 * ks + 1][0], S[2 * ks + 1][1]), pk2(S[2 * ks + 1][2], S[2 * ks + 1][3])});
                const u32x2 a0 = *(const LAS u32x2*)(QT + fr * 136 + 32 * ks + 4 * fq), a1 = *(const LAS u32x2*)(QT + fr * 136 + 32 * ks + 16 + 4 * fq);
                const u32x2 c0 = *(const LAS u32x2*)(QT + (16 + fr) * 136 + 32 * ks + 4 * fq), c1 = *(const LAS u32x2*)(QT + (16 + fr) * 136 + 32 * ks + 16 + 4 * fq);
                o0 = mfma16(sa, __builtin_bit_cast(bf16x8, (u32x4){a0.x, a0.y, a1.x, a1.y}), o0);
                o1 = mfma16(sa, __builtin_bit_cast(bf16x8, (u32x4){c0.x, c0.y, c1.x, c1.y}), o1); }
            { const u32x2 v0 = *(const LAS u32x2*)(VT + (16 * w + fr) * 40 + 4 * fq), v1 = *(const LAS u32x2*)(VT + (16 * w + fr) * 40 + 16 + 4 * fq);
              const bf16x8 va = __builtin_bit_cast(bf16x8, (u32x4){v0.x, v0.y, v1.x, v1.y});
              o0 = mfma16(va, pf0, o0); o1 = mfma16(va, pf1, o1); }
            *(LAS f32x4*)(OS + fr * 132 + 16 * w + 4 * fq) = o0; *(LAS f32x4*)(OS + (16 + fr) * 132 + 16 * w + 4 * fq) = o1;
        }
        { const bf16x8 vfr = *(const LAS bf16x8*)(VT + (16 * w + fr) * 40 + 8 * fq);
#pragma unroll
          for (int i = 0; i < 8; ++i) { const f32x4 dv4 = *(const LAS f32x4*)(DEC + 16 * i + 4 * fq); S[i] = S[i] * dv4;
              S[i] = mfma16(*(const LAS bf16x8*)(KHT + (16 * i + fr) * 40 + 8 * fq), vfr, S[i]); } }
        if (PROBE_SEL == 14) PT_ACC(lds, PT_NOW() - tk0);
        } }
        if (PROBE_SEL == 15) tk0 = PT_NOW();
        WG_BAR();
        if (PROBE_SEL == 15) PT_ACC(lds, PT_NOW() - tk0);
        if (FULL) {
            LAS float* OS = (LAS float*)(lds + HOS_OFF + cs * HOS_SZ);
            f32x4 o0 = *(const LAS f32x4*)(OS + fc * 132 + 8 * dvg), o1 = *(const LAS f32x4*)(OS + fc * 132 + 8 * dvg + 4);
            if (!SECOND) { *(f32x4*)op = o0; *(f32x4*)(op + 4) = o1; }
            else { o0 = o0 + op0; o1 = o1 + op1;
                float sq = (o0[0] * o0[0] + o0[1] * o0[1]) + (o0[2] * o0[2] + o0[3] * o0[3]) + (o1[0] * o1[0] + o1[1] * o1[1]) + (o1[2] * o1[2] + o1[3] * o1[3]);
                sq += __shfl_xor(sq, 1); sq += __shfl_xor(sq, 2); sq += __shfl_xor(sq, 4); sq += __shfl_xor(sq, 8);
                const float rs = __builtin_amdgcn_rsqf(sq * (1.f / 128.f) + EPS);
                u32x4 ow; ow.x = pk2(o0[0] * rs * ng0[0] * bflo(gw4.x), o0[1] * rs * ng0[1] * bfhi(gw4.x));
                ow.y = pk2(o0[2] * rs * ng0[2] * bflo(gw4.y), o0[3] * rs * ng0[3] * bfhi(gw4.y));
                ow.z = pk2(o1[0] * rs * ng1[0] * bflo(gw4.z), o1[1] * rs * ng1[1] * bfhi(gw4.z));
                ow.w = pk2(o1[2] * rs * ng1[2] * bflo(gw4.w), o1[3] * rs * ng1[3] * bfhi(gw4.w));
                *(u32x4*)(MIXED + (size_t)(b * SEQ + ftok) * DM + h * 128 + 8 * dvg) = ow; }
        }
    }
    WG_BAR();
#undef HG_LOAD
#undef HG_PREP
}
__device__ __forceinline__ float hg_lb(const float* hg_lb_all, int layer, int dir, int ch) {
    if (layer == 0) return 0.f;
    const float a0 = hg_lb_all[(0 * 2 + dir) * 512 + ch], a1 = hg_lb_all[(1 * 2 + dir) * 512 + ch], mx = fmaxf(a0, a1), e0 = __expf(a0 - mx), e1 = __expf(a1 - mx);
    return e1 / (e0 + e1);
}
__device__ __forceinline__ void hg_passA_item(LAS unsigned char* lds, const Params& p, int layer, int item) {
    const int dir = item & 1, seg = (item >> 1) & (NSEG - 1), h = (item >> 4) & 3, b = item >> 6;
    if ((dir == 0 && seg == NSEG - 1) || (dir == 1 && seg == 0)) return;
    int tid_ = threadIdx.x; asm volatile("" : "+v"(tid_)); const int tid = tid_, w = __builtin_amdgcn_readfirstlane(tid >> 6), lane = tid & 63;
    const float lb = hg_lb(p.hg_lb, layer, dir, h * 128 + 16 * w + (lane & 15));
    f32x4 S[8];
#pragma unroll
    for (int i = 0; i < 8; ++i) S[i] = (f32x4){0.f, 0.f, 0.f, 0.f};
    float bsum = 1.f;
    hg_segment<false, false>(lds, (const bf16*)(p.ws + WS_P), b, h, dir, seg, lb, S, bsum, nullptr, nullptr, nullptr);
    u32x2* sl = (u32x2*)(p.ws + WS_SLOC) + (size_t)item * 4096;
#pragma unroll
    for (int i = 0; i < 8; ++i) sl[(w * 8 + i) * 64 + lane] = (u32x2){pk2(S[i][0], S[i][1]), pk2(S[i][2], S[i][3])};
    if (lane < 16) ((float*)(p.ws + WS_DSEG))[(size_t)item * 128 + 16 * w + (lane & 15)] = bsum;
    __syncthreads();
}
__device__ __forceinline__ unsigned long long hg_passB_item(LAS unsigned char* lds, const Params& p, int layer, int item) {
    unsigned long long tsub = 0, t0_ = 0;
    const int seg = item & (NSEG - 1), h = (item >> 3) & 3, b = item >> 5;
    int tid_ = threadIdx.x; asm volatile("" : "+v"(tid_)); const int tid = tid_, w = __builtin_amdgcn_readfirstlane(tid >> 6), lane = tid & 63, fr = lane & 15, fq = lane >> 4;
    const u32x2* slb = (const u32x2*)(p.ws + WS_SLOC); const float* dsg = (const float*)(p.ws + WS_DSEG);
    float* OP = p.out;   bf16* MIXED = (bf16*)(p.ws + WS_MIX); const bf16* P = (const bf16*)(p.ws + WS_P);
#pragma unroll 1
    for (int dir = 0; dir < 2; ++dir) {
        const float lb = hg_lb(p.hg_lb, layer, dir, h * 128 + 16 * w + (lane & 15));
        f32x4 S[8];
#pragma unroll
        for (int i = 0; i < 8; ++i) S[i] = (f32x4){0.f, 0.f, 0.f, 0.f};
        const int nprev = dir == 0 ? seg : (NSEG - 1 - seg);
        if (PROBE_SEL == 11) t0_ = PT_NOW();
#pragma unroll 1
        for (int q = 0; q < nprev; q += 2) {
            const bool two = q + 1 < nprev; const int sA = dir == 0 ? q : (NSEG - 1 - q), sB = two ? (dir == 0 ? q + 1 : (NSEG - 2 - q)) : sA;
            const int itA = ((b * 4 + h) * NSEG + sA) * 2 + dir, itB = ((b * 4 + h) * NSEG + sB) * 2 + dir;
            const u32x2* slA = slb + (size_t)itA * 4096; const float* dcA = dsg + (size_t)itA * 128; const u32x2* slB = slb + (size_t)itB * 4096; const float* dcB = dsg + (size_t)itB * 128;
            f32x4 dvA[8], dvB[8]; u32x2 svA[8], svB[8];
#pragma unroll
            for (int i = 0; i < 8; ++i) { dvA[i] = *(const f32x4*)(dcA + 16 * i + 4 * fq); svA[i] = slA[(w * 8 + i) * 64 + lane]; dvB[i] = *(const f32x4*)(dcB + 16 * i + 4 * fq); svB[i] = slB[(w * 8 + i) * 64 + lane]; }
            __builtin_amdgcn_sched_barrier(0);
#pragma unroll
            for (int i = 0; i < 8; ++i) { S[i] = S[i] * dvA[i] + (f32x4){bflo(svA[i].x), bfhi(svA[i].x), bflo(svA[i].y), bfhi(svA[i].y)};
                if (two) S[i] = S[i] * dvB[i] + (f32x4){bflo(svB[i].x), bfhi(svB[i].x), bflo(svB[i].y), bfhi(svB[i].y)}; } }
        if (PROBE_SEL == 11) PT_ACC(lds, PT_NOW() - t0_);
        if (PROBE_SEL == 10) t0_ = PT_NOW();
        float bsum = 1.f;
        if (dir == 0) hg_segment<true, false>(lds, P, b, h, 0, seg, lb, S, bsum, OP, MIXED, p.hg_ng + layer * 128);
        else hg_segment<true, true>(lds, P, b, h, 1, seg, lb, S, bsum, OP, MIXED, p.hg_ng + layer * 128);
        if (PROBE_SEL == 10) PT_ACC(lds, PT_NOW() - t0_);
        if (PROBE_SEL == 12) t0_ = PT_NOW();
        __syncthreads();
        if (PROBE_SEL == 12) PT_ACC(lds, PT_NOW() - t0_);
    }
    return tsub;
}

constexpr int NA_KS = 584, NA_RPB_OFF = 64 * NA_KS * 2;
__device__ __forceinline__ int clampi(int v, int lo, int hi) { return v < lo ? lo : (v > hi ? hi : v); }
__device__ __forceinline__ void na_item(LAS unsigned char* lds, const Params& p, int layer, int item) {
    const int rp = item & 15, h = (item >> 4) & 3, b = item >> 6, r0 = 2 * rp, kbase = clampi(r0 - 4, 0, 24);
    int tid_ = threadIdx.x; asm volatile("" : "+v"(tid_)); const int tid = tid_, w = __builtin_amdgcn_readfirstlane(tid >> 6), lane = tid & 63, fr = lane & 15, fq = lane >> 4;
    const bf16* P = (const bf16*)(p.ws + WS_P); bf16* MIXED = (bf16*)(p.ws + WS_MIX);
    LAS bf16* VT = (LAS bf16*)lds; LAS float* RPB = (LAS float*)(lds + NA_RPB_OFF);
    const int rl = w >> 2, j = w & 3, r = r0 + rl, kr0 = clampi(r - 4, 0, 24), kc0 = clampi(16 * j - 8, 0, 32);
    const size_t qtok = (size_t)b * SEQ + r * 64 + 16 * j + fr;
    u32x4 vbuf[9];
#pragma unroll
    for (int it = 0; it < 9; ++it) { const int key = it * 64 + lane, dg = w; int trow = kbase * 64 + key; trow = trow > SEQ - 1 ? SEQ - 1 : trow;
        vbuf[it] = *(const u32x4*)(P + (size_t)(b * SEQ + trow) * DIN + C_NV + h * 64 + 8 * dg); }
    bf16x8 qf[2], kfa[16], kfb[16];
#pragma unroll
    for (int ks = 0; ks < 2; ++ks) qf[ks] = *(const bf16x8*)(P + qtok * DIN + C_NQ + h * 64 + 32 * ks + 8 * fq);
#define NA_KLOAD(dst, hh) do { _Pragma("unroll") for (int k8 = 0; k8 < 8; ++k8) { const int kt = (hh) * 8 + k8, krl = kt >> 1, half = kt & 1; \
        const size_t ktok = (size_t)b * SEQ + (kr0 + krl) * 64 + kc0 + 16 * half + fr; \
        _Pragma("unroll") for (int ks = 0; ks < 2; ++ks) dst[k8 * 2 + ks] = *(const bf16x8*)(P + ktok * DIN + C_NK + h * 64 + 32 * ks + 8 * fq); } } while (0)
    NA_KLOAD(kfa, 0);
    __builtin_amdgcn_sched_barrier(0);
#pragma unroll
    for (int it = 0; it < 9; ++it) { const int key = it * 64 + lane, dg = w; const u32x4 v = vbuf[it];
        LAS bf16* dst = VT + (8 * dg) * NA_KS + key;
        dst[0 * NA_KS] = (bf16)(v.x & 0xffffu); dst[1 * NA_KS] = (bf16)(v.x >> 16); dst[2 * NA_KS] = (bf16)(v.y & 0xffffu); dst[3 * NA_KS] = (bf16)(v.y >> 16);
        dst[4 * NA_KS] = (bf16)(v.z & 0xffffu); dst[5 * NA_KS] = (bf16)(v.z >> 16); dst[6 * NA_KS] = (bf16)(v.w & 0xffffu); dst[7 * NA_KS] = (bf16)(v.w >> 16); }
    for (int i = tid; i < 465; i += NTHR) RPB[i] = p.rpb[(size_t)(layer * 4 + h) * 465 + i];
    NA_KLOAD(kfb, 1);
    __builtin_amdgcn_sched_barrier(0);
    WG_BAR();
    f32x4 s[16];
#pragma unroll
    for (int k8 = 0; k8 < 8; ++k8) { f32x4 a = (f32x4){0.f, 0.f, 0.f, 0.f};
#pragma unroll
        for (int ks = 0; ks < 2; ++ks) a = mfma16(kfa[k8 * 2 + ks], qf[ks], a);
        s[k8] = a; }
#pragma unroll
    for (int k8 = 0; k8 < 8; ++k8) { f32x4 a = (f32x4){0.f, 0.f, 0.f, 0.f};
#pragma unroll
        for (int ks = 0; ks < 2; ++ks) a = mfma16(kfb[k8 * 2 + ks], qf[ks], a);
        s[8 + k8] = a; }
#undef NA_KLOAD
    const int qc = 16 * j + fr, qs = clampi(qc - 8, 0, 48);
    float mx = -1e30f;
#pragma unroll
    for (int kt = 0; kt < 16; ++kt) { const int krl = kt >> 1, half = kt & 1; const int ridx = kr0 + krl - r + 7;
        float bz[4];
#pragma unroll
        for (int i = 0; i < 4; ++i) { const int kc = kc0 + 16 * half + 4 * fq + i; bz[i] = RPB[ridx * 31 + clampi(kc - qc + 15, 0, 30)]; }
#pragma unroll
        for (int i = 0; i < 4; ++i) { const int kc = kc0 + 16 * half + 4 * fq + i; const bool valid = kc >= qs && kc < qs + 16;
            const float v = valid ? s[kt][i] * 0.125f + bz[i] : -1e30f; s[kt][i] = v; mx = fmaxf(mx, v); } }
    mx = fmaxf(mx, __shfl_xor(mx, 16)); mx = fmaxf(mx, __shfl_xor(mx, 32));
    float sum = 0.f;
#pragma unroll
    for (int kt = 0; kt < 16; ++kt)
#pragma unroll
        for (int i = 0; i < 4; ++i) { const float e = __expf(s[kt][i] - mx); s[kt][i] = e; sum += e; }
    sum += __shfl_xor(sum, 16); sum += __shfl_xor(sum, 32);
    f32x4 o[4];
#pragma unroll
    for (int dt = 0; dt < 4; ++dt) o[dt] = (f32x4){0.f, 0.f, 0.f, 0.f};
#pragma unroll
    for (int kk = 0; kk < 8; ++kk) {
        const u32x4 pw = (u32x4){pk2(s[2 * kk][0], s[2 * kk][1]), pk2(s[2 * kk][2], s[2 * kk][3]), pk2(s[2 * kk + 1][0], s[2 * kk + 1][1]), pk2(s[2 * kk + 1][2], s[2 * kk + 1][3])};
        const bf16x8 pf = __builtin_bit_cast(bf16x8, pw);
        const int keyoff = (kr0 + kk - kbase) * 64 + kc0 + 4 * fq;
#pragma unroll
        for (int dt = 0; dt < 4; ++dt) { const u32x2 lo = *(const LAS u32x2*)(VT + (16 * dt + fr) * NA_KS + keyoff), hi = *(const LAS u32x2*)(VT + (16 * dt + fr) * NA_KS + keyoff + 16);
            const bf16x8 vf = __builtin_bit_cast(bf16x8, (u32x4){lo.x, lo.y, hi.x, hi.y});
            o[dt] = mfma16(vf, pf, o[dt]); } }
    const float inv = 1.f / sum;
#pragma unroll
    for (int dt = 0; dt < 4; ++dt) *(u32x2*)(MIXED + qtok * DM + 512 + h * 64 + 16 * dt + 4 * fq) = (u32x2){pk2(o[dt][0] * inv, o[dt][1] * inv), pk2(o[dt][2] * inv, o[dt][3] * inv)};
    WG_BAR();
}

__device__ __forceinline__ void conv_item(LAS unsigned char* lds, const Params& p, int layer, int item) {
    const int b = item >> 6, t0 = (item & 63) * 32;
    int tid_ = threadIdx.x; asm volatile("" : "+v"(tid_)); const int tid = tid_, w = __builtin_amdgcn_readfirstlane(tid >> 6), lane = tid & 63;
    const bf16* P = (const bf16*)(p.ws + WS_P); bf16* MIXED = (bf16*)(p.ws + WS_MIX);
    LAS float* U = (LAS float*)lds; LAS float* CO = U + 62 * 256;
    u32x4 ca4[4], cg4[4];
#pragma unroll
    for (int it = 0; it < 4; ++it) { const int u = it * NTHR + tid, tt = u >> 5, c8 = u & 31, t = t0 - 15 + tt; ca4[it] = (u32x4){0u, 0u, 0u, 0u}; cg4[it] = ca4[it];
        if (u < 62 * 32 && t >= 0 && t < SEQ) { const bf16* rp = P + (size_t)(b * SEQ + t) * DIN; ca4[it] = *(const u32x4*)(rp + C_CA + 8 * c8); cg4[it] = *(const u32x4*)(rp + C_CG + 8 * c8); } }
    const int c = tid & 255, half = tid >> 8;
    float wk[31];
#pragma unroll
    for (int k = 0; k < 31; ++k) wk[k] = p.cw[(size_t)(layer * 31 + k) * 256 + c];
    const float bias = p.cb[layer * 256 + c];
    __builtin_amdgcn_sched_barrier(0);
#pragma unroll
    for (int it = 0; it < 4; ++it) { const int u = it * NTHR + tid, tt = u >> 5, c8 = u & 31; const u32x4 a = ca4[it], g = cg4[it];
        if (u < 62 * 32) {
            const f32x4 u0 = (f32x4){bflo(a.x) * sigm(bflo(g.x)), bfhi(a.x) * sigm(bfhi(g.x)), bflo(a.y) * sigm(bflo(g.y)), bfhi(a.y) * sigm(bfhi(g.y))};
            const f32x4 u1 = (f32x4){bflo(a.z) * sigm(bflo(g.z)), bfhi(a.z) * sigm(bfhi(g.z)), bflo(a.w) * sigm(bflo(g.w)), bfhi(a.w) * sigm(bfhi(g.w))};
            *(LAS f32x4*)(U + tt * 256 + 8 * c8) = u0; *(LAS f32x4*)(U + tt * 256 + 8 * c8 + 4) = u1; } }
    WG_BAR();
#pragma unroll 1
    for (int g = 0; g < 2; ++g) { const int base = 16 * half + 8 * g; float win[38];
#pragma unroll
        for (int i = 0; i < 38; ++i) win[i] = U[(base + i) * 256 + c];
#pragma unroll
        for (int o = 0; o < 8; ++o) { float a = bias;
#pragma unroll
            for (int k = 0; k < 31; ++k) a += wk[k] * win[o + k];
            CO[(base + o) * 256 + c] = a; } }
    __syncthreads();
    const f32x4 lg = *(const f32x4*)(p.lng + layer * 256 + 4 * lane), lbv = *(const f32x4*)(p.lnb + layer * 256 + 4 * lane);
#pragma unroll
    for (int q = 0; q < 4; ++q) { const int tl = 4 * w + q; const f32x4 v = *(const LAS f32x4*)(CO + tl * 256 + 4 * lane);
        const float mean = wave_sum((v.x + v.y) + (v.z + v.w)) * (1.f / 256.f); const f32x4 dd = v - mean;
        const float var = wave_sum((dd.x * dd.x + dd.y * dd.y) + (dd.z * dd.z + dd.w * dd.w)) * (1.f / 256.f); const float rs = __builtin_amdgcn_rsqf(var + EPS);
        f32x4 y = dd * rs * lg + lbv; y = (f32x4){silu_f0(y.x), silu_f0(y.y), silu_f0(y.z), silu_f0(y.w)};
        *(u32x2*)(MIXED + (size_t)(b * SEQ + t0 + tl) * DM + 768 + 4 * lane) = (u32x2){pk2(y.x, y.y), pk2(y.z, y.w)}; }
    __syncthreads();
}

#define XB_TMO      128
#define XB_XCNT(j)  (256  + 64 * (j))
#define XB_XSUB(j)  (1280 + 64 * (j))
#define XB_XGEN(j)  (2304 + 64 * (j))
#define XB_TOP      3328
#define XB_TOPGEN   3392
#define XCD_BAR_WORDS 3456
#define XB_SPIN_CAP (1u << 18)

__device__ __forceinline__ unsigned xb_ld(unsigned* p)              { return __hip_atomic_load(p, __ATOMIC_RELAXED, __HIP_MEMORY_SCOPE_AGENT); }
__device__ __forceinline__ unsigned xb_add(unsigned* p, unsigned v) { return __hip_atomic_fetch_add(p, v, __ATOMIC_RELAXED, __HIP_MEMORY_SCOPE_AGENT); }
__device__ __forceinline__ unsigned xb_xcc_id() { return (unsigned)__builtin_amdgcn_s_getreg((3 << 11) | 20) & 0xFu; }
#define XB_SPIN(cond, bar) do { unsigned _sp = 0; while (cond) { __builtin_amdgcn_s_sleep(1); \
    if ((++_sp & 255u) == 0u) { if (xb_ld(&(bar)[XB_TMO])) break; if (_sp > XB_SPIN_CAP) { atomicAdd(&(bar)[XB_TMO], 1u); break; } } } } while (0)

struct XcdBarrier {
    unsigned* bar; unsigned x;
    volatile LAS unsigned* st;
};

__device__ __forceinline__ XcdBarrier xcd_barrier_post(unsigned* bar, volatile LAS unsigned* st) {
    XcdBarrier b; b.bar = bar; b.x = xb_xcc_id(); b.st = st;
    if (threadIdx.x == 0) (void)xb_add(&bar[XB_XCNT(b.x)], 1u);
    return b;
}
__device__ __forceinline__ void xcd_barrier_complete(unsigned* bar, unsigned x, unsigned& nloc, unsigned& nx) {
    const unsigned G = gridDim.x * gridDim.y * gridDim.z;
    unsigned sum, cnt, mine, sp = 0u;
    for (;;) {
        sum = 0u; cnt = 0u; mine = 0u;
#pragma unroll
        for (unsigned j = 0; j < 16; ++j) { const unsigned c = xb_ld(&bar[XB_XCNT(j)]); sum += c; cnt += (c > 0u) ? 1u : 0u; mine = (j == x) ? c : mine; }
        if (sum == G) break;
        __builtin_amdgcn_s_sleep(1);
        if ((++sp & 255u) == 0u) { if (xb_ld(&bar[XB_TMO])) break; if (sp > XB_SPIN_CAP) { atomicAdd(&bar[XB_TMO], 1u); break; } }
    }
    nloc = mine > 0u ? mine : 1u; nx = cnt > 0u ? cnt : 1u;
}

__device__ __forceinline__ void xcd_barrier(const XcdBarrier& b) {
    asm volatile("s_waitcnt vmcnt(0)" ::: "memory");
    __syncthreads();
    if (threadIdx.x == 0) {
        unsigned* bar = b.bar;
        __builtin_amdgcn_s_waitcnt(0);
        unsigned nloc = b.st[0], nx = b.st[1];
        if (nloc == 0u) { xcd_barrier_complete(bar, b.x, nloc, nx); b.st[0] = nloc; b.st[1] = nx; }
        const unsigned old = xb_add(&bar[XB_XSUB(b.x)], 1u);
        const unsigned gen = old / nloc;
        if (old + 1u == (gen + 1u) * nloc) {
            __builtin_amdgcn_fence(__ATOMIC_RELEASE, "agent");
            asm volatile("s_waitcnt vmcnt(0)" ::: "memory");
            const unsigned og = xb_add(&bar[XB_TOP], 1u);
            const unsigned tg = og / nx;
            if (og + 1u == (tg + 1u) * nx) xb_add(&bar[XB_TOPGEN], 1u);
            else XB_SPIN(xb_ld(&bar[XB_TOPGEN]) == tg, bar);
            __builtin_amdgcn_fence(__ATOMIC_ACQUIRE, "agent");
            xb_add(&bar[XB_XGEN(b.x)], 1u);
            asm volatile("s_waitcnt vmcnt(0)" ::: "memory");
        } else {
            XB_SPIN(xb_ld(&bar[XB_XGEN(b.x)]) == gen, bar);
            __builtin_amdgcn_fence(__ATOMIC_ACQUIRE, "agent");
            asm volatile("s_waitcnt vmcnt(0)" ::: "memory");
        }
    }
    __syncthreads();
}

#if 0
#define PROBE_SEL_UNUSED (-1)
#endif
#ifndef REP_HA
#define REP_HA 1
#endif
#ifndef REP_NA
#define REP_NA 1
#endif
#ifndef REP_CV
#define REP_CV 1
#endif
#ifndef REP_F
#define REP_F 1
#endif
#ifndef REP_B
#define REP_B 1
#endif
#define GRID_BAR() do { XcdBarrier xb_; xb_.bar = (unsigned*)(ws + WS_BAR); xb_.x = xb_xcc_id(); xb_.st = (volatile LAS unsigned*)(lds + XB_ST_OFF); xcd_barrier(xb_); } while (0)
#define PHASE_END(kind) do { GRID_BAR(); if (PROBE_SEL >= 0 && PROBE_SEL < 10 && threadIdx.x == 0) { volatile LAS unsigned long long* pv_ = (volatile LAS unsigned long long*)(lds + PT_WORDS_OFF + 8); const unsigned long long t_ = PT_NOW(); if ((kind) == PROBE_SEL) PT_ACC(lds, t_ - pv_[0]); pv_[0] = t_; } } while (0)
constexpr size_t WS_BAR = 4096, WS_CTL_BYTES = 65536;
constexpr int XB_ST_OFF = 140288;
constexpr int RS_OFF = 131072;
constexpr int LDS_BYTES = 147456;
#define KARGS(q_) const Params& q_ = p_unused;
__global__ void __launch_bounds__(NTHR, 2) fwd_megakernel(Params p_unused) {
    extern __shared__ __attribute__((aligned(16))) unsigned char lds_raw[];
    LAS unsigned char* lds = (LAS unsigned char*)lds_raw;
    int tid_ = threadIdx.x; asm volatile("" : "+v"(tid_)); const int tid = tid_, lane = tid & 63, wave = __builtin_amdgcn_readfirstlane(tid >> 6);
    const int G = gridDim.x, bid = blockIdx.x, gw = bid * NWAVES + wave, NGW = G * NWAVES;
    unsigned char* ws; { KARGS(q0); ws = q0.ws; }

    if (tid < 2) ((volatile LAS unsigned*)(lds + XB_ST_OFF))[tid] = 0u;
    __syncthreads();
    if (ws == nullptr) cg::this_grid().sync();
    (void)xcd_barrier_post((unsigned*)(ws + WS_BAR), (volatile LAS unsigned*)(lds + XB_ST_OFF));
    if (PROBE_SEL >= 0 && threadIdx.x == 0) { ((volatile LAS unsigned*)(lds + PT_WORDS_OFF))[0] = 0u; *(volatile LAS unsigned long long*)(lds + PT_WORDS_OFF + 8) = PT_NOW(); }
    { KARGS(q); prologue(q, lds, gw, NGW, wave, lane); }
    PHASE_END(0);
    if (PROBE_SEL == 8) { PHASE_END(9); PHASE_END(8); }
#pragma unroll 1
    for (int l = 0; l < DEPTH; ++l) {
        unsigned char* wsl; { KARGS(ql); wsl = ql.ws; }
        float* ssq = (float*)(wsl + WS_SSQ); bf16* XB = (bf16*)(wsl + WS_XB); bf16* PB = (bf16*)(wsl + WS_P); bf16* MIXED = (bf16*)(wsl + WS_MIX);
        {
            pg8::Gemm g{XB, (const bf16*)(wsl + WS_WIN + l * WS_WIN_L), M, DIN, DM}; pg8::StaticOrder S; S.init(M, DIN, G, bid);
            pg8::rstd_table((LAS float*)(lds + RS_OFF), ssq, S); pg8::EpiScale E{PB, DIN, (LAS float*)(lds + RS_OFF), 0x303u};
            pg8::gemm_phase<pg8::EpiScale, pg8::StaticOrder, true, true>(lds, g, S, E);
        }
        PHASE_END(1);
#pragma unroll 1
        for (int rep = 0; rep < REP_HA; ++rep)
        { KARGS(q); for (int it = bid; it < BATCH * 4 * NSEG * 2; it += G) hg_passA_item(lds, q, l, it); }
#pragma unroll 1
        for (int rep = 0; rep < REP_NA; ++rep)
        { KARGS(q); for (int it = bid; it < BATCH * 4 * 16; it += G) na_item(lds, q, l, it); }
#pragma unroll 1
        for (int rep = 0; rep < REP_CV; ++rep)
        { KARGS(q); for (int it = bid; it < BATCH * 64; it += G) conv_item(lds, q, l, it); }
        PHASE_END(2);
#pragma unroll 1
        for (int rep = 0; rep < REP_B; ++rep)
        { KARGS(q); for (int it = bid; it < BATCH * 4 * NSEG; it += G) (void)hg_passB_item(lds, q, l, it); }
        PHASE_END(3);
        {
            pg8::Gemm g{MIXED, (const bf16*)(wsl + WS_WOUT + l * WS_WOUT_L), M, DM, DM}; pg8::StaticOrder S; S.init(M, DM, G, bid);
            pg8::EpiRes E{XB, ssq};
            pg8::gemm_phase<pg8::EpiRes, pg8::StaticOrder, true, true>(lds, g, S, E);
        }
        PHASE_END(4);
        {
            pg8::Gemm g{XB, (const bf16*)(wsl + WS_WGU + l * WS_WGU_L), M, 2 * FFN, DM}; pg8::StaticOrder S; S.init(M, 2 * FFN, G, bid);
            pg8::rstd_table((LAS float*)(lds + RS_OFF), ssq, S); pg8::EpiSwiGLU E{PB, FFN, (LAS float*)(lds + RS_OFF)};
            pg8::gemm_phase<pg8::EpiSwiGLU, pg8::StaticOrder, true, true>(lds, g, S, E);
        }
        PHASE_END(5);
        {
            pg8::Gemm g{PB, (const bf16*)(wsl + WS_WDN + l * WS_WDN_L), M, DM, FFN}; pg8::StaticOrder S; S.init(M, DM, G, bid);
            pg8::EpiRes E{XB, ssq};
            pg8::gemm_phase<pg8::EpiRes, pg8::StaticOrder, true, true>(lds, g, S, E);
        }
        PHASE_END(6);
    }
    float pdelta = 0.f;
    int tf_ = threadIdx.x; asm volatile("" : "+v"(tf_)); const int lanef = tf_ & 63, gwf = bid * NWAVES + __builtin_amdgcn_readfirstlane(tf_ >> 6);
    KARGS(qf); unsigned char* wsf = qf.ws; const float* ssq = (const float*)(wsf + WS_SSQ); const bf16* XB = (const bf16*)(wsf + WS_XB);
    if (PROBE_SEL >= 0) {
        unsigned* tw = (unsigned*)(wsf + 64);
        if (bid == 0 && threadIdx.x == 0) __hip_atomic_store(tw, ((volatile LAS unsigned*)(lds + PT_WORDS_OFF))[0], __ATOMIC_RELAXED, __HIP_MEMORY_SCOPE_AGENT);
        GRID_BAR();
        pdelta = (float)__hip_atomic_load(tw, __ATOMIC_RELAXED, __HIP_MEMORY_SCOPE_AGENT) * 1e-6f;
    }
#pragma unroll 1
    for (int rep = 0; rep < REP_F; ++rep)
    for (int m = gwf; m < M; m += 2 * NGW) {
        const int m2 = (m + NGW < M) ? m + NGW : m;
        float pa = lanef < 16 ? ssq[(size_t)(lanef & 15) * M + m] : 0.f, pc = lanef < 16 ? ssq[(size_t)(lanef & 15) * M + m2] : 0.f;
        const u32x4* xa = (const u32x4*)(XB + (size_t)m * DM) + lanef; const u32x4* xc = (const u32x4*)(XB + (size_t)m2 * DM) + lanef;
        u32x4 va[2], vc[2]; f32x4 gg[4];
#pragma unroll
        for (int j = 0; j < 2; ++j) { va[j] = xa[64 * j]; vc[j] = xc[64 * j]; gg[2 * j] = *(const f32x4*)(qf.fin_g + 512 * j + 8 * lanef); gg[2 * j + 1] = *(const f32x4*)(qf.fin_g + 512 * j + 8 * lanef + 4); }
        __builtin_amdgcn_sched_barrier(0);
        pa = wave_sum(pa); pc = wave_sum(pc);
        const float ra = __builtin_amdgcn_rsqf(pa * (1.f / DM) + EPS), rc = __builtin_amdgcn_rsqf(pc * (1.f / DM) + EPS);
        const f32x4 pd = (PROBE_SEL >= 0) ? (f32x4){pdelta, -pdelta, pdelta, -pdelta} : (f32x4){0.f, 0.f, 0.f, 0.f};
#pragma unroll
        for (int j = 0; j < 2; ++j) {
            { const u32x4 r = va[j]; float* o = qf.out + (size_t)m * DM + 512 * j + 8 * lanef;
              f32x4 v0 = (f32x4){bflo(r.x), bfhi(r.x), bflo(r.y), bfhi(r.y)} * ra * gg[2 * j], v1 = (f32x4){bflo(r.z), bfhi(r.z), bflo(r.w), bfhi(r.w)} * ra * gg[2 * j + 1];
              if (PROBE_SEL >= 0 && m < 256) { v0 = v0 + pd; v1 = v1 + pd; }
              *(f32x4*)o = v0; *(f32x4*)(o + 4) = v1; }
            if (m2 != m) { const u32x4 r = vc[j]; float* o = qf.out + (size_t)m2 * DM + 512 * j + 8 * lanef;
              f32x4 v0 = (f32x4){bflo(r.x), bfhi(r.x), bflo(r.y), bfhi(r.y)} * rc * gg[2 * j], v1 = (f32x4){bflo(r.z), bfhi(r.z), bflo(r.w), bfhi(r.w)} * rc * gg[2 * j + 1];
              if (PROBE_SEL >= 0 && m2 < 256) { v0 = v0 + pd; v1 = v1 + pd; }
              *(f32x4*)o = v0; *(f32x4*)(o + 4) = v1; } }
    }
}

extern "C" void kernel_launch(void* const* d_in, const int* in_sizes, int n_in, void* d_out, int out_size, void* d_ws, size_t ws_size, hipStream_t stream) {
    static int grid_blocks = 0;
    if (grid_blocks == 0) {
        if (n_in != 15 || out_size != M * DM || ws_size < WS_END) { fprintf(stderr, "kernel_launch: unexpected shapes (n_in %d out %d ws %zu)\n", n_in, out_size, ws_size); grid_blocks = -1; return; }
        int dev = 0, cus = 0, per_cu = 0;
        hipGetDevice(&dev); hipDeviceGetAttribute(&cus, hipDeviceAttributeMultiprocessorCount, dev);
        hipFuncSetAttribute((const void*)fwd_megakernel, hipFuncAttributeMaxDynamicSharedMemorySize, LDS_BYTES);
        hipOccupancyMaxActiveBlocksPerMultiprocessor(&per_cu, (const void*)fwd_megakernel, NTHR, LDS_BYTES);
        if (per_cu < 1) { fprintf(stderr, "kernel_launch: occupancy query says %d blocks per CU\n", per_cu); per_cu = 1; }
        (void)hipGetLastError();
        grid_blocks = cus * 1;
    }
    if (grid_blocks < 0) return;
    Params p{};
    p.x = (const float*)d_in[0]; p.mix_g = (const float*)d_in[1]; p.w_in = (const float*)d_in[2]; p.hg_lb = (const float*)d_in[3]; p.hg_ng = (const float*)d_in[4];
    p.rpb = (const float*)d_in[5]; p.cw = (const float*)d_in[6]; p.cb = (const float*)d_in[7]; p.lng = (const float*)d_in[8]; p.lnb = (const float*)d_in[9];
    p.w_out = (const float*)d_in[10]; p.ffn_g = (const float*)d_in[11]; p.w_gu = (const float*)d_in[12]; p.w_dn = (const float*)d_in[13]; p.fin_g = (const float*)d_in[14];
    p.out = (float*)d_out; p.ws = (unsigned char*)d_ws;
    if (hipMemsetAsync(d_ws, 0, WS_CTL_BYTES, stream) != hipSuccess) { fprintf(stderr, "kernel_launch: hipMemsetAsync failed\n"); return; }
    void* args[] = {&p};
    hipError_t e = hipLaunchCooperativeKernel((const void*)fwd_megakernel, dim3(grid_blocks), dim3(NTHR), args, LDS_BYTES, stream);
    if (e != hipSuccess) fprintf(stderr, "cooperative launch failed: %s (grid %d)\n", hipGetErrorString(e), grid_blocks);
}
```

```cpp
#include <hip/hip_runtime.h>
#include <hip/hip_cooperative_groups.h>
#include <cstdio>
#include <cstdint>
namespace cg = cooperative_groups;

namespace pg8 {
#define PG8_LAS __attribute__((address_space(3)))
typedef unsigned short bf16_t;
typedef short bf16x8 __attribute__((ext_vector_type(8)));
typedef float f32x4 __attribute__((ext_vector_type(4)));
typedef unsigned u32x4 __attribute__((ext_vector_type(4)));
constexpr int BM = 256, BK = 64, HALF = 128, HTB = HALF * BK * 2  , STAGE_BYTES = 8 * HTB, NXCD = 8, WGM = 8;

__host__ __device__ __forceinline__ int lds_byte(int r, int c) { const int st = (r >> 4) * 2 + (c >> 5), rr = r & 15, cc = c & 31, ob = rr * 64 + cc * 2; return st * 1024 + (ob ^ (((ob >> 9) & 1) << 5)); }
__host__ __device__ __forceinline__ void stage_rc(int b, int& R, int& C) { const int st = b / 1024, sb = b % 1024, swz = sb ^ (((sb >> 9) & 1) << 5); R = (st >> 1) * 16 + swz / 64; C = (st & 1) * 32 + (swz % 64) / 2; }
__host__ __device__ __forceinline__ int perm32(int rho) { const int n = rho >> 4, i = rho & 15; return 8 * (i >> 2) + 4 * n + (i & 3); }

struct Unit { int pm, pn; };
struct Gemm { const bf16_t* A; const bf16_t* Bt; int M, N, K; };

struct StaticOrder {
    int nM, nN, nwg, G, c;
    __host__ __device__ void init(int M, int N, int G_, int c_) { nM = M / BM; nN = N / BM; nwg = nM * nN; G = G_; c = c_; }
    __host__ __device__ bool next(int i, Unit& u) const {
        const long L = (long)i * G + c; if (L >= nwg) return false;
        int wgid = (int)L; { const int q = nwg / NXCD, r = nwg % NXCD, xcd = wgid % NXCD, off = wgid / NXCD; wgid = (xcd < r ? xcd * (q + 1) : r * (q + 1) + (xcd - r) * q) + off; }
        const int nig = WGM * nN, gid = wgid / nig, fm = gid * WGM, gsz = (nM - fm) < WGM ? (nM - fm) : WGM;
        u.pm = fm + ((wgid % nig) % gsz); u.pn = (wgid % nig) / gsz; return true;
    }
    __device__ __forceinline__ void a_ready(const Unit&) const {}
    __device__ __forceinline__ void done(const Unit&) const {}
};
__device__ __forceinline__ unsigned cvt_pk_bf16(float lo, float hi) { unsigned r; asm volatile("v_cvt_pk_bf16_f32 %0, %1, %2" : "=v"(r) : "v"(lo), "v"(hi)); return r; }
typedef float f32x2 __attribute__((ext_vector_type(2)));
constexpr int MROWS = 16384, DMODEL = 1024, NPART = 16;
constexpr float NORM_EPS = 1e-6f;
__device__ __forceinline__ float row_rstd(const float* ssq, int row) {
    float s = 0.f;
#pragma unroll
    for (int p = 0; p < NPART; ++p) s += ssq[(size_t)p * MROWS + row];
    return __builtin_amdgcn_rsqf(s * (1.f / DMODEL) + NORM_EPS);
}
__device__ __forceinline__ float silu_f(float x) { return x * __builtin_amdgcn_rcpf(1.f + __expf(-x)); }

struct EpiScale {
    static constexpr bool PERM = true, AFTER_DRAIN = false;
    bf16_t* O; int ldc; const PG8_LAS float* RS; unsigned silu_mask;
    __device__ __forceinline__ void operator()(const f32x4 (&acc)[2][2][4][2], const Unit& u, int ui, int wr, int wc, int fr, int fq) const {
        const int row0 = u.pm * BM + wr * 64 + fr, col0 = u.pn * BM + wc * 32 + 8 * fq; const bool act = (silu_mask >> u.pn) & 1u;
#pragma unroll
        for (int ai = 0; ai < 2; ++ai)
#pragma unroll
            for (int m = 0; m < 4; ++m) { const int row = row0 + ai * HALF + m * 16; const float rs = RS[ui * BM + wr * 64 + fr + ai * HALF + m * 16]; bf16_t* rowp = O + (size_t)row * ldc + col0;
#pragma unroll
                for (int bj = 0; bj < 2; ++bj) { f32x4 v0 = acc[ai][bj][m][0] * rs, v1 = acc[ai][bj][m][1] * rs;
                    if (act) { v0 = (f32x4){silu_f(v0[0]), silu_f(v0[1]), silu_f(v0[2]), silu_f(v0[3])}; v1 = (f32x4){silu_f(v1[0]), silu_f(v1[1]), silu_f(v1[2]), silu_f(v1[3])}; }
                    u32x4 w; w.x = cvt_pk_bf16(v0[0], v0[1]); w.y = cvt_pk_bf16(v0[2], v0[3]); w.z = cvt_pk_bf16(v1[0], v1[1]); w.w = cvt_pk_bf16(v1[2], v1[3]);
                    *(u32x4*)(rowp + bj * HALF) = w; } __builtin_amdgcn_sched_barrier(0); }
    }
};
struct EpiRes {
    static constexpr bool PERM = true, AFTER_DRAIN = false;
    bf16_t* XB; float* ssq;
    __device__ __forceinline__ void operator()(const f32x4 (&acc)[2][2][4][2], const Unit& u, int ui, int wr, int wc, int fr, int fq) const {
        const int row0 = u.pm * BM + wr * 64 + fr, col0 = u.pn * BM + wc * 32 + 8 * fq;
#pragma unroll
        for (int ai = 0; ai < 2; ++ai)
#pragma unroll
            for (int mm = 0; mm < 4; mm += 2) {
                u32x4 rr[2][2];
#pragma unroll
                for (int q = 0; q < 2; ++q)
#pragma unroll
                    for (int bj = 0; bj < 2; ++bj) rr[q][bj] = *(const u32x4*)(XB + (size_t)(row0 + ai * HALF + (mm + q) * 16) * DMODEL + col0 + bj * HALF);
                __builtin_amdgcn_sched_barrier(0);
#pragma unroll
                for (int q = 0; q < 2; ++q) { const int m = mm + q, row = row0 + ai * HALF + m * 16; const size_t o = (size_t)row * DMODEL + col0; float sq = 0.f;
#pragma unroll
                    for (int bj = 0; bj < 2; ++bj) { const u32x4 r = rr[q][bj];
                        const f32x4 r0 = (f32x4){__builtin_bit_cast(float, r.x << 16), __builtin_bit_cast(float, r.x & 0xffff0000u), __builtin_bit_cast(float, r.y << 16), __builtin_bit_cast(float, r.y & 0xffff0000u)};
                        const f32x4 r1 = (f32x4){__builtin_bit_cast(float, r.z << 16), __builtin_bit_cast(float, r.z & 0xffff0000u), __builtin_bit_cast(float, r.w << 16), __builtin_bit_cast(float, r.w & 0xffff0000u)};
                        const f32x4 v0 = acc[ai][bj][m][0] + r0, v1 = acc[ai][bj][m][1] + r1;
                        u32x4 w; w.x = cvt_pk_bf16(v0[0], v0[1]); w.y = cvt_pk_bf16(v0[2], v0[3]); w.z = cvt_pk_bf16(v1[0], v1[1]); w.w = cvt_pk_bf16(v1[2], v1[3]);
                        *(u32x4*)(XB + o + bj * HALF) = w;
                        sq += (v0[0] * v0[0] + v0[1] * v0[1]) + (v0[2] * v0[2] + v0[3] * v0[3]) + (v1[0] * v1[0] + v1[1] * v1[1]) + (v1[2] * v1[2] + v1[3] * v1[3]); }
                    sq += __shfl_xor(sq, 16); sq += __shfl_xor(sq, 32);
                    if (fq == 0) ssq[(size_t)(u.pn * 4 + wc) * MROWS + row] = sq; }
                __builtin_amdgcn_sched_barrier(0); }
    }
};
struct EpiSwiGLU {
    static constexpr bool PERM = true, AFTER_DRAIN = false;
    bf16_t* O; int ldc; const PG8_LAS float* RS;
    __device__ __forceinline__ void operator()(const f32x4 (&acc)[2][2][4][2], const Unit& u, int ui, int wr, int wc, int fr, int fq) const {
        const int row0 = u.pm * BM + wr * 64 + fr, col0 = u.pn * HALF + wc * 32 + 8 * fq;
#pragma unroll
        for (int ai = 0; ai < 2; ++ai)
#pragma unroll
            for (int m = 0; m < 4; ++m) { const int row = row0 + ai * HALF + m * 16; const float rs = RS[ui * BM + wr * 64 + fr + ai * HALF + m * 16];
                const f32x4 g0 = acc[ai][0][m][0] * rs, g1 = acc[ai][0][m][1] * rs, u0 = acc[ai][1][m][0] * rs, u1 = acc[ai][1][m][1] * rs;
                u32x4 w; w.x = cvt_pk_bf16(silu_f(g0[0]) * u0[0], silu_f(g0[1]) * u0[1]); w.y = cvt_pk_bf16(silu_f(g0[2]) * u0[2], silu_f(g0[3]) * u0[3]);
                w.z = cvt_pk_bf16(silu_f(g1[0]) * u1[0], silu_f(g1[1]) * u1[1]); w.w = cvt_pk_bf16(silu_f(g1[2]) * u1[2], silu_f(g1[3]) * u1[3]);
                *(u32x4*)(O + (size_t)row * ldc + col0) = w; __builtin_amdgcn_sched_barrier(0); }
    }
};
template <class Sched> __device__ __forceinline__ void rstd_table(PG8_LAS float* RS, const float* ssq, const Sched& S) {
    int tx_ = threadIdx.x; asm volatile("" : "+v"(tx_));
    Unit u; const int t = tx_ & (BM - 1);
    for (int i = __builtin_amdgcn_readfirstlane(tx_ >> 8); S.next(i, u); i += 2) {
        float v[NPART];
#pragma unroll
        for (int p = 0; p < NPART; ++p) v[p] = ssq[(size_t)p * MROWS + u.pm * BM + t];
        __builtin_amdgcn_sched_barrier(0);
        const float s = (((v[0] + v[1]) + (v[2] + v[3])) + ((v[4] + v[5]) + (v[6] + v[7]))) + (((v[8] + v[9]) + (v[10] + v[11])) + ((v[12] + v[13]) + (v[14] + v[15])));
        RS[i * BM + t] = __builtin_amdgcn_rsqf(s * (1.f / DMODEL) + NORM_EPS);
    }
    __syncthreads();
}
template <class Epi, class Sched, bool ALIGN_EPI = false, bool SP2 = false>
__device__ __forceinline__ void gemm_phase(PG8_LAS unsigned char* lds, const Gemm g, const Sched& S, const Epi& E) {
    int tid_ = threadIdx.x; asm volatile("" : "+v"(tid_));
    const int tid = tid_, wid = __builtin_amdgcn_readfirstlane(tid >> 6), lane = tid & 63, wr = wid >> 2, wc = wid & 3, fr = lane & 15, fq = lane >> 4;
    const int K = g.K, nt = K / BK;
    unsigned voffA[2], voffB[2];
#pragma unroll
    for (int i = 0; i < 2; ++i) { int R, C; stage_rc(tid * 16 + i * 8192, R, C); const int Rb = Epi::PERM ? ((R & ~31) + perm32(R & 31)) : R;
        voffA[i] = (unsigned)(R * K + C) * 2u; voffB[i] = (unsigned)(Rb * K + C) * 2u; }
    const size_t kstep = (size_t)(BK * 2);
    const size_t hstep = (size_t)HALF * K * 2;
    const size_t tstep = 2 * hstep;
    const unsigned ldsw = (unsigned)wid * 1024u;
    const int aoff = lds_byte(wr * 64 + fr, fq * 8), boff = lds_byte(wc * 32 + fr, fq * 8);
#define PG8_SA(b, h) (((b) * 2 + (h)) * HTB)
#define PG8_SB(b, h) ((4 + (b) * 2 + (h)) * HTB)
#define PG8_STAGE(bufoff, gbase, voff) do { _Pragma("unroll") for (int _i = 0; _i < 2; ++_i) \
        __builtin_amdgcn_global_load_lds((const unsigned*)((const char*)(gbase) + (voff)[_i]), (PG8_LAS unsigned*)(lds + (bufoff) + ldsw + _i * 8192), 16, 0, 0); } while (0)
#define PG8_LDA(dst, b, h) do { _Pragma("unroll") for (int m = 0; m < 4; ++m) _Pragma("unroll") for (int k = 0; k < 2; ++k) dst[m][k] = *(const PG8_LAS bf16x8*)(lds + PG8_SA(b, h) + aoff + m * 2048 + k * 1024); } while (0)
#define PG8_LDB(dst, b, h) do { _Pragma("unroll") for (int n = 0; n < 2; ++n) _Pragma("unroll") for (int k = 0; k < 2; ++k) dst[n][k] = *(const PG8_LAS bf16x8*)(lds + PG8_SB(b, h) + boff + n * 2048 + k * 1024); } while (0)
#define PG8_MMA(ai, bj, At, Bt) do { __builtin_amdgcn_s_setprio(1); _Pragma("unroll") for (int m = 0; m < 4; ++m) _Pragma("unroll") for (int n = 0; n < 2; ++n) _Pragma("unroll") for (int k = 0; k < 2; ++k) \
        acc[ai][bj][m][n] = __builtin_amdgcn_mfma_f32_16x16x32_bf16(Bt[n][k], At[m][k], acc[ai][bj][m][n], 0, 0, 0); __builtin_amdgcn_s_setprio(0); } while (0)
#define PG8_WAIT_V(n) asm volatile("s_waitcnt vmcnt(" #n ")" ::: "memory")
#define PG8_WAIT_L(n) asm volatile("s_waitcnt lgkmcnt(" #n ")" ::: "memory")
#define PG8_BAR __builtin_amdgcn_s_barrier()
#define PG8_SCHED __builtin_amdgcn_sched_barrier(0)
    Unit cur, nxt; int ui = 0;
    if (!S.next(0, cur)) return;
    f32x4 acc[2][2][4][2];
#pragma unroll
    for (int a = 0; a < 2; ++a)
#pragma unroll
        for (int b = 0; b < 2; ++b)
#pragma unroll
            for (int m = 0; m < 4; ++m)
#pragma unroll
                for (int n = 0; n < 2; ++n) acc[a][b][m][n] = (f32x4){0.f, 0.f, 0.f, 0.f};
    bf16x8 At[4][2], B0[2][2], B1[2][2];
    const char* cA = (const char*)g.A + (size_t)cur.pm * tstep; const char* cB = (const char*)g.Bt + (size_t)cur.pn * tstep;
    S.a_ready(cur);
    if constexpr (SP2) {
        PG8_STAGE(PG8_SB(0, 0), cB, voffB); PG8_STAGE(PG8_SB(0, 1), cB + hstep, voffB); PG8_STAGE(PG8_SA(0, 0), cA, voffA); PG8_STAGE(PG8_SA(0, 1), cA + hstep, voffA);
        if (wr == 1) PG8_BAR;
        PG8_WAIT_V(2); PG8_BAR;
        PG8_STAGE(PG8_SB(1, 0), cB + kstep, voffB); PG8_STAGE(PG8_SA(1, 0), cA + kstep, voffA); PG8_STAGE(PG8_SB(1, 1), cB + hstep + kstep, voffB);
        PG8_WAIT_V(6); PG8_BAR;
    } else {
        PG8_STAGE(PG8_SB(0, 0), cB, voffB); PG8_STAGE(PG8_SA(0, 0), cA, voffA); PG8_STAGE(PG8_SB(0, 1), cB + hstep, voffB); PG8_STAGE(PG8_SA(0, 1), cA + hstep, voffA);
        if (wr == 1) PG8_BAR;
        PG8_WAIT_V(4); PG8_BAR;
        PG8_STAGE(PG8_SB(1, 0), cB + kstep, voffB); PG8_STAGE(PG8_SA(1, 0), cA + kstep, voffA); PG8_STAGE(PG8_SB(1, 1), cB + hstep + kstep, voffB);
        PG8_WAIT_V(6); PG8_BAR;
    }
    for (;;) {
        const bool has_next = S.next(ui + 1, nxt);
        const char* nA = has_next ? (const char*)g.A + (size_t)nxt.pm * tstep : cA; const char* nB = has_next ? (const char*)g.Bt + (size_t)nxt.pn * tstep : cB;
        for (int t = 0; t < nt; t += 2) {
            const bool last = (t == nt - 2);
            const char* a1 = cA + (size_t)(t + 1) * kstep;
            const char* a2 = last ? nA : cA + (size_t)(t + 2) * kstep; const char* b2 = last ? nB : cB + (size_t)(t + 2) * kstep;
            const char* a3 = a2 + kstep; const char* b3 = b2 + kstep;
            if (last && has_next) S.a_ready(nxt);
            if constexpr (SP2) {
            PG8_LDB(B0, 0, 0); PG8_LDB(B1, 0, 1); PG8_SCHED; PG8_LDA(At, 0, 0); PG8_STAGE(PG8_SA(1, 1), a1 + hstep, voffA);
            PG8_WAIT_V(8); PG8_WAIT_L(0); PG8_BAR; PG8_MMA(0, 0, At, B0); PG8_MMA(0, 1, At, B1); PG8_BAR; PG8_SCHED;
            PG8_LDA(At, 0, 1); PG8_STAGE(PG8_SB(0, 0), b2, voffB); PG8_STAGE(PG8_SB(0, 1), b2 + hstep, voffB); PG8_STAGE(PG8_SA(0, 0), a2, voffA);
            PG8_WAIT_V(8); PG8_WAIT_L(0); PG8_BAR; PG8_MMA(1, 0, At, B0); PG8_MMA(1, 1, At, B1); PG8_BAR; PG8_SCHED;
            PG8_LDB(B0, 1, 0); PG8_LDB(B1, 1, 1); PG8_SCHED; PG8_LDA(At, 1, 0); PG8_STAGE(PG8_SA(0, 1), a2 + hstep, voffA);
            PG8_WAIT_V(8); PG8_WAIT_L(0); PG8_BAR; PG8_MMA(0, 0, At, B0); PG8_MMA(0, 1, At, B1); PG8_BAR; PG8_SCHED;
            PG8_LDA(At, 1, 1); PG8_STAGE(PG8_SB(1, 0), b3, voffB); PG8_STAGE(PG8_SB(1, 1), b3 + hstep, voffB); PG8_STAGE(PG8_SA(1, 0), a3, voffA);
            PG8_WAIT_V(8); PG8_WAIT_L(0); PG8_BAR; PG8_MMA(1, 0, At, B0); PG8_MMA(1, 1, At, B1); PG8_BAR; PG8_SCHED;
            } else {
            PG8_LDB(B0, 0, 0); PG8_SCHED; PG8_LDA(At, 0, 0); PG8_STAGE(PG8_SA(1, 1), a1 + hstep, voffA);
            PG8_WAIT_L(8); PG8_BAR; PG8_WAIT_L(0); PG8_MMA(0, 0, At, B0); PG8_BAR; PG8_SCHED;
            PG8_LDB(B1, 0, 1); PG8_STAGE(PG8_SB(0, 0), b2, voffB);
            PG8_BAR; PG8_WAIT_L(0); PG8_MMA(0, 1, At, B1); PG8_BAR;
            PG8_LDA(At, 0, 1); PG8_STAGE(PG8_SA(0, 0), a2, voffA);
            PG8_BAR; PG8_WAIT_L(0); PG8_MMA(1, 0, At, B0); PG8_BAR; PG8_SCHED;
            PG8_STAGE(PG8_SB(0, 1), b2 + hstep, voffB);
            PG8_WAIT_V(6); PG8_BAR; PG8_MMA(1, 1, At, B1); PG8_BAR;
            PG8_LDB(B0, 1, 0); PG8_SCHED; PG8_LDA(At, 1, 0); PG8_STAGE(PG8_SA(0, 1), a2 + hstep, voffA);
            PG8_WAIT_L(8); PG8_BAR; PG8_WAIT_L(0); PG8_MMA(0, 0, At, B0); PG8_BAR; PG8_SCHED;
            PG8_LDB(B1, 1, 1); PG8_STAGE(PG8_SB(1, 0), b3, voffB);
            PG8_BAR; PG8_WAIT_L(0); PG8_MMA(0, 1, At, B1); PG8_BAR;
            PG8_LDA(At, 1, 1); PG8_STAGE(PG8_SA(1, 0), a3, voffA);
            PG8_BAR; PG8_WAIT_L(0); PG8_MMA(1, 0, At, B0); PG8_BAR; PG8_SCHED;
            PG8_STAGE(PG8_SB(1, 1), b3 + hstep, voffB);
            PG8_WAIT_V(6); PG8_BAR; PG8_MMA(1, 1, At, B1); PG8_BAR;
            }
        }
        if constexpr (ALIGN_EPI) { if (wr == 0) PG8_BAR; }
        if constexpr (!Epi::AFTER_DRAIN) { E(acc, cur, ui, wr, wc, fr, fq); S.done(cur); }
        if (!has_next) break;
#pragma unroll
        for (int a = 0; a < 2; ++a)
#pragma unroll
            for (int b = 0; b < 2; ++b)
#pragma unroll
                for (int m = 0; m < 4; ++m)
#pragma unroll
                    for (int n = 0; n < 2; ++n) acc[a][b][m][n] = (f32x4){0.f, 0.f, 0.f, 0.f};
        cur = nxt; cA = nA; cB = nB; ++ui;
        if constexpr (ALIGN_EPI) { if (wr == 1) PG8_BAR; }
    }
    PG8_WAIT_V(0);
    if constexpr (!ALIGN_EPI) { if (wr == 0) PG8_BAR; }
    PG8_BAR;
    if constexpr (Epi::AFTER_DRAIN) { E.fused(acc, cur, wr, wc, fr, fq, lds, wid, lane); S.done(cur); }
#undef PG8_SA
#undef PG8_SB
#undef PG8_STAGE
#undef PG8_LDA
#undef PG8_LDB
#undef PG8_MMA
#undef PG8_WAIT_V
#undef PG8_WAIT_L
#undef PG8_BAR
#undef PG8_SCHED
}
}
#ifndef PROBE_SEL
#define PROBE_SEL (-1)
#endif
#define PT_NOW() __builtin_amdgcn_s_memrealtime()
#define PT_WORDS_OFF 140304
#define PT_ACC(lds_, dt_) do { if (threadIdx.x == 0) { volatile __attribute__((address_space(3))) unsigned* a_ = (volatile __attribute__((address_space(3))) unsigned*)((lds_) + PT_WORDS_OFF); a_[0] = a_[0] + (unsigned)(dt_); } } while (0)
#define LAS __attribute__((address_space(3)))
typedef unsigned short bf16;
typedef float f32x4 __attribute__((ext_vector_type(4)));
typedef short bf16x8 __attribute__((ext_vector_type(8)));
typedef unsigned u32x4 __attribute__((ext_vector_type(4)));
typedef unsigned u32x2 __attribute__((ext_vector_type(2)));
constexpr int NWAVES = 8, NTHR = 512;
constexpr int BATCH = 8, SEQ = 2048, DM = 1024, M = BATCH * SEQ, DIN = 3840, FFN = 2816, DEPTH = 2;
constexpr int C_HQ = 0, C_HFF = 512, C_HI = 1536, C_HG = 2048, C_NQ = 2560, C_NK = 2816, C_NV = 3072, C_CA = 3328, C_CG = 3584;
constexpr int NSEG = 8, SEGLEN = SEQ / NSEG, CHS = SEGLEN / 32;
constexpr float EPS = 1e-6f;
constexpr size_t MiB = 1u << 20;
constexpr size_t WS_SSQ = 1 * MiB;
constexpr size_t WS_WIN = 2 * MiB, WS_WIN_L = (size_t)DIN * DM * 2;
constexpr size_t WS_WOUT = 17 * MiB, WS_WOUT_L = (size_t)DM * DM * 2;
constexpr size_t WS_WGU = 21 * MiB, WS_WGU_L = (size_t)2 * FFN * DM * 2;
constexpr size_t WS_WDN = 43 * MiB, WS_WDN_L = (size_t)DM * FFN * 2;
constexpr size_t WS_P = 54 * MiB;
constexpr size_t WS_MIX = 174 * MiB;
constexpr size_t WS_XB = 206 * MiB;
constexpr size_t WS_SLOC = 238 * MiB;
constexpr size_t WS_DSEG = 254 * MiB;
constexpr size_t WS_END = 255 * MiB;

__device__ __forceinline__ float bf2f(unsigned short h) { return __builtin_bit_cast(float, (unsigned)h << 16); }
__device__ __forceinline__ float bflo(unsigned w) { return __builtin_bit_cast(float, w << 16); }
__device__ __forceinline__ float bfhi(unsigned w) { return __builtin_bit_cast(float, w & 0xffff0000u); }
typedef float f32x2_t __attribute__((ext_vector_type(2)));
typedef __bf16 bf16x2_t __attribute__((ext_vector_type(2)));
__device__ __forceinline__ unsigned pk2(float lo, float hi) { const f32x2_t v = {lo, hi}; const bf16x2_t b = __builtin_convertvector(v, bf16x2_t); return __builtin_bit_cast(unsigned, b); }
__device__ __forceinline__ unsigned short f2bf(float v) { return (unsigned short)(pk2(v, 0.f) & 0xffffu); }
__device__ __forceinline__ float wave_sum(float v) {
#pragma unroll
    for (int o = 1; o < 64; o <<= 1) v += __shfl_xor(v, o);
    return v;
}
__device__ __forceinline__ float sigm(float x) { return __builtin_amdgcn_rcpf(1.f + __expf(-x)); }
__device__ __forceinline__ float silu_f0(float x) { return x * sigm(x); }
__device__ __forceinline__ f32x4 mfma16(bf16x8 a, bf16x8 b, f32x4 c) { return __builtin_amdgcn_mfma_f32_16x16x32_bf16(a, b, c, 0, 0, 0); }
#define LDS_WAIT() asm volatile("s_waitcnt lgkmcnt(0)" ::: "memory")

struct Params {
    const float *x, *mix_g, *w_in, *hg_lb, *hg_ng, *rpb, *cw, *cb, *lng, *lnb, *w_out, *ffn_g, *w_gu, *w_dn, *fin_g;
    float* out; unsigned char* ws;
};

__device__ __forceinline__ void transpose_item(const float* W, int K, int N, bf16* WT, const float* gk, bool gu, LAS float* scr, int item, int lane) {
    const int nblk = N / 32, kb = item / nblk, nb = item % nblk, k0 = 64 * kb, n0 = 32 * nb;
    float wv[32];
#pragma unroll
    for (int i = 0; i < 32; ++i) { const int kk = 2 * i + (lane >> 5); wv[i] = W[(size_t)(k0 + kk) * N + n0 + (lane & 31)]; }
    const float gs = gk ? gk[k0 + lane] : 1.f;
    __builtin_amdgcn_sched_barrier(0);
#pragma unroll
    for (int i = 0; i < 32; ++i) { const int kk = 2 * i + (lane >> 5); scr[kk * 33 + (lane & 31)] = wv[i] * __shfl(gs, kk); }
    LDS_WAIT(); asm volatile("" ::: "memory");
    const int c = lane & 7;
    int r0 = n0;
    if (gu) { const int up = n0 >= FFN ? 1 : 0, cc = n0 - up * FFN; r0 = 256 * (cc >> 7) + (cc & 127) + up * 128; }
#pragma unroll
    for (int j = 0; j < 4; ++j) { const int n = (lane >> 3) + 8 * j; const LAS float* s = scr + (8 * c) * 33 + n;
        u32x4 o; o.x = pk2(s[0 * 33], s[1 * 33]); o.y = pk2(s[2 * 33], s[3 * 33]); o.z = pk2(s[4 * 33], s[5 * 33]); o.w = pk2(s[6 * 33], s[7 * 33]);
        *(u32x4*)(WT + (size_t)(r0 + n) * K + k0 + 8 * c) = o; }
    LDS_WAIT(); asm volatile("" ::: "memory");
}
__device__ __forceinline__ void prologue(const Params& p, LAS unsigned char* lds, int gw, int NGW, int wave, int lane) {
    LAS float* scr = (LAS float*)(lds + wave * 16384);
    constexpr int I_IN = (DM / 64) * (DIN / 32), I_OUT = (DM / 64) * (DM / 32), I_GU = (DM / 64) * (2 * FFN / 32), I_DN = (FFN / 64) * (DM / 32), I_L = I_IN + I_OUT + I_GU + I_DN;
    for (int it = gw; it < DEPTH * I_L; it += NGW) {
        const int l = it / I_L; int r = it % I_L;
        if (r < I_IN) { transpose_item(p.w_in + (size_t)l * DM * DIN, DM, DIN, (bf16*)(p.ws + WS_WIN + l * WS_WIN_L), p.mix_g + l * DM, false, scr, r, lane); continue; } r -= I_IN;
        if (r < I_OUT) { transpose_item(p.w_out + (size_t)l * DM * DM, DM, DM, (bf16*)(p.ws + WS_WOUT + l * WS_WOUT_L), nullptr, false, scr, r, lane); continue; } r -= I_OUT;
        if (r < I_GU) { transpose_item(p.w_gu + (size_t)l * DM * 2 * FFN, DM, 2 * FFN, (bf16*)(p.ws + WS_WGU + l * WS_WGU_L), p.ffn_g + l * DM, true, scr, r, lane); continue; } r -= I_GU;
        transpose_item(p.w_dn + (size_t)l * FFN * DM, FFN, DM, (bf16*)(p.ws + WS_WDN + l * WS_WDN_L), nullptr, false, scr, r, lane);
    }
    bf16* XB = (bf16*)(p.ws + WS_XB); float* ssq = (float*)(p.ws + WS_SSQ);
    for (int m = gw; m < M; m += 2 * NGW) {
        const int m2 = m + NGW;
        const f32x4* xa = (const f32x4*)(p.x + (size_t)m * DM) + lane; const f32x4* xc = (const f32x4*)(p.x + (size_t)(m2 < M ? m2 : m) * DM) + lane;
        f32x4 va[4], vc[4];
#pragma unroll
        for (int j = 0; j < 4; ++j) { va[j] = xa[64 * j]; vc[j] = xc[64 * j]; }
        __builtin_amdgcn_sched_barrier(0);
        float sa = 0.f, sc = 0.f;
        unsigned long long* oa = (unsigned long long*)(XB + (size_t)m * DM) + lane; unsigned long long* oc = (unsigned long long*)(XB + (size_t)m2 * DM) + lane;
#pragma unroll
        for (int j = 0; j < 4; ++j) { sa += (va[j].x * va[j].x + va[j].y * va[j].y) + (va[j].z * va[j].z + va[j].w * va[j].w); sc += (vc[j].x * vc[j].x + vc[j].y * vc[j].y) + (vc[j].z * vc[j].z + vc[j].w * vc[j].w);
            oa[64 * j] = (unsigned long long)pk2(va[j].x, va[j].y) | ((unsigned long long)pk2(va[j].z, va[j].w) << 32);
            if (m2 < M) oc[64 * j] = (unsigned long long)pk2(vc[j].x, vc[j].y) | ((unsigned long long)pk2(vc[j].z, vc[j].w) << 32); }
        sa = wave_sum(sa); sc = wave_sum(sc);
        if (lane < 16) { ssq[(size_t)lane * M + m] = lane == 0 ? sa : 0.f; if (m2 < M) ssq[(size_t)lane * M + m2] = lane == 0 ? sc : 0.f; }
    }
}

constexpr int HS_SET = 37888, HQ_OFF = 0, HK_OFF = 8704, HKH_OFF = 17408, HV_OFF = 27648;
constexpr int HOS_OFF = 2 * HS_SET, HOS_SZ = 16896, HDEC_OFF = HOS_OFF + 2 * HOS_SZ;
#define WG_BAR() asm volatile("s_waitcnt lgkmcnt(0)\n\ts_barrier" ::: "memory")
template <bool FULL, bool SECOND>
__device__ __forceinline__ void hg_segment(LAS unsigned char* lds, const bf16* P, int b, int h, int dir, int seg, float lb, f32x4 (&S)[8], float& bsum,
                                           float* OP, bf16* MIXED, const float* norm_g) {
    int tid_ = threadIdx.x; asm volatile("" : "+v"(tid_)); const int tid = tid_, w = __builtin_amdgcn_readfirstlane(tid >> 6), lane = tid & 63, fr = lane & 15, fq = lane >> 4;
    unsigned long long tk0 = 0;
    const int d = 16 * w + (lane & 15), grp = lane >> 4;
    const int zcol = C_HFF + dir * 512 + h * 128 + d, qcol = C_HQ + h * 128 + d, vcol = C_HI + h * 128 + d;
    const float oml = 1.f - lb;
    const int ts = dir == 0 ? 1 : -1, tb0 = dir == 0 ? seg * SEGLEN : (seg * SEGLEN + SEGLEN - 1);
    const long rstep = (long)ts * DIN;
    const int fc = tid >> 4, dvg = tid & 15;
    f32x4 ng0 = (f32x4){0.f, 0.f, 0.f, 0.f}, ng1 = ng0;
    if (FULL && SECOND) { ng0 = *(const f32x4*)(norm_g + 8 * dvg); ng1 = *(const f32x4*)(norm_g + 8 * dvg + 4); }
    unsigned short zn[8], qn[8], vn[8];
#define HG_LOAD(n_) do { const bf16* rowp_ = P + (size_t)(b * SEQ + tb0 + ts * (32 * (n_) + 8 * grp)) * DIN; \
        _Pragma("unroll") for (int e = 0; e < 8; ++e) { const bf16* r_ = rowp_ + rstep * e; zn[e] = r_[zcol]; if (FULL) qn[e] = r_[qcol]; else qn[e] = 0; vn[e] = r_[vcol]; } } while (0)
#define HG_PREP(s_) do { LAS unsigned char* set_ = lds + (s_) * HS_SET; LAS bf16* QT_ = (LAS bf16*)(set_ + HQ_OFF); LAS bf16* KT_ = (LAS bf16*)(set_ + HK_OFF); \
        f32x2_t Ev[4], kvv[4]; float run = 1.f;                                     \
        _Pragma("unroll") for (int e2 = 0; e2 < 4; ++e2) { \
            f32x2_t z = {__builtin_amdgcn_fmed3f(bf2f(zn[2 * e2]), -40.f, 40.f), __builtin_amdgcn_fmed3f(bf2f(zn[2 * e2 + 1]), -40.f, 40.f)}; \
            const f32x2_t t = z * (-1.4426950408889634f); const f32x2_t den = (f32x2_t){__builtin_amdgcn_exp2f(t.x), __builtin_amdgcn_exp2f(t.y)} + 1.0f; \
            const f32x2_t inv = {__builtin_amdgcn_rcpf(den.x), __builtin_amdgcn_rcpf(den.y)};              \
            const f32x2_t fv = inv * oml + lb; kvv[e2] = inv * (-oml) + oml;                                  \
            run *= fv.x; Ev[e2].x = run; run *= fv.y; Ev[e2].y = run; } \
        float pre = 1.f, tot = 1.f; \
        _Pragma("unroll") for (int g2 = 0; g2 < 4; ++g2) { const float t = __shfl(run, (g2 << 4) | (lane & 15)); tot *= t; if (g2 < grp) pre *= t; } \
        unsigned khp[4], vvp[4]; \
        _Pragma("unroll") for (int e2 = 0; e2 < 4; ++e2) { const f32x2_t E = Ev[e2] * pre; const f32x2_t r = {__builtin_amdgcn_rcpf(E.x), __builtin_amdgcn_rcpf(E.y)}; const f32x2_t kt = kvv[e2] * r; \
            if (FULL) { const int c0 = 8 * grp + 2 * e2; const f32x2_t qs = (f32x2_t){bf2f(qn[2 * e2]), bf2f(qn[2 * e2 + 1])} * E; const unsigned qw = pk2(qs.x, qs.y), kw = pk2(kt.x, kt.y); \
                QT_[c0 * 136 + d] = (bf16)(qw & 0xffffu); QT_[(c0 + 1) * 136 + d] = (bf16)(qw >> 16); KT_[c0 * 136 + d] = (bf16)(kw & 0xffffu); KT_[(c0 + 1) * 136 + d] = (bf16)(kw >> 16); } \
            const f32x2_t kh = kt * tot; khp[e2] = pk2(kh.x, kh.y); vvp[e2] = (unsigned)vn[2 * e2] | ((unsigned)vn[2 * e2 + 1] << 16); } \
        *(LAS u32x4*)((LAS bf16*)(set_ + HKH_OFF) + d * 40 + 8 * grp) = (u32x4){khp[0], khp[1], khp[2], khp[3]}; \
        *(LAS u32x4*)((LAS bf16*)(set_ + HV_OFF) + d * 40 + 8 * grp) = (u32x4){vvp[0], vvp[1], vvp[2], vvp[3]}; \
        if (grp == 0) { ((LAS float*)(lds + HDEC_OFF))[(s_) * 128 + d] = tot; bsum *= tot; } } while (0)
    HG_LOAD(0);
    __builtin_amdgcn_sched_barrier(0);
    HG_PREP(0);
    __builtin_amdgcn_sched_barrier(0);
    if (CHS > 1) HG_LOAD(1);
    WG_BAR();
#pragma unroll 1
    for (int n = 0; n < CHS; ++n) {
        const int tb = tb0 + ts * 32 * n, cs = n & 1;
        const int ftok = tb + ts * fc;
        f32x4 op0 = (f32x4){0.f, 0.f, 0.f, 0.f}, op1 = op0; u32x4 gw4 = (u32x4){0u, 0u, 0u, 0u};
        float* op = OP + ((size_t)((b * 4 + h) * SEQ + ftok)) * 128 + 8 * dvg;
        if (FULL && SECOND) { op0 = *(const f32x4*)op; op1 = *(const f32x4*)(op + 4); gw4 = *(const u32x4*)(P + (size_t)(b * SEQ + ftok) * DIN + C_HG + h * 128 + 8 * dvg); }
        __builtin_amdgcn_sched_barrier(0);
#pragma unroll 1
        for (int ph = 0; ph < 2; ++ph) {
        if ((ph == 0) == (w < 4)) { if (PROBE_SEL == 13) tk0 = PT_NOW(); if (n + 1 < CHS) { HG_PREP(cs ^ 1); __builtin_amdgcn_sched_barrier(0); if (n + 2 < CHS) HG_LOAD(n + 2); } if (PROBE_SEL == 13) PT_ACC(lds, PT_NOW() - tk0); }
        else {
        if (PROBE_SEL == 14) tk0 = PT_NOW();
        LAS unsigned char* set = lds + cs * HS_SET;
        LAS bf16* QT = (LAS bf16*)(set + HQ_OFF); LAS bf16* KT = (LAS bf16*)(set + HK_OFF); LAS bf16* KHT = (LAS bf16*)(set + HKH_OFF); LAS bf16* VT = (LAS bf16*)(set + HV_OFF);
        LAS float* OS = (LAS float*)(lds + HOS_OFF + cs * HOS_SZ); LAS float* DEC = (LAS float*)(lds + HDEC_OFF) + cs * 128;
        if (FULL) {
            f32x4 p00 = (f32x4){0.f, 0.f, 0.f, 0.f}, p01 = p00, p11 = p00;
#pragma unroll
            for (int ks = 0; ks < 4; ++ks) {
                const bf16x8 k0 = *(const LAS bf16x8*)(KT + fr * 136 + 32 * ks + 8 * fq), k1 = *(const LAS bf16x8*)(KT + (16 + fr) * 136 + 32 * ks + 8 * fq);
                const bf16x8 q0 = *(const LAS bf16x8*)(QT + fr * 136 + 32 * ks + 8 * fq), q1 = *(const LAS bf16x8*)(QT + (16 + fr) * 136 + 32 * ks + 8 * fq);
                p00 = mfma16(k0, q0, p00); p01 = mfma16(k0, q1, p01); p11 = mfma16(k1, q1, p11); }
#pragma unroll
            for (int i = 0; i < 4; ++i) { const bool keep = 4 * fq + i <= fr; p00[i] = keep ? p00[i] : 0.f; p11[i] = keep ? p11[i] : 0.f; }
            const bf16x8 pf0 = __builtin_bit_cast(bf16x8, (u32x4){pk2(p00[0], p00[1]), pk2(p00[2], p00[3]), 0u, 0u});
            const bf16x8 pf1 = __builtin_bit_cast(bf16x8, (u32x4){pk2(p01[0], p01[1]), pk2(p01[2], p01[3]), pk2(p11[0], p11[1]), pk2(p11[2], p11[3])});
            f32x4 o0 = (f32x4){0.f, 0.f, 0.f, 0.f}, o1 = o0;
#pragma unroll
            for (int ks = 0; ks < 4; ++ks) {
                const bf16x8 sa = __builtin_bit_cast(bf16x8, (u32x4){pk2(S[2 * ks][0], S[2 * ks][1]), pk2(S[2 * ks][2], S[2 * ks][3]), pk2(S[2 * ks + 1][0], S[2 * ks + 1][1]), pk2(S[2 * ks + 1][2], S[2 * ks + 1][3])});
                const u32x2 a0 = *(const LAS u32x2*)(QT + fr * 136 + 32 * ks + 4 * fq), a1 = *(const LAS u32x2*)(QT + fr * 136 + 32 * ks + 16 + 4 * fq);
                const u32x2 c0 = *(const LAS u32x2*)(QT + (16 + fr) * 136 + 32 * ks + 4 * fq), c1 = *(const LAS u32x2*)(QT + (16 + fr) * 136 + 32 * ks + 16 + 4 * fq);
                o0 = mfma16(sa, __builtin_bit_cast(bf16x8, (u32x4){a0.x, a0.y, a1.x, a1.y}), o0);
                o1 = mfma16(sa, __builtin_bit_cast(bf16x8, (u32x4){c0.x, c0.y, c1.x, c1.y}), o1); }
            { const u32x2 v0 = *(const LAS u32x2*)(VT + (16 * w + fr) * 40 + 4 * fq), v1 = *(const LAS u32x2*)(VT + (16 * w + fr) * 40 + 16 + 4 * fq);
              const bf16x8 va = __builtin_bit_cast(bf16x8, (u32x4){v0.x, v0.y, v1.x, v1.y});
              o0 = mfma16(va, pf0, o0); o1 = mfma16(va, pf1, o1); }
            *(LAS f32x4*)(OS + fr * 132 + 16 * w + 4 * fq) = o0; *(LAS f32x4*)(OS + (16 + fr) * 132 + 16 * w + 4 * fq) = o1;
        }
        { const bf16x8 vfr = *(const LAS bf16x8*)(VT + (16 * w + fr) * 40 + 8 * fq);
#pragma unroll
          for (int i = 0; i < 8; ++i) { const f32x4 dv4 = *(const LAS f32x4*)(DEC + 16 * i + 4 * fq); S[i] = S[i] * dv4;
              S[i] = mfma16(*(const LAS bf16x8*)(KHT + (16 * i + fr) * 40 + 8 * fq), vfr, S[i]); } }
        if (PROBE_SEL == 14) PT_ACC(lds, PT_NOW() - tk0);
        } }
        if (PROBE_SEL == 15) tk0 = PT_NOW();
        WG_BAR();
        if (PROBE_SEL == 15) PT_ACC(lds, PT_NOW() - tk0);
        if (FULL) {
            LAS float* OS = (LAS float*)(lds + HOS_OFF + cs * HOS_SZ);
            f32x4 o0 = *(const LAS f32x4*)(OS + fc * 132 + 8 * dvg), o1 = *(const LAS f32x4*)(OS + fc * 132 + 8 * dvg + 4);
            if (!SECOND) { *(f32x4*)op = o0; *(f32x4*)(op + 4) = o1; }
            else { o0 = o0 + op0; o1 = o1 + op1;
                float sq = (o0[0] * o0[0] + o0[1] * o0[1]) + (o0[2] * o0[2] + o0[3] * o0[3]) + (o1[0] * o1[0] + o1[1] * o1[1]) + (o1[2] * o1[2] + o1[3] * o1[3]);
                sq += __shfl_xor(sq, 1); sq += __shfl_xor(sq, 2); sq += __shfl_xor(sq, 4); sq += __shfl_xor(sq, 8);
                const float rs = __builtin_amdgcn_rsqf(sq * (1.f / 128.f) + EPS);
                u32x4 ow; ow.x = pk2(o0[0] * rs * ng0[0] * bflo(gw4.x), o0[1] * rs * ng0[1] * bfhi(gw4.x));
                ow.y = pk2(o0[2] * rs * ng0[2] * bflo(gw4.y), o0[3] * rs * ng0[3] * bfhi(gw4.y));
                ow.z = pk2(o1[0] * rs * ng1[0] * bflo(gw4.z), o1[1] * rs * ng1[1] * bfhi(gw4.z));
                ow.w = pk2(o1[2] * rs * ng1[2] * bflo(gw4.w), o1[3] * rs * ng1[3] * bfhi(gw4.w));
                *(u32x4*)(MIXED + (size_t)(b * SEQ + ftok) * DM + h * 128 + 8 * dvg) = ow; }
        }
    }
    WG_BAR();
#undef HG_LOAD
#undef HG_PREP
}
__device__ __forceinline__ float hg_lb(const float* hg_lb_all, int layer, int dir, int ch) {
    if (layer == 0) return 0.f;
    const float a0 = hg_lb_all[(0 * 2 + dir) * 512 + ch], a1 = hg_lb_all[(1 * 2 + dir) * 512 + ch], mx = fmaxf(a0, a1), e0 = __expf(a0 - mx), e1 = __expf(a1 - mx);
    return e1 / (e0 + e1);
}
__device__ __forceinline__ void hg_passA_item(LAS unsigned char* lds, const Params& p, int layer, int item) {
    const int dir = item & 1, seg = (item >> 1) & (NSEG - 1), h = (item >> 4) & 3, b = item >> 6;
    if ((dir == 0 && seg == NSEG - 1) || (dir == 1 && seg == 0)) return;
    int tid_ = threadIdx.x; asm volatile("" : "+v"(tid_)); const int tid = tid_, w = __builtin_amdgcn_readfirstlane(tid >> 6), lane = tid & 63;
    const float lb = hg_lb(p.hg_lb, layer, dir, h * 128 + 16 * w + (lane & 15));
    f32x4 S[8];
#pragma unroll
    for (int i = 0; i < 8; ++i) S[i] = (f32x4){0.f, 0.f, 0.f, 0.f};
    float bsum = 1.f;
    hg_segment<false, false>(lds, (const bf16*)(p.ws + WS_P), b, h, dir, seg, lb, S, bsum, nullptr, nullptr, nullptr);
    u32x2* sl = (u32x2*)(p.ws + WS_SLOC) + (size_t)item * 4096;
#pragma unroll
    for (int i = 0; i < 8; ++i) sl[(w * 8 + i) * 64 + lane] = (u32x2){pk2(S[i][0], S[i][1]), pk2(S[i][2], S[i][3])};
    if (lane < 16) ((float*)(p.ws + WS_DSEG))[(size_t)item * 128 + 16 * w + (lane & 15)] = bsum;
    __syncthreads();
}
__device__ __forceinline__ unsigned long long hg_passB_item(LAS unsigned char* lds, const Params& p, int layer, int item) {
    unsigned long long tsub = 0, t0_ = 0;
    const int seg = item & (NSEG - 1), h = (item >> 3) & 3, b = item >> 5;
    int tid_ = threadIdx.x; asm volatile("" : "+v"(tid_)); const int tid = tid_, w = __builtin_amdgcn_readfirstlane(tid >> 6), lane = tid & 63, fr = lane & 15, fq = lane >> 4;
    const u32x2* slb = (const u32x2*)(p.ws + WS_SLOC); const float* dsg = (const float*)(p.ws + WS_DSEG);
    float* OP = p.out;   bf16* MIXED = (bf16*)(p.ws + WS_MIX); const bf16* P = (const bf16*)(p.ws + WS_P);
#pragma unroll 1
    for (int dir = 0; dir < 2; ++dir) {
        const float lb = hg_lb(p.hg_lb, layer, dir, h * 128 + 16 * w + (lane & 15));
        f32x4 S[8];
#pragma unroll
        for (int i = 0; i < 8; ++i) S[i] = (f32x4){0.f, 0.f, 0.f, 0.f};
        const int nprev = dir == 0 ? seg : (NSEG - 1 - seg);
        if (PROBE_SEL == 11) t0_ = PT_NOW();
#pragma unroll 1
        for (int q = 0; q < nprev; q += 2) {
            const bool two = q + 1 < nprev; const int sA = dir == 0 ? q : (NSEG - 1 - q), sB = two ? (dir == 0 ? q + 1 : (NSEG - 2 - q)) : sA;
            const int itA = ((b * 4 + h) * NSEG + sA) * 2 + dir, itB = ((b * 4 + h) * NSEG + sB) * 2 + dir;
            const u32x2* slA = slb + (size_t)itA * 4096; const float* dcA = dsg + (size_t)itA * 128; const u32x2* slB = slb + (size_t)itB * 4096; const float* dcB = dsg + (size_t)itB * 128;
            f32x4 dvA[8], dvB[8]; u32x2 svA[8], svB[8];
#pragma unroll
            for (int i = 0; i < 8; ++i) { dvA[i] = *(const f32x4*)(dcA + 16 * i + 4 * fq); svA[i] = slA[(w * 8 + i) * 64 + lane]; dvB[i] = *(const f32x4*)(dcB + 16 * i + 4 * fq); svB[i] = slB[(w * 8 + i) * 64 + lane]; }
            __builtin_amdgcn_sched_barrier(0);
#pragma unroll
            for (int i = 0; i < 8; ++i) { S[i] = S[i] * dvA[i] + (f32x4){bflo(svA[i].x), bfhi(svA[i].x), bflo(svA[i].y), bfhi(svA[i].y)};
                if (two) S[i] = S[i] * dvB[i] + (f32x4){bflo(svB[i].x), bfhi(svB[i].x), bflo(svB[i].y), bfhi(svB[i].y)}; } }
        if (PROBE_SEL == 11) PT_ACC(lds, PT_NOW() - t0_);
        if (PROBE_SEL == 10) t0_ = PT_NOW();
        float bsum = 1.f;
        if (dir == 0) hg_segment<true, false>(lds, P, b, h, 0, seg, lb, S, bsum, OP, MIXED, p.hg_ng + layer * 128);
        else hg_segment<true, true>(lds, P, b, h, 1, seg, lb, S, bsum, OP, MIXED, p.hg_ng + layer * 128);
        if (PROBE_SEL == 10) PT_ACC(lds, PT_NOW() - t0_);
        if (PROBE_SEL == 12) t0_ = PT_NOW();
        __syncthreads();
        if (PROBE_SEL == 12) PT_ACC(lds, PT_NOW() - t0_);
    }
    return tsub;
}

constexpr int NA_KS = 584, NA_RPB_OFF = 64 * NA_KS * 2;
__device__ __forceinline__ int clampi(int v, int lo, int hi) { return v < lo ? lo : (v > hi ? hi : v); }
__device__ __forceinline__ void na_item(LAS unsigned char* lds, const Params& p, int layer, int item) {
    const int rp = item & 15, h = (item >> 4) & 3, b = item >> 6, r0 = 2 * rp, kbase = clampi(r0 - 4, 0, 24);
    int tid_ = threadIdx.x; asm volatile("" : "+v"(tid_)); const int tid = tid_, w = __builtin_amdgcn_readfirstlane(tid >> 6), lane = tid & 63, fr = lane & 15, fq = lane >> 4;
    const bf16* P = (const bf16*)(p.ws + WS_P); bf16* MIXED = (bf16*)(p.ws + WS_MIX);
    LAS bf16* VT = (LAS bf16*)lds; LAS float* RPB = (LAS float*)(lds + NA_RPB_OFF);
    const int rl = w >> 2, j = w & 3, r = r0 + rl, kr0 = clampi(r - 4, 0, 24), kc0 = clampi(16 * j - 8, 0, 32);
    const size_t qtok = (size_t)b * SEQ + r * 64 + 16 * j + fr;
    u32x4 vbuf[9];
#pragma unroll
    for (int it = 0; it < 9; ++it) { const int key = it * 64 + lane, dg = w; int trow = kbase * 64 + key; trow = trow > SEQ - 1 ? SEQ - 1 : trow;
        vbuf[it] = *(const u32x4*)(P + (size_t)(b * SEQ + trow) * DIN + C_NV + h * 64 + 8 * dg); }
    bf16x8 qf[2], kfa[16], kfb[16];
#pragma unroll
    for (int ks = 0; ks < 2; ++ks) qf[ks] = *(const bf16x8*)(P + qtok * DIN + C_NQ + h * 64 + 32 * ks + 8 * fq);
#define NA_KLOAD(dst, hh) do { _Pragma("unroll") for (int k8 = 0; k8 < 8; ++k8) { const int kt = (hh) * 8 + k8, krl = kt >> 1, half = kt & 1; \
        const size_t ktok = (size_t)b * SEQ + (kr0 + krl) * 64 + kc0 + 16 * half + fr; \
        _Pragma("unroll") for (int ks = 0; ks < 2; ++ks) dst[k8 * 2 + ks] = *(const bf16x8*)(P + ktok * DIN + C_NK + h * 64 + 32 * ks + 8 * fq); } } while (0)
    NA_KLOAD(kfa, 0);
    __builtin_amdgcn_sched_barrier(0);
#pragma unroll
    for (int it = 0; it < 9; ++it) { const int key = it * 64 + lane, dg = w; const u32x4 v = vbuf[it];
        LAS bf16* dst = VT + (8 * dg) * NA_KS + key;
        dst[0 * NA_KS] = (bf16)(v.x & 0xffffu); dst[1 * NA_KS] = (bf16)(v.x >> 16); dst[2 * NA_KS] = (bf16)(v.y & 0xffffu); dst[3 * NA_KS] = (bf16)(v.y >> 16);
        dst[4 * NA_KS] = (bf16)(v.z & 0xffffu); dst[5 * NA_KS] = (bf16)(v.z >> 16); dst[6 * NA_KS] = (bf16)(v.w & 0xffffu); dst[7 * NA_KS] = (bf16)(v.w >> 16); }
    for (int i = tid; i < 465; i += NTHR) RPB[i] = p.rpb[(size_t)(layer * 4 + h) * 465 + i];
    NA_KLOAD(kfb, 1);
    __builtin_amdgcn_sched_barrier(0);
    WG_BAR();
    f32x4 s[16];
#pragma unroll
    for (int k8 = 0; k8 < 8; ++k8) { f32x4 a = (f32x4){0.f, 0.f, 0.f, 0.f};
#pragma unroll
        for (int ks = 0; ks < 2; ++ks) a = mfma16(kfa[k8 * 2 + ks], qf[ks], a);
        s[k8] = a; }
#pragma unroll
    for (int k8 = 0; k8 < 8; ++k8) { f32x4 a = (f32x4){0.f, 0.f, 0.f, 0.f};
#pragma unroll
        for (int ks = 0; ks < 2; ++ks) a = mfma16(kfb[k8 * 2 + ks], qf[ks], a);
        s[8 + k8] = a; }
#undef NA_KLOAD
    const int qc = 16 * j + fr, qs = clampi(qc - 8, 0, 48);
    float mx = -1e30f;
#pragma unroll
    for (int kt = 0; kt < 16; ++kt) { const int krl = kt >> 1, half = kt & 1; const int ridx = kr0 + krl - r + 7;
        float bz[4];
#pragma unroll
        for (int i = 0; i < 4; ++i) { const int kc = kc0 + 16 * half + 4 * fq + i; bz[i] = RPB[ridx * 31 + clampi(kc - qc + 15, 0, 30)]; }
#pragma unroll
        for (int i = 0; i < 4; ++i) { const int kc = kc0 + 16 * half + 4 * fq + i; const bool valid = kc >= qs && kc < qs + 16;
            const float v = valid ? s[kt][i] * 0.125f + bz[i] : -1e30f; s[kt][i] = v; mx = fmaxf(mx, v); } }
    mx = fmaxf(mx, __shfl_xor(mx, 16)); mx = fmaxf(mx, __shfl_xor(mx, 32));
    float sum = 0.f;
#pragma unroll
    for (int kt = 0; kt < 16; ++kt)
#pragma unroll
        for (int i = 0; i < 4; ++i) { const float e = __expf(s[kt][i] - mx); s[kt][i] = e; sum += e; }
    sum += __shfl_xor(sum, 16); sum += __shfl_xor(sum, 32);
    f32x4 o[4];
#pragma unroll
    for (int dt = 0; dt < 4; ++dt) o[dt] = (f32x4){0.f, 0.f, 0.f, 0.f};
#pragma unroll
    for (int kk = 0; kk < 8; ++kk) {
        const u32x4 pw = (u32x4){pk2(s[2 * kk][0], s[2 * kk][1]), pk2(s[2 * kk][2], s[2 * kk][3]), pk2(s[2 * kk + 1][0], s[2 * kk + 1][1]), pk2(s[2 * kk + 1][2], s[2 * kk + 1][3])};
        const bf16x8 pf = __builtin_bit_cast(bf16x8, pw);
        const int keyoff = (kr0 + kk - kbase) * 64 + kc0 + 4 * fq;
#pragma unroll
        for (int dt = 0; dt < 4; ++dt) { const u32x2 lo = *(const LAS u32x2*)(VT + (16 * dt + fr) * NA_KS + keyoff), hi = *(const LAS u32x2*)(VT + (16 * dt + fr) * NA_KS + keyoff + 16);
            const bf16x8 vf = __builtin_bit_cast(bf16x8, (u32x4){lo.x, lo.y, hi.x, hi.y});
            o[dt] = mfma16(vf, pf, o[dt]); } }
    const float inv = 1.f / sum;
#pragma unroll
    for (int dt = 0; dt < 4; ++dt) *(u32x2*)(MIXED + qtok * DM + 512 + h * 64 + 16 * dt + 4 * fq) = (u32x2){pk2(o[dt][0] * inv, o[dt][1] * inv), pk2(o[dt][2] * inv, o[dt][3] * inv)};
    WG_BAR();
}

__device__ __forceinline__ void conv_item(LAS unsigned char* lds, const Params& p, int layer, int item) {
    const int b = item >> 6, t0 = (item & 63) * 32;
    int tid_ = threadIdx.x; asm volatile("" : "+v"(tid_)); const int tid = tid_, w = __builtin_amdgcn_readfirstlane(tid >> 6), lane = tid & 63;
    const bf16* P = (const bf16*)(p.ws + WS_P); bf16* MIXED = (bf16*)(p.ws + WS_MIX);
    LAS float* U = (LAS float*)lds; LAS float* CO = U + 62 * 256;
    u32x4 ca4[4], cg4[4];
#pragma unroll
    for (int it = 0; it < 4; ++it) { const int u = it * NTHR + tid, tt = u >> 5, c8 = u & 31, t = t0 - 15 + tt; ca4[it] = (u32x4){0u, 0u, 0u, 0u}; cg4[it] = ca4[it];
        if (u < 62 * 32 && t >= 0 && t < SEQ) { const bf16* rp = P + (size_t)(b * SEQ + t) * DIN; ca4[it] = *(const u32x4*)(rp + C_CA + 8 * c8); cg4[it] = *(const u32x4*)(rp + C_CG + 8 * c8); } }
    const int c = tid & 255, half = tid >> 8;
    float wk[31];
#pragma unroll
    for (int k = 0; k < 31; ++k) wk[k] = p.cw[(size_t)(layer * 31 + k) * 256 + c];
    const float bias = p.cb[layer * 256 + c];
    __builtin_amdgcn_sched_barrier(0);
#pragma unroll
    for (int it = 0; it < 4; ++it) { const int u = it * NTHR + tid, tt = u >> 5, c8 = u & 31; const u32x4 a = ca4[it], g = cg4[it];
        if (u < 62 * 32) {
            const f32x4 u0 = (f32x4){bflo(a.x) * sigm(bflo(g.x)), bfhi(a.x) * sigm(bfhi(g.x)), bflo(a.y) * sigm(bflo(g.y)), bfhi(a.y) * sigm(bfhi(g.y))};
            const f32x4 u1 = (f32x4){bflo(a.z) * sigm(bflo(g.z)), bfhi(a.z) * sigm(bfhi(g.z)), bflo(a.w) * sigm(bflo(g.w)), bfhi(a.w) * sigm(bfhi(g.w))};
            *(LAS f32x4*)(U + tt * 256 + 8 * c8) = u0; *(LAS f32x4*)(U + tt * 256 + 8 * c8 + 4) = u1; } }
    WG_BAR();
#pragma unroll 1
    for (int g = 0; g < 2; ++g) { const int base = 16 * half + 8 * g; float win[38];
#pragma unroll
        for (int i = 0; i < 38; ++i) win[i] = U[(base + i) * 256 + c];
#pragma unroll
        for (int o = 0; o < 8; ++o) { float a = bias;
#pragma unroll
            for (int k = 0; k < 31; ++k) a += wk[k] * win[o + k];
            CO[(base + o) * 256 + c] = a; } }
    __syncthreads();
    const f32x4 lg = *(const f32x4*)(p.lng + layer * 256 + 4 * lane), lbv = *(const f32x4*)(p.lnb + layer * 256 + 4 * lane);
#pragma unroll
    for (int q = 0; q < 4; ++q) { const int tl = 4 * w + q; const f32x4 v = *(const LAS f32x4*)(CO + tl * 256 + 4 * lane);
        const float mean = wave_sum((v.x + v.y) + (v.z + v.w)) * (1.f / 256.f); const f32x4 dd = v - mean;
        const float var = wave_sum((dd.x * dd.x + dd.y * dd.y) + (dd.z * dd.z + dd.w * dd.w)) * (1.f / 256.f); const float rs = __builtin_amdgcn_rsqf(var + EPS);
        f32x4 y = dd * rs * lg + lbv; y = (f32x4){silu_f0(y.x), silu_f0(y.y), silu_f0(y.z), silu_f0(y.w)};
        *(u32x2*)(MIXED + (size_t)(b * SEQ + t0 + tl) * DM + 768 + 4 * lane) = (u32x2){pk2(y.x, y.y), pk2(y.z, y.w)}; }
    __syncthreads();
}

#define XB_TMO      128
#define XB_XCNT(j)  (256  + 64 * (j))
#define XB_XSUB(j)  (1280 + 64 * (j))
#define XB_XGEN(j)  (2304 + 64 * (j))
#define XB_TOP      3328
#define XB_TOPGEN   3392
#define XCD_BAR_WORDS 3456
#define XB_SPIN_CAP (1u << 18)

__device__ __forceinline__ unsigned xb_ld(unsigned* p)              { return __hip_atomic_load(p, __ATOMIC_RELAXED, __HIP_MEMORY_SCOPE_AGENT); }
__device__ __forceinline__ unsigned xb_add(unsigned* p, unsigned v) { return __hip_atomic_fetch_add(p, v, __ATOMIC_RELAXED, __HIP_MEMORY_SCOPE_AGENT); }
__device__ __forceinline__ unsigned xb_xcc_id() { return (unsigned)__builtin_amdgcn_s_getreg((3 << 11) | 20) & 0xFu; }
#define XB_SPIN(cond, bar) do { unsigned _sp = 0; while (cond) { __builtin_amdgcn_s_sleep(1); \
    if ((++_sp & 255u) == 0u) { if (xb_ld(&(bar)[XB_TMO])) break; if (_sp > XB_SPIN_CAP) { atomicAdd(&(bar)[XB_TMO], 1u); break; } } } } while (0)

struct XcdBarrier {
    unsigned* bar; unsigned x;
    volatile LAS unsigned* st;
};

__device__ __forceinline__ XcdBarrier xcd_barrier_post(unsigned* bar, volatile LAS unsigned* st) {
    XcdBarrier b; b.bar = bar; b.x = xb_xcc_id(); b.st = st;
    if (threadIdx.x == 0) (void)xb_add(&bar[XB_XCNT(b.x)], 1u);
    return b;
}
__device__ __forceinline__ void xcd_barrier_complete(unsigned* bar, unsigned x, unsigned& nloc, unsigned& nx) {
    const unsigned G = gridDim.x * gridDim.y * gridDim.z;
    unsigned sum, cnt, mine, sp = 0u;
    for (;;) {
        sum = 0u; cnt = 0u; mine = 0u;
#pragma unroll
        for (unsigned j = 0; j < 16; ++j) { const unsigned c = xb_ld(&bar[XB_XCNT(j)]); sum += c; cnt += (c > 0u) ? 1u : 0u; mine = (j == x) ? c : mine; }
        if (sum == G) break;
        __builtin_amdgcn_s_sleep(1);
        if ((++sp & 255u) == 0u) { if (xb_ld(&bar[XB_TMO])) break; if (sp > XB_SPIN_CAP) { atomicAdd(&bar[XB_TMO], 1u); break; } }
    }
    nloc = mine > 0u ? mine : 1u; nx = cnt > 0u ? cnt : 1u;
}

__device__ __forceinline__ void xcd_barrier(const XcdBarrier& b) {
    asm volatile("s_waitcnt vmcnt(0)" ::: "memory");
    __syncthreads();
    if (threadIdx.x == 0) {
        unsigned* bar = b.bar;
        __builtin_amdgcn_s_waitcnt(0);
        unsigned nloc = b.st[0], nx = b.st[1];
        if (nloc == 0u) { xcd_barrier_complete(bar, b.x, nloc, nx); b.st[0] = nloc; b.st[1] = nx; }
        const unsigned old = xb_add(&bar[XB_XSUB(b.x)], 1u);
        const unsigned gen = old / nloc;
        if (old + 1u == (gen + 1u) * nloc) {
            __builtin_amdgcn_fence(__ATOMIC_RELEASE, "agent");
            asm volatile("s_waitcnt vmcnt(0)" ::: "memory");
            const unsigned og = xb_add(&bar[XB_TOP], 1u);
            const unsigned tg = og / nx;
            if (og + 1u == (tg + 1u) * nx) xb_add(&bar[XB_TOPGEN], 1u);
            else XB_SPIN(xb_ld(&bar[XB_TOPGEN]) == tg, bar);
            __builtin_amdgcn_fence(__ATOMIC_ACQUIRE, "agent");
            xb_add(&bar[XB_XGEN(b.x)], 1u);
            asm volatile("s_waitcnt vmcnt(0)" ::: "memory");
        } else {
            XB_SPIN(xb_ld(&bar[XB_XGEN(b.x)]) == gen, bar);
            __builtin_amdgcn_fence(__ATOMIC_ACQUIRE, "agent");
            asm volatile("s_waitcnt vmcnt(0)" ::: "memory");
        }
    }
    __syncthreads();
}

#if 0
#define PROBE_SEL_UNUSED (-1)
#endif
#ifndef REP_HA
#define REP_HA 1
#endif
#ifndef REP_NA
#define REP_NA 1
#endif
#ifndef REP_CV
#define REP_CV 1
#endif
#ifndef REP_F
#define REP_F 1
#endif
#ifndef REP_B
#define REP_B 1
#endif
#define GRID_BAR() do { XcdBarrier xb_; xb_.bar = (unsigned*)(ws + WS_BAR); xb_.x = xb_xcc_id(); xb_.st = (volatile LAS unsigned*)(lds + XB_ST_OFF); xcd_barrier(xb_); } while (0)
#define PHASE_END(kind) do { GRID_BAR(); if (PROBE_SEL >= 0 && PROBE_SEL < 10 && threadIdx.x == 0) { volatile LAS unsigned long long* pv_ = (volatile LAS unsigned long long*)(lds + PT_WORDS_OFF + 8); const unsigned long long t_ = PT_NOW(); if ((kind) == PROBE_SEL || PROBE_SEL == 9) PT_ACC(lds, t_ - pv_[0]); pv_[0] = t_; } } while (0)
constexpr size_t WS_BAR = 4096, WS_CTL_BYTES = 65536;
constexpr int XB_ST_OFF = 140288;
constexpr int RS_OFF = 131072;
constexpr int LDS_BYTES = 147456;
#define KARGS(q_) const Params& q_ = p_unused;
__global__ void __launch_bounds__(NTHR, 2) fwd_megakernel(Params p_unused) {
    extern __shared__ __attribute__((aligned(16))) unsigned char lds_raw[];
    LAS unsigned char* lds = (LAS unsigned char*)lds_raw;
    int tid_ = threadIdx.x; asm volatile("" : "+v"(tid_)); const int tid = tid_, lane = tid & 63, wave = __builtin_amdgcn_readfirstlane(tid >> 6);
    const int G = gridDim.x, bid = blockIdx.x, gw = bid * NWAVES + wave, NGW = G * NWAVES;
    unsigned char* ws; { KARGS(q0); ws = q0.ws; }

    if (tid < 2) ((volatile LAS unsigned*)(lds + XB_ST_OFF))[tid] = 0u;
    __syncthreads();
    if (ws == nullptr) cg::this_grid().sync();
    (void)xcd_barrier_post((unsigned*)(ws + WS_BAR), (volatile LAS unsigned*)(lds + XB_ST_OFF));
    if (PROBE_SEL >= 0 && threadIdx.x == 0) { ((volatile LAS unsigned*)(lds + PT_WORDS_OFF))[0] = 0u; *(volatile LAS unsigned long long*)(lds + PT_WORDS_OFF + 8) = PT_NOW(); }
    { KARGS(q); prologue(q, lds, gw, NGW, wave, lane); }
    PHASE_END(0);
    if (PROBE_SEL == 8) { PHASE_END(9); PHASE_END(8); }
#pragma unroll 1
    for (int l = 0; l < DEPTH; ++l) {
        unsigned char* wsl; { KARGS(ql); wsl = ql.ws; }
        float* ssq = (float*)(wsl + WS_SSQ); bf16* XB = (bf16*)(wsl + WS_XB); bf16* PB = (bf16*)(wsl + WS_P); bf16* MIXED = (bf16*)(wsl + WS_MIX);
        {
            pg8::Gemm g{XB, (const bf16*)(wsl + WS_WIN + l * WS_WIN_L), M, DIN, DM}; pg8::StaticOrder S; S.init(M, DIN, G, bid);
            pg8::rstd_table((LAS float*)(lds + RS_OFF), ssq, S); pg8::EpiScale E{PB, DIN, (LAS float*)(lds + RS_OFF), 0x303u};
            pg8::gemm_phase<pg8::EpiScale, pg8::StaticOrder, true, true>(lds, g, S, E);
        }
        PHASE_END(1);
#pragma unroll 1
        for (int rep = 0; rep < REP_HA; ++rep)
        { KARGS(q); for (int it = bid; it < BATCH * 4 * NSEG * 2; it += G) hg_passA_item(lds, q, l, it); }
#pragma unroll 1
        for (int rep = 0; rep < REP_NA; ++rep)
        { KARGS(q); for (int it = bid; it < BATCH * 4 * 16; it += G) na_item(lds, q, l, it); }
#pragma unroll 1
        for (int rep = 0; rep < REP_CV; ++rep)
        { KARGS(q); for (int it = bid; it < BATCH * 64; it += G) conv_item(lds, q, l, it); }
        PHASE_END(2);
#pragma unroll 1
        for (int rep = 0; rep < REP_B; ++rep)
        { KARGS(q); for (int it = bid; it < BATCH * 4 * NSEG; it += G) (void)hg_passB_item(lds, q, l, it); }
        PHASE_END(3);
        {
            pg8::Gemm g{MIXED, (const bf16*)(wsl + WS_WOUT + l * WS_WOUT_L), M, DM, DM}; pg8::StaticOrder S; S.init(M, DM, G, bid);
            pg8::EpiRes E{XB, ssq};
            pg8::gemm_phase<pg8::EpiRes, pg8::StaticOrder, true, true>(lds, g, S, E);
        }
        PHASE_END(4);
        {
            pg8::Gemm g{XB, (const bf16*)(wsl + WS_WGU + l * WS_WGU_L), M, 2 * FFN, DM}; pg8::StaticOrder S; S.init(M, 2 * FFN, G, bid);
            pg8::rstd_table((LAS float*)(lds + RS_OFF), ssq, S); pg8::EpiSwiGLU E{PB, FFN, (LAS float*)(lds + RS_OFF)};
            pg8::gemm_phase<pg8::EpiSwiGLU, pg8::StaticOrder, true, true>(lds, g, S, E);
        }
        PHASE_END(5);
        {
            pg8::Gemm g{PB, (const bf16*)(wsl + WS_WDN + l * WS_WDN_L), M, DM, FFN}; pg8::StaticOrder S; S.init(M, DM, G, bid);
            pg8::EpiRes E{XB, ssq};
            pg8::gemm_phase<pg8::EpiRes, pg8::StaticOrder, true, true>(lds, g, S, E);
        }
        PHASE_END(6);
    }
    float pdelta = 0.f;
    int tf_ = threadIdx.x; asm volatile("" : "+v"(tf_)); const int lanef = tf_ & 63, gwf = bid * NWAVES + __builtin_amdgcn_readfirstlane(tf_ >> 6);
    KARGS(qf); unsigned char* wsf = qf.ws; const float* ssq = (const float*)(wsf + WS_SSQ); const bf16* XB = (const bf16*)(wsf + WS_XB);
    if (PROBE_SEL >= 0) {
        unsigned* tw = (unsigned*)(wsf + 64);
        if (bid == 0 && threadIdx.x == 0) __hip_atomic_store(tw, ((volatile LAS unsigned*)(lds + PT_WORDS_OFF))[0], __ATOMIC_RELAXED, __HIP_MEMORY_SCOPE_AGENT);
        GRID_BAR();
        pdelta = (float)__hip_atomic_load(tw, __ATOMIC_RELAXED, __HIP_MEMORY_SCOPE_AGENT) * (PROBE_SEL == 9 ? 0.5e-6f : 1e-6f);
    }
#pragma unroll 1
    for (int rep = 0; rep < REP_F; ++rep)
    for (int m = gwf; m < M; m += 2 * NGW) {
        const int m2 = (m + NGW < M) ? m + NGW : m;
        float pa = lanef < 16 ? ssq[(size_t)(lanef & 15) * M + m] : 0.f, pc = lanef < 16 ? ssq[(size_t)(lanef & 15) * M + m2] : 0.f;
        const u32x4* xa = (const u32x4*)(XB + (size_t)m * DM) + lanef; const u32x4* xc = (const u32x4*)(XB + (size_t)m2 * DM) + lanef;
        u32x4 va[2], vc[2]; f32x4 gg[4];
#pragma unroll
        for (int j = 0; j < 2; ++j) { va[j] = xa[64 * j]; vc[j] = xc[64 * j]; gg[2 * j] = *(const f32x4*)(qf.fin_g + 512 * j + 8 * lanef); gg[2 * j + 1] = *(const f32x4*)(qf.fin_g + 512 * j + 8 * lanef + 4); }
        __builtin_amdgcn_sched_barrier(0);
        pa = wave_sum(pa); pc = wave_sum(pc);
        const float ra = __builtin_amdgcn_rsqf(pa * (1.f / DM) + EPS), rc = __builtin_amdgcn_rsqf(pc * (1.f / DM) + EPS);
        const f32x4 pd = (PROBE_SEL >= 0) ? (f32x4){pdelta, -pdelta, pdelta, -pdelta} : (f32x4){0.f, 0.f, 0.f, 0.f};
#pragma unroll
        for (int j = 0; j < 2; ++j) {
            { const u32x4 r = va[j]; float* o = qf.out + (size_t)m * DM + 512 * j + 8 * lanef;
              f32x4 v0 = (f32x4){bflo(r.x), bfhi(r.x), bflo(r.y), bfhi(r.y)} * ra * gg[2 * j], v1 = (f32x4){bflo(r.z), bfhi(r.z), bflo(r.w), bfhi(r.w)} * ra * gg[2 * j + 1];
              if (PROBE_SEL >= 0 && m < 256) { v0 = v0 + pd; v1 = v1 + pd; }
              *(f32x4*)o = v0; *(f32x4*)(o + 4) = v1; }
            if (m2 != m) { const u32x4 r = vc[j]; float* o = qf.out + (size_t)m2 * DM + 512 * j + 8 * lanef;
              f32x4 v0 = (f32x4){bflo(r.x), bfhi(r.x), bflo(r.y), bfhi(r.y)} * rc * gg[2 * j], v1 = (f32x4){bflo(r.z), bfhi(r.z), bflo(r.w), bfhi(r.w)} * rc * gg[2 * j + 1];
              if (PROBE_SEL >= 0 && m2 < 256) { v0 = v0 + pd; v1 = v1 + pd; }
              *(f32x4*)o = v0; *(f32x4*)(o + 4) = v1; } }
    }
}

extern "C" void kernel_launch(void* const* d_in, const int* in_sizes, int n_in, void* d_out, int out_size, void* d_ws, size_t ws_size, hipStream_t stream) {
    static int grid_blocks = 0;
    if (grid_blocks == 0) {
        if (n_in != 15 || out_size != M * DM || ws_size < WS_END) { fprintf(stderr, "kernel_launch: unexpected shapes (n_in %d out %d ws %zu)\n", n_in, out_size, ws_size); grid_blocks = -1; return; }
        int dev = 0, cus = 0, per_cu = 0;
        hipGetDevice(&dev); hipDeviceGetAttribute(&cus, hipDeviceAttributeMultiprocessorCount, dev);
        hipFuncSetAttribute((const void*)fwd_megakernel, hipFuncAttributeMaxDynamicSharedMemorySize, LDS_BYTES);
        hipOccupancyMaxActiveBlocksPerMultiprocessor(&per_cu, (const void*)fwd_megakernel, NTHR, LDS_BYTES);
        if (per_cu < 1) { fprintf(stderr, "kernel_launch: occupancy query says %d blocks per CU\n", per_cu); per_cu = 1; }
        (void)hipGetLastError();
        grid_blocks = cus * 1;
    }
    if (grid_blocks < 0) return;
    Params p{};
    p.x = (const float*)d_in[0]; p.mix_g = (const float*)d_in[1]; p.w_in = (const float*)d_in[2]; p.hg_lb = (const float*)d_in[3]; p.hg_ng = (const float*)d_in[4];
    p.rpb = (const float*)d_in[5]; p.cw = (const float*)d_in[6]; p.cb = (const float*)d_in[7]; p.lng = (const float*)d_in[8]; p.lnb = (const float*)d_in[9];
    p.w_out = (const float*)d_in[10]; p.ffn_g = (const float*)d_in[11]; p.w_gu = (const float*)d_in[12]; p.w_dn = (const float*)d_in[13]; p.fin_g = (const float*)d_in[14];
    p.out = (float*)d_out; p.ws = (unsigned char*)d_ws;
    if (hipMemsetAsync(d_ws, 0, WS_CTL_BYTES, stream) != hipSuccess) { fprintf(stderr, "kernel_launch: hipMemsetAsync failed\n"); return; }
    void* args[] = {&p};
    hipError_t e = hipLaunchCooperativeKernel((const void*)fwd_megakernel, dim3(grid_blocks), dim3(NTHR), args, LDS_BYTES, stream);
    if (e != hipSuccess) fprintf(stderr, "cooperative launch failed: %s (grid %d)\n", hipGetErrorString(e), grid_blocks);
}
```

```cpp
#include <hip/hip_runtime.h>
#include <hip/hip_cooperative_groups.h>
#include <cstdio>
#include <cstdint>
namespace cg = cooperative_groups;

namespace pg8 {
#define PG8_LAS __attribute__((address_space(3)))
typedef unsigned short bf16_t;
typedef short bf16x8 __attribute__((ext_vector_type(8)));
typedef float f32x4 __attribute__((ext_vector_type(4)));
typedef unsigned u32x4 __attribute__((ext_vector_type(4)));
constexpr int BM = 256, BK = 64, HALF = 128, HTB = HALF * BK * 2  , STAGE_BYTES = 8 * HTB, NXCD = 8, WGM = 8;

__host__ __device__ __forceinline__ int lds_byte(int r, int c) { const int st = (r >> 4) * 2 + (c >> 5), rr = r & 15, cc = c & 31, ob = rr * 64 + cc * 2; return st * 1024 + (ob ^ (((ob >> 9) & 1) << 5)); }
__host__ __device__ __forceinline__ void stage_rc(int b, int& R, int& C) { const int st = b / 1024, sb = b % 1024, swz = sb ^ (((sb >> 9) & 1) << 5); R = (st >> 1) * 16 + swz / 64; C = (st & 1) * 32 + (swz % 64) / 2; }
__host__ __device__ __forceinline__ int perm32(int rho) { const int n = rho >> 4, i = rho & 15; return 8 * (i >> 2) + 4 * n + (i & 3); }

struct Unit { int pm, pn; };
struct Gemm { const bf16_t* A; const bf16_t* Bt; int M, N, K; };

struct StaticOrder {
    int nM, nN, nwg, G, c;
    __host__ __device__ void init(int M, int N, int G_, int c_) { nM = M / BM; nN = N / BM; nwg = nM * nN; G = G_; c = c_; }
    __host__ __device__ bool next(int i, Unit& u) const {
        const long L = (long)i * G + c; if (L >= nwg) return false;
        int wgid = (int)L; { const int q = nwg / NXCD, r = nwg % NXCD, xcd = wgid % NXCD, off = wgid / NXCD; wgid = (xcd < r ? xcd * (q + 1) : r * (q + 1) + (xcd - r) * q) + off; }
        const int nig = WGM * nN, gid = wgid / nig, fm = gid * WGM, gsz = (nM - fm) < WGM ? (nM - fm) : WGM;
        u.pm = fm + ((wgid % nig) % gsz); u.pn = (wgid % nig) / gsz; return true;
    }
    __device__ __forceinline__ void a_ready(const Unit&) const {}
    __device__ __forceinline__ void done(const Unit&) const {}
};
__device__ __forceinline__ unsigned cvt_pk_bf16(float lo, float hi) { unsigned r; asm volatile("v_cvt_pk_bf16_f32 %0, %1, %2" : "=v"(r) : "v"(lo), "v"(hi)); return r; }
typedef float f32x2 __attribute__((ext_vector_type(2)));
constexpr int MROWS = 16384, DMODEL = 1024, NPART = 16;
constexpr float NORM_EPS = 1e-6f;
__device__ __forceinline__ float row_rstd(const float* ssq, int row) {
    float s = 0.f;
#pragma unroll
    for (int p = 0; p < NPART; ++p) s += ssq[(size_t)p * MROWS + row];
    return __builtin_amdgcn_rsqf(s * (1.f / DMODEL) + NORM_EPS);
}
__device__ __forceinline__ float silu_f(float x) { return x * __builtin_amdgcn_rcpf(1.f + __expf(-x)); }

struct EpiScale {
    static constexpr bool PERM = true, AFTER_DRAIN = false;
    bf16_t* O; int ldc; const PG8_LAS float* RS; unsigned silu_mask;
    __device__ __forceinline__ void operator()(const f32x4 (&acc)[2][2][4][2], const Unit& u, int ui, int wr, int wc, int fr, int fq) const {
        const int row0 = u.pm * BM + wr * 64 + fr, col0 = u.pn * BM + wc * 32 + 8 * fq; const bool act = (silu_mask >> u.pn) & 1u;
#pragma unroll
        for (int ai = 0; ai < 2; ++ai)
#pragma unroll
            for (int m = 0; m < 4; ++m) { const int row = row0 + ai * HALF + m * 16; const float rs = RS[ui * BM + wr * 64 + fr + ai * HALF + m * 16]; bf16_t* rowp = O + (size_t)row * ldc + col0;
#pragma unroll
                for (int bj = 0; bj < 2; ++bj) { f32x4 v0 = acc[ai][bj][m][0] * rs, v1 = acc[ai][bj][m][1] * rs;
                    if (act) { v0 = (f32x4){silu_f(v0[0]), silu_f(v0[1]), silu_f(v0[2]), silu_f(v0[3])}; v1 = (f32x4){silu_f(v1[0]), silu_f(v1[1]), silu_f(v1[2]), silu_f(v1[3])}; }
                    u32x4 w; w.x = cvt_pk_bf16(v0[0], v0[1]); w.y = cvt_pk_bf16(v0[2], v0[3]); w.z = cvt_pk_bf16(v1[0], v1[1]); w.w = cvt_pk_bf16(v1[2], v1[3]);
                    *(u32x4*)(rowp + bj * HALF) = w; } __builtin_amdgcn_sched_barrier(0); }
    }
};
struct EpiRes {
    static constexpr bool PERM = true, AFTER_DRAIN = false;
    bf16_t* XB; float* ssq;
    __device__ __forceinline__ void operator()(const f32x4 (&acc)[2][2][4][2], const Unit& u, int ui, int wr, int wc, int fr, int fq) const {
        const int row0 = u.pm * BM + wr * 64 + fr, col0 = u.pn * BM + wc * 32 + 8 * fq;
#pragma unroll
        for (int ai = 0; ai < 2; ++ai)
#pragma unroll
            for (int mm = 0; mm < 4; mm += 2) {
                u32x4 rr[2][2];
#pragma unroll
                for (int q = 0; q < 2; ++q)
#pragma unroll
                    for (int bj = 0; bj < 2; ++bj) rr[q][bj] = *(const u32x4*)(XB + (size_t)(row0 + ai * HALF + (mm + q) * 16) * DMODEL + col0 + bj * HALF);
                __builtin_amdgcn_sched_barrier(0);
#pragma unroll
                for (int q = 0; q < 2; ++q) { const int m = mm + q, row = row0 + ai * HALF + m * 16; const size_t o = (size_t)row * DMODEL + col0; float sq = 0.f;
#pragma unroll
                    for (int bj = 0; bj < 2; ++bj) { const u32x4 r = rr[q][bj];
                        const f32x4 r0 = (f32x4){__builtin_bit_cast(float, r.x << 16), __builtin_bit_cast(float, r.x & 0xffff0000u), __builtin_bit_cast(float, r.y << 16), __builtin_bit_cast(float, r.y & 0xffff0000u)};
                        const f32x4 r1 = (f32x4){__builtin_bit_cast(float, r.z << 16), __builtin_bit_cast(float, r.z & 0xffff0000u), __builtin_bit_cast(float, r.w << 16), __builtin_bit_cast(float, r.w & 0xffff0000u)};
                        const f32x4 v0 = acc[ai][bj][m][0] + r0, v1 = acc[ai][bj][m][1] + r1;
                        u32x4 w; w.x = cvt_pk_bf16(v0[0], v0[1]); w.y = cvt_pk_bf16(v0[2], v0[3]); w.z = cvt_pk_bf16(v1[0], v1[1]); w.w = cvt_pk_bf16(v1[2], v1[3]);
                        *(u32x4*)(XB + o + bj * HALF) = w;
                        sq += (v0[0] * v0[0] + v0[1] * v0[1]) + (v0[2] * v0[2] + v0[3] * v0[3]) + (v1[0] * v1[0] + v1[1] * v1[1]) + (v1[2] * v1[2] + v1[3] * v1[3]); }
                    sq += __shfl_xor(sq, 16); sq += __shfl_xor(sq, 32);
                    if (fq == 0) ssq[(size_t)(u.pn * 4 + wc) * MROWS + row] = sq; }
                __builtin_amdgcn_sched_barrier(0); }
    }
};
struct EpiSwiGLU {
    static constexpr bool PERM = true, AFTER_DRAIN = false;
    bf16_t* O; int ldc; const PG8_LAS float* RS;
    __device__ __forceinline__ void operator()(const f32x4 (&acc)[2][2][4][2], const Unit& u, int ui, int wr, int wc, int fr, int fq) const {
        const int row0 = u.pm * BM + wr * 64 + fr, col0 = u.pn * HALF + wc * 32 + 8 * fq;
#pragma unroll
        for (int ai = 0; ai < 2; ++ai)
#pragma unroll
            for (int m = 0; m < 4; ++m) { const int row = row0 + ai * HALF + m * 16; const float rs = RS[ui * BM + wr * 64 + fr + ai * HALF + m * 16];
                const f32x4 g0 = acc[ai][0][m][0] * rs, g1 = acc[ai][0][m][1] * rs, u0 = acc[ai][1][m][0] * rs, u1 = acc[ai][1][m][1] * rs;
                u32x4 w; w.x = cvt_pk_bf16(silu_f(g0[0]) * u0[0], silu_f(g0[1]) * u0[1]); w.y = cvt_pk_bf16(silu_f(g0[2]) * u0[2], silu_f(g0[3]) * u0[3]);
                w.z = cvt_pk_bf16(silu_f(g1[0]) * u1[0], silu_f(g1[1]) * u1[1]); w.w = cvt_pk_bf16(silu_f(g1[2]) * u1[2], silu_f(g1[3]) * u1[3]);
                *(u32x4*)(O + (size_t)row * ldc + col0) = w; __builtin_amdgcn_sched_barrier(0); }
    }
};
template <class Sched> __device__ __forceinline__ void rstd_table(PG8_LAS float* RS, const float* ssq, const Sched& S) {
    int tx_ = threadIdx.x; asm volatile("" : "+v"(tx_));
    Unit u; const int t = tx_ & (BM - 1);
    for (int i = __builtin_amdgcn_readfirstlane(tx_ >> 8); S.next(i, u); i += 2) {
        float v[NPART];
#pragma unroll
        for (int p = 0; p < NPART; ++p) v[p] = ssq[(size_t)p * MROWS + u.pm * BM + t];
        __builtin_amdgcn_sched_barrier(0);
        const float s = (((v[0] + v[1]) + (v[2] + v[3])) + ((v[4] + v[5]) + (v[6] + v[7]))) + (((v[8] + v[9]) + (v[10] + v[11])) + ((v[12] + v[13]) + (v[14] + v[15])));
        RS[i * BM + t] = __builtin_amdgcn_rsqf(s * (1.f / DMODEL) + NORM_EPS);
    }
    __syncthreads();
}
template <class Epi, class Sched, bool ALIGN_EPI = false, bool SP2 = false>
__device__ __forceinline__ void gemm_phase(PG8_LAS unsigned char* lds, const Gemm g, const Sched& S, const Epi& E) {
    int tid_ = threadIdx.x; asm volatile("" : "+v"(tid_));
    const int tid = tid_, wid = __builtin_amdgcn_readfirstlane(tid >> 6), lane = tid & 63, wr = wid >> 2, wc = wid & 3, fr = lane & 15, fq = lane >> 4;
    const int K = g.K, nt = K / BK;
    unsigned voffA[2], voffB[2];
#pragma unroll
    for (int i = 0; i < 2; ++i) { int R, C; stage_rc(tid * 16 + i * 8192, R, C); const int Rb = Epi::PERM ? ((R & ~31) + perm32(R & 31)) : R;
        voffA[i] = (unsigned)(R * K + C) * 2u; voffB[i] = (unsigned)(Rb * K + C) * 2u; }
    const size_t kstep = (size_t)(BK * 2);
    const size_t hstep = (size_t)HALF * K * 2;
    const size_t tstep = 2 * hstep;
    const unsigned ldsw = (unsigned)wid * 1024u;
    const int aoff = lds_byte(wr * 64 + fr, fq * 8), boff = lds_byte(wc * 32 + fr, fq * 8);
#define PG8_SA(b, h) (((b) * 2 + (h)) * HTB)
#define PG8_SB(b, h) ((4 + (b) * 2 + (h)) * HTB)
#define PG8_STAGE(bufoff, gbase, voff) do { _Pragma("unroll") for (int _i = 0; _i < 2; ++_i) \
        __builtin_amdgcn_global_load_lds((const unsigned*)((const char*)(gbase) + (voff)[_i]), (PG8_LAS unsigned*)(lds + (bufoff) + ldsw + _i * 8192), 16, 0, 0); } while (0)
#define PG8_LDA(dst, b, h) do { _Pragma("unroll") for (int m = 0; m < 4; ++m) _Pragma("unroll") for (int k = 0; k < 2; ++k) dst[m][k] = *(const PG8_LAS bf16x8*)(lds + PG8_SA(b, h) + aoff + m * 2048 + k * 1024); } while (0)
#define PG8_LDB(dst, b, h) do { _Pragma("unroll") for (int n = 0; n < 2; ++n) _Pragma("unroll") for (int k = 0; k < 2; ++k) dst[n][k] = *(const PG8_LAS bf16x8*)(lds + PG8_SB(b, h) + boff + n * 2048 + k * 1024); } while (0)
#define PG8_MMA(ai, bj, At, Bt) do { __builtin_amdgcn_s_setprio(1); _Pragma("unroll") for (int m = 0; m < 4; ++m) _Pragma("unroll") for (int n = 0; n < 2; ++n) _Pragma("unroll") for (int k = 0; k < 2; ++k) \
        acc[ai][bj][m][n] = __builtin_amdgcn_mfma_f32_16x16x32_bf16(Bt[n][k], At[m][k], acc[ai][bj][m][n], 0, 0, 0); __builtin_amdgcn_s_setprio(0); } while (0)
#define PG8_WAIT_V(n) asm volatile("s_waitcnt vmcnt(" #n ")" ::: "memory")
#define PG8_WAIT_L(n) asm volatile("s_waitcnt lgkmcnt(" #n ")" ::: "memory")
#define PG8_BAR __builtin_amdgcn_s_barrier()
#define PG8_SCHED __builtin_amdgcn_sched_barrier(0)
    Unit cur, nxt; int ui = 0;
    if (!S.next(0, cur)) return;
    f32x4 acc[2][2][4][2];
#pragma unroll
    for (int a = 0; a < 2; ++a)
#pragma unroll
        for (int b = 0; b < 2; ++b)
#pragma unroll
            for (int m = 0; m < 4; ++m)
#pragma unroll
                for (int n = 0; n < 2; ++n) acc[a][b][m][n] = (f32x4){0.f, 0.f, 0.f, 0.f};
    bf16x8 At[4][2], B0[2][2], B1[2][2];
    const char* cA = (const char*)g.A + (size_t)cur.pm * tstep; const char* cB = (const char*)g.Bt + (size_t)cur.pn * tstep;
    S.a_ready(cur);
    if constexpr (SP2) {
        PG8_STAGE(PG8_SB(0, 0), cB, voffB); PG8_STAGE(PG8_SB(0, 1), cB + hstep, voffB); PG8_STAGE(PG8_SA(0, 0), cA, voffA); PG8_STAGE(PG8_SA(0, 1), cA + hstep, voffA);
        if (wr == 1) PG8_BAR;
        PG8_WAIT_V(2); PG8_BAR;
        PG8_STAGE(PG8_SB(1, 0), cB + kstep, voffB); PG8_STAGE(PG8_SA(1, 0), cA + kstep, voffA); PG8_STAGE(PG8_SB(1, 1), cB + hstep + kstep, voffB);
        PG8_WAIT_V(6); PG8_BAR;
    } else {
        PG8_STAGE(PG8_SB(0, 0), cB, voffB); PG8_STAGE(PG8_SA(0, 0), cA, voffA); PG8_STAGE(PG8_SB(0, 1), cB + hstep, voffB); PG8_STAGE(PG8_SA(0, 1), cA + hstep, voffA);
        if (wr == 1) PG8_BAR;
        PG8_WAIT_V(4); PG8_BAR;
        PG8_STAGE(PG8_SB(1, 0), cB + kstep, voffB); PG8_STAGE(PG8_SA(1, 0), cA + kstep, voffA); PG8_STAGE(PG8_SB(1, 1), cB + hstep + kstep, voffB);
        PG8_WAIT_V(6); PG8_BAR;
    }
    for (;;) {
        const bool has_next = S.next(ui + 1, nxt);
        const char* nA = has_next ? (const char*)g.A + (size_t)nxt.pm * tstep : cA; const char* nB = has_next ? (const char*)g.Bt + (size_t)nxt.pn * tstep : cB;
        for (int t = 0; t < nt; t += 2) {
            const bool last = (t == nt - 2);
            const char* a1 = cA + (size_t)(t + 1) * kstep;
            const char* a2 = last ? nA : cA + (size_t)(t + 2) * kstep; const char* b2 = last ? nB : cB + (size_t)(t + 2) * kstep;
            const char* a3 = a2 + kstep; const char* b3 = b2 + kstep;
            if (last && has_next) S.a_ready(nxt);
            if constexpr (SP2) {
            PG8_LDB(B0, 0, 0); PG8_LDB(B1, 0, 1); PG8_SCHED; PG8_LDA(At, 0, 0); PG8_STAGE(PG8_SA(1, 1), a1 + hstep, voffA);
            PG8_WAIT_V(8); PG8_WAIT_L(0); PG8_BAR; PG8_MMA(0, 0, At, B0); PG8_MMA(0, 1, At, B1); PG8_BAR; PG8_SCHED;
            PG8_LDA(At, 0, 1); PG8_STAGE(PG8_SB(0, 0), b2, voffB); PG8_STAGE(PG8_SB(0, 1), b2 + hstep, voffB); PG8_STAGE(PG8_SA(0, 0), a2, voffA);
            PG8_WAIT_V(8); PG8_WAIT_L(0); PG8_BAR; PG8_MMA(1, 0, At, B0); PG8_MMA(1, 1, At, B1); PG8_BAR; PG8_SCHED;
            PG8_LDB(B0, 1, 0); PG8_LDB(B1, 1, 1); PG8_SCHED; PG8_LDA(At, 1, 0); PG8_STAGE(PG8_SA(0, 1), a2 + hstep, voffA);
            PG8_WAIT_V(8); PG8_WAIT_L(0); PG8_BAR; PG8_MMA(0, 0, At, B0); PG8_MMA(0, 1, At, B1); PG8_BAR; PG8_SCHED;
            PG8_LDA(At, 1, 1); PG8_STAGE(PG8_SB(1, 0), b3, voffB); PG8_STAGE(PG8_SB(1, 1), b3 + hstep, voffB); PG8_STAGE(PG8_SA(1, 0), a3, voffA);
            PG8_WAIT_V(8); PG8_WAIT_L(0); PG8_BAR; PG8_MMA(1, 0, At, B0); PG8_MMA(1, 1, At, B1); PG8_BAR; PG8_SCHED;
            } else {
            PG8_LDB(B0, 0, 0); PG8_SCHED; PG8_LDA(At, 0, 0); PG8_STAGE(PG8_SA(1, 1), a1 + hstep, voffA);
            PG8_WAIT_L(8); PG8_BAR; PG8_WAIT_L(0); PG8_MMA(0, 0, At, B0); PG8_BAR; PG8_SCHED;
            PG8_LDB(B1, 0, 1); PG8_STAGE(PG8_SB(0, 0), b2, voffB);
            PG8_BAR; PG8_WAIT_L(0); PG8_MMA(0, 1, At, B1); PG8_BAR;
            PG8_LDA(At, 0, 1); PG8_STAGE(PG8_SA(0, 0), a2, voffA);
            PG8_BAR; PG8_WAIT_L(0); PG8_MMA(1, 0, At, B0); PG8_BAR; PG8_SCHED;
            PG8_STAGE(PG8_SB(0, 1), b2 + hstep, voffB);
            PG8_WAIT_V(6); PG8_BAR; PG8_MMA(1, 1, At, B1); PG8_BAR;
            PG8_LDB(B0, 1, 0); PG8_SCHED; PG8_LDA(At, 1, 0); PG8_STAGE(PG8_SA(0, 1), a2 + hstep, voffA);
            PG8_WAIT_L(8); PG8_BAR; PG8_WAIT_L(0); PG8_MMA(0, 0, At, B0); PG8_BAR; PG8_SCHED;
            PG8_LDB(B1, 1, 1); PG8_STAGE(PG8_SB(1, 0), b3, voffB);
            PG8_BAR; PG8_WAIT_L(0); PG8_MMA(0, 1, At, B1); PG8_BAR;
            PG8_LDA(At, 1, 1); PG8_STAGE(PG8_SA(1, 0), a3, voffA);
            PG8_BAR; PG8_WAIT_L(0); PG8_MMA(1, 0, At, B0); PG8_BAR; PG8_SCHED;
            PG8_STAGE(PG8_SB(1, 1), b3 + hstep, voffB);
            PG8_WAIT_V(6); PG8_BAR; PG8_MMA(1, 1, At, B1); PG8_BAR;
            }
        }
        if constexpr (ALIGN_EPI) { if (wr == 0) PG8_BAR; }
        if constexpr (!Epi::AFTER_DRAIN) { E(acc, cur, ui, wr, wc, fr, fq); S.done(cur); }
        if (!has_next) break;
#pragma unroll
        for (int a = 0; a < 2; ++a)
#pragma unroll
            for (int b = 0; b < 2; ++b)
#pragma unroll
                for (int m = 0; m < 4; ++m)
#pragma unroll
                    for (int n = 0; n < 2; ++n) acc[a][b][m][n] = (f32x4){0.f, 0.f, 0.f, 0.f};
        cur = nxt; cA = nA; cB = nB; ++ui;
        if constexpr (ALIGN_EPI) { if (wr == 1) PG8_BAR; }
    }
    PG8_WAIT_V(0);
    if constexpr (!ALIGN_EPI) { if (wr == 0) PG8_BAR; }
    PG8_BAR;
    if constexpr (Epi::AFTER_DRAIN) { E.fused(acc, cur, wr, wc, fr, fq, lds, wid, lane); S.done(cur); }
#undef PG8_SA
#undef PG8_SB
#undef PG8_STAGE
#undef PG8_LDA
#undef PG8_LDB
#undef PG8_MMA
#undef PG8_WAIT_V
#undef PG8_WAIT_L
#undef PG8_BAR
#undef PG8_SCHED
}
}
#ifndef PROBE_SEL
#define PROBE_SEL (-1)
#endif
#define PT_NOW() __builtin_amdgcn_s_memrealtime()
#define PT_WORDS_OFF 140304
#define PT_ACC(lds_, dt_) do { if (threadIdx.x == 0) { volatile __attribute__((address_space(3))) unsigned* a_ = (volatile __attribute__((address_space(3))) unsigned*)((lds_) + PT_WORDS_OFF); a_[0] = a_[0] + (unsigned)(dt_); } } while (0)
#define LAS __attribute__((address_space(3)))
typedef unsigned short bf16;
typedef float f32x4 __attribute__((ext_vector_type(4)));
typedef short bf16x8 __attribute__((ext_vector_type(8)));
typedef unsigned u32x4 __attribute__((ext_vector_type(4)));
typedef unsigned u32x2 __attribute__((ext_vector_type(2)));
constexpr int NWAVES = 8, NTHR = 512;
constexpr int BATCH = 8, SEQ = 2048, DM = 1024, M = BATCH * SEQ, DIN = 3840, FFN = 2816, DEPTH = 2;
constexpr int C_HQ = 0, C_HFF = 512, C_HI = 1536, C_HG = 2048, C_NQ = 2560, C_NK = 2816, C_NV = 3072, C_CA = 3328, C_CG = 3584;
constexpr int NSEG = 8, SEGLEN = SEQ / NSEG, CHS = SEGLEN / 32;
constexpr float EPS = 1e-6f;
constexpr size_t MiB = 1u << 20;
constexpr size_t WS_SSQ = 1 * MiB;
constexpr size_t WS_WIN = 2 * MiB, WS_WIN_L = (size_t)DIN * DM * 2;
constexpr size_t WS_WOUT = 17 * MiB, WS_WOUT_L = (size_t)DM * DM * 2;
constexpr size_t WS_WGU = 21 * MiB, WS_WGU_L = (size_t)2 * FFN * DM * 2;
constexpr size_t WS_WDN = 43 * MiB, WS_WDN_L = (size_t)DM * FFN * 2;
constexpr size_t WS_P = 54 * MiB;
constexpr size_t WS_MIX = 174 * MiB;
constexpr size_t WS_XB = 206 * MiB;
constexpr size_t WS_SLOC = 238 * MiB;
constexpr size_t WS_DSEG = 254 * MiB;
constexpr size_t WS_END = 255 * MiB;

__device__ __forceinline__ float bf2f(unsigned short h) { return __builtin_bit_cast(float, (unsigned)h << 16); }
__device__ __forceinline__ float bflo(unsigned w) { return __builtin_bit_cast(float, w << 16); }
__device__ __forceinline__ float bfhi(unsigned w) { return __builtin_bit_cast(float, w & 0xffff0000u); }
typedef float f32x2_t __attribute__((ext_vector_type(2)));
typedef __bf16 bf16x2_t __attribute__((ext_vector_type(2)));
__device__ __forceinline__ unsigned pk2(float lo, float hi) { const f32x2_t v = {lo, hi}; const bf16x2_t b = __builtin_convertvector(v, bf16x2_t); return __builtin_bit_cast(unsigned, b); }
__device__ __forceinline__ unsigned short f2bf(float v) { return (unsigned short)(pk2(v, 0.f) & 0xffffu); }
__device__ __forceinline__ float wave_sum(float v) {
#pragma unroll
    for (int o = 1; o < 64; o <<= 1) v += __shfl_xor(v, o);
    return v;
}
__device__ __forceinline__ float sigm(float x) { return __builtin_amdgcn_rcpf(1.f + __expf(-x)); }
__device__ __forceinline__ float silu_f0(float x) { return x * sigm(x); }
__device__ __forceinline__ f32x4 mfma16(bf16x8 a, bf16x8 b, f32x4 c) { return __builtin_amdgcn_mfma_f32_16x16x32_bf16(a, b, c, 0, 0, 0); }
#define LDS_WAIT() asm volatile("s_waitcnt lgkmcnt(0)" ::: "memory")

struct Params {
    const float *x, *mix_g, *w_in, *hg_lb, *hg_ng, *rpb, *cw, *cb, *lng, *lnb, *w_out, *ffn_g, *w_gu, *w_dn, *fin_g;
    float* out; unsigned char* ws;
};

__device__ __forceinline__ void transpose_item(const float* W, int K, int N, bf16* WT, const float* gk, bool gu, LAS float* scr, int item, int lane) {
    const int nblk = N / 64, kb = item / nblk, nb = item % nblk, k0 = 64 * kb, n0 = 64 * nb;
    const float gs = gk ? gk[k0 + lane] : 1.f;
    const float* src = W + (size_t)k0 * N + n0 + lane;
#pragma unroll
    for (int hh = 0; hh < 2; ++hh) {
        float wv[32];
#pragma unroll
        for (int i = 0; i < 32; ++i) wv[i] = src[(size_t)(32 * hh + i) * N];
        __builtin_amdgcn_sched_barrier(0);
#pragma unroll
        for (int i = 0; i < 32; ++i) scr[(32 * hh + i) * 65 + lane] = wv[i] * __shfl(gs, 32 * hh + i);
    }
    LDS_WAIT(); asm volatile("" ::: "memory");
    const int c = lane & 7;
    int r0 = n0;
    if (gu) { const int up = n0 >= FFN ? 1 : 0, cc = n0 - up * FFN; r0 = 256 * (cc >> 7) + (cc & 127) + up * 128; }
#pragma unroll
    for (int j = 0; j < 8; ++j) { const int n = (lane >> 3) + 8 * j; const LAS float* s = scr + (8 * c) * 65 + n;
        u32x4 o; o.x = pk2(s[0 * 65], s[1 * 65]); o.y = pk2(s[2 * 65], s[3 * 65]); o.z = pk2(s[4 * 65], s[5 * 65]); o.w = pk2(s[6 * 65], s[7 * 65]);
        *(u32x4*)(WT + (size_t)(r0 + n) * K + k0 + 8 * c) = o; }
    LDS_WAIT(); asm volatile("" ::: "memory");
}
__device__ __forceinline__ void prologue(const Params& p, LAS unsigned char* lds, int gw, int NGW, int wave, int lane) {
    LAS float* scr = (LAS float*)(lds + wave * 16640);
    constexpr int I_IN = (DM / 64) * (DIN / 64), I_OUT = (DM / 64) * (DM / 64), I_GU = (DM / 64) * (2 * FFN / 64), I_DN = (FFN / 64) * (DM / 64), I_L = I_IN + I_OUT + I_GU + I_DN;
    for (int it = gw; it < DEPTH * I_L; it += NGW) {
        const int l = it / I_L; int r = it % I_L;
        if (r < I_IN) { transpose_item(p.w_in + (size_t)l * DM * DIN, DM, DIN, (bf16*)(p.ws + WS_WIN + l * WS_WIN_L), p.mix_g + l * DM, false, scr, r, lane); continue; } r -= I_IN;
        if (r < I_OUT) { transpose_item(p.w_out + (size_t)l * DM * DM, DM, DM, (bf16*)(p.ws + WS_WOUT + l * WS_WOUT_L), nullptr, false, scr, r, lane); continue; } r -= I_OUT;
        if (r < I_GU) { transpose_item(p.w_gu + (size_t)l * DM * 2 * FFN, DM, 2 * FFN, (bf16*)(p.ws + WS_WGU + l * WS_WGU_L), p.ffn_g + l * DM, true, scr, r, lane); continue; } r -= I_GU;
        transpose_item(p.w_dn + (size_t)l * FFN * DM, FFN, DM, (bf16*)(p.ws + WS_WDN + l * WS_WDN_L), nullptr, false, scr, r, lane);
    }
    bf16* XB = (bf16*)(p.ws + WS_XB); float* ssq = (float*)(p.ws + WS_SSQ);
    for (int m = gw; m < M; m += 2 * NGW) {
        const int m2 = m + NGW;
        const f32x4* xa = (const f32x4*)(p.x + (size_t)m * DM) + lane; const f32x4* xc = (const f32x4*)(p.x + (size_t)(m2 < M ? m2 : m) * DM) + lane;
        f32x4 va[4], vc[4];
#pragma unroll
        for (int j = 0; j < 4; ++j) { va[j] = xa[64 * j]; vc[j] = xc[64 * j]; }
        __builtin_amdgcn_sched_barrier(0);
        float sa = 0.f, sc = 0.f;
        unsigned long long* oa = (unsigned long long*)(XB + (size_t)m * DM) + lane; unsigned long long* oc = (unsigned long long*)(XB + (size_t)m2 * DM) + lane;
#pragma unroll
        for (int j = 0; j < 4; ++j) { sa += (va[j].x * va[j].x + va[j].y * va[j].y) + (va[j].z * va[j].z + va[j].w * va[j].w); sc += (vc[j].x * vc[j].x + vc[j].y * vc[j].y) + (vc[j].z * vc[j].z + vc[j].w * vc[j].w);
            oa[64 * j] = (unsigned long long)pk2(va[j].x, va[j].y) | ((unsigned long long)pk2(va[j].z, va[j].w) << 32);
            if (m2 < M) oc[64 * j] = (unsigned long long)pk2(vc[j].x, vc[j].y) | ((unsigned long long)pk2(vc[j].z, vc[j].w) << 32); }
        sa = wave_sum(sa); sc = wave_sum(sc);
        if (lane < 16) { ssq[(size_t)lane * M + m] = lane == 0 ? sa : 0.f; if (m2 < M) ssq[(size_t)lane * M + m2] = lane == 0 ? sc : 0.f; }
    }
}

constexpr int HS_SET = 37888, HQ_OFF = 0, HK_OFF = 8704, HKH_OFF = 17408, HV_OFF = 27648;
constexpr int HOS_OFF = 2 * HS_SET, HOS_SZ = 16896, HDEC_OFF = HOS_OFF + 2 * HOS_SZ;
#define WG_BAR() asm volatile("s_waitcnt lgkmcnt(0)\n\ts_barrier" ::: "memory")
template <bool FULL, bool SECOND>
__device__ __forceinline__ void hg_segment(LAS unsigned char* lds, const bf16* P, int b, int h, int dir, int seg, float lb, f32x4 (&S)[8], float& bsum,
                                           float* OP, bf16* MIXED, const float* norm_g) {
    int tid_ = threadIdx.x; asm volatile("" : "+v"(tid_)); const int tid = tid_, w = __builtin_amdgcn_readfirstlane(tid >> 6), lane = tid & 63, fr = lane & 15, fq = lane >> 4;
    unsigned long long tk0 = 0;
    const int d = 16 * w + (lane & 15), grp = lane >> 4;
    const int zcol = C_HFF + dir * 512 + h * 128 + d, qcol = C_HQ + h * 128 + d, vcol = C_HI + h * 128 + d;
    const float oml = 1.f - lb;
    const int ts = dir == 0 ? 1 : -1, tb0 = dir == 0 ? seg * SEGLEN : (seg * SEGLEN + SEGLEN - 1);
    const long rstep = (long)ts * DIN;
    const int fc = tid >> 4, dvg = tid & 15;
    f32x4 ng0 = (f32x4){0.f, 0.f, 0.f, 0.f}, ng1 = ng0;
    if (FULL && SECOND) { ng0 = *(const f32x4*)(norm_g + 8 * dvg); ng1 = *(const f32x4*)(norm_g + 8 * dvg + 4); }
    unsigned short zn[8], qn[8], vn[8];
#define HG_LOAD(n_) do { const bf16* rowp_ = P + (size_t)(b * SEQ + tb0 + ts * (32 * (n_) + 8 * grp)) * DIN; \
        _Pragma("unroll") for (int e = 0; e < 8; ++e) { const bf16* r_ = rowp_ + rstep * e; zn[e] = r_[zcol]; if (FULL) qn[e] = r_[qcol]; else qn[e] = 0; vn[e] = r_[vcol]; } } while (0)
#define HG_PREP(s_) do { LAS unsigned char* set_ = lds + (s_) * HS_SET; LAS bf16* QT_ = (LAS bf16*)(set_ + HQ_OFF); LAS bf16* KT_ = (LAS bf16*)(set_ + HK_OFF); \
        f32x2_t Ev[4], kvv[4]; float run = 1.f;                                     \
        _Pragma("unroll") for (int e2 = 0; e2 < 4; ++e2) { \
            f32x2_t z = {__builtin_amdgcn_fmed3f(bf2f(zn[2 * e2]), -40.f, 40.f), __builtin_amdgcn_fmed3f(bf2f(zn[2 * e2 + 1]), -40.f, 40.f)}; \
            const f32x2_t t = z * (-1.4426950408889634f); const f32x2_t den = (f32x2_t){__builtin_amdgcn_exp2f(t.x), __builtin_amdgcn_exp2f(t.y)} + 1.0f; \
            const f32x2_t inv = {__builtin_amdgcn_rcpf(den.x), __builtin_amdgcn_rcpf(den.y)};              \
            const f32x2_t fv = inv * oml + lb; kvv[e2] = inv * (-oml) + oml;                                  \
            run *= fv.x; Ev[e2].x = run; run *= fv.y; Ev[e2].y = run; } \
        float pre = 1.f, tot = 1.f; \
        _Pragma("unroll") for (int g2 = 0; g2 < 4; ++g2) { const float t = __shfl(run, (g2 << 4) | (lane & 15)); tot *= t; if (g2 < grp) pre *= t; } \
        unsigned khp[4], vvp[4]; \
        _Pragma("unroll") for (int e2 = 0; e2 < 4; ++e2) { const f32x2_t E = Ev[e2] * pre; const f32x2_t r = {__builtin_amdgcn_rcpf(E.x), __builtin_amdgcn_rcpf(E.y)}; const f32x2_t kt = kvv[e2] * r; \
            if (FULL) { const int c0 = 8 * grp + 2 * e2; const f32x2_t qs = (f32x2_t){bf2f(qn[2 * e2]), bf2f(qn[2 * e2 + 1])} * E; const unsigned qw = pk2(qs.x, qs.y), kw = pk2(kt.x, kt.y); \
                QT_[c0 * 136 + d] = (bf16)(qw & 0xffffu); QT_[(c0 + 1) * 136 + d] = (bf16)(qw >> 16); KT_[c0 * 136 + d] = (bf16)(kw & 0xffffu); KT_[(c0 + 1) * 136 + d] = (bf16)(kw >> 16); } \
            const f32x2_t kh = kt * tot; khp[e2] = pk2(kh.x, kh.y); vvp[e2] = (unsigned)vn[2 * e2] | ((unsigned)vn[2 * e2 + 1] << 16); } \
        *(LAS u32x4*)((LAS bf16*)(set_ + HKH_OFF) + d * 40 + 8 * grp) = (u32x4){khp[0], khp[1], khp[2], khp[3]}; \
        *(LAS u32x4*)((LAS bf16*)(set_ + HV_OFF) + d * 40 + 8 * grp) = (u32x4){vvp[0], vvp[1], vvp[2], vvp[3]}; \
        if (grp == 0) { ((LAS float*)(lds + HDEC_OFF))[(s_) * 128 + d] = tot; bsum *= tot; } } while (0)
    HG_LOAD(0);
    __builtin_amdgcn_sched_barrier(0);
    HG_PREP(0);
    __builtin_amdgcn_sched_barrier(0);
    if (CHS > 1) HG_LOAD(1);
    WG_BAR();
#pragma unroll 1
    for (int n = 0; n < CHS; ++n) {
        const int tb = tb0 + ts * 32 * n, cs = n & 1;
        const int ftok = tb + ts * fc;
        f32x4 op0 = (f32x4){0.f, 0.f, 0.f, 0.f}, op1 = op0; u32x4 gw4 = (u32x4){0u, 0u, 0u, 0u};
        float* op = OP + ((size_t)((b * 4 + h) * SEQ + ftok)) * 128 + 8 * dvg;
        if (FULL && SECOND) { op0 = *(const f32x4*)op; op1 = *(const f32x4*)(op + 4); gw4 = *(const u32x4*)(P + (size_t)(b * SEQ + ftok) * DIN + C_HG + h * 128 + 8 * dvg); }
        __builtin_amdgcn_sched_barrier(0);
#pragma unroll 1
        for (int ph = 0; ph < 2; ++ph) {
        if ((ph == 0) == (w < 4)) { if (PROBE_SEL == 13) tk0 = PT_NOW(); if (n + 1 < CHS) { HG_PREP(cs ^ 1); __builtin_amdgcn_sched_barrier(0); if (n + 2 < CHS) HG_LOAD(n + 2); } if (PROBE_SEL == 13) PT_ACC(lds, PT_NOW() - tk0); }
        else {
        if (PROBE_SEL == 14) tk0 = PT_NOW();
        LAS unsigned char* set = lds + cs * HS_SET;
        LAS bf16* QT = (LAS bf16*)(set + HQ_OFF); LAS bf16* KT = (LAS bf16*)(set + HK_OFF); LAS bf16* KHT = (LAS bf16*)(set + HKH_OFF); LAS bf16* VT = (LAS bf16*)(set + HV_OFF);
        LAS float* OS = (LAS float*)(lds + HOS_OFF + cs * HOS_SZ); LAS float* DEC = (LAS float*)(lds + HDEC_OFF) + cs * 128;
        if (FULL) {
            f32x4 p00 = (f32x4){0.f, 0.f, 0.f, 0.f}, p01 = p00, p11 = p00;
#pragma unroll
            for (int ks = 0; ks < 4; ++ks) {
                const bf16x8 k0 = *(const LAS bf16x8*)(KT + fr * 136 + 32 * ks + 8 * fq), k1 = *(const LAS bf16x8*)(KT + (16 + fr) * 136 + 32 * ks + 8 * fq);
                const bf16x8 q0 = *(const LAS bf16x8*)(QT + fr * 136 + 32 * ks + 8 * fq), q1 = *(const LAS bf16x8*)(QT + (16 + fr) * 136 + 32 * ks + 8 * fq);
                p00 = mfma16(k0, q0, p00); p01 = mfma16(k0, q1, p01); p11 = mfma16(k1, q1, p11); }
#pragma unroll
            for (int i = 0; i < 4; ++i) { const bool keep = 4 * fq + i <= fr; p00[i] = keep ? p00[i] : 0.f; p11[i] = keep ? p11[i] : 0.f; }
            const bf16x8 pf0 = __builtin_bit_cast(bf16x8, (u32x4){pk2(p00[0], p00[1]), pk2(p00[2], p00[3]), 0u, 0u});
            const bf16x8 pf1 = __builtin_bit_cast(bf16x8, (u32x4){pk2(p01[0], p01[1]), pk2(p01[2], p01[3]), pk2(p11[0], p11[1]), pk2(p11[2], p11[3])});
            f32x4 o0 = (f32x4){0.f, 0.f, 0.f, 0.f}, o1 = o0;
#pragma unroll
            for (int ks = 0; ks < 4; ++ks) {
                const bf16x8 sa = __builtin_bit_cast(bf16x8, (u32x4){pk2(S[2 * ks][0], S[2 * ks][1]), pk2(S[2 * ks][2], S[2 * ks][3]), pk2(S[2 * ks + 1][0], S[2 * ks + 1][1]), pk2(S[2 * ks + 1][2], S[2 * ks + 1][3])});
                const u32x2 a0 = *(const LAS u32x2*)(QT + fr * 136 + 32 * ks + 4 * fq), a1 = *(const LAS u32x2*)(QT + fr * 136 + 32 * ks + 16 + 4 * fq);
                const u32x2 c0 = *(const LAS u32x2*)(QT + (16 + fr) * 136 + 32 * ks + 4 * fq), c1 = *(const LAS u32x2*)(QT + (16 + fr) * 136 + 32 * ks + 16 + 4 * fq);
                o0 = mfma16(sa, __builtin_bit_cast(bf16x8, (u32x4){a0.x, a0.y, a1.x, a1.y}), o0);
                o1 = mfma16(sa, __builtin_bit_cast(bf16x8, (u32x4){c0.x, c0.y, c1.x, c1.y}), o1); }
            { const u32x2 v0 = *(const LAS u32x2*)(VT + (16 * w + fr) * 40 + 4 * fq), v1 = *(const LAS u32x2*)(VT + (16 * w + fr) * 40 + 16 + 4 * fq);
              const bf16x8 va = __builtin_bit_cast(bf16x8, (u32x4){v0.x, v0.y, v1.x, v1.y});
              o0 = mfma16(va, pf0, o0); o1 = mfma16(va, pf1, o1); }
            *(LAS f32x4*)(OS + fr * 132 + 16 * w + 4 * fq) = o0; *(LAS f32x4*)(OS + (16 + fr) * 132 + 16 * w + 4 * fq) = o1;
        }
        { const bf16x8 vfr = *(const LAS bf16x8*)(VT + (16 * w + fr) * 40 + 8 * fq);
#pragma unroll
          for (int i = 0; i < 8; ++i) { const f32x4 dv4 = *(const LAS f32x4*)(DEC + 16 * i + 4 * fq); S[i] = S[i] * dv4;
              S[i] = mfma16(*(const LAS bf16x8*)(KHT + (16 * i + fr) * 40 + 8 * fq), vfr, S[i]); } }
        if (PROBE_SEL == 14) PT_ACC(lds, PT_NOW() - tk0);
        } }
        if (PROBE_SEL == 15) tk0 = PT_NOW();
        WG_BAR();
        if (PROBE_SEL == 15) PT_ACC(lds, PT_NOW() - tk0);
        if (FULL) {
            LAS float* OS = (LAS float*)(lds + HOS_OFF + cs * HOS_SZ);
            f32x4 o0 = *(const LAS f32x4*)(OS + fc * 132 + 8 * dvg), o1 = *(const LAS f32x4*)(OS + fc * 132 + 8 * dvg + 4);
            if (!SECOND) { *(f32x4*)op = o0; *(f32x4*)(op + 4) = o1; }
            else { o0 = o0 + op0; o1 = o1 + op1;
                float sq = (o0[0] * o0[0] + o0[1] * o0[1]) + (o0[2] * o0[2] + o0[3] * o0[3]) + (o1[0] * o1[0] + o1[1] * o1[1]) + (o1[2] * o1[2] + o1[3] * o1[3]);
                sq += __shfl_xor(sq, 1); sq += __shfl_xor(sq, 2); sq += __shfl_xor(sq, 4); sq += __shfl_xor(sq, 8);
                const float rs = __builtin_amdgcn_rsqf(sq * (1.f / 128.f) + EPS);
                u32x4 ow; ow.x = pk2(o0[0] * rs * ng0[0] * bflo(gw4.x), o0[1] * rs * ng0[1] * bfhi(gw4.x));
                ow.y = pk2(o0[2] * rs * ng0[2] * bflo(gw4.y), o0[3] * rs * ng0[3] * bfhi(gw4.y));
                ow.z = pk2(o1[0] * rs * ng1[0] * bflo(gw4.z), o1[1] * rs * ng1[1] * bfhi(gw4.z));
                ow.w = pk2(o1[2] * rs * ng1[2] * bflo(gw4.w), o1[3] * rs * ng1[3] * bfhi(gw4.w));
                *(u32x4*)(MIXED + (size_t)(b * SEQ + ftok) * DM + h * 128 + 8 * dvg) = ow; }
        }
    }
    WG_BAR();
#undef HG_LOAD
#undef HG_PREP
}
__device__ __forceinline__ float hg_lb(const float* hg_lb_all, int layer, int dir, int ch) {
    if (layer == 0) return 0.f;
    const float a0 = hg_lb_all[(0 * 2 + dir) * 512 + ch], a1 = hg_lb_all[(1 * 2 + dir) * 512 + ch], mx = fmaxf(a0, a1), e0 = __expf(a0 - mx), e1 = __expf(a1 - mx);
    return e1 / (e0 + e1);
}
__device__ __forceinline__ void hg_passA_item(LAS unsigned char* lds, const Params& p, int layer, int item) {
    const int dir = item & 1, seg = (item >> 1) & (NSEG - 1), h = (item >> 4) & 3, b = item >> 6;
    if ((dir == 0 && seg == NSEG - 1) || (dir == 1 && seg == 0)) return;
    int tid_ = threadIdx.x; asm volatile("" : "+v"(tid_)); const int tid = tid_, w = __builtin_amdgcn_readfirstlane(tid >> 6), lane = tid & 63;
    const float lb = hg_lb(p.hg_lb, layer, dir, h * 128 + 16 * w + (lane & 15));
    f32x4 S[8];
#pragma unroll
    for (int i = 0; i < 8; ++i) S[i] = (f32x4){0.f, 0.f, 0.f, 0.f};
    float bsum = 1.f;
    hg_segment<false, false>(lds, (const bf16*)(p.ws + WS_P), b, h, dir, seg, lb, S, bsum, nullptr, nullptr, nullptr);
    u32x2* sl = (u32x2*)(p.ws + WS_SLOC) + (size_t)item * 4096;
#pragma unroll
    for (int i = 0; i < 8; ++i) sl[(w * 8 + i) * 64 + lane] = (u32x2){pk2(S[i][0], S[i][1]), pk2(S[i][2], S[i][3])};
    if (lane < 16) ((float*)(p.ws + WS_DSEG))[(size_t)item * 128 + 16 * w + (lane & 15)] = bsum;
    __syncthreads();
}
__device__ __forceinline__ unsigned long long hg_passB_item(LAS unsigned char* lds, const Params& p, int layer, int item) {
    unsigned long long tsub = 0, t0_ = 0;
    const int seg = item & (NSEG - 1), h = (item >> 3) & 3, b = item >> 5;
    int tid_ = threadIdx.x; asm volatile("" : "+v"(tid_)); const int tid = tid_, w = __builtin_amdgcn_readfirstlane(tid >> 6), lane = tid & 63, fr = lane & 15, fq = lane >> 4;
    const u32x2* slb = (const u32x2*)(p.ws + WS_SLOC); const float* dsg = (const float*)(p.ws + WS_DSEG);
    float* OP = p.out;   bf16* MIXED = (bf16*)(p.ws + WS_MIX); const bf16* P = (const bf16*)(p.ws + WS_P);
#pragma unroll 1
    for (int dir = 0; dir < 2; ++dir) {
        const float lb = hg_lb(p.hg_lb, layer, dir, h * 128 + 16 * w + (lane & 15));
        f32x4 S[8];
#pragma unroll
        for (int i = 0; i < 8; ++i) S[i] = (f32x4){0.f, 0.f, 0.f, 0.f};
        const int nprev = dir == 0 ? seg : (NSEG - 1 - seg);
        if (PROBE_SEL == 11) t0_ = PT_NOW();
#pragma unroll 1
        for (int q = 0; q < nprev; q += 2) {
            const bool two = q + 1 < nprev; const int sA = dir == 0 ? q : (NSEG - 1 - q), sB = two ? (dir == 0 ? q + 1 : (NSEG - 2 - q)) : sA;
            const int itA = ((b * 4 + h) * NSEG + sA) * 2 + dir, itB = ((b * 4 + h) * NSEG + sB) * 2 + dir;
            const u32x2* slA = slb + (size_t)itA * 4096; const float* dcA = dsg + (size_t)itA * 128; const u32x2* slB = slb + (size_t)itB * 4096; const float* dcB = dsg + (size_t)itB * 128;
            f32x4 dvA[8], dvB[8]; u32x2 svA[8], svB[8];
#pragma unroll
            for (int i = 0; i < 8; ++i) { dvA[i] = *(const f32x4*)(dcA + 16 * i + 4 * fq); svA[i] = slA[(w * 8 + i) * 64 + lane]; dvB[i] = *(const f32x4*)(dcB + 16 * i + 4 * fq); svB[i] = slB[(w * 8 + i) * 64 + lane]; }
            __builtin_amdgcn_sched_barrier(0);
#pragma unroll
            for (int i = 0; i < 8; ++i) { S[i] = S[i] * dvA[i] + (f32x4){bflo(svA[i].x), bfhi(svA[i].x), bflo(svA[i].y), bfhi(svA[i].y)};
                if (two) S[i] = S[i] * dvB[i] + (f32x4){bflo(svB[i].x), bfhi(svB[i].x), bflo(svB[i].y), bfhi(svB[i].y)}; } }
        if (PROBE_SEL == 11) PT_ACC(lds, PT_NOW() - t0_);
        if (PROBE_SEL == 10) t0_ = PT_NOW();
        float bsum = 1.f;
        if (dir == 0) hg_segment<true, false>(lds, P, b, h, 0, seg, lb, S, bsum, OP, MIXED, p.hg_ng + layer * 128);
        else hg_segment<true, true>(lds, P, b, h, 1, seg, lb, S, bsum, OP, MIXED, p.hg_ng + layer * 128);
        if (PROBE_SEL == 10) PT_ACC(lds, PT_NOW() - t0_);
        if (PROBE_SEL == 12) t0_ = PT_NOW();
        __syncthreads();
        if (PROBE_SEL == 12) PT_ACC(lds, PT_NOW() - t0_);
    }
    return tsub;
}

constexpr int NA_KS = 584, NA_RPB_OFF = 64 * NA_KS * 2;
__device__ __forceinline__ int clampi(int v, int lo, int hi) { return v < lo ? lo : (v > hi ? hi : v); }
__device__ __forceinline__ void na_item(LAS unsigned char* lds, const Params& p, int layer, int item) {
    const int rp = item & 15, h = (item >> 4) & 3, b = item >> 6, r0 = 2 * rp, kbase = clampi(r0 - 4, 0, 24);
    int tid_ = threadIdx.x; asm volatile("" : "+v"(tid_)); const int tid = tid_, w = __builtin_amdgcn_readfirstlane(tid >> 6), lane = tid & 63, fr = lane & 15, fq = lane >> 4;
    const bf16* P = (const bf16*)(p.ws + WS_P); bf16* MIXED = (bf16*)(p.ws + WS_MIX);
    LAS bf16* VT = (LAS bf16*)lds; LAS float* RPB = (LAS float*)(lds + NA_RPB_OFF);
    const int rl = w >> 2, j = w & 3, r = r0 + rl, kr0 = clampi(r - 4, 0, 24), kc0 = clampi(16 * j - 8, 0, 32);
    const size_t qtok = (size_t)b * SEQ + r * 64 + 16 * j + fr;
    u32x4 vbuf[9];
#pragma unroll
    for (int it = 0; it < 9; ++it) { const int key = it * 64 + lane, dg = w; int trow = kbase * 64 + key; trow = trow > SEQ - 1 ? SEQ - 1 : trow;
        vbuf[it] = *(const u32x4*)(P + (size_t)(b * SEQ + trow) * DIN + C_NV + h * 64 + 8 * dg); }
    bf16x8 qf[2], kfa[16], kfb[16];
#pragma unroll
    for (int ks = 0; ks < 2; ++ks) qf[ks] = *(const bf16x8*)(P + qtok * DIN + C_NQ + h * 64 + 32 * ks + 8 * fq);
#define NA_KLOAD(dst, hh) do { _Pragma("unroll") for (int k8 = 0; k8 < 8; ++k8) { const int kt = (hh) * 8 + k8, krl = kt >> 1, half = kt & 1; \
        const size_t ktok = (size_t)b * SEQ + (kr0 + krl) * 64 + kc0 + 16 * half + fr; \
        _Pragma("unroll") for (int ks = 0; ks < 2; ++ks) dst[k8 * 2 + ks] = *(const bf16x8*)(P + ktok * DIN + C_NK + h * 64 + 32 * ks + 8 * fq); } } while (0)
    NA_KLOAD(kfa, 0);
    __builtin_amdgcn_sched_barrier(0);
#pragma unroll
    for (int it = 0; it < 9; ++it) { const int key = it * 64 + lane, dg = w; const u32x4 v = vbuf[it];
        LAS bf16* dst = VT + (8 * dg) * NA_KS + key;
        dst[0 * NA_KS] = (bf16)(v.x & 0xffffu); dst[1 * NA_KS] = (bf16)(v.x >> 16); dst[2 * NA_KS] = (bf16)(v.y & 0xffffu); dst[3 * NA_KS] = (bf16)(v.y >> 16);
        dst[4 * NA_KS] = (bf16)(v.z & 0xffffu); dst[5 * NA_KS] = (bf16)(v.z >> 16); dst[6 * NA_KS] = (bf16)(v.w & 0xffffu); dst[7 * NA_KS] = (bf16)(v.w >> 16); }
    for (int i = tid; i < 465; i += NTHR) RPB[i] = p.rpb[(size_t)(layer * 4 + h) * 465 + i];
    NA_KLOAD(kfb, 1);
    __builtin_amdgcn_sched_barrier(0);
    WG_BAR();
    f32x4 s[16];
#pragma unroll
    for (int k8 = 0; k8 < 8; ++k8) { f32x4 a = (f32x4){0.f, 0.f, 0.f, 0.f};
#pragma unroll
        for (int ks = 0; ks < 2; ++ks) a = mfma16(kfa[k8 * 2 + ks], qf[ks], a);
        s[k8] = a; }
#pragma unroll
    for (int k8 = 0; k8 < 8; ++k8) { f32x4 a = (f32x4){0.f, 0.f, 0.f, 0.f};
#pragma unroll
        for (int ks = 0; ks < 2; ++ks) a = mfma16(kfb[k8 * 2 + ks], qf[ks], a);
        s[8 + k8] = a; }
#undef NA_KLOAD
    const int qc = 16 * j + fr, qs = clampi(qc - 8, 0, 48);
    float mx = -1e30f;
#pragma unroll
    for (int kt = 0; kt < 16; ++kt) { const int krl = kt >> 1, half = kt & 1; const int ridx = kr0 + krl - r + 7;
        float bz[4];
#pragma unroll
        for (int i = 0; i < 4; ++i) { const int kc = kc0 + 16 * half + 4 * fq + i; bz[i] = RPB[ridx * 31 + clampi(kc - qc + 15, 0, 30)]; }
#pragma unroll
        for (int i = 0; i < 4; ++i) { const int kc = kc0 + 16 * half + 4 * fq + i; const bool valid = kc >= qs && kc < qs + 16;
            const float v = valid ? s[kt][i] * 0.125f + bz[i] : -1e30f; s[kt][i] = v; mx = fmaxf(mx, v); } }
    mx = fmaxf(mx, __shfl_xor(mx, 16)); mx = fmaxf(mx, __shfl_xor(mx, 32));
    float sum = 0.f;
#pragma unroll
    for (int kt = 0; kt < 16; ++kt)
#pragma unroll
        for (int i = 0; i < 4; ++i) { const float e = __expf(s[kt][i] - mx); s[kt][i] = e; sum += e; }
    sum += __shfl_xor(sum, 16); sum += __shfl_xor(sum, 32);
    f32x4 o[4];
#pragma unroll
    for (int dt = 0; dt < 4; ++dt) o[dt] = (f32x4){0.f, 0.f, 0.f, 0.f};
#pragma unroll
    for (int kk = 0; kk < 8; ++kk) {
        const u32x4 pw = (u32x4){pk2(s[2 * kk][0], s[2 * kk][1]), pk2(s[2 * kk][2], s[2 * kk][3]), pk2(s[2 * kk + 1][0], s[2 * kk + 1][1]), pk2(s[2 * kk + 1][2], s[2 * kk + 1][3])};
        const bf16x8 pf = __builtin_bit_cast(bf16x8, pw);
        const int keyoff = (kr0 + kk - kbase) * 64 + kc0 + 4 * fq;
#pragma unroll
        for (int dt = 0; dt < 4; ++dt) { const u32x2 lo = *(const LAS u32x2*)(VT + (16 * dt + fr) * NA_KS + keyoff), hi = *(const LAS u32x2*)(VT + (16 * dt + fr) * NA_KS + keyoff + 16);
            const bf16x8 vf = __builtin_bit_cast(bf16x8, (u32x4){lo.x, lo.y, hi.x, hi.y});
            o[dt] = mfma16(vf, pf, o[dt]); } }
    const float inv = 1.f / sum;
#pragma unroll
    for (int dt = 0; dt < 4; ++dt) *(u32x2*)(MIXED + qtok * DM + 512 + h * 64 + 16 * dt + 4 * fq) = (u32x2){pk2(o[dt][0] * inv, o[dt][1] * inv), pk2(o[dt][2] * inv, o[dt][3] * inv)};
    WG_BAR();
}

__device__ __forceinline__ void conv_item(LAS unsigned char* lds, const Params& p, int layer, int item) {
    const int b = item >> 6, t0 = (item & 63) * 32;
    int tid_ = threadIdx.x; asm volatile("" : "+v"(tid_)); const int tid = tid_, w = __builtin_amdgcn_readfirstlane(tid >> 6), lane = tid & 63;
    const bf16* P = (const bf16*)(p.ws + WS_P); bf16* MIXED = (bf16*)(p.ws + WS_MIX);
    LAS float* U = (LAS float*)lds; LAS float* CO = U + 62 * 256;
    u32x4 ca4[4], cg4[4];
#pragma unroll
    for (int it = 0; it < 4; ++it) { const int u = it * NTHR + tid, tt = u >> 5, c8 = u & 31, t = t0 - 15 + tt; ca4[it] = (u32x4){0u, 0u, 0u, 0u}; cg4[it] = ca4[it];
        if (u < 62 * 32 && t >= 0 && t < SEQ) { const bf16* rp = P + (size_t)(b * SEQ + t) * DIN; ca4[it] = *(const u32x4*)(rp + C_CA + 8 * c8); cg4[it] = *(const u32x4*)(rp + C_CG + 8 * c8); } }
    const int c = tid & 255, half = tid >> 8;
    float wk[31];
#pragma unroll
    for (int k = 0; k < 31; ++k) wk[k] = p.cw[(size_t)(layer * 31 + k) * 256 + c];
    const float bias = p.cb[layer * 256 + c];
    __builtin_amdgcn_sched_barrier(0);
#pragma unroll
    for (int it = 0; it < 4; ++it) { const int u = it * NTHR + tid, tt = u >> 5, c8 = u & 31; const u32x4 a = ca4[it], g = cg4[it];
        if (u < 62 * 32) {
            const f32x4 u0 = (f32x4){bflo(a.x) * sigm(bflo(g.x)), bfhi(a.x) * sigm(bfhi(g.x)), bflo(a.y) * sigm(bflo(g.y)), bfhi(a.y) * sigm(bfhi(g.y))};
            const f32x4 u1 = (f32x4){bflo(a.z) * sigm(bflo(g.z)), bfhi(a.z) * sigm(bfhi(g.z)), bflo(a.w) * sigm(bflo(g.w)), bfhi(a.w) * sigm(bfhi(g.w))};
            *(LAS f32x4*)(U + tt * 256 + 8 * c8) = u0; *(LAS f32x4*)(U + tt * 256 + 8 * c8 + 4) = u1; } }
    WG_BAR();
#pragma unroll 1
    for (int g = 0; g < 2; ++g) { const int base = 16 * half + 8 * g; float win[38];
#pragma unroll
        for (int i = 0; i < 38; ++i) win[i] = U[(base + i) * 256 + c];
#pragma unroll
        for (int o = 0; o < 8; ++o) { float a = bias;
#pragma unroll
            for (int k = 0; k < 31; ++k) a += wk[k] * win[o + k];
            CO[(base + o) * 256 + c] = a; } }
    __syncthreads();
    const f32x4 lg = *(const f32x4*)(p.lng + layer * 256 + 4 * lane), lbv = *(const f32x4*)(p.lnb + layer * 256 + 4 * lane);
#pragma unroll
    for (int q = 0; q < 4; ++q) { const int tl = 4 * w + q; const f32x4 v = *(const LAS f32x4*)(CO + tl * 256 + 4 * lane);
        const float mean = wave_sum((v.x + v.y) + (v.z + v.w)) * (1.f / 256.f); const f32x4 dd = v - mean;
        const float var = wave_sum((dd.x * dd.x + dd.y * dd.y) + (dd.z * dd.z + dd.w * dd.w)) * (1.f / 256.f); const float rs = __builtin_amdgcn_rsqf(var + EPS);
        f32x4 y = dd * rs * lg + lbv; y = (f32x4){silu_f0(y.x), silu_f0(y.y), silu_f0(y.z), silu_f0(y.w)};
        *(u32x2*)(MIXED + (size_t)(b * SEQ + t0 + tl) * DM + 768 + 4 * lane) = (u32x2){pk2(y.x, y.y), pk2(y.z, y.w)}; }
    __syncthreads();
}

#define XB_TMO      128
#define XB_XCNT(j)  (256  + 64 * (j))
#define XB_XSUB(j)  (1280 + 64 * (j))
#define XB_XGEN(j)  (2304 + 64 * (j))
#define XB_TOP      3328
#define XB_TOPGEN   3392
#define XCD_BAR_WORDS 3456
#define XB_SPIN_CAP (1u << 18)

__device__ __forceinline__ unsigned xb_ld(unsigned* p)              { return __hip_atomic_load(p, __ATOMIC_RELAXED, __HIP_MEMORY_SCOPE_AGENT); }
__device__ __forceinline__ unsigned xb_add(unsigned* p, unsigned v) { return __hip_atomic_fetch_add(p, v, __ATOMIC_RELAXED, __HIP_MEMORY_SCOPE_AGENT); }
__device__ __forceinline__ unsigned xb_xcc_id() { return (unsigned)__builtin_amdgcn_s_getreg((3 << 11) | 20) & 0xFu; }
#define XB_SPIN(cond, bar) do { unsigned _sp = 0; while (cond) { __builtin_amdgcn_s_sleep(1); \
    if ((++_sp & 255u) == 0u) { if (xb_ld(&(bar)[XB_TMO])) break; if (_sp > XB_SPIN_CAP) { atomicAdd(&(bar)[XB_TMO], 1u); break; } } } } while (0)

struct XcdBarrier {
    unsigned* bar; unsigned x;
    volatile LAS unsigned* st;
};

__device__ __forceinline__ XcdBarrier xcd_barrier_post(unsigned* bar, volatile LAS unsigned* st) {
    XcdBarrier b; b.bar = bar; b.x = xb_xcc_id(); b.st = st;
    if (threadIdx.x == 0) (void)xb_add(&bar[XB_XCNT(b.x)], 1u);
    return b;
}
__device__ __forceinline__ void xcd_barrier_complete(unsigned* bar, unsigned x, unsigned& nloc, unsigned& nx) {
    const unsigned G = gridDim.x * gridDim.y * gridDim.z;
    unsigned sum, cnt, mine, sp = 0u;
    for (;;) {
        sum = 0u; cnt = 0u; mine = 0u;
#pragma unroll
        for (unsigned j = 0; j < 16; ++j) { const unsigned c = xb_ld(&bar[XB_XCNT(j)]); sum += c; cnt += (c > 0u) ? 1u : 0u; mine = (j == x) ? c : mine; }
        if (sum == G) break;
        __builtin_amdgcn_s_sleep(1);
        if ((++sp & 255u) == 0u) { if (xb_ld(&bar[XB_TMO])) break; if (sp > XB_SPIN_CAP) { atomicAdd(&bar[XB_TMO], 1u); break; } }
    }
    nloc = mine > 0u ? mine : 1u; nx = cnt > 0u ? cnt : 1u;
}

__device__ __forceinline__ void xcd_barrier(const XcdBarrier& b) {
    asm volatile("s_waitcnt vmcnt(0)" ::: "memory");
    __syncthreads();
    if (threadIdx.x == 0) {
        unsigned* bar = b.bar;
        __builtin_amdgcn_s_waitcnt(0);
        unsigned nloc = b.st[0], nx = b.st[1];
        if (nloc == 0u) { xcd_barrier_complete(bar, b.x, nloc, nx); b.st[0] = nloc; b.st[1] = nx; }
        const unsigned old = xb_add(&bar[XB_XSUB(b.x)], 1u);
        const unsigned gen = old / nloc;
        if (old + 1u == (gen + 1u) * nloc) {
            __builtin_amdgcn_fence(__ATOMIC_RELEASE, "agent");
            asm volatile("s_waitcnt vmcnt(0)" ::: "memory");
            const unsigned og = xb_add(&bar[XB_TOP], 1u);
            const unsigned tg = og / nx;
            if (og + 1u == (tg + 1u) * nx) xb_add(&bar[XB_TOPGEN], 1u);
            else XB_SPIN(xb_ld(&bar[XB_TOPGEN]) == tg, bar);
            __builtin_amdgcn_fence(__ATOMIC_ACQUIRE, "agent");
            xb_add(&bar[XB_XGEN(b.x)], 1u);
            asm volatile("s_waitcnt vmcnt(0)" ::: "memory");
        } else {
            XB_SPIN(xb_ld(&bar[XB_XGEN(b.x)]) == gen, bar);
            __builtin_amdgcn_fence(__ATOMIC_ACQUIRE, "agent");
            asm volatile("s_waitcnt vmcnt(0)" ::: "memory");
        }
    }
    __syncthreads();
}

#if 0
#define PROBE_SEL_UNUSED (-1)
#endif
#ifndef REP_HA
#define REP_HA 1
#endif
#ifndef REP_NA
#define REP_NA 1
#endif
#ifndef REP_CV
#define REP_CV 1
#endif
#ifndef REP_F
#define REP_F 1
#endif
#ifndef REP_B
#define REP_B 1
#endif
#define GRID_BAR() do { XcdBarrier xb_; xb_.bar = (unsigned*)(ws + WS_BAR); xb_.x = xb_xcc_id(); xb_.st = (volatile LAS unsigned*)(lds + XB_ST_OFF); xcd_barrier(xb_); } while (0)
#define PHASE_END(kind) do { GRID_BAR(); if (PROBE_SEL >= 0 && PROBE_SEL < 10 && threadIdx.x == 0) { volatile LAS unsigned long long* pv_ = (volatile LAS unsigned long long*)(lds + PT_WORDS_OFF + 8); const unsigned long long t_ = PT_NOW(); if ((kind) == PROBE_SEL || PROBE_SEL == 9) PT_ACC(lds, t_ - pv_[0]); pv_[0] = t_; } } while (0)
constexpr size_t WS_BAR = 4096, WS_CTL_BYTES = 65536;
constexpr int XB_ST_OFF = 140288;
constexpr int RS_OFF = 131072;
constexpr int LDS_BYTES = 147456;
#define KARGS(q_) const Params& q_ = p_unused;
__global__ void __launch_bounds__(NTHR, 2) fwd_megakernel(Params p_unused) {
    extern __shared__ __attribute__((aligned(16))) unsigned char lds_raw[];
    LAS unsigned char* lds = (LAS unsigned char*)lds_raw;
    int tid_ = threadIdx.x; asm volatile("" : "+v"(tid_)); const int tid = tid_, lane = tid & 63, wave = __builtin_amdgcn_readfirstlane(tid >> 6);
    const int G = gridDim.x, bid = blockIdx.x, gw = bid * NWAVES + wave, NGW = G * NWAVES;
    unsigned char* ws; { KARGS(q0); ws = q0.ws; }

    if (tid < 2) ((volatile LAS unsigned*)(lds + XB_ST_OFF))[tid] = 0u;
    __syncthreads();
    if (ws == nullptr) cg::this_grid().sync();
    (void)xcd_barrier_post((unsigned*)(ws + WS_BAR), (volatile LAS unsigned*)(lds + XB_ST_OFF));
    if (PROBE_SEL >= 0 && threadIdx.x == 0) { ((volatile LAS unsigned*)(lds + PT_WORDS_OFF))[0] = 0u; *(volatile LAS unsigned long long*)(lds + PT_WORDS_OFF + 8) = PT_NOW(); }
    { KARGS(q); prologue(q, lds, gw, NGW, wave, lane); }
    PHASE_END(0);
    if (PROBE_SEL == 8) { PHASE_END(9); PHASE_END(8); }
#pragma unroll 1
    for (int l = 0; l < DEPTH; ++l) {
        unsigned char* wsl; { KARGS(ql); wsl = ql.ws; }
        float* ssq = (float*)(wsl + WS_SSQ); bf16* XB = (bf16*)(wsl + WS_XB); bf16* PB = (bf16*)(wsl + WS_P); bf16* MIXED = (bf16*)(wsl + WS_MIX);
        {
            pg8::Gemm g{XB, (const bf16*)(wsl + WS_WIN + l * WS_WIN_L), M, DIN, DM}; pg8::StaticOrder S; S.init(M, DIN, G, bid);
            pg8::rstd_table((LAS float*)(lds + RS_OFF), ssq, S); pg8::EpiScale E{PB, DIN, (LAS float*)(lds + RS_OFF), 0x303u};
            pg8::gemm_phase<pg8::EpiScale, pg8::StaticOrder, true, true>(lds, g, S, E);
        }
        PHASE_END(1);
#pragma unroll 1
        for (int rep = 0; rep < REP_HA; ++rep)
        { KARGS(q); for (int it = bid; it < BATCH * 4 * NSEG * 2; it += G) hg_passA_item(lds, q, l, it); }
#pragma unroll 1
        for (int rep = 0; rep < REP_NA; ++rep)
        { KARGS(q); for (int it = bid; it < BATCH * 4 * 16; it += G) na_item(lds, q, l, it); }
#pragma unroll 1
        for (int rep = 0; rep < REP_CV; ++rep)
        { KARGS(q); for (int it = bid; it < BATCH * 64; it += G) conv_item(lds, q, l, it); }
        PHASE_END(2);
#pragma unroll 1
        for (int rep = 0; rep < REP_B; ++rep)
        { KARGS(q); for (int it = bid; it < BATCH * 4 * NSEG; it += G) (void)hg_passB_item(lds, q, l, it); }
        PHASE_END(3);
        {
            pg8::Gemm g{MIXED, (const bf16*)(wsl + WS_WOUT + l * WS_WOUT_L), M, DM, DM}; pg8::StaticOrder S; S.init(M, DM, G, bid);
            pg8::EpiRes E{XB, ssq};
            pg8::gemm_phase<pg8::EpiRes, pg8::StaticOrder, true, true>(lds, g, S, E);
        }
        PHASE_END(4);
        {
            pg8::Gemm g{XB, (const bf16*)(wsl + WS_WGU + l * WS_WGU_L), M, 2 * FFN, DM}; pg8::StaticOrder S; S.init(M, 2 * FFN, G, bid);
            pg8::rstd_table((LAS float*)(lds + RS_OFF), ssq, S); pg8::EpiSwiGLU E{PB, FFN, (LAS float*)(lds + RS_OFF)};
            pg8::gemm_phase<pg8::EpiSwiGLU, pg8::StaticOrder, true, true>(lds, g, S, E);
        }
        PHASE_END(5);
        {
            pg8::Gemm g{PB, (const bf16*)(wsl + WS_WDN + l * WS_WDN_L), M, DM, FFN}; pg8::StaticOrder S; S.init(M, DM, G, bid);
            pg8::EpiRes E{XB, ssq};
            pg8::gemm_phase<pg8::EpiRes, pg8::StaticOrder, true, true>(lds, g, S, E);
        }
        PHASE_END(6);
    }
    float pdelta = 0.f;
    int tf_ = threadIdx.x; asm volatile("" : "+v"(tf_)); const int lanef = tf_ & 63, gwf = bid * NWAVES + __builtin_amdgcn_readfirstlane(tf_ >> 6);
    KARGS(qf); unsigned char* wsf = qf.ws; const float* ssq = (const float*)(wsf + WS_SSQ); const bf16* XB = (const bf16*)(wsf + WS_XB);
    if (PROBE_SEL >= 0) {
        unsigned* tw = (unsigned*)(wsf + 64);
        if (bid == 0 && threadIdx.x == 0) __hip_atomic_store(tw, ((volatile LAS unsigned*)(lds + PT_WORDS_OFF))[0], __ATOMIC_RELAXED, __HIP_MEMORY_SCOPE_AGENT);
        GRID_BAR();
        pdelta = (float)__hip_atomic_load(tw, __ATOMIC_RELAXED, __HIP_MEMORY_SCOPE_AGENT) * (PROBE_SEL == 9 ? 0.5e-6f : 1e-6f);
    }
#pragma unroll 1
    for (int rep = 0; rep < REP_F; ++rep)
    for (int m = gwf; m < M; m += 2 * NGW) {
        const int m2 = (m + NGW < M) ? m + NGW : m;
        float pa = lanef < 16 ? ssq[(size_t)(lanef & 15) * M + m] : 0.f, pc = lanef < 16 ? ssq[(size_t)(lanef & 15) * M + m2] : 0.f;
        const u32x4* xa = (const u32x4*)(XB + (size_t)m * DM) + lanef; const u32x4* xc = (const u32x4*)(XB + (size_t)m2 * DM) + lanef;
        u32x4 va[2], vc[2]; f32x4 gg[4];
#pragma unroll
        for (int j = 0; j < 2; ++j) { va[j] = xa[64 * j]; vc[j] = xc[64 * j]; gg[2 * j] = *(const f32x4*)(qf.fin_g + 512 * j + 8 * lanef); gg[2 * j + 1] = *(const f32x4*)(qf.fin_g + 512 * j + 8 * lanef + 4); }
        __builtin_amdgcn_sched_barrier(0);
        pa = wave_sum(pa); pc = wave_sum(pc);
        const float ra = __builtin_amdgcn_rsqf(pa * (1.f / DM) + EPS), rc = __builtin_amdgcn_rsqf(pc * (1.f / DM) + EPS);
        const f32x4 pd = (PROBE_SEL >= 0) ? (f32x4){pdelta, -pdelta, pdelta, -pdelta} : (f32x4){0.f, 0.f, 0.f, 0.f};
#pragma unroll
        for (int j = 0; j < 2; ++j) {
            { const u32x4 r = va[j]; float* o = qf.out + (size_t)m * DM + 512 * j + 8 * lanef;
              f32x4 v0 = (f32x4){bflo(r.x), bfhi(r.x), bflo(r.y), bfhi(r.y)} * ra * gg[2 * j], v1 = (f32x4){bflo(r.z), bfhi(r.z), bflo(r.w), bfhi(r.w)} * ra * gg[2 * j + 1];
              if (PROBE_SEL >= 0 && m < 256) { v0 = v0 + pd; v1 = v1 + pd; }
              *(f32x4*)o = v0; *(f32x4*)(o + 4) = v1; }
            if (m2 != m) { const u32x4 r = vc[j]; float* o = qf.out + (size_t)m2 * DM + 512 * j + 8 * lanef;
              f32x4 v0 = (f32x4){bflo(r.x), bfhi(r.x), bflo(r.y), bfhi(r.y)} * rc * gg[2 * j], v1 = (f32x4){bflo(r.z), bfhi(r.z), bflo(r.w), bfhi(r.w)} * rc * gg[2 * j + 1];
              if (PROBE_SEL >= 0 && m2 < 256) { v0 = v0 + pd; v1 = v1 + pd; }
              *(f32x4*)o = v0; *(f32x4*)(o + 4) = v1; } }
    }
}

extern "C" void kernel_launch(void* const* d_in, const int* in_sizes, int n_in, void* d_out, int out_size, void* d_ws, size_t ws_size, hipStream_t stream) {
    static int grid_blocks = 0;
    if (grid_blocks == 0) {
        if (n_in != 15 || out_size != M * DM || ws_size < WS_END) { fprintf(stderr, "kernel_launch: unexpected shapes (n_in %d out %d ws %zu)\n", n_in, out_size, ws_size); grid_blocks = -1; return; }
        int dev = 0, cus = 0, per_cu = 0;
        hipGetDevice(&dev); hipDeviceGetAttribute(&cus, hipDeviceAttributeMultiprocessorCount, dev);
        hipFuncSetAttribute((const void*)fwd_megakernel, hipFuncAttributeMaxDynamicSharedMemorySize, LDS_BYTES);
        hipOccupancyMaxActiveBlocksPerMultiprocessor(&per_cu, (const void*)fwd_megakernel, NTHR, LDS_BYTES);
        if (per_cu < 1) { fprintf(stderr, "kernel_launch: occupancy query says %d blocks per CU\n", per_cu); per_cu = 1; }
        (void)hipGetLastError();
        grid_blocks = cus * 1;
    }
    if (grid_blocks < 0) return;
    Params p{};
    p.x = (const float*)d_in[0]; p.mix_g = (const float*)d_in[1]; p.w_in = (const float*)d_in[2]; p.hg_lb = (const float*)d_in[3]; p.hg_ng = (const float*)d_in[4];
    p.rpb = (const float*)d_in[5]; p.cw = (const float*)d_in[6]; p.cb = (const float*)d_in[7]; p.lng = (const float*)d_in[8]; p.lnb = (const float*)d_in[9];
    p.w_out = (const float*)d_in[10]; p.ffn_g = (const float*)d_in[11]; p.w_gu = (const float*)d_in[12]; p.w_dn = (const float*)d_in[13]; p.fin_g = (const float*)d_in[14];
    p.out = (float*)d_out; p.ws = (unsigned char*)d_ws;
    if (hipMemsetAsync(d_ws, 0, WS_CTL_BYTES, stream) != hipSuccess) { fprintf(stderr, "kernel_launch: hipMemsetAsync failed\n"); return; }
    void* args[] = {&p};
    hipError_t e = hipLaunchCooperativeKernel((const void*)fwd_megakernel, dim3(grid_blocks), dim3(NTHR), args, LDS_BYTES, stream);
    if (e != hipSuccess) fprintf(stderr, "cooperative launch failed: %s (grid %d)\n", hipGetErrorString(e), grid_blocks);
}
```

```cpp
#include <hip/hip_runtime.h>
#include <hip/hip_cooperative_groups.h>
#include <cstdio>
#include <cstdint>
namespace cg = cooperative_groups;

namespace pg8 {
#define PG8_LAS __attribute__((address_space(3)))
typedef unsigned short bf16_t;
typedef short bf16x8 __attribute__((ext_vector_type(8)));
typedef float f32x4 __attribute__((ext_vector_type(4)));
typedef unsigned u32x4 __attribute__((ext_vector_type(4)));
constexpr int BM = 256, BK = 64, HALF = 128, HTB = HALF * BK * 2  , STAGE_BYTES = 8 * HTB, NXCD = 8, WGM = 8;

__host__ __device__ __forceinline__ int lds_byte(int r, int c) { const int st = (r >> 4) * 2 + (c >> 5), rr = r & 15, cc = c & 31, ob = rr * 64 + cc * 2; return st * 1024 + (ob ^ (((ob >> 9) & 1) << 5)); }
__host__ __device__ __forceinline__ void stage_rc(int b, int& R, int& C) { const int st = b / 1024, sb = b % 1024, swz = sb ^ (((sb >> 9) & 1) << 5); R = (st >> 1) * 16 + swz / 64; C = (st & 1) * 32 + (swz % 64) / 2; }
__host__ __device__ __forceinline__ int perm32(int rho) { const int n = rho >> 4, i = rho & 15; return 8 * (i >> 2) + 4 * n + (i & 3); }

struct Unit { int pm, pn; };
struct Gemm { const bf16_t* A; const bf16_t* Bt; int M, N, K; };

struct StaticOrder {
    int nM, nN, nwg, G, c;
    __host__ __device__ void init(int M, int N, int G_, int c_) { nM = M / BM; nN = N / BM; nwg = nM * nN; G = G_; c = c_; }
    __host__ __device__ bool next(int i, Unit& u) const {
        const long L = (long)i * G + c; if (L >= nwg) return false;
        int wgid = (int)L; { const int q = nwg / NXCD, r = nwg % NXCD, xcd = wgid % NXCD, off = wgid / NXCD; wgid = (xcd < r ? xcd * (q + 1) : r * (q + 1) + (xcd - r) * q) + off; }
        const int nig = WGM * nN, gid = wgid / nig, fm = gid * WGM, gsz = (nM - fm) < WGM ? (nM - fm) : WGM;
        u.pm = fm + ((wgid % nig) % gsz); u.pn = (wgid % nig) / gsz; return true;
    }
    __device__ __forceinline__ void a_ready(const Unit&) const {}
    __device__ __forceinline__ void done(const Unit&) const {}
};
__device__ __forceinline__ unsigned cvt_pk_bf16(float lo, float hi) { unsigned r; asm volatile("v_cvt_pk_bf16_f32 %0, %1, %2" : "=v"(r) : "v"(lo), "v"(hi)); return r; }
typedef float f32x2 __attribute__((ext_vector_type(2)));
constexpr int MROWS = 16384, DMODEL = 1024, NPART = 16;
constexpr float NORM_EPS = 1e-6f;
__device__ __forceinline__ float row_rstd(const float* ssq, int row) {
    float s = 0.f;
#pragma unroll
    for (int p = 0; p < NPART; ++p) s += ssq[(size_t)p * MROWS + row];
    return __builtin_amdgcn_rsqf(s * (1.f / DMODEL) + NORM_EPS);
}
__device__ __forceinline__ float silu_f(float x) { return x * __builtin_amdgcn_rcpf(1.f + __expf(-x)); }

struct EpiScale {
    static constexpr bool PERM = true, AFTER_DRAIN = false;
    bf16_t* O; int ldc; const PG8_LAS float* RS; unsigned silu_mask;
    __device__ __forceinline__ void operator()(const f32x4 (&acc)[2][2][4][2], const Unit& u, int ui, int wr, int wc, int fr, int fq) const {
        const int row0 = u.pm * BM + wr * 64 + fr, col0 = u.pn * BM + wc * 32 + 8 * fq; const bool act = (silu_mask >> u.pn) & 1u;
#pragma unroll
        for (int ai = 0; ai < 2; ++ai)
#pragma unroll
            for (int m = 0; m < 4; ++m) { const int row = row0 + ai * HALF + m * 16; const float rs = RS[ui * BM + wr * 64 + fr + ai * HALF + m * 16]; bf16_t* rowp = O + (size_t)row * ldc + col0;
#pragma unroll
                for (int bj = 0; bj < 2; ++bj) { f32x4 v0 = acc[ai][bj][m][0] * rs, v1 = acc[ai][bj][m][1] * rs;
                    if (act) { v0 = (f32x4){silu_f(v0[0]), silu_f(v0[1]), silu_f(v0[2]), silu_f(v0[3])}; v1 = (f32x4){silu_f(v1[0]), silu_f(v1[1]), silu_f(v1[2]), silu_f(v1[3])}; }
                    u32x4 w; w.x = cvt_pk_bf16(v0[0], v0[1]); w.y = cvt_pk_bf16(v0[2], v0[3]); w.z = cvt_pk_bf16(v1[0], v1[1]); w.w = cvt_pk_bf16(v1[2], v1[3]);
                    *(u32x4*)(rowp + bj * HALF) = w; } __builtin_amdgcn_sched_barrier(0); }
    }
};
struct EpiRes {
    static constexpr bool PERM = true, AFTER_DRAIN = false;
    bf16_t* XB; float* ssq;
    __device__ __forceinline__ void operator()(const f32x4 (&acc)[2][2][4][2], const Unit& u, int ui, int wr, int wc, int fr, int fq) const {
        const int row0 = u.pm * BM + wr * 64 + fr, col0 = u.pn * BM + wc * 32 + 8 * fq;
#pragma unroll
        for (int ai = 0; ai < 2; ++ai)
#pragma unroll
            for (int mm = 0; mm < 4; mm += 2) {
                u32x4 rr[2][2];
#pragma unroll
                for (int q = 0; q < 2; ++q)
#pragma unroll
                    for (int bj = 0; bj < 2; ++bj) rr[q][bj] = *(const u32x4*)(XB + (size_t)(row0 + ai * HALF + (mm + q) * 16) * DMODEL + col0 + bj * HALF);
                __builtin_amdgcn_sched_barrier(0);
#pragma unroll
                for (int q = 0; q < 2; ++q) { const int m = mm + q, row = row0 + ai * HALF + m * 16; const size_t o = (size_t)row * DMODEL + col0; float sq = 0.f;
#pragma unroll
                    for (int bj = 0; bj < 2; ++bj) { const u32x4 r = rr[q][bj];
                        const f32x4 r0 = (f32x4){__builtin_bit_cast(float, r.x << 16), __builtin_bit_cast(float, r.x & 0xffff0000u), __builtin_bit_cast(float, r.y << 16), __builtin_bit_cast(float, r.y & 0xffff0000u)};
                        const f32x4 r1 = (f32x4){__builtin_bit_cast(float, r.z << 16), __builtin_bit_cast(float, r.z & 0xffff0000u), __builtin_bit_cast(float, r.w << 16), __builtin_bit_cast(float, r.w & 0xffff0000u)};
                        const f32x4 v0 = acc[ai][bj][m][0] + r0, v1 = acc[ai][bj][m][1] + r1;
                        u32x4 w; w.x = cvt_pk_bf16(v0[0], v0[1]); w.y = cvt_pk_bf16(v0[2], v0[3]); w.z = cvt_pk_bf16(v1[0], v1[1]); w.w = cvt_pk_bf16(v1[2], v1[3]);
                        *(u32x4*)(XB + o + bj * HALF) = w;
                        sq += (v0[0] * v0[0] + v0[1] * v0[1]) + (v0[2] * v0[2] + v0[3] * v0[3]) + (v1[0] * v1[0] + v1[1] * v1[1]) + (v1[2] * v1[2] + v1[3] * v1[3]); }
                    sq += __shfl_xor(sq, 16); sq += __shfl_xor(sq, 32);
                    if (fq == 0) ssq[(size_t)(u.pn * 4 + wc) * MROWS + row] = sq; }
                __builtin_amdgcn_sched_barrier(0); }
    }
};
struct EpiSwiGLU {
    static constexpr bool PERM = true, AFTER_DRAIN = false;
    bf16_t* O; int ldc; const PG8_LAS float* RS;
    __device__ __forceinline__ void operator()(const f32x4 (&acc)[2][2][4][2], const Unit& u, int ui, int wr, int wc, int fr, int fq) const {
        const int row0 = u.pm * BM + wr * 64 + fr, col0 = u.pn * HALF + wc * 32 + 8 * fq;
#pragma unroll
        for (int ai = 0; ai < 2; ++ai)
#pragma unroll
            for (int m = 0; m < 4; ++m) { const int row = row0 + ai * HALF + m * 16; const float rs = RS[ui * BM + wr * 64 + fr + ai * HALF + m * 16];
                const f32x4 g0 = acc[ai][0][m][0] * rs, g1 = acc[ai][0][m][1] * rs, u0 = acc[ai][1][m][0] * rs, u1 = acc[ai][1][m][1] * rs;
                u32x4 w; w.x = cvt_pk_bf16(silu_f(g0[0]) * u0[0], silu_f(g0[1]) * u0[1]); w.y = cvt_pk_bf16(silu_f(g0[2]) * u0[2], silu_f(g0[3]) * u0[3]);
                w.z = cvt_pk_bf16(silu_f(g1[0]) * u1[0], silu_f(g1[1]) * u1[1]); w.w = cvt_pk_bf16(silu_f(g1[2]) * u1[2], silu_f(g1[3]) * u1[3]);
                *(u32x4*)(O + (size_t)row * ldc + col0) = w; __builtin_amdgcn_sched_barrier(0); }
    }
};
template <class Sched> __device__ __forceinline__ void rstd_table(PG8_LAS float* RS, const float* ssq, const Sched& S) {
    int tx_ = threadIdx.x; asm volatile("" : "+v"(tx_));
    Unit u; const int t = tx_ & (BM - 1);
    for (int i = __builtin_amdgcn_readfirstlane(tx_ >> 8); S.next(i, u); i += 2) {
        float v[NPART];
#pragma unroll
        for (int p = 0; p < NPART; ++p) v[p] = ssq[(size_t)p * MROWS + u.pm * BM + t];
        __builtin_amdgcn_sched_barrier(0);
        const float s = (((v[0] + v[1]) + (v[2] + v[3])) + ((v[4] + v[5]) + (v[6] + v[7]))) + (((v[8] + v[9]) + (v[10] + v[11])) + ((v[12] + v[13]) + (v[14] + v[15])));
        RS[i * BM + t] = __builtin_amdgcn_rsqf(s * (1.f / DMODEL) + NORM_EPS);
    }
    __syncthreads();
}
template <class Epi, class Sched, bool ALIGN_EPI = false, bool SP2 = false>
__device__ __forceinline__ void gemm_phase(PG8_LAS unsigned char* lds, const Gemm g, const Sched& S, const Epi& E) {
    int tid_ = threadIdx.x; asm volatile("" : "+v"(tid_));
    const int tid = tid_, wid = __builtin_amdgcn_readfirstlane(tid >> 6), lane = tid & 63, wr = wid >> 2, wc = wid & 3, fr = lane & 15, fq = lane >> 4;
    const int K = g.K, nt = K / BK;
    unsigned voffA[2], voffB[2];
#pragma unroll
    for (int i = 0; i < 2; ++i) { int R, C; stage_rc(tid * 16 + i * 8192, R, C); const int Rb = Epi::PERM ? ((R & ~31) + perm32(R & 31)) : R;
        voffA[i] = (unsigned)(R * K + C) * 2u; voffB[i] = (unsigned)(Rb * K + C) * 2u; }
    const size_t kstep = (size_t)(BK * 2);
    const size_t hstep = (size_t)HALF * K * 2;
    const size_t tstep = 2 * hstep;
    const unsigned ldsw = (unsigned)wid * 1024u;
    const int aoff = lds_byte(wr * 64 + fr, fq * 8), boff = lds_byte(wc * 32 + fr, fq * 8);
#define PG8_SA(b, h) (((b) * 2 + (h)) * HTB)
#define PG8_SB(b, h) ((4 + (b) * 2 + (h)) * HTB)
#define PG8_STAGE(bufoff, gbase, voff) do { _Pragma("unroll") for (int _i = 0; _i < 2; ++_i) \
        __builtin_amdgcn_global_load_lds((const unsigned*)((const char*)(gbase) + (voff)[_i]), (PG8_LAS unsigned*)(lds + (bufoff) + ldsw + _i * 8192), 16, 0, 0); } while (0)
#define PG8_LDA(dst, b, h) do { _Pragma("unroll") for (int m = 0; m < 4; ++m) _Pragma("unroll") for (int k = 0; k < 2; ++k) dst[m][k] = *(const PG8_LAS bf16x8*)(lds + PG8_SA(b, h) + aoff + m * 2048 + k * 1024); } while (0)
#define PG8_LDB(dst, b, h) do { _Pragma("unroll") for (int n = 0; n < 2; ++n) _Pragma("unroll") for (int k = 0; k < 2; ++k) dst[n][k] = *(const PG8_LAS bf16x8*)(lds + PG8_SB(b, h) + boff + n * 2048 + k * 1024); } while (0)
#define PG8_MMA(ai, bj, At, Bt) do { __builtin_amdgcn_s_setprio(1); _Pragma("unroll") for (int m = 0; m < 4; ++m) _Pragma("unroll") for (int n = 0; n < 2; ++n) _Pragma("unroll") for (int k = 0; k < 2; ++k) \
        acc[ai][bj][m][n] = __builtin_amdgcn_mfma_f32_16x16x32_bf16(Bt[n][k], At[m][k], acc[ai][bj][m][n], 0, 0, 0); __builtin_amdgcn_s_setprio(0); } while (0)
#define PG8_WAIT_V(n) asm volatile("s_waitcnt vmcnt(" #n ")" ::: "memory")
#define PG8_WAIT_L(n) asm volatile("s_waitcnt lgkmcnt(" #n ")" ::: "memory")
#define PG8_BAR __builtin_amdgcn_s_barrier()
#define PG8_SCHED __builtin_amdgcn_sched_barrier(0)
    Unit cur, nxt; int ui = 0;
    if (!S.next(0, cur)) return;
    f32x4 acc[2][2][4][2];
#pragma unroll
    for (int a = 0; a < 2; ++a)
#pragma unroll
        for (int b = 0; b < 2; ++b)
#pragma unroll
            for (int m = 0; m < 4; ++m)
#pragma unroll
                for (int n = 0; n < 2; ++n) acc[a][b][m][n] = (f32x4){0.f, 0.f, 0.f, 0.f};
    bf16x8 At[4][2], B0[2][2], B1[2][2];
    const char* cA = (const char*)g.A + (size_t)cur.pm * tstep; const char* cB = (const char*)g.Bt + (size_t)cur.pn * tstep;
    S.a_ready(cur);
    if constexpr (SP2) {
        PG8_STAGE(PG8_SB(0, 0), cB, voffB); PG8_STAGE(PG8_SB(0, 1), cB + hstep, voffB); PG8_STAGE(PG8_SA(0, 0), cA, voffA); PG8_STAGE(PG8_SA(0, 1), cA + hstep, voffA);
        if (wr == 1) PG8_BAR;
        PG8_WAIT_V(2); PG8_BAR;
        PG8_STAGE(PG8_SB(1, 0), cB + kstep, voffB); PG8_STAGE(PG8_SA(1, 0), cA + kstep, voffA); PG8_STAGE(PG8_SB(1, 1), cB + hstep + kstep, voffB);
        PG8_WAIT_V(6); PG8_BAR;
    } else {
        PG8_STAGE(PG8_SB(0, 0), cB, voffB); PG8_STAGE(PG8_SA(0, 0), cA, voffA); PG8_STAGE(PG8_SB(0, 1), cB + hstep, voffB); PG8_STAGE(PG8_SA(0, 1), cA + hstep, voffA);
        if (wr == 1) PG8_BAR;
        PG8_WAIT_V(4); PG8_BAR;
        PG8_STAGE(PG8_SB(1, 0), cB + kstep, voffB); PG8_STAGE(PG8_SA(1, 0), cA + kstep, voffA); PG8_STAGE(PG8_SB(1, 1), cB + hstep + kstep, voffB);
        PG8_WAIT_V(6); PG8_BAR;
    }
    for (;;) {
        const bool has_next = S.next(ui + 1, nxt);
        const char* nA = has_next ? (const char*)g.A + (size_t)nxt.pm * tstep : cA; const char* nB = has_next ? (const char*)g.Bt + (size_t)nxt.pn * tstep : cB;
        for (int t = 0; t < nt; t += 2) {
            const bool last = (t == nt - 2);
            const char* a1 = cA + (size_t)(t + 1) * kstep;
            const char* a2 = last ? nA : cA + (size_t)(t + 2) * kstep; const char* b2 = last ? nB : cB + (size_t)(t + 2) * kstep;
            const char* a3 = a2 + kstep; const char* b3 = b2 + kstep;
            if (last && has_next) S.a_ready(nxt);
            if constexpr (SP2) {
            PG8_LDB(B0, 0, 0); PG8_LDB(B1, 0, 1); PG8_SCHED; PG8_LDA(At, 0, 0); PG8_STAGE(PG8_SA(1, 1), a1 + hstep, voffA);
            PG8_WAIT_V(8); PG8_WAIT_L(0); PG8_BAR; PG8_MMA(0, 0, At, B0); PG8_MMA(0, 1, At, B1); PG8_BAR; PG8_SCHED;
            PG8_LDA(At, 0, 1); PG8_STAGE(PG8_SB(0, 0), b2, voffB); PG8_STAGE(PG8_SB(0, 1), b2 + hstep, voffB); PG8_STAGE(PG8_SA(0, 0), a2, voffA);
            PG8_WAIT_V(8); PG8_WAIT_L(0); PG8_BAR; PG8_MMA(1, 0, At, B0); PG8_MMA(1, 1, At, B1); PG8_BAR; PG8_SCHED;
            PG8_LDB(B0, 1, 0); PG8_LDB(B1, 1, 1); PG8_SCHED; PG8_LDA(At, 1, 0); PG8_STAGE(PG8_SA(0, 1), a2 + hstep, voffA);
            PG8_WAIT_V(8); PG8_WAIT_L(0); PG8_BAR; PG8_MMA(0, 0, At, B0); PG8_MMA(0, 1, At, B1); PG8_BAR; PG8_SCHED;
            PG8_LDA(At, 1, 1); PG8_STAGE(PG8_SB(1, 0), b3, voffB); PG8_STAGE(PG8_SB(1, 1), b3 + hstep, voffB); PG8_STAGE(PG8_SA(1, 0), a3, voffA);
            PG8_WAIT_V(8); PG8_WAIT_L(0); PG8_BAR; PG8_MMA(1, 0, At, B0); PG8_MMA(1, 1, At, B1); PG8_BAR; PG8_SCHED;
            } else {
            PG8_LDB(B0, 0, 0); PG8_SCHED; PG8_LDA(At, 0, 0); PG8_STAGE(PG8_SA(1, 1), a1 + hstep, voffA);
            PG8_WAIT_L(8); PG8_BAR; PG8_WAIT_L(0); PG8_MMA(0, 0, At, B0); PG8_BAR; PG8_SCHED;
            PG8_LDB(B1, 0, 1); PG8_STAGE(PG8_SB(0, 0), b2, voffB);
            PG8_BAR; PG8_WAIT_L(0); PG8_MMA(0, 1, At, B1); PG8_BAR;
            PG8_LDA(At, 0, 1); PG8_STAGE(PG8_SA(0, 0), a2, voffA);
            PG8_BAR; PG8_WAIT_L(0); PG8_MMA(1, 0, At, B0); PG8_BAR; PG8_SCHED;
            PG8_STAGE(PG8_SB(0, 1), b2 + hstep, voffB);
            PG8_WAIT_V(6); PG8_BAR; PG8_MMA(1, 1, At, B1); PG8_BAR;
            PG8_LDB(B0, 1, 0); PG8_SCHED; PG8_LDA(At, 1, 0); PG8_STAGE(PG8_SA(0, 1), a2 + hstep, voffA);
            PG8_WAIT_L(8); PG8_BAR; PG8_WAIT_L(0); PG8_MMA(0, 0, At, B0); PG8_BAR; PG8_SCHED;
            PG8_LDB(B1, 1, 1); PG8_STAGE(PG8_SB(1, 0), b3, voffB);
            PG8_BAR; PG8_WAIT_L(0); PG8_MMA(0, 1, At, B1); PG8_BAR;
            PG8_LDA(At, 1, 1); PG8_STAGE(PG8_SA(1, 0), a3, voffA);
            PG8_BAR; PG8_WAIT_L(0); PG8_MMA(1, 0, At, B0); PG8_BAR; PG8_SCHED;
            PG8_STAGE(PG8_SB(1, 1), b3 + hstep, voffB);
            PG8_WAIT_V(6); PG8_BAR; PG8_MMA(1, 1, At, B1); PG8_BAR;
            }
        }
        if constexpr (ALIGN_EPI) { if (wr == 0) PG8_BAR; }
        if constexpr (!Epi::AFTER_DRAIN) { E(acc, cur, ui, wr, wc, fr, fq); S.done(cur); }
        if (!has_next) break;
#pragma unroll
        for (int a = 0; a < 2; ++a)
#pragma unroll
            for (int b = 0; b < 2; ++b)
#pragma unroll
                for (int m = 0; m < 4; ++m)
#pragma unroll
                    for (int n = 0; n < 2; ++n) acc[a][b][m][n] = (f32x4){0.f, 0.f, 0.f, 0.f};
        cur = nxt; cA = nA; cB = nB; ++ui;
        if constexpr (ALIGN_EPI) { if (wr == 1) PG8_BAR; }
    }
    PG8_WAIT_V(0);
    if constexpr (!ALIGN_EPI) { if (wr == 0) PG8_BAR; }
    PG8_BAR;
    if constexpr (Epi::AFTER_DRAIN) { E.fused(acc, cur, wr, wc, fr, fq, lds, wid, lane); S.done(cur); }
#undef PG8_SA
#undef PG8_SB
#undef PG8_STAGE
#undef PG8_LDA
#undef PG8_LDB
#undef PG8_MMA
#undef PG8_WAIT_V
#undef PG8_WAIT_L
#undef PG8_BAR
#undef PG8_SCHED
}
}
#ifndef PROBE_SEL
#define PROBE_SEL (-1)
#endif
#define PT_NOW() __builtin_amdgcn_s_memrealtime()
#define PT_WORDS_OFF 140304
#define PT_ACC(lds_, dt_) do { if (threadIdx.x == 0) { volatile __attribute__((address_space(3))) unsigned* a_ = (volatile __attribute__((address_space(3))) unsigned*)((lds_) + PT_WORDS_OFF); a_[0] = a_[0] + (unsigned)(dt_); } } while (0)
#define LAS __attribute__((address_space(3)))
typedef unsigned short bf16;
typedef float f32x4 __attribute__((ext_vector_type(4)));
typedef short bf16x8 __attribute__((ext_vector_type(8)));
typedef unsigned u32x4 __attribute__((ext_vector_type(4)));
typedef unsigned u32x2 __attribute__((ext_vector_type(2)));
constexpr int NWAVES = 8, NTHR = 512;
constexpr int BATCH = 8, SEQ = 2048, DM = 1024, M = BATCH * SEQ, DIN = 3840, FFN = 2816, DEPTH = 2;
constexpr int C_HQ = 0, C_HFF = 512, C_HI = 1536, C_HG = 2048, C_NQ = 2560, C_NK = 2816, C_NV = 3072, C_CA = 3328, C_CG = 3584;
constexpr int NSEG = 8, SEGLEN = SEQ / NSEG, CHS = SEGLEN / 32;
constexpr float EPS = 1e-6f;
constexpr size_t MiB = 1u << 20;
constexpr size_t WS_SSQ = 1 * MiB;
constexpr size_t WS_WIN = 2 * MiB, WS_WIN_L = (size_t)DIN * DM * 2;
constexpr size_t WS_WOUT = 17 * MiB, WS_WOUT_L = (size_t)DM * DM * 2;
constexpr size_t WS_WGU = 21 * MiB, WS_WGU_L = (size_t)2 * FFN * DM * 2;
constexpr size_t WS_WDN = 43 * MiB, WS_WDN_L = (size_t)DM * FFN * 2;
constexpr size_t WS_P = 54 * MiB;
constexpr size_t WS_MIX = 174 * MiB;
constexpr size_t WS_XB = 206 * MiB;
constexpr size_t WS_SLOC = 238 * MiB;
constexpr size_t WS_DSEG = 254 * MiB;
constexpr size_t WS_END = 255 * MiB;

__device__ __forceinline__ float bf2f(unsigned short h) { return __builtin_bit_cast(float, (unsigned)h << 16); }
__device__ __forceinline__ float bflo(unsigned w) { return __builtin_bit_cast(float, w << 16); }
__device__ __forceinline__ float bfhi(unsigned w) { return __builtin_bit_cast(float, w & 0xffff0000u); }
typedef float f32x2_t __attribute__((ext_vector_type(2)));
typedef __bf16 bf16x2_t __attribute__((ext_vector_type(2)));
__device__ __forceinline__ unsigned pk2(float lo, float hi) { const f32x2_t v = {lo, hi}; const bf16x2_t b = __builtin_convertvector(v, bf16x2_t); return __builtin_bit_cast(unsigned, b); }
__device__ __forceinline__ unsigned short f2bf(float v) { return (unsigned short)(pk2(v, 0.f) & 0xffffu); }
__device__ __forceinline__ float wave_sum(float v) {
#pragma unroll
    for (int o = 1; o < 64; o <<= 1) v += __shfl_xor(v, o);
    return v;
}
__device__ __forceinline__ float sigm(float x) { return __builtin_amdgcn_rcpf(1.f + __expf(-x)); }
__device__ __forceinline__ float silu_f0(float x) { return x * sigm(x); }
__device__ __forceinline__ f32x4 mfma16(bf16x8 a, bf16x8 b, f32x4 c) { return __builtin_amdgcn_mfma_f32_16x16x32_bf16(a, b, c, 0, 0, 0); }
#define LDS_WAIT() asm volatile("s_waitcnt lgkmcnt(0)" ::: "memory")

struct Params {
    const float *x, *mix_g, *w_in, *hg_lb, *hg_ng, *rpb, *cw, *cb, *lng, *lnb, *w_out, *ffn_g, *w_gu, *w_dn, *fin_g;
    float* out; unsigned char* ws;
};

__device__ __forceinline__ void transpose_item(const float* W, int K, int N, bf16* WT, const float* gk, bool gu, LAS float* scr, int item, int lane) {
    const int nblk = N / 64, kb = item / nblk, nb = item % nblk, k0 = 64 * kb, n0 = 64 * nb;
    const float gs = gk ? gk[k0 + lane] : 1.f;
    const float* src = W + (size_t)k0 * N + n0 + lane;
#pragma unroll
    for (int hh = 0; hh < 2; ++hh) {
        float wv[32];
#pragma unroll
        for (int i = 0; i < 32; ++i) wv[i] = src[(size_t)(32 * hh + i) * N];
        __builtin_amdgcn_sched_barrier(0);
#pragma unroll
        for (int i = 0; i < 32; ++i) scr[(32 * hh + i) * 65 + lane] = wv[i] * __shfl(gs, 32 * hh + i);
    }
    LDS_WAIT(); asm volatile("" ::: "memory");
    const int c = lane & 7;
    int r0 = n0;
    if (gu) { const int up = n0 >= FFN ? 1 : 0, cc = n0 - up * FFN; r0 = 256 * (cc >> 7) + (cc & 127) + up * 128; }
#pragma unroll
    for (int j = 0; j < 8; ++j) { const int n = (lane >> 3) + 8 * j; const LAS float* s = scr + (8 * c) * 65 + n;
        u32x4 o; o.x = pk2(s[0 * 65], s[1 * 65]); o.y = pk2(s[2 * 65], s[3 * 65]); o.z = pk2(s[4 * 65], s[5 * 65]); o.w = pk2(s[6 * 65], s[7 * 65]);
        *(u32x4*)(WT + (size_t)(r0 + n) * K + k0 + 8 * c) = o; }
    LDS_WAIT(); asm volatile("" ::: "memory");
}
constexpr int I_IN = (DM / 64) * (DIN / 64), I_OUT = (DM / 64) * (DM / 64), I_GU = (DM / 64) * (2 * FFN / 64), I_DN = (FFN / 64) * (DM / 64), I_L = I_IN + I_OUT + I_GU + I_DN;
__device__ __forceinline__ void convert_weights(const Params& p, LAS unsigned char* lds, int lo, int hi, int w0, int nw, int wave, int lane) {
    LAS float* scr = (LAS float*)(lds + wave * 16640);
    for (int it = lo + w0; it < hi; it += nw) {
        const int l = it / I_L; int r = it % I_L;
        if (r < I_IN) { transpose_item(p.w_in + (size_t)l * DM * DIN, DM, DIN, (bf16*)(p.ws + WS_WIN + l * WS_WIN_L), p.mix_g + l * DM, false, scr, r, lane); continue; } r -= I_IN;
        if (r < I_OUT) { transpose_item(p.w_out + (size_t)l * DM * DM, DM, DM, (bf16*)(p.ws + WS_WOUT + l * WS_WOUT_L), nullptr, false, scr, r, lane); continue; } r -= I_OUT;
        if (r < I_GU) { transpose_item(p.w_gu + (size_t)l * DM * 2 * FFN, DM, 2 * FFN, (bf16*)(p.ws + WS_WGU + l * WS_WGU_L), p.ffn_g + l * DM, true, scr, r, lane); continue; } r -= I_GU;
        transpose_item(p.w_dn + (size_t)l * FFN * DM, FFN, DM, (bf16*)(p.ws + WS_WDN + l * WS_WDN_L), nullptr, false, scr, r, lane);
    }
}
__device__ __forceinline__ void prologue(const Params& p, LAS unsigned char* lds, int gw, int NGW, int wave, int lane) {
    convert_weights(p, lds, 0, I_IN, gw, NGW, wave, lane);
    bf16* XB = (bf16*)(p.ws + WS_XB); float* ssq = (float*)(p.ws + WS_SSQ);
    for (int m = gw; m < M; m += 2 * NGW) {
        const int m2 = m + NGW;
        const f32x4* xa = (const f32x4*)(p.x + (size_t)m * DM) + lane; const f32x4* xc = (const f32x4*)(p.x + (size_t)(m2 < M ? m2 : m) * DM) + lane;
        f32x4 va[4], vc[4];
#pragma unroll
        for (int j = 0; j < 4; ++j) { va[j] = xa[64 * j]; vc[j] = xc[64 * j]; }
        __builtin_amdgcn_sched_barrier(0);
        float sa = 0.f, sc = 0.f;
        unsigned long long* oa = (unsigned long long*)(XB + (size_t)m * DM) + lane; unsigned long long* oc = (unsigned long long*)(XB + (size_t)m2 * DM) + lane;
#pragma unroll
        for (int j = 0; j < 4; ++j) { sa += (va[j].x * va[j].x + va[j].y * va[j].y) + (va[j].z * va[j].z + va[j].w * va[j].w); sc += (vc[j].x * vc[j].x + vc[j].y * vc[j].y) + (vc[j].z * vc[j].z + vc[j].w * vc[j].w);
            oa[64 * j] = (unsigned long long)pk2(va[j].x, va[j].y) | ((unsigned long long)pk2(va[j].z, va[j].w) << 32);
            if (m2 < M) oc[64 * j] = (unsigned long long)pk2(vc[j].x, vc[j].y) | ((unsigned long long)pk2(vc[j].z, vc[j].w) << 32); }
        sa = wave_sum(sa); sc = wave_sum(sc);
        if (lane < 16) { ssq[(size_t)lane * M + m] = lane == 0 ? sa : 0.f; if (m2 < M) ssq[(size_t)lane * M + m2] = lane == 0 ? sc : 0.f; }
    }
}

constexpr int HS_SET = 37888, HQ_OFF = 0, HK_OFF = 8704, HKH_OFF = 17408, HV_OFF = 27648;
constexpr int HOS_OFF = 2 * HS_SET, HOS_SZ = 16896, HDEC_OFF = HOS_OFF + 2 * HOS_SZ;
#define WG_BAR() asm volatile("s_waitcnt lgkmcnt(0)\n\ts_barrier" ::: "memory")
template <bool FULL, bool SECOND>
__device__ __forceinline__ void hg_segment(LAS unsigned char* lds, const bf16* P, int b, int h, int dir, int seg, float lb, f32x4 (&S)[8], float& bsum,
                                           float* OP, bf16* MIXED, const float* norm_g) {
    int tid_ = threadIdx.x; asm volatile("" : "+v"(tid_)); const int tid = tid_, w = __builtin_amdgcn_readfirstlane(tid >> 6), lane = tid & 63, fr = lane & 15, fq = lane >> 4;
    unsigned long long tk0 = 0;
    const int d = 16 * w + (lane & 15), grp = lane >> 4;
    const int zcol = C_HFF + dir * 512 + h * 128 + d, qcol = C_HQ + h * 128 + d, vcol = C_HI + h * 128 + d;
    const float oml = 1.f - lb;
    const int ts = dir == 0 ? 1 : -1, tb0 = dir == 0 ? seg * SEGLEN : (seg * SEGLEN + SEGLEN - 1);
    const long rstep = (long)ts * DIN;
    const int fc = tid >> 4, dvg = tid & 15;
    f32x4 ng0 = (f32x4){0.f, 0.f, 0.f, 0.f}, ng1 = ng0;
    if (FULL && SECOND) { ng0 = *(const f32x4*)(norm_g + 8 * dvg); ng1 = *(const f32x4*)(norm_g + 8 * dvg + 4); }
    unsigned short zn[8], qn[8], vn[8];
#define HG_LOAD(n_) do { const bf16* rowp_ = P + (size_t)(b * SEQ + tb0 + ts * (32 * (n_) + 8 * grp)) * DIN; \
        _Pragma("unroll") for (int e = 0; e < 8; ++e) { const bf16* r_ = rowp_ + rstep * e; zn[e] = r_[zcol]; if (FULL) qn[e] = r_[qcol]; else qn[e] = 0; vn[e] = r_[vcol]; } } while (0)
#define HG_PREP(s_) do { LAS unsigned char* set_ = lds + (s_) * HS_SET; LAS bf16* QT_ = (LAS bf16*)(set_ + HQ_OFF); LAS bf16* KT_ = (LAS bf16*)(set_ + HK_OFF); \
        f32x2_t Ev[4], kvv[4]; float run = 1.f;                                     \
        _Pragma("unroll") for (int e2 = 0; e2 < 4; ++e2) { \
            f32x2_t z = {__builtin_amdgcn_fmed3f(bf2f(zn[2 * e2]), -40.f, 40.f), __builtin_amdgcn_fmed3f(bf2f(zn[2 * e2 + 1]), -40.f, 40.f)}; \
            const f32x2_t t = z * (-1.4426950408889634f); const f32x2_t den = (f32x2_t){__builtin_amdgcn_exp2f(t.x), __builtin_amdgcn_exp2f(t.y)} + 1.0f; \
            const f32x2_t inv = {__builtin_amdgcn_rcpf(den.x), __builtin_amdgcn_rcpf(den.y)};              \
            const f32x2_t fv = inv * oml + lb; kvv[e2] = inv * (-oml) + oml;                                  \
            run *= fv.x; Ev[e2].x = run; run *= fv.y; Ev[e2].y = run; } \
        float pre = 1.f, tot = 1.f; \
        _Pragma("unroll") for (int g2 = 0; g2 < 4; ++g2) { const float t = __shfl(run, (g2 << 4) | (lane & 15)); tot *= t; if (g2 < grp) pre *= t; } \
        unsigned khp[4], vvp[4]; \
        _Pragma("unroll") for (int e2 = 0; e2 < 4; ++e2) { const f32x2_t E = Ev[e2] * pre; const f32x2_t r = {__builtin_amdgcn_rcpf(E.x), __builtin_amdgcn_rcpf(E.y)}; const f32x2_t kt = kvv[e2] * r; \
            if (FULL) { const int c0 = 8 * grp + 2 * e2; const f32x2_t qs = (f32x2_t){bf2f(qn[2 * e2]), bf2f(qn[2 * e2 + 1])} * E; const unsigned qw = pk2(qs.x, qs.y), kw = pk2(kt.x, kt.y); \
                QT_[c0 * 136 + d] = (bf16)(qw & 0xffffu); QT_[(c0 + 1) * 136 + d] = (bf16)(qw >> 16); KT_[c0 * 136 + d] = (bf16)(kw & 0xffffu); KT_[(c0 + 1) * 136 + d] = (bf16)(kw >> 16); } \
            const f32x2_t kh = kt * tot; khp[e2] = pk2(kh.x, kh.y); vvp[e2] = (unsigned)vn[2 * e2] | ((unsigned)vn[2 * e2 + 1] << 16); } \
        *(LAS u32x4*)((LAS bf16*)(set_ + HKH_OFF) + d * 40 + 8 * grp) = (u32x4){khp[0], khp[1], khp[2], khp[3]}; \
        *(LAS u32x4*)((LAS bf16*)(set_ + HV_OFF) + d * 40 + 8 * grp) = (u32x4){vvp[0], vvp[1], vvp[2], vvp[3]}; \
        if (grp == 0) { ((LAS float*)(lds + HDEC_OFF))[(s_) * 128 + d] = tot; bsum *= tot; } } while (0)
    HG_LOAD(0);
    __builtin_amdgcn_sched_barrier(0);
    HG_PREP(0);
    __builtin_amdgcn_sched_barrier(0);
    if (CHS > 1) HG_LOAD(1);
    WG_BAR();
#pragma unroll 1
    for (int n = 0; n < CHS; ++n) {
        const int tb = tb0 + ts * 32 * n, cs = n & 1;
        const int ftok = tb + ts * fc;
        f32x4 op0 = (f32x4){0.f, 0.f, 0.f, 0.f}, op1 = op0; u32x4 gw4 = (u32x4){0u, 0u, 0u, 0u};
        float* op = OP + ((size_t)((b * 4 + h) * SEQ + ftok)) * 128 + 8 * dvg;
        if (FULL && SECOND) { op0 = *(const f32x4*)op; op1 = *(const f32x4*)(op + 4); gw4 = *(const u32x4*)(P + (size_t)(b * SEQ + ftok) * DIN + C_HG + h * 128 + 8 * dvg); }
        __builtin_amdgcn_sched_barrier(0);
#pragma unroll 1
        for (int ph = 0; ph < 2; ++ph) {
        if ((ph == 0) == (w < 4)) { if (PROBE_SEL == 13) tk0 = PT_NOW(); if (n + 1 < CHS) { HG_PREP(cs ^ 1); __builtin_amdgcn_sched_barrier(0); if (n + 2 < CHS) HG_LOAD(n + 2); } if (PROBE_SEL == 13) PT_ACC(lds, PT_NOW() - tk0); }
        else {
        if (PROBE_SEL == 14) tk0 = PT_NOW();
        LAS unsigned char* set = lds + cs * HS_SET;
        LAS bf16* QT = (LAS bf16*)(set + HQ_OFF); LAS bf16* KT = (LAS bf16*)(set + HK_OFF); LAS bf16* KHT = (LAS bf16*)(set + HKH_OFF); LAS bf16* VT = (LAS bf16*)(set + HV_OFF);
        LAS float* OS = (LAS float*)(lds + HOS_OFF + cs * HOS_SZ); LAS float* DEC = (LAS float*)(lds + HDEC_OFF) + cs * 128;
        if (FULL) {
            f32x4 p00 = (f32x4){0.f, 0.f, 0.f, 0.f}, p01 = p00, p11 = p00;
#pragma unroll
            for (int ks = 0; ks < 4; ++ks) {
                const bf16x8 k0 = *(const LAS bf16x8*)(KT + fr * 136 + 32 * ks + 8 * fq), k1 = *(const LAS bf16x8*)(KT + (16 + fr) * 136 + 32 * ks + 8 * fq);
                const bf16x8 q0 = *(const LAS bf16x8*)(QT + fr * 136 + 32 * ks + 8 * fq), q1 = *(const LAS bf16x8*)(QT + (16 + fr) * 136 + 32 * ks + 8 * fq);
                p00 = mfma16(k0, q0, p00); p01 = mfma16(k0, q1, p01); p11 = mfma16(k1, q1, p11); }
#pragma unroll
            for (int i = 0; i < 4; ++i) { const bool keep = 4 * fq + i <= fr; p00[i] = keep ? p00[i] : 0.f; p11[i] = keep ? p11[i] : 0.f; }
            const bf16x8 pf0 = __builtin_bit_cast(bf16x8, (u32x4){pk2(p00[0], p00[1]), pk2(p00[2], p00[3]), 0u, 0u});
            const bf16x8 pf1 = __builtin_bit_cast(bf16x8, (u32x4){pk2(p01[0], p01[1]), pk2(p01[2], p01[3]), pk2(p11[0], p11[1]), pk2(p11[2], p11[3])});
            f32x4 o0 = (f32x4){0.f, 0.f, 0.f, 0.f}, o1 = o0;
#pragma unroll
            for (int ks = 0; ks < 4; ++ks) {
                const bf16x8 sa = __builtin_bit_cast(bf16x8, (u32x4){pk2(S[2 * ks][0], S[2 * ks][1]), pk2(S[2 * ks][2], S[2 * ks][3]), pk2(S[2 * ks + 1][0], S[2 * ks + 1][1]), pk2(S[2 * ks + 1][2], S[2 * ks + 1][3])});
                const u32x2 a0 = *(const LAS u32x2*)(QT + fr * 136 + 32 * ks + 4 * fq), a1 = *(const LAS u32x2*)(QT + fr * 136 + 32 * ks + 16 + 4 * fq);
                const u32x2 c0 = *(const LAS u32x2*)(QT + (16 + fr) * 136 + 32 * ks + 4 * fq), c1 = *(const LAS u32x2*)(QT + (16 + fr) * 136 + 32 * ks + 16 + 4 * fq);
                o0 = mfma16(sa, __builtin_bit_cast(bf16x8, (u32x4){a0.x, a0.y, a1.x, a1.y}), o0);
                o1 = mfma16(sa, __builtin_bit_cast(bf16x8, (u32x4){c0.x, c0.y, c1.x, c1.y}), o1); }
            { const u32x2 v0 = *(const LAS u32x2*)(VT + (16 * w + fr) * 40 + 4 * fq), v1 = *(const LAS u32x2*)(VT + (16 * w + fr) * 40 + 16 + 4 * fq);
              const bf16x8 va = __builtin_bit_cast(bf16x8, (u32x4){v0.x, v0.y, v1.x, v1.y});
              o0 = mfma16(va, pf0, o0); o1 = mfma16(va, pf1, o1); }
            *(LAS f32x4*)(OS + fr * 132 + 16 * w + 4 * fq) = o0; *(LAS f32x4*)(OS + (16 + fr) * 132 + 16 * w + 4 * fq) = o1;
        }
        { const bf16x8 vfr = *(const LAS bf16x8*)(VT + (16 * w + fr) * 40 + 8 * fq);
#pragma unroll
          for (int i = 0; i < 8; ++i) { const f32x4 dv4 = *(const LAS f32x4*)(DEC + 16 * i + 4 * fq); S[i] = S[i] * dv4;
              S[i] = mfma16(*(const LAS bf16x8*)(KHT + (16 * i + fr) * 40 + 8 * fq), vfr, S[i]); } }
        if (PROBE_SEL == 14) PT_ACC(lds, PT_NOW() - tk0);
        } }
        if (PROBE_SEL == 15) tk0 = PT_NOW();
        WG_BAR();
        if (PROBE_SEL == 15) PT_ACC(lds, PT_NOW() - tk0);
        if (FULL) {
            LAS float* OS = (LAS float*)(lds + HOS_OFF + cs * HOS_SZ);
            f32x4 o0 = *(const LAS f32x4*)(OS + fc * 132 + 8 * dvg), o1 = *(const LAS f32x4*)(OS + fc * 132 + 8 * dvg + 4);
            if (!SECOND) { *(f32x4*)op = o0; *(f32x4*)(op + 4) = o1; }
            else { o0 = o0 + op0; o1 = o1 + op1;
                float sq = (o0[0] * o0[0] + o0[1] * o0[1]) + (o0[2] * o0[2] + o0[3] * o0[3]) + (o1[0] * o1[0] + o1[1] * o1[1]) + (o1[2] * o1[2] + o1[3] * o1[3]);
                sq += __shfl_xor(sq, 1); sq += __shfl_xor(sq, 2); sq += __shfl_xor(sq, 4); sq += __shfl_xor(sq, 8);
                const float rs = __builtin_amdgcn_rsqf(sq * (1.f / 128.f) + EPS);
                u32x4 ow; ow.x = pk2(o0[0] * rs * ng0[0] * bflo(gw4.x), o0[1] * rs * ng0[1] * bfhi(gw4.x));
                ow.y = pk2(o0[2] * rs * ng0[2] * bflo(gw4.y), o0[3] * rs * ng0[3] * bfhi(gw4.y));
                ow.z = pk2(o1[0] * rs * ng1[0] * bflo(gw4.z), o1[1] * rs * ng1[1] * bfhi(gw4.z));
                ow.w = pk2(o1[2] * rs * ng1[2] * bflo(gw4.w), o1[3] * rs * ng1[3] * bfhi(gw4.w));
                *(u32x4*)(MIXED + (size_t)(b * SEQ + ftok) * DM + h * 128 + 8 * dvg) = ow; }
        }
    }
    WG_BAR();
#undef HG_LOAD
#undef HG_PREP
}
__device__ __forceinline__ float hg_lb(const float* hg_lb_all, int layer, int dir, int ch) {
    if (layer == 0) return 0.f;
    const float a0 = hg_lb_all[(0 * 2 + dir) * 512 + ch], a1 = hg_lb_all[(1 * 2 + dir) * 512 + ch], mx = fmaxf(a0, a1), e0 = __expf(a0 - mx), e1 = __expf(a1 - mx);
    return e1 / (e0 + e1);
}
__device__ __forceinline__ void hg_passA_item(LAS unsigned char* lds, const Params& p, int layer, int item) {
    const int dir = item & 1, seg = (item >> 1) & (NSEG - 1), h = (item >> 4) & 3, b = item >> 6;
    if ((dir == 0 && seg == NSEG - 1) || (dir == 1 && seg == 0)) return;
    int tid_ = threadIdx.x; asm volatile("" : "+v"(tid_)); const int tid = tid_, w = __builtin_amdgcn_readfirstlane(tid >> 6), lane = tid & 63;
    const float lb = hg_lb(p.hg_lb, layer, dir, h * 128 + 16 * w + (lane & 15));
    f32x4 S[8];
#pragma unroll
    for (int i = 0; i < 8; ++i) S[i] = (f32x4){0.f, 0.f, 0.f, 0.f};
    float bsum = 1.f;
    hg_segment<false, false>(lds, (const bf16*)(p.ws + WS_P), b, h, dir, seg, lb, S, bsum, nullptr, nullptr, nullptr);
    u32x2* sl = (u32x2*)(p.ws + WS_SLOC) + (size_t)item * 4096;
#pragma unroll
    for (int i = 0; i < 8; ++i) sl[(w * 8 + i) * 64 + lane] = (u32x2){pk2(S[i][0], S[i][1]), pk2(S[i][2], S[i][3])};
    if (lane < 16) ((float*)(p.ws + WS_DSEG))[(size_t)item * 128 + 16 * w + (lane & 15)] = bsum;
    __syncthreads();
}
__device__ __forceinline__ unsigned long long hg_passB_item(LAS unsigned char* lds, const Params& p, int layer, int item) {
    unsigned long long tsub = 0, t0_ = 0;
    const int seg = item & (NSEG - 1), h = (item >> 3) & 3, b = item >> 5;
    int tid_ = threadIdx.x; asm volatile("" : "+v"(tid_)); const int tid = tid_, w = __builtin_amdgcn_readfirstlane(tid >> 6), lane = tid & 63, fr = lane & 15, fq = lane >> 4;
    const u32x2* slb = (const u32x2*)(p.ws + WS_SLOC); const float* dsg = (const float*)(p.ws + WS_DSEG);
    float* OP = p.out;   bf16* MIXED = (bf16*)(p.ws + WS_MIX); const bf16* P = (const bf16*)(p.ws + WS_P);
#pragma unroll 1
    for (int dir = 0; dir < 2; ++dir) {
        const float lb = hg_lb(p.hg_lb, layer, dir, h * 128 + 16 * w + (lane & 15));
        f32x4 S[8];
#pragma unroll
        for (int i = 0; i < 8; ++i) S[i] = (f32x4){0.f, 0.f, 0.f, 0.f};
        const int nprev = dir == 0 ? seg : (NSEG - 1 - seg);
        if (PROBE_SEL == 11) t0_ = PT_NOW();
#pragma unroll 1
        for (int q = 0; q < nprev; q += 2) {
            const bool two = q + 1 < nprev; const int sA = dir == 0 ? q : (NSEG - 1 - q), sB = two ? (dir == 0 ? q + 1 : (NSEG - 2 - q)) : sA;
            const int itA = ((b * 4 + h) * NSEG + sA) * 2 + dir, itB = ((b * 4 + h) * NSEG + sB) * 2 + dir;
            const u32x2* slA = slb + (size_t)itA * 4096; const float* dcA = dsg + (size_t)itA * 128; const u32x2* slB = slb + (size_t)itB * 4096; const float* dcB = dsg + (size_t)itB * 128;
            f32x4 dvA[8], dvB[8]; u32x2 svA[8], svB[8];
#pragma unroll
            for (int i = 0; i < 8; ++i) { dvA[i] = *(const f32x4*)(dcA + 16 * i + 4 * fq); svA[i] = slA[(w * 8 + i) * 64 + lane]; dvB[i] = *(const f32x4*)(dcB + 16 * i + 4 * fq); svB[i] = slB[(w * 8 + i) * 64 + lane]; }
            __builtin_amdgcn_sched_barrier(0);
#pragma unroll
            for (int i = 0; i < 8; ++i) { S[i] = S[i] * dvA[i] + (f32x4){bflo(svA[i].x), bfhi(svA[i].x), bflo(svA[i].y), bfhi(svA[i].y)};
                if (two) S[i] = S[i] * dvB[i] + (f32x4){bflo(svB[i].x), bfhi(svB[i].x), bflo(svB[i].y), bfhi(svB[i].y)}; } }
        if (PROBE_SEL == 11) PT_ACC(lds, PT_NOW() - t0_);
        if (PROBE_SEL == 10) t0_ = PT_NOW();
        float bsum = 1.f;
        if (dir == 0) hg_segment<true, false>(lds, P, b, h, 0, seg, lb, S, bsum, OP, MIXED, p.hg_ng + layer * 128);
        else hg_segment<true, true>(lds, P, b, h, 1, seg, lb, S, bsum, OP, MIXED, p.hg_ng + layer * 128);
        if (PROBE_SEL == 10) PT_ACC(lds, PT_NOW() - t0_);
        if (PROBE_SEL == 12) t0_ = PT_NOW();
        __syncthreads();
        if (PROBE_SEL == 12) PT_ACC(lds, PT_NOW() - t0_);
    }
    return tsub;
}

constexpr int NA_KS = 584, NA_RPB_OFF = 64 * NA_KS * 2;
__device__ __forceinline__ int clampi(int v, int lo, int hi) { return v < lo ? lo : (v > hi ? hi : v); }
__device__ __forceinline__ void na_item(LAS unsigned char* lds, const Params& p, int layer, int item) {
    const int rp = item & 15, h = (item >> 4) & 3, b = item >> 6, r0 = 2 * rp, kbase = clampi(r0 - 4, 0, 24);
    int tid_ = threadIdx.x; asm volatile("" : "+v"(tid_)); const int tid = tid_, w = __builtin_amdgcn_readfirstlane(tid >> 6), lane = tid & 63, fr = lane & 15, fq = lane >> 4;
    const bf16* P = (const bf16*)(p.ws + WS_P); bf16* MIXED = (bf16*)(p.ws + WS_MIX);
    LAS bf16* VT = (LAS bf16*)lds; LAS float* RPB = (LAS float*)(lds + NA_RPB_OFF);
    const int rl = w >> 2, j = w & 3, r = r0 + rl, kr0 = clampi(r - 4, 0, 24), kc0 = clampi(16 * j - 8, 0, 32);
    const size_t qtok = (size_t)b * SEQ + r * 64 + 16 * j + fr;
    u32x4 vbuf[9];
#pragma unroll
    for (int it = 0; it < 9; ++it) { const int key = it * 64 + lane, dg = w; int trow = kbase * 64 + key; trow = trow > SEQ - 1 ? SEQ - 1 : trow;
        vbuf[it] = *(const u32x4*)(P + (size_t)(b * SEQ + trow) * DIN + C_NV + h * 64 + 8 * dg); }
    bf16x8 qf[2], kfa[16], kfb[16];
#pragma unroll
    for (int ks = 0; ks < 2; ++ks) qf[ks] = *(const bf16x8*)(P + qtok * DIN + C_NQ + h * 64 + 32 * ks + 8 * fq);
#define NA_KLOAD(dst, hh) do { _Pragma("unroll") for (int k8 = 0; k8 < 8; ++k8) { const int kt = (hh) * 8 + k8, krl = kt >> 1, half = kt & 1; \
        const size_t ktok = (size_t)b * SEQ + (kr0 + krl) * 64 + kc0 + 16 * half + fr; \
        _Pragma("unroll") for (int ks = 0; ks < 2; ++ks) dst[k8 * 2 + ks] = *(const bf16x8*)(P + ktok * DIN + C_NK + h * 64 + 32 * ks + 8 * fq); } } while (0)
    NA_KLOAD(kfa, 0);
    __builtin_amdgcn_sched_barrier(0);
#pragma unroll
    for (int it = 0; it < 9; ++it) { const int key = it * 64 + lane, dg = w; const u32x4 v = vbuf[it];
        LAS bf16* dst = VT + (8 * dg) * NA_KS + key;
        dst[0 * NA_KS] = (bf16)(v.x & 0xffffu); dst[1 * NA_KS] = (bf16)(v.x >> 16); dst[2 * NA_KS] = (bf16)(v.y & 0xffffu); dst[3 * NA_KS] = (bf16)(v.y >> 16);
        dst[4 * NA_KS] = (bf16)(v.z & 0xffffu); dst[5 * NA_KS] = (bf16)(v.z >> 16); dst[6 * NA_KS] = (bf16)(v.w & 0xffffu); dst[7 * NA_KS] = (bf16)(v.w >> 16); }
    for (int i = tid; i < 465; i += NTHR) RPB[i] = p.rpb[(size_t)(layer * 4 + h) * 465 + i];
    NA_KLOAD(kfb, 1);
    __builtin_amdgcn_sched_barrier(0);
    WG_BAR();
    f32x4 s[16];
#pragma unroll
    for (int k8 = 0; k8 < 8; ++k8) { f32x4 a = (f32x4){0.f, 0.f, 0.f, 0.f};
#pragma unroll
        for (int ks = 0; ks < 2; ++ks) a = mfma16(kfa[k8 * 2 + ks], qf[ks], a);
        s[k8] = a; }
#pragma unroll
    for (int k8 = 0; k8 < 8; ++k8) { f32x4 a = (f32x4){0.f, 0.f, 0.f, 0.f};
#pragma unroll
        for (int ks = 0; ks < 2; ++ks) a = mfma16(kfb[k8 * 2 + ks], qf[ks], a);
        s[8 + k8] = a; }
#undef NA_KLOAD
    const int qc = 16 * j + fr, qs = clampi(qc - 8, 0, 48);
    float mx = -1e30f;
#pragma unroll
    for (int kt = 0; kt < 16; ++kt) { const int krl = kt >> 1, half = kt & 1; const int ridx = kr0 + krl - r + 7;
        float bz[4];
#pragma unroll
        for (int i = 0; i < 4; ++i) { const int kc = kc0 + 16 * half + 4 * fq + i; bz[i] = RPB[ridx * 31 + clampi(kc - qc + 15, 0, 30)]; }
#pragma unroll
        for (int i = 0; i < 4; ++i) { const int kc = kc0 + 16 * half + 4 * fq + i; const bool valid = kc >= qs && kc < qs + 16;
            const float v = valid ? s[kt][i] * 0.125f + bz[i] : -1e30f; s[kt][i] = v; mx = fmaxf(mx, v); } }
    mx = fmaxf(mx, __shfl_xor(mx, 16)); mx = fmaxf(mx, __shfl_xor(mx, 32));
    float sum = 0.f;
#pragma unroll
    for (int kt = 0; kt < 16; ++kt)
#pragma unroll
        for (int i = 0; i < 4; ++i) { const float e = __expf(s[kt][i] - mx); s[kt][i] = e; sum += e; }
    sum += __shfl_xor(sum, 16); sum += __shfl_xor(sum, 32);
    f32x4 o[4];
#pragma unroll
    for (int dt = 0; dt < 4; ++dt) o[dt] = (f32x4){0.f, 0.f, 0.f, 0.f};
#pragma unroll
    for (int kk = 0; kk < 8; ++kk) {
        const u32x4 pw = (u32x4){pk2(s[2 * kk][0], s[2 * kk][1]), pk2(s[2 * kk][2], s[2 * kk][3]), pk2(s[2 * kk + 1][0], s[2 * kk + 1][1]), pk2(s[2 * kk + 1][2], s[2 * kk + 1][3])};
        const bf16x8 pf = __builtin_bit_cast(bf16x8, pw);
        const int keyoff = (kr0 + kk - kbase) * 64 + kc0 + 4 * fq;
#pragma unroll
        for (int dt = 0; dt < 4; ++dt) { const u32x2 lo = *(const LAS u32x2*)(VT + (16 * dt + fr) * NA_KS + keyoff), hi = *(const LAS u32x2*)(VT + (16 * dt + fr) * NA_KS + keyoff + 16);
            const bf16x8 vf = __builtin_bit_cast(bf16x8, (u32x4){lo.x, lo.y, hi.x, hi.y});
            o[dt] = mfma16(vf, pf, o[dt]); } }
    const float inv = 1.f / sum;
#pragma unroll
    for (int dt = 0; dt < 4; ++dt) *(u32x2*)(MIXED + qtok * DM + 512 + h * 64 + 16 * dt + 4 * fq) = (u32x2){pk2(o[dt][0] * inv, o[dt][1] * inv), pk2(o[dt][2] * inv, o[dt][3] * inv)};
    WG_BAR();
}

__device__ __forceinline__ void conv_item(LAS unsigned char* lds, const Params& p, int layer, int item) {
    const int b = item >> 6, t0 = (item & 63) * 32;
    int tid_ = threadIdx.x; asm volatile("" : "+v"(tid_)); const int tid = tid_, w = __builtin_amdgcn_readfirstlane(tid >> 6), lane = tid & 63;
    const bf16* P = (const bf16*)(p.ws + WS_P); bf16* MIXED = (bf16*)(p.ws + WS_MIX);
    LAS float* U = (LAS float*)lds; LAS float* CO = U + 62 * 256;
    u32x4 ca4[4], cg4[4];
#pragma unroll
    for (int it = 0; it < 4; ++it) { const int u = it * NTHR + tid, tt = u >> 5, c8 = u & 31, t = t0 - 15 + tt; ca4[it] = (u32x4){0u, 0u, 0u, 0u}; cg4[it] = ca4[it];
        if (u < 62 * 32 && t >= 0 && t < SEQ) { const bf16* rp = P + (size_t)(b * SEQ + t) * DIN; ca4[it] = *(const u32x4*)(rp + C_CA + 8 * c8); cg4[it] = *(const u32x4*)(rp + C_CG + 8 * c8); } }
    const int c = tid & 255, half = tid >> 8;
    float wk[31];
#pragma unroll
    for (int k = 0; k < 31; ++k) wk[k] = p.cw[(size_t)(layer * 31 + k) * 256 + c];
    const float bias = p.cb[layer * 256 + c];
    __builtin_amdgcn_sched_barrier(0);
#pragma unroll
    for (int it = 0; it < 4; ++it) { const int u = it * NTHR + tid, tt = u >> 5, c8 = u & 31; const u32x4 a = ca4[it], g = cg4[it];
        if (u < 62 * 32) {
            const f32x4 u0 = (f32x4){bflo(a.x) * sigm(bflo(g.x)), bfhi(a.x) * sigm(bfhi(g.x)), bflo(a.y) * sigm(bflo(g.y)), bfhi(a.y) * sigm(bfhi(g.y))};
            const f32x4 u1 = (f32x4){bflo(a.z) * sigm(bflo(g.z)), bfhi(a.z) * sigm(bfhi(g.z)), bflo(a.w) * sigm(bflo(g.w)), bfhi(a.w) * sigm(bfhi(g.w))};
            *(LAS f32x4*)(U + tt * 256 + 8 * c8) = u0; *(LAS f32x4*)(U + tt * 256 + 8 * c8 + 4) = u1; } }
    WG_BAR();
#pragma unroll 1
    for (int g = 0; g < 2; ++g) { const int base = 16 * half + 8 * g; float win[38];
#pragma unroll
        for (int i = 0; i < 38; ++i) win[i] = U[(base + i) * 256 + c];
#pragma unroll
        for (int o = 0; o < 8; ++o) { float a = bias;
#pragma unroll
            for (int k = 0; k < 31; ++k) a += wk[k] * win[o + k];
            CO[(base + o) * 256 + c] = a; } }
    __syncthreads();
    const f32x4 lg = *(const f32x4*)(p.lng + layer * 256 + 4 * lane), lbv = *(const f32x4*)(p.lnb + layer * 256 + 4 * lane);
#pragma unroll
    for (int q = 0; q < 4; ++q) { const int tl = 4 * w + q; const f32x4 v = *(const LAS f32x4*)(CO + tl * 256 + 4 * lane);
        const float mean = wave_sum((v.x + v.y) + (v.z + v.w)) * (1.f / 256.f); const f32x4 dd = v - mean;
        const float var = wave_sum((dd.x * dd.x + dd.y * dd.y) + (dd.z * dd.z + dd.w * dd.w)) * (1.f / 256.f); const float rs = __builtin_amdgcn_rsqf(var + EPS);
        f32x4 y = dd * rs * lg + lbv; y = (f32x4){silu_f0(y.x), silu_f0(y.y), silu_f0(y.z), silu_f0(y.w)};
        *(u32x2*)(MIXED + (size_t)(b * SEQ + t0 + tl) * DM + 768 + 4 * lane) = (u32x2){pk2(y.x, y.y), pk2(y.z, y.w)}; }
    __syncthreads();
}

#define XB_TMO      128
#define XB_XCNT(j)  (256  + 64 * (j))
#define XB_XSUB(j)  (1280 + 64 * (j))
#define XB_XGEN(j)  (2304 + 64 * (j))
#define XB_TOP      3328
#define XB_TOPGEN   3392
#define XCD_BAR_WORDS 3456
#define XB_SPIN_CAP (1u << 18)

__device__ __forceinline__ unsigned xb_ld(unsigned* p)              { return __hip_atomic_load(p, __ATOMIC_RELAXED, __HIP_MEMORY_SCOPE_AGENT); }
__device__ __forceinline__ unsigned xb_add(unsigned* p, unsigned v) { return __hip_atomic_fetch_add(p, v, __ATOMIC_RELAXED, __HIP_MEMORY_SCOPE_AGENT); }
__device__ __forceinline__ unsigned xb_xcc_id() { return (unsigned)__builtin_amdgcn_s_getreg((3 << 11) | 20) & 0xFu; }
#define XB_SPIN(cond, bar) do { unsigned _sp = 0; while (cond) { __builtin_amdgcn_s_sleep(1); \
    if ((++_sp & 255u) == 0u) { if (xb_ld(&(bar)[XB_TMO])) break; if (_sp > XB_SPIN_CAP) { atomicAdd(&(bar)[XB_TMO], 1u); break; } } } } while (0)

struct XcdBarrier {
    unsigned* bar; unsigned x;
    volatile LAS unsigned* st;
};

__device__ __forceinline__ XcdBarrier xcd_barrier_post(unsigned* bar, volatile LAS unsigned* st) {
    XcdBarrier b; b.bar = bar; b.x = xb_xcc_id(); b.st = st;
    if (threadIdx.x == 0) (void)xb_add(&bar[XB_XCNT(b.x)], 1u);
    return b;
}
__device__ __forceinline__ void xcd_barrier_complete(unsigned* bar, unsigned x, unsigned& nloc, unsigned& nx) {
    const unsigned G = gridDim.x * gridDim.y * gridDim.z;
    unsigned sum, cnt, mine, sp = 0u;
    for (;;) {
        sum = 0u; cnt = 0u; mine = 0u;
#pragma unroll
        for (unsigned j = 0; j < 16; ++j) { const unsigned c = xb_ld(&bar[XB_XCNT(j)]); sum += c; cnt += (c > 0u) ? 1u : 0u; mine = (j == x) ? c : mine; }
        if (sum == G) break;
        __builtin_amdgcn_s_sleep(1);
        if ((++sp & 255u) == 0u) { if (xb_ld(&bar[XB_TMO])) break; if (sp > XB_SPIN_CAP) { atomicAdd(&bar[XB_TMO], 1u); break; } }
    }
    nloc = mine > 0u ? mine : 1u; nx = cnt > 0u ? cnt : 1u;
}

__device__ __forceinline__ void xcd_barrier(const XcdBarrier& b) {
    asm volatile("s_waitcnt vmcnt(0)" ::: "memory");
    __syncthreads();
    if (threadIdx.x == 0) {
        unsigned* bar = b.bar;
        __builtin_amdgcn_s_waitcnt(0);
        unsigned nloc = b.st[0], nx = b.st[1];
        if (nloc == 0u) { xcd_barrier_complete(bar, b.x, nloc, nx); b.st[0] = nloc; b.st[1] = nx; }
        const unsigned old = xb_add(&bar[XB_XSUB(b.x)], 1u);
        const unsigned gen = old / nloc;
        if (old + 1u == (gen + 1u) * nloc) {
            __builtin_amdgcn_fence(__ATOMIC_RELEASE, "agent");
            asm volatile("s_waitcnt vmcnt(0)" ::: "memory");
            const unsigned og = xb_add(&bar[XB_TOP], 1u);
            const unsigned tg = og / nx;
            if (og + 1u == (tg + 1u) * nx) xb_add(&bar[XB_TOPGEN], 1u);
            else XB_SPIN(xb_ld(&bar[XB_TOPGEN]) == tg, bar);
            __builtin_amdgcn_fence(__ATOMIC_ACQUIRE, "agent");
            xb_add(&bar[XB_XGEN(b.x)], 1u);
            asm volatile("s_waitcnt vmcnt(0)" ::: "memory");
        } else {
            XB_SPIN(xb_ld(&bar[XB_XGEN(b.x)]) == gen, bar);
            __builtin_amdgcn_fence(__ATOMIC_ACQUIRE, "agent");
            asm volatile("s_waitcnt vmcnt(0)" ::: "memory");
        }
    }
    __syncthreads();
}

#if 0
#define PROBE_SEL_UNUSED (-1)
#endif
#ifndef REP_HA
#define REP_HA 1
#endif
#ifndef REP_NA
#define REP_NA 1
#endif
#ifndef REP_CV
#define REP_CV 1
#endif
#ifndef REP_F
#define REP_F 1
#endif
#ifndef REP_B
#define REP_B 1
#endif
#define GRID_BAR() do { XcdBarrier xb_; xb_.bar = (unsigned*)(ws + WS_BAR); xb_.x = xb_xcc_id(); xb_.st = (volatile LAS unsigned*)(lds + XB_ST_OFF); xcd_barrier(xb_); } while (0)
#define PHASE_END(kind) do { GRID_BAR(); if (PROBE_SEL >= 0 && PROBE_SEL < 10 && threadIdx.x == 0) { volatile LAS unsigned long long* pv_ = (volatile LAS unsigned long long*)(lds + PT_WORDS_OFF + 8); const unsigned long long t_ = PT_NOW(); if ((kind) == PROBE_SEL || PROBE_SEL == 9) PT_ACC(lds, t_ - pv_[0]); pv_[0] = t_; } } while (0)
constexpr size_t WS_BAR = 4096, WS_CTL_BYTES = 65536;
constexpr int XB_ST_OFF = 140288;
constexpr int RS_OFF = 131072;
constexpr int LDS_BYTES = 147456;
#define KARGS(q_) const Params& q_ = p_unused;
__global__ void __launch_bounds__(NTHR, 2) fwd_megakernel(Params p_unused) {
    extern __shared__ __attribute__((aligned(16))) unsigned char lds_raw[];
    LAS unsigned char* lds = (LAS unsigned char*)lds_raw;
    int tid_ = threadIdx.x; asm volatile("" : "+v"(tid_)); const int tid = tid_, lane = tid & 63, wave = __builtin_amdgcn_readfirstlane(tid >> 6);
    const int G = gridDim.x, bid = blockIdx.x, gw = bid * NWAVES + wave, NGW = G * NWAVES;
    unsigned char* ws; { KARGS(q0); ws = q0.ws; }

    if (tid < 2) ((volatile LAS unsigned*)(lds + XB_ST_OFF))[tid] = 0u;
    __syncthreads();
    if (ws == nullptr) cg::this_grid().sync();
    (void)xcd_barrier_post((unsigned*)(ws + WS_BAR), (volatile LAS unsigned*)(lds + XB_ST_OFF));
    if (PROBE_SEL >= 0 && threadIdx.x == 0) { ((volatile LAS unsigned*)(lds + PT_WORDS_OFF))[0] = 0u; *(volatile LAS unsigned long long*)(lds + PT_WORDS_OFF + 8) = PT_NOW(); }
    { KARGS(q); prologue(q, lds, gw, NGW, wave, lane); }
    PHASE_END(0);
    if (PROBE_SEL == 8) { PHASE_END(9); PHASE_END(8); }
#pragma unroll 1
    for (int l = 0; l < DEPTH; ++l) {
        unsigned char* wsl; { KARGS(ql); wsl = ql.ws; }
        float* ssq = (float*)(wsl + WS_SSQ); bf16* XB = (bf16*)(wsl + WS_XB); bf16* PB = (bf16*)(wsl + WS_P); bf16* MIXED = (bf16*)(wsl + WS_MIX);
        {
            pg8::Gemm g{XB, (const bf16*)(wsl + WS_WIN + l * WS_WIN_L), M, DIN, DM}; pg8::StaticOrder S; S.init(M, DIN, G, bid);
            pg8::rstd_table((LAS float*)(lds + RS_OFF), ssq, S); pg8::EpiScale E{PB, DIN, (LAS float*)(lds + RS_OFF), 0x303u};
            pg8::gemm_phase<pg8::EpiScale, pg8::StaticOrder, true, true>(lds, g, S, E);
            if (l == 0) {
                KARGS(qc); const int nfull = (M / 256) * (DIN / 256) % G, first = nfull ? nfull : 0, nidle = G - first;
                if (bid >= first) { int tc_ = threadIdx.x; asm volatile("" : "+v"(tc_)); const int wv_ = __builtin_amdgcn_readfirstlane(tc_ >> 6); convert_weights(qc, lds, I_IN, I_IN + I_OUT + I_GU, (bid - first) * NWAVES + wv_, nidle * NWAVES, wv_, tc_ & 63); }
            }
        }
        PHASE_END(1);
#pragma unroll 1
        for (int rep = 0; rep < REP_HA; ++rep)
        { KARGS(q); for (int it = bid; it < BATCH * 4 * NSEG * 2; it += G) hg_passA_item(lds, q, l, it); }
#pragma unroll 1
        for (int rep = 0; rep < REP_NA; ++rep)
        { KARGS(q); for (int it = bid; it < BATCH * 4 * 16; it += G) na_item(lds, q, l, it); }
#pragma unroll 1
        for (int rep = 0; rep < REP_CV; ++rep)
        { KARGS(q); for (int it = bid; it < BATCH * 64; it += G) conv_item(lds, q, l, it); }
        PHASE_END(2);
#pragma unroll 1
        for (int rep = 0; rep < REP_B; ++rep)
        { KARGS(q); for (int it = bid; it < BATCH * 4 * NSEG; it += G) (void)hg_passB_item(lds, q, l, it); }
        PHASE_END(3);
        {
            pg8::Gemm g{MIXED, (const bf16*)(wsl + WS_WOUT + l * WS_WOUT_L), M, DM, DM}; pg8::StaticOrder S; S.init(M, DM, G, bid);
            pg8::EpiRes E{XB, ssq};
            pg8::gemm_phase<pg8::EpiRes, pg8::StaticOrder, true, true>(lds, g, S, E);
        }
        PHASE_END(4);
        {
            pg8::Gemm g{XB, (const bf16*)(wsl + WS_WGU + l * WS_WGU_L), M, 2 * FFN, DM}; pg8::StaticOrder S; S.init(M, 2 * FFN, G, bid);
            pg8::rstd_table((LAS float*)(lds + RS_OFF), ssq, S); pg8::EpiSwiGLU E{PB, FFN, (LAS float*)(lds + RS_OFF)};
            pg8::gemm_phase<pg8::EpiSwiGLU, pg8::StaticOrder, true, true>(lds, g, S, E);
            if (l == 0) {
                KARGS(qc); const int nfull = (M / 256) * (2 * FFN / 256) % G, first = nfull ? nfull : 0, nidle = G - first;
                if (bid >= first) { int tc_ = threadIdx.x; asm volatile("" : "+v"(tc_)); const int wv_ = __builtin_amdgcn_readfirstlane(tc_ >> 6); convert_weights(qc, lds, I_IN + I_OUT + I_GU, DEPTH * I_L, (bid - first) * NWAVES + wv_, nidle * NWAVES, wv_, tc_ & 63); }
            }
        }
        PHASE_END(5);
        {
            pg8::Gemm g{PB, (const bf16*)(wsl + WS_WDN + l * WS_WDN_L), M, DM, FFN}; pg8::StaticOrder S; S.init(M, DM, G, bid);
            pg8::EpiRes E{XB, ssq};
            pg8::gemm_phase<pg8::EpiRes, pg8::StaticOrder, true, true>(lds, g, S, E);
        }
        PHASE_END(6);
    }
    float pdelta = 0.f;
    int tf_ = threadIdx.x; asm volatile("" : "+v"(tf_)); const int lanef = tf_ & 63, gwf = bid * NWAVES + __builtin_amdgcn_readfirstlane(tf_ >> 6);
    KARGS(qf); unsigned char* wsf = qf.ws; const float* ssq = (const float*)(wsf + WS_SSQ); const bf16* XB = (const bf16*)(wsf + WS_XB);
    if (PROBE_SEL >= 0) {
        unsigned* tw = (unsigned*)(wsf + 64);
        if (bid == 0 && threadIdx.x == 0) __hip_atomic_store(tw, ((volatile LAS unsigned*)(lds + PT_WORDS_OFF))[0], __ATOMIC_RELAXED, __HIP_MEMORY_SCOPE_AGENT);
        GRID_BAR();
        pdelta = (float)__hip_atomic_load(tw, __ATOMIC_RELAXED, __HIP_MEMORY_SCOPE_AGENT) * (PROBE_SEL == 9 ? 0.5e-6f : 1e-6f);
    }
#pragma unroll 1
    for (int rep = 0; rep < REP_F; ++rep)
    for (int m = gwf; m < M; m += 2 * NGW) {
        const int m2 = (m + NGW < M) ? m + NGW : m;
        float pa = lanef < 16 ? ssq[(size_t)(lanef & 15) * M + m] : 0.f, pc = lanef < 16 ? ssq[(size_t)(lanef & 15) * M + m2] : 0.f;
        const u32x4* xa = (const u32x4*)(XB + (size_t)m * DM) + lanef; const u32x4* xc = (const u32x4*)(XB + (size_t)m2 * DM) + lanef;
        u32x4 va[2], vc[2]; f32x4 gg[4];
#pragma unroll
        for (int j = 0; j < 2; ++j) { va[j] = xa[64 * j]; vc[j] = xc[64 * j]; gg[2 * j] = *(const f32x4*)(qf.fin_g + 512 * j + 8 * lanef); gg[2 * j + 1] = *(const f32x4*)(qf.fin_g + 512 * j + 8 * lanef + 4); }
        __builtin_amdgcn_sched_barrier(0);
        pa = wave_sum(pa); pc = wave_sum(pc);
        const float ra = __builtin_amdgcn_rsqf(pa * (1.f / DM) + EPS), rc = __builtin_amdgcn_rsqf(pc * (1.f / DM) + EPS);
        const f32x4 pd = (PROBE_SEL >= 0) ? (f32x4){pdelta, -pdelta, pdelta, -pdelta} : (f32x4){0.f, 0.f, 0.f, 0.f};
#pragma unroll
        for (int j = 0; j < 2; ++j) {
            { const u32x4 r = va[j]; float* o = qf.out + (size_t)m * DM + 512 * j + 8 * lanef;
              f32x4 v0 = (f32x4){bflo(r.x), bfhi(r.x), bflo(r.y), bfhi(r.y)} * ra * gg[2 * j], v1 = (f32x4){bflo(r.z), bfhi(r.z), bflo(r.w), bfhi(r.w)} * ra * gg[2 * j + 1];
              if (PROBE_SEL >= 0 && m < 256) { v0 = v0 + pd; v1 = v1 + pd; }
              *(f32x4*)o = v0; *(f32x4*)(o + 4) = v1; }
            if (m2 != m) { const u32x4 r = vc[j]; float* o = qf.out + (size_t)m2 * DM + 512 * j + 8 * lanef;
              f32x4 v0 = (f32x4){bflo(r.x), bfhi(r.x), bflo(r.y), bfhi(r.y)} * rc * gg[2 * j], v1 = (f32x4){bflo(r.z), bfhi(r.z), bflo(r.w), bfhi(r.w)} * rc * gg[2 * j + 1];
              if (PROBE_SEL >= 0 && m2 < 256) { v0 = v0 + pd; v1 = v1 + pd; }
              *(f32x4*)o = v0; *(f32x4*)(o + 4) = v1; } }
    }
}

extern "C" void kernel_launch(void* const* d_in, const int* in_sizes, int n_in, void* d_out, int out_size, void* d_ws, size_t ws_size, hipStream_t stream) {
    static int grid_blocks = 0;
    if (grid_blocks == 0) {
        if (n_in != 15 || out_size != M * DM || ws_size < WS_END) { fprintf(stderr, "kernel_launch: unexpected shapes (n_in %d out %d ws %zu)\n", n_in, out_size, ws_size); grid_blocks = -1; return; }
        int dev = 0, cus = 0, per_cu = 0;
        hipGetDevice(&dev); hipDeviceGetAttribute(&cus, hipDeviceAttributeMultiprocessorCount, dev);
        hipFuncSetAttribute((const void*)fwd_megakernel, hipFuncAttributeMaxDynamicSharedMemorySize, LDS_BYTES);
        hipOccupancyMaxActiveBlocksPerMultiprocessor(&per_cu, (const void*)fwd_megakernel, NTHR, LDS_BYTES);
        if (per_cu < 1) { fprintf(stderr, "kernel_launch: occupancy query says %d blocks per CU\n", per_cu); per_cu = 1; }
        (void)hipGetLastError();
        grid_blocks = cus * 1;
    }
    if (grid_blocks < 0) return;
    Params p{};
    p.x = (const float*)d_in[0]; p.mix_g = (const float*)d_in[1]; p.w_in = (const float*)d_in[2]; p.hg_lb = (const float*)d_in[3]; p.hg_ng = (const float*)d_in[4];
    p.rpb = (const float*)d_in[5]; p.cw = (const float*)d_in[6]; p.cb = (const float*)d_in[7]; p.lng = (const float*)d_in[8]; p.lnb = (const float*)d_in[9];
    p.w_out = (const float*)d_in[10]; p.ffn_g = (const float*)d_in[11]; p.w_gu = (const float*)d_in[12]; p.w_dn = (const float*)d_in[13]; p.fin_g = (const float*)d_in[14];
    p.out = (float*)d_out; p.ws = (unsigned char*)d_ws;
    if (hipMemsetAsync(d_ws, 0, WS_CTL_BYTES, stream) != hipSuccess) { fprintf(stderr, "kernel_launch: hipMemsetAsync failed\n"); return; }
    void* args[] = {&p};
    hipError_t e = hipLaunchCooperativeKernel((const void*)fwd_megakernel, dim3(grid_blocks), dim3(NTHR), args, LDS_BYTES, stream);
    if (e != hipSuccess) fprintf(stderr, "cooperative launch failed: %s (grid %d)\n", hipGetErrorString(e), grid_blocks);
}
```

```cpp
#include <hip/hip_runtime.h>
#include <hip/hip_cooperative_groups.h>
#include <cstdio>
#include <cstdint>
namespace cg = cooperative_groups;

namespace pg8 {
#define PG8_LAS __attribute__((address_space(3)))
typedef unsigned short bf16_t;
typedef short bf16x8 __attribute__((ext_vector_type(8)));
typedef float f32x4 __attribute__((ext_vector_type(4)));
typedef unsigned u32x4 __attribute__((ext_vector_type(4)));
constexpr int BM = 256, BK = 64, HALF = 128, HTB = HALF * BK * 2  , STAGE_BYTES = 8 * HTB, NXCD = 8, WGM = 8;

__host__ __device__ __forceinline__ int lds_byte(int r, int c) { const int st = (r >> 4) * 2 + (c >> 5), rr = r & 15, cc = c & 31, ob = rr * 64 + cc * 2; return st * 1024 + (ob ^ (((ob >> 9) & 1) << 5)); }
__host__ __device__ __forceinline__ void stage_rc(int b, int& R, int& C) { const int st = b / 1024, sb = b % 1024, swz = sb ^ (((sb >> 9) & 1) << 5); R = (st >> 1) * 16 + swz / 64; C = (st & 1) * 32 + (swz % 64) / 2; }
__host__ __device__ __forceinline__ int perm32(int rho) { const int n = rho >> 4, i = rho & 15; return 8 * (i >> 2) + 4 * n + (i & 3); }

struct Unit { int pm, pn; };
struct Gemm { const bf16_t* A; const bf16_t* Bt; int M, N, K; };

struct StaticOrder {
    int nM, nN, nwg, G, c;
    __host__ __device__ void init(int M, int N, int G_, int c_) { nM = M / BM; nN = N / BM; nwg = nM * nN; G = G_; c = c_; }
    __host__ __device__ bool next(int i, Unit& u) const {
        const long L = (long)i * G + c; if (L >= nwg) return false;
        int wgid = (int)L; { const int q = nwg / NXCD, r = nwg % NXCD, xcd = wgid % NXCD, off = wgid / NXCD; wgid = (xcd < r ? xcd * (q + 1) : r * (q + 1) + (xcd - r) * q) + off; }
        const int nig = WGM * nN, gid = wgid / nig, fm = gid * WGM, gsz = (nM - fm) < WGM ? (nM - fm) : WGM;
        u.pm = fm + ((wgid % nig) % gsz); u.pn = (wgid % nig) / gsz; return true;
    }
    __device__ __forceinline__ void a_ready(const Unit&) const {}
    __device__ __forceinline__ void done(const Unit&) const {}
};
__device__ __forceinline__ unsigned cvt_pk_bf16(float lo, float hi) { unsigned r; asm volatile("v_cvt_pk_bf16_f32 %0, %1, %2" : "=v"(r) : "v"(lo), "v"(hi)); return r; }
typedef float f32x2 __attribute__((ext_vector_type(2)));
constexpr int MROWS = 16384, DMODEL = 1024, NPART = 16;
constexpr float NORM_EPS = 1e-6f;
__device__ __forceinline__ float row_rstd(const float* ssq, int row) {
    float s = 0.f;
#pragma unroll
    for (int p = 0; p < NPART; ++p) s += ssq[(size_t)p * MROWS + row];
    return __builtin_amdgcn_rsqf(s * (1.f / DMODEL) + NORM_EPS);
}
__device__ __forceinline__ float silu_f(float x) { return x * __builtin_amdgcn_rcpf(1.f + __expf(-x)); }

struct EpiScale {
    static constexpr bool PERM = true, AFTER_DRAIN = false;
    bf16_t* O; int ldc; const PG8_LAS float* RS; unsigned silu_mask;
    __device__ __forceinline__ void operator()(const f32x4 (&acc)[2][2][4][2], const Unit& u, int ui, int wr, int wc, int fr, int fq) const {
        const int row0 = u.pm * BM + wr * 64 + fr, col0 = u.pn * BM + wc * 32 + 8 * fq; const bool act = (silu_mask >> u.pn) & 1u;
#pragma unroll
        for (int ai = 0; ai < 2; ++ai)
#pragma unroll
            for (int m = 0; m < 4; ++m) { const int row = row0 + ai * HALF + m * 16; const float rs = RS[ui * BM + wr * 64 + fr + ai * HALF + m * 16]; bf16_t* rowp = O + (size_t)row * ldc + col0;
#pragma unroll
                for (int bj = 0; bj < 2; ++bj) { f32x4 v0 = acc[ai][bj][m][0] * rs, v1 = acc[ai][bj][m][1] * rs;
                    if (act) { v0 = (f32x4){silu_f(v0[0]), silu_f(v0[1]), silu_f(v0[2]), silu_f(v0[3])}; v1 = (f32x4){silu_f(v1[0]), silu_f(v1[1]), silu_f(v1[2]), silu_f(v1[3])}; }
                    u32x4 w; w.x = cvt_pk_bf16(v0[0], v0[1]); w.y = cvt_pk_bf16(v0[2], v0[3]); w.z = cvt_pk_bf16(v1[0], v1[1]); w.w = cvt_pk_bf16(v1[2], v1[3]);
                    *(u32x4*)(rowp + bj * HALF) = w; } __builtin_amdgcn_sched_barrier(0); }
    }
};
struct EpiRes {
    static constexpr bool PERM = true, AFTER_DRAIN = false;
    bf16_t* XB; float* ssq;
    __device__ __forceinline__ void operator()(const f32x4 (&acc)[2][2][4][2], const Unit& u, int ui, int wr, int wc, int fr, int fq) const {
        const int row0 = u.pm * BM + wr * 64 + fr, col0 = u.pn * BM + wc * 32 + 8 * fq;
#pragma unroll
        for (int ai = 0; ai < 2; ++ai)
#pragma unroll
            for (int mm = 0; mm < 4; mm += 2) {
                u32x4 rr[2][2];
#pragma unroll
                for (int q = 0; q < 2; ++q)
#pragma unroll
                    for (int bj = 0; bj < 2; ++bj) rr[q][bj] = *(const u32x4*)(XB + (size_t)(row0 + ai * HALF + (mm + q) * 16) * DMODEL + col0 + bj * HALF);
                __builtin_amdgcn_sched_barrier(0);
#pragma unroll
                for (int q = 0; q < 2; ++q) { const int m = mm + q, row = row0 + ai * HALF + m * 16; const size_t o = (size_t)row * DMODEL + col0; float sq = 0.f;
#pragma unroll
                    for (int bj = 0; bj < 2; ++bj) { const u32x4 r = rr[q][bj];
                        const f32x4 r0 = (f32x4){__builtin_bit_cast(float, r.x << 16), __builtin_bit_cast(float, r.x & 0xffff0000u), __builtin_bit_cast(float, r.y << 16), __builtin_bit_cast(float, r.y & 0xffff0000u)};
                        const f32x4 r1 = (f32x4){__builtin_bit_cast(float, r.z << 16), __builtin_bit_cast(float, r.z & 0xffff0000u), __builtin_bit_cast(float, r.w << 16), __builtin_bit_cast(float, r.w & 0xffff0000u)};
                        const f32x4 v0 = acc[ai][bj][m][0] + r0, v1 = acc[ai][bj][m][1] + r1;
                        u32x4 w; w.x = cvt_pk_bf16(v0[0], v0[1]); w.y = cvt_pk_bf16(v0[2], v0[3]); w.z = cvt_pk_bf16(v1[0], v1[1]); w.w = cvt_pk_bf16(v1[2], v1[3]);
                        *(u32x4*)(XB + o + bj * HALF) = w;
                        sq += (v0[0] * v0[0] + v0[1] * v0[1]) + (v0[2] * v0[2] + v0[3] * v0[3]) + (v1[0] * v1[0] + v1[1] * v1[1]) + (v1[2] * v1[2] + v1[3] * v1[3]); }
                    sq += __shfl_xor(sq, 16); sq += __shfl_xor(sq, 32);
                    if (fq == 0) ssq[(size_t)(u.pn * 4 + wc) * MROWS + row] = sq; }
                __builtin_amdgcn_sched_barrier(0); }
    }
};
struct EpiSwiGLU {
    static constexpr bool PERM = true, AFTER_DRAIN = false;
    bf16_t* O; int ldc; const PG8_LAS float* RS;
    __device__ __forceinline__ void operator()(const f32x4 (&acc)[2][2][4][2], const Unit& u, int ui, int wr, int wc, int fr, int fq) const {
        const int row0 = u.pm * BM + wr * 64 + fr, col0 = u.pn * HALF + wc * 32 + 8 * fq;
#pragma unroll
        for (int ai = 0; ai < 2; ++ai)
#pragma unroll
            for (int m = 0; m < 4; ++m) { const int row = row0 + ai * HALF + m * 16; const float rs = RS[ui * BM + wr * 64 + fr + ai * HALF + m * 16];
                const f32x4 g0 = acc[ai][0][m][0] * rs, g1 = acc[ai][0][m][1] * rs, u0 = acc[ai][1][m][0] * rs, u1 = acc[ai][1][m][1] * rs;
                u32x4 w; w.x = cvt_pk_bf16(silu_f(g0[0]) * u0[0], silu_f(g0[1]) * u0[1]); w.y = cvt_pk_bf16(silu_f(g0[2]) * u0[2], silu_f(g0[3]) * u0[3]);
                w.z = cvt_pk_bf16(silu_f(g1[0]) * u1[0], silu_f(g1[1]) * u1[1]); w.w = cvt_pk_bf16(silu_f(g1[2]) * u1[2], silu_f(g1[3]) * u1[3]);
                *(u32x4*)(O + (size_t)row * ldc + col0) = w; __builtin_amdgcn_sched_barrier(0); }
    }
};
template <class Sched> __device__ __forceinline__ void rstd_table(PG8_LAS float* RS, const float* ssq, const Sched& S) {
    int tx_ = threadIdx.x; asm volatile("" : "+v"(tx_));
    Unit u; const int t = tx_ & (BM - 1);
    for (int i = __builtin_amdgcn_readfirstlane(tx_ >> 8); S.next(i, u); i += 2) {
        float v[NPART];
#pragma unroll
        for (int p = 0; p < NPART; ++p) v[p] = ssq[(size_t)p * MROWS + u.pm * BM + t];
        __builtin_amdgcn_sched_barrier(0);
        const float s = (((v[0] + v[1]) + (v[2] + v[3])) + ((v[4] + v[5]) + (v[6] + v[7]))) + (((v[8] + v[9]) + (v[10] + v[11])) + ((v[12] + v[13]) + (v[14] + v[15])));
        RS[i * BM + t] = __builtin_amdgcn_rsqf(s * (1.f / DMODEL) + NORM_EPS);
    }
    __syncthreads();
}
template <class Epi, class Sched, bool ALIGN_EPI = false, bool SP2 = false>
__device__ __forceinline__ void gemm_phase(PG8_LAS unsigned char* lds, const Gemm g, const Sched& S, const Epi& E) {
    int tid_ = threadIdx.x; asm volatile("" : "+v"(tid_));
    const int tid = tid_, wid = __builtin_amdgcn_readfirstlane(tid >> 6), lane = tid & 63, wr = wid >> 2, wc = wid & 3, fr = lane & 15, fq = lane >> 4;
    const int K = g.K, nt = K / BK;
    unsigned voffA[2], voffB[2];
#pragma unroll
    for (int i = 0; i < 2; ++i) { int R, C; stage_rc(tid * 16 + i * 8192, R, C); const int Rb = Epi::PERM ? ((R & ~31) + perm32(R & 31)) : R;
        voffA[i] = (unsigned)(R * K + C) * 2u; voffB[i] = (unsigned)(Rb * K + C) * 2u; }
    const size_t kstep = (size_t)(BK * 2);
    const size_t hstep = (size_t)HALF * K * 2;
    const size_t tstep = 2 * hstep;
    const unsigned ldsw = (unsigned)wid * 1024u;
    const int aoff = lds_byte(wr * 64 + fr, fq * 8), boff = lds_byte(wc * 32 + fr, fq * 8);
#define PG8_SA(b, h) (((b) * 2 + (h)) * HTB)
#define PG8_SB(b, h) ((4 + (b) * 2 + (h)) * HTB)
#define PG8_STAGE(bufoff, gbase, voff) do { _Pragma("unroll") for (int _i = 0; _i < 2; ++_i) \
        __builtin_amdgcn_global_load_lds((const unsigned*)((const char*)(gbase) + (voff)[_i]), (PG8_LAS unsigned*)(lds + (bufoff) + ldsw + _i * 8192), 16, 0, 0); } while (0)
#define PG8_LDA(dst, b, h) do { _Pragma("unroll") for (int m = 0; m < 4; ++m) _Pragma("unroll") for (int k = 0; k < 2; ++k) dst[m][k] = *(const PG8_LAS bf16x8*)(lds + PG8_SA(b, h) + aoff + m * 2048 + k * 1024); } while (0)
#define PG8_LDB(dst, b, h) do { _Pragma("unroll") for (int n = 0; n < 2; ++n) _Pragma("unroll") for (int k = 0; k < 2; ++k) dst[n][k] = *(const PG8_LAS bf16x8*)(lds + PG8_SB(b, h) + boff + n * 2048 + k * 1024); } while (0)
#define PG8_MMA(ai, bj, At, Bt) do { __builtin_amdgcn_s_setprio(1); _Pragma("unroll") for (int m = 0; m < 4; ++m) _Pragma("unroll") for (int n = 0; n < 2; ++n) _Pragma("unroll") for (int k = 0; k < 2; ++k) \
        acc[ai][bj][m][n] = __builtin_amdgcn_mfma_f32_16x16x32_bf16(Bt[n][k], At[m][k], acc[ai][bj][m][n], 0, 0, 0); __builtin_amdgcn_s_setprio(0); } while (0)
#define PG8_WAIT_V(n) asm volatile("s_waitcnt vmcnt(" #n ")" ::: "memory")
#define PG8_WAIT_L(n) asm volatile("s_waitcnt lgkmcnt(" #n ")" ::: "memory")
#define PG8_BAR __builtin_amdgcn_s_barrier()
#define PG8_SCHED __builtin_amdgcn_sched_barrier(0)
    Unit cur, nxt; int ui = 0;
    if (!S.next(0, cur)) return;
    f32x4 acc[2][2][4][2];
#pragma unroll
    for (int a = 0; a < 2; ++a)
#pragma unroll
        for (int b = 0; b < 2; ++b)
#pragma unroll
            for (int m = 0; m < 4; ++m)
#pragma unroll
                for (int n = 0; n < 2; ++n) acc[a][b][m][n] = (f32x4){0.f, 0.f, 0.f, 0.f};
    bf16x8 At[4][2], B0[2][2], B1[2][2];
    const char* cA = (const char*)g.A + (size_t)cur.pm * tstep; const char* cB = (const char*)g.Bt + (size_t)cur.pn * tstep;
    S.a_ready(cur);
    if constexpr (SP2) {
        PG8_STAGE(PG8_SB(0, 0), cB, voffB); PG8_STAGE(PG8_SB(0, 1), cB + hstep, voffB); PG8_STAGE(PG8_SA(0, 0), cA, voffA); PG8_STAGE(PG8_SA(0, 1), cA + hstep, voffA);
        if (wr == 1) PG8_BAR;
        PG8_WAIT_V(2); PG8_BAR;
        PG8_STAGE(PG8_SB(1, 0), cB + kstep, voffB); PG8_STAGE(PG8_SA(1, 0), cA + kstep, voffA); PG8_STAGE(PG8_SB(1, 1), cB + hstep + kstep, voffB);
        PG8_WAIT_V(6); PG8_BAR;
    } else {
        PG8_STAGE(PG8_SB(0, 0), cB, voffB); PG8_STAGE(PG8_SA(0, 0), cA, voffA); PG8_STAGE(PG8_SB(0, 1), cB + hstep, voffB); PG8_STAGE(PG8_SA(0, 1), cA + hstep, voffA);
        if (wr == 1) PG8_BAR;
        PG8_WAIT_V(4); PG8_BAR;
        PG8_STAGE(PG8_SB(1, 0), cB + kstep, voffB); PG8_STAGE(PG8_SA(1, 0), cA + kstep, voffA); PG8_STAGE(PG8_SB(1, 1), cB + hstep + kstep, voffB);
        PG8_WAIT_V(6); PG8_BAR;
    }
    for (;;) {
        const bool has_next = S.next(ui + 1, nxt);
        const char* nA = has_next ? (const char*)g.A + (size_t)nxt.pm * tstep : cA; const char* nB = has_next ? (const char*)g.Bt + (size_t)nxt.pn * tstep : cB;
        for (int t = 0; t < nt; t += 2) {
            const bool last = (t == nt - 2);
            const char* a1 = cA + (size_t)(t + 1) * kstep;
            const char* a2 = last ? nA : cA + (size_t)(t + 2) * kstep; const char* b2 = last ? nB : cB + (size_t)(t + 2) * kstep;
            const char* a3 = a2 + kstep; const char* b3 = b2 + kstep;
            if (last && has_next) S.a_ready(nxt);
            if constexpr (SP2) {
            PG8_LDB(B0, 0, 0); PG8_LDB(B1, 0, 1); PG8_SCHED; PG8_LDA(At, 0, 0); PG8_STAGE(PG8_SA(1, 1), a1 + hstep, voffA);
            PG8_WAIT_V(8); PG8_WAIT_L(0); PG8_BAR; PG8_MMA(0, 0, At, B0); PG8_MMA(0, 1, At, B1); PG8_BAR; PG8_SCHED;
            PG8_LDA(At, 0, 1); PG8_STAGE(PG8_SB(0, 0), b2, voffB); PG8_STAGE(PG8_SB(0, 1), b2 + hstep, voffB); PG8_STAGE(PG8_SA(0, 0), a2, voffA);
            PG8_WAIT_V(8); PG8_WAIT_L(0); PG8_BAR; PG8_MMA(1, 0, At, B0); PG8_MMA(1, 1, At, B1); PG8_BAR; PG8_SCHED;
            PG8_LDB(B0, 1, 0); PG8_LDB(B1, 1, 1); PG8_SCHED; PG8_LDA(At, 1, 0); PG8_STAGE(PG8_SA(0, 1), a2 + hstep, voffA);
            PG8_WAIT_V(8); PG8_WAIT_L(0); PG8_BAR; PG8_MMA(0, 0, At, B0); PG8_MMA(0, 1, At, B1); PG8_BAR; PG8_SCHED;
            PG8_LDA(At, 1, 1); PG8_STAGE(PG8_SB(1, 0), b3, voffB); PG8_STAGE(PG8_SB(1, 1), b3 + hstep, voffB); PG8_STAGE(PG8_SA(1, 0), a3, voffA);
            PG8_WAIT_V(8); PG8_WAIT_L(0); PG8_BAR; PG8_MMA(1, 0, At, B0); PG8_MMA(1, 1, At, B1); PG8_BAR; PG8_SCHED;
            } else {
            PG8_LDB(B0, 0, 0); PG8_SCHED; PG8_LDA(At, 0, 0); PG8_STAGE(PG8_SA(1, 1), a1 + hstep, voffA);
            PG8_WAIT_L(8); PG8_BAR; PG8_WAIT_L(0); PG8_MMA(0, 0, At, B0); PG8_BAR; PG8_SCHED;
            PG8_LDB(B1, 0, 1); PG8_STAGE(PG8_SB(0, 0), b2, voffB);
            PG8_BAR; PG8_WAIT_L(0); PG8_MMA(0, 1, At, B1); PG8_BAR;
            PG8_LDA(At, 0, 1); PG8_STAGE(PG8_SA(0, 0), a2, voffA);
            PG8_BAR; PG8_WAIT_L(0); PG8_MMA(1, 0, At, B0); PG8_BAR; PG8_SCHED;
            PG8_STAGE(PG8_SB(0, 1), b2 + hstep, voffB);
            PG8_WAIT_V(6); PG8_BAR; PG8_MMA(1, 1, At, B1); PG8_BAR;
            PG8_LDB(B0, 1, 0); PG8_SCHED; PG8_LDA(At, 1, 0); PG8_STAGE(PG8_SA(0, 1), a2 + hstep, voffA);
            PG8_WAIT_L(8); PG8_BAR; PG8_WAIT_L(0); PG8_MMA(0, 0, At, B0); PG8_BAR; PG8_SCHED;
            PG8_LDB(B1, 1, 1); PG8_STAGE(PG8_SB(1, 0), b3, voffB);
            PG8_BAR; PG8_WAIT_L(0); PG8_MMA(0, 1, At, B1); PG8_BAR;
            PG8_LDA(At, 1, 1); PG8_STAGE(PG8_SA(1, 0), a3, voffA);
            PG8_BAR; PG8_WAIT_L(0); PG8_MMA(1, 0, At, B0); PG8_BAR; PG8_SCHED;
            PG8_STAGE(PG8_SB(1, 1), b3 + hstep, voffB);
            PG8_WAIT_V(6); PG8_BAR; PG8_MMA(1, 1, At, B1); PG8_BAR;
            }
        }
        if constexpr (ALIGN_EPI) { if (wr == 0) PG8_BAR; }
        if constexpr (!Epi::AFTER_DRAIN) { E(acc, cur, ui, wr, wc, fr, fq); S.done(cur); }
        if (!has_next) break;
#pragma unroll
        for (int a = 0; a < 2; ++a)
#pragma unroll
            for (int b = 0; b < 2; ++b)
#pragma unroll
                for (int m = 0; m < 4; ++m)
#pragma unroll
                    for (int n = 0; n < 2; ++n) acc[a][b][m][n] = (f32x4){0.f, 0.f, 0.f, 0.f};
        cur = nxt; cA = nA; cB = nB; ++ui;
        if constexpr (ALIGN_EPI) { if (wr == 1) PG8_BAR; }
    }
    PG8_WAIT_V(0);
    if constexpr (!ALIGN_EPI) { if (wr == 0) PG8_BAR; }
    PG8_BAR;
    if constexpr (Epi::AFTER_DRAIN) { E.fused(acc, cur, wr, wc, fr, fq, lds, wid, lane); S.done(cur); }
#undef PG8_SA
#undef PG8_SB
#undef PG8_STAGE
#undef PG8_LDA
#undef PG8_LDB
#undef PG8_MMA
#undef PG8_WAIT_V
#undef PG8_WAIT_L
#undef PG8_BAR
#undef PG8_SCHED
}
}
#ifndef PROBE_SEL
#define PROBE_SEL (-1)
#endif
#define PT_NOW() __builtin_amdgcn_s_memrealtime()
#define PT_WORDS_OFF 140304
#define PT_ACC(lds_, dt_) do { if (threadIdx.x == 0) { volatile __attribute__((address_space(3))) unsigned* a_ = (volatile __attribute__((address_space(3))) unsigned*)((lds_) + PT_WORDS_OFF); a_[0] = a_[0] + (unsigned)(dt_); } } while (0)
#define LAS __attribute__((address_space(3)))
typedef unsigned short bf16;
typedef float f32x4 __attribute__((ext_vector_type(4)));
typedef short bf16x8 __attribute__((ext_vector_type(8)));
typedef unsigned u32x4 __attribute__((ext_vector_type(4)));
typedef unsigned u32x2 __attribute__((ext_vector_type(2)));
constexpr int NWAVES = 8, NTHR = 512;
constexpr int BATCH = 8, SEQ = 2048, DM = 1024, M = BATCH * SEQ, DIN = 3840, FFN = 2816, DEPTH = 2;
constexpr int C_HQ = 0, C_HFF = 512, C_HI = 1536, C_HG = 2048, C_NQ = 2560, C_NK = 2816, C_NV = 3072, C_CA = 3328, C_CG = 3584;
constexpr int NSEG = 8, SEGLEN = SEQ / NSEG, CHS = SEGLEN / 32;
constexpr float EPS = 1e-6f;
constexpr size_t MiB = 1u << 20;
constexpr size_t WS_SSQ = 1 * MiB;
constexpr size_t WS_WIN = 2 * MiB, WS_WIN_L = (size_t)DIN * DM * 2;
constexpr size_t WS_WOUT = 17 * MiB, WS_WOUT_L = (size_t)DM * DM * 2;
constexpr size_t WS_WGU = 21 * MiB, WS_WGU_L = (size_t)2 * FFN * DM * 2;
constexpr size_t WS_WDN = 43 * MiB, WS_WDN_L = (size_t)DM * FFN * 2;
constexpr size_t WS_P = 54 * MiB;
constexpr size_t WS_MIX = 174 * MiB;
constexpr size_t WS_XB = 206 * MiB;
constexpr size_t WS_SLOC = 238 * MiB;
constexpr size_t WS_DSEG = 254 * MiB;
constexpr size_t WS_END = 255 * MiB;

__device__ __forceinline__ float bf2f(unsigned short h) { return __builtin_bit_cast(float, (unsigned)h << 16); }
__device__ __forceinline__ float bflo(unsigned w) { return __builtin_bit_cast(float, w << 16); }
__device__ __forceinline__ float bfhi(unsigned w) { return __builtin_bit_cast(float, w & 0xffff0000u); }
typedef float f32x2_t __attribute__((ext_vector_type(2)));
typedef __bf16 bf16x2_t __attribute__((ext_vector_type(2)));
__device__ __forceinline__ unsigned pk2(float lo, float hi) { const f32x2_t v = {lo, hi}; const bf16x2_t b = __builtin_convertvector(v, bf16x2_t); return __builtin_bit_cast(unsigned, b); }
__device__ __forceinline__ unsigned short f2bf(float v) { return (unsigned short)(pk2(v, 0.f) & 0xffffu); }
__device__ __forceinline__ float wave_sum(float v) {
#pragma unroll
    for (int o = 1; o < 64; o <<= 1) v += __shfl_xor(v, o);
    return v;
}
__device__ __forceinline__ float sigm(float x) { return __builtin_amdgcn_rcpf(1.f + __expf(-x)); }
__device__ __forceinline__ float silu_f0(float x) { return x * sigm(x); }
__device__ __forceinline__ f32x4 mfma16(bf16x8 a, bf16x8 b, f32x4 c) { return __builtin_amdgcn_mfma_f32_16x16x32_bf16(a, b, c, 0, 0, 0); }
#define LDS_WAIT() asm volatile("s_waitcnt lgkmcnt(0)" ::: "memory")

struct Params {
    const float *x, *mix_g, *w_in, *hg_lb, *hg_ng, *rpb, *cw, *cb, *lng, *lnb, *w_out, *ffn_g, *w_gu, *w_dn, *fin_g;
    float* out; unsigned char* ws;
};

__device__ __forceinline__ void transpose_item(const float* W, int K, int N, bf16* WT, const float* gk, bool gu, LAS float* scr, int item, int lane) {
    const int nblk = N / 64, kb = item / nblk, nb = item % nblk, k0 = 64 * kb, n0 = 64 * nb;
    const float gs = gk ? gk[k0 + lane] : 1.f;
    const float* src = W + (size_t)k0 * N + n0 + lane;
#pragma unroll
    for (int hh = 0; hh < 2; ++hh) {
        float wv[32];
#pragma unroll
        for (int i = 0; i < 32; ++i) wv[i] = src[(size_t)(32 * hh + i) * N];
        __builtin_amdgcn_sched_barrier(0);
#pragma unroll
        for (int i = 0; i < 32; ++i) scr[(32 * hh + i) * 65 + lane] = wv[i] * __shfl(gs, 32 * hh + i);
    }
    LDS_WAIT(); asm volatile("" ::: "memory");
    const int c = lane & 7;
    int r0 = n0;
    if (gu) { const int up = n0 >= FFN ? 1 : 0, cc = n0 - up * FFN; r0 = 256 * (cc >> 7) + (cc & 127) + up * 128; }
#pragma unroll
    for (int j = 0; j < 8; ++j) { const int n = (lane >> 3) + 8 * j; const LAS float* s = scr + (8 * c) * 65 + n;
        u32x4 o; o.x = pk2(s[0 * 65], s[1 * 65]); o.y = pk2(s[2 * 65], s[3 * 65]); o.z = pk2(s[4 * 65], s[5 * 65]); o.w = pk2(s[6 * 65], s[7 * 65]);
        *(u32x4*)(WT + (size_t)(r0 + n) * K + k0 + 8 * c) = o; }
    LDS_WAIT(); asm volatile("" ::: "memory");
}
constexpr int I_IN = (DM / 64) * (DIN / 64), I_OUT = (DM / 64) * (DM / 64), I_GU = (DM / 64) * (2 * FFN / 64), I_DN = (FFN / 64) * (DM / 64), I_L = I_IN + I_OUT + I_GU + I_DN;
__device__ __forceinline__ void convert_weights(const Params& p, LAS unsigned char* lds, int lo, int hi, int w0, int nw, int wave, int lane) {
    LAS float* scr = (LAS float*)(lds + wave * 16640);
    for (int it = lo + w0; it < hi; it += nw) {
        const int l = it / I_L; int r = it % I_L;
        if (r < I_IN) { transpose_item(p.w_in + (size_t)l * DM * DIN, DM, DIN, (bf16*)(p.ws + WS_WIN + l * WS_WIN_L), p.mix_g + l * DM, false, scr, r, lane); continue; } r -= I_IN;
        if (r < I_OUT) { transpose_item(p.w_out + (size_t)l * DM * DM, DM, DM, (bf16*)(p.ws + WS_WOUT + l * WS_WOUT_L), nullptr, false, scr, r, lane); continue; } r -= I_OUT;
        if (r < I_GU) { transpose_item(p.w_gu + (size_t)l * DM * 2 * FFN, DM, 2 * FFN, (bf16*)(p.ws + WS_WGU + l * WS_WGU_L), p.ffn_g + l * DM, true, scr, r, lane); continue; } r -= I_GU;
        transpose_item(p.w_dn + (size_t)l * FFN * DM, FFN, DM, (bf16*)(p.ws + WS_WDN + l * WS_WDN_L), nullptr, false, scr, r, lane);
    }
}
__device__ __forceinline__ void prologue(const Params& p, LAS unsigned char* lds, int gw, int NGW, int wave, int lane) {
    convert_weights(p, lds, 0, I_IN, gw, NGW, wave, lane);
    bf16* XB = (bf16*)(p.ws + WS_XB); float* ssq = (float*)(p.ws + WS_SSQ);
    for (int m = gw; m < M; m += 2 * NGW) {
        const int m2 = m + NGW;
        const f32x4* xa = (const f32x4*)(p.x + (size_t)m * DM) + lane; const f32x4* xc = (const f32x4*)(p.x + (size_t)(m2 < M ? m2 : m) * DM) + lane;
        f32x4 va[4], vc[4];
#pragma unroll
        for (int j = 0; j < 4; ++j) { va[j] = xa[64 * j]; vc[j] = xc[64 * j]; }
        __builtin_amdgcn_sched_barrier(0);
        float sa = 0.f, sc = 0.f;
        unsigned long long* oa = (unsigned long long*)(XB + (size_t)m * DM) + lane; unsigned long long* oc = (unsigned long long*)(XB + (size_t)m2 * DM) + lane;
#pragma unroll
        for (int j = 0; j < 4; ++j) { sa += (va[j].x * va[j].x + va[j].y * va[j].y) + (va[j].z * va[j].z + va[j].w * va[j].w); sc += (vc[j].x * vc[j].x + vc[j].y * vc[j].y) + (vc[j].z * vc[j].z + vc[j].w * vc[j].w);
            oa[64 * j] = (unsigned long long)pk2(va[j].x, va[j].y) | ((unsigned long long)pk2(va[j].z, va[j].w) << 32);
            if (m2 < M) oc[64 * j] = (unsigned long long)pk2(vc[j].x, vc[j].y) | ((unsigned long long)pk2(vc[j].z, vc[j].w) << 32); }
        sa = wave_sum(sa); sc = wave_sum(sc);
        if (lane < 16) { ssq[(size_t)lane * M + m] = lane == 0 ? sa : 0.f; if (m2 < M) ssq[(size_t)lane * M + m2] = lane == 0 ? sc : 0.f; }
    }
}

constexpr int HS_SET = 37888, HQ_OFF = 0, HK_OFF = 8704, HKH_OFF = 17408, HV_OFF = 27648;
constexpr int HOS_OFF = 2 * HS_SET, HOS_SZ = 16896, HDEC_OFF = HOS_OFF + 2 * HOS_SZ;
#define WG_BAR() asm volatile("s_waitcnt lgkmcnt(0)\n\ts_barrier" ::: "memory")
template <bool FULL, bool SECOND>
__device__ __forceinline__ void hg_segment(LAS unsigned char* lds, const bf16* P, int b, int h, int dir, int seg, float lb, f32x4 (&S)[8], float& bsum,
                                           float* OP, bf16* MIXED, const float* norm_g) {
    int tid_ = threadIdx.x; asm volatile("" : "+v"(tid_)); const int tid = tid_, w = __builtin_amdgcn_readfirstlane(tid >> 6), lane = tid & 63, fr = lane & 15, fq = lane >> 4;
    unsigned long long tk0 = 0;
    const int d = 16 * w + (lane & 15), grp = lane >> 4;
    const int zcol = C_HFF + dir * 512 + h * 128 + d, qcol = C_HQ + h * 128 + d, vcol = C_HI + h * 128 + d;
    const float oml = 1.f - lb;
    const int ts = dir == 0 ? 1 : -1, tb0 = dir == 0 ? seg * SEGLEN : (seg * SEGLEN + SEGLEN - 1);
    const long rstep = (long)ts * DIN;
    const int fc = tid >> 4, dvg = tid & 15;
    f32x4 ng0 = (f32x4){0.f, 0.f, 0.f, 0.f}, ng1 = ng0;
    if (FULL && SECOND) { ng0 = *(const f32x4*)(norm_g + 8 * dvg); ng1 = *(const f32x4*)(norm_g + 8 * dvg + 4); }
    unsigned short zn[8], qn[8], vn[8];
#define HG_LOAD(n_) do { const bf16* rowp_ = P + (size_t)(b * SEQ + tb0 + ts * (32 * (n_) + 8 * grp)) * DIN; \
        _Pragma("unroll") for (int e = 0; e < 8; ++e) { const bf16* r_ = rowp_ + rstep * e; zn[e] = r_[zcol]; if (FULL) qn[e] = r_[qcol]; else qn[e] = 0; vn[e] = r_[vcol]; } } while (0)
#define HG_PREP(s_) do { LAS unsigned char* set_ = lds + (s_) * HS_SET; LAS bf16* QT_ = (LAS bf16*)(set_ + HQ_OFF); LAS bf16* KT_ = (LAS bf16*)(set_ + HK_OFF); \
        f32x2_t Ev[4], kvv[4]; float run = 1.f;                                     \
        _Pragma("unroll") for (int e2 = 0; e2 < 4; ++e2) { \
            f32x2_t z = {__builtin_amdgcn_fmed3f(bf2f(zn[2 * e2]), -40.f, 40.f), __builtin_amdgcn_fmed3f(bf2f(zn[2 * e2 + 1]), -40.f, 40.f)}; \
            const f32x2_t t = z * (-1.4426950408889634f); const f32x2_t den = (f32x2_t){__builtin_amdgcn_exp2f(t.x), __builtin_amdgcn_exp2f(t.y)} + 1.0f; \
            const f32x2_t inv = {__builtin_amdgcn_rcpf(den.x), __builtin_amdgcn_rcpf(den.y)};              \
            const f32x2_t fv = inv * oml + lb; kvv[e2] = inv * (-oml) + oml;                                  \
            run *= fv.x; Ev[e2].x = run; run *= fv.y; Ev[e2].y = run; } \
        float pre = 1.f, tot = 1.f; \
        _Pragma("unroll") for (int g2 = 0; g2 < 4; ++g2) { const float t = __shfl(run, (g2 << 4) | (lane & 15)); tot *= t; if (g2 < grp) pre *= t; } \
        unsigned khp[4], vvp[4]; \
        _Pragma("unroll") for (int e2 = 0; e2 < 4; ++e2) { const f32x2_t E = Ev[e2] * pre; const f32x2_t r = {__builtin_amdgcn_rcpf(E.x), __builtin_amdgcn_rcpf(E.y)}; const f32x2_t kt = kvv[e2] * r; \
            if (FULL) { const int c0 = 8 * grp + 2 * e2; const f32x2_t qs = (f32x2_t){bf2f(qn[2 * e2]), bf2f(qn[2 * e2 + 1])} * E; const unsigned qw = pk2(qs.x, qs.y), kw = pk2(kt.x, kt.y); \
                QT_[c0 * 136 + d] = (bf16)(qw & 0xffffu); QT_[(c0 + 1) * 136 + d] = (bf16)(qw >> 16); KT_[c0 * 136 + d] = (bf16)(kw & 0xffffu); KT_[(c0 + 1) * 136 + d] = (bf16)(kw >> 16); } \
            const f32x2_t kh = kt * tot; khp[e2] = pk2(kh.x, kh.y); vvp[e2] = (unsigned)vn[2 * e2] | ((unsigned)vn[2 * e2 + 1] << 16); } \
        *(LAS u32x4*)((LAS bf16*)(set_ + HKH_OFF) + d * 40 + 8 * grp) = (u32x4){khp[0], khp[1], khp[2], khp[3]}; \
        *(LAS u32x4*)((LAS bf16*)(set_ + HV_OFF) + d * 40 + 8 * grp) = (u32x4){vvp[0], vvp[1], vvp[2], vvp[3]}; \
        if (grp == 0) { ((LAS float*)(lds + HDEC_OFF))[(s_) * 128 + d] = tot; bsum *= tot; } } while (0)
    HG_LOAD(0);
    __builtin_amdgcn_sched_barrier(0);
    HG_PREP(0);
    __builtin_amdgcn_sched_barrier(0);
    if (CHS > 1) HG_LOAD(1);
    WG_BAR();
#pragma unroll 1
    for (int n = 0; n < CHS; ++n) {
        const int tb = tb0 + ts * 32 * n, cs = n & 1;
        const int ftok = tb + ts * fc;
        f32x4 op0 = (f32x4){0.f, 0.f, 0.f, 0.f}, op1 = op0; u32x4 gw4 = (u32x4){0u, 0u, 0u, 0u};
        float* op = OP + ((size_t)((b * 4 + h) * SEQ + ftok)) * 128 + 8 * dvg;
        if (FULL && SECOND) { op0 = *(const f32x4*)op; op1 = *(const f32x4*)(op + 4); gw4 = *(const u32x4*)(P + (size_t)(b * SEQ + ftok) * DIN + C_HG + h * 128 + 8 * dvg); }
        __builtin_amdgcn_sched_barrier(0);
#pragma unroll 1
        for (int ph = 0; ph < 2; ++ph) {
        if ((ph == 0) == (w < 4)) { if (PROBE_SEL == 13) tk0 = PT_NOW(); if (n + 1 < CHS) { HG_PREP(cs ^ 1); __builtin_amdgcn_sched_barrier(0); if (n + 2 < CHS) HG_LOAD(n + 2); } if (PROBE_SEL == 13) PT_ACC(lds, PT_NOW() - tk0); }
        else {
        if (PROBE_SEL == 14) tk0 = PT_NOW();
        LAS unsigned char* set = lds + cs * HS_SET;
        LAS bf16* QT = (LAS bf16*)(set + HQ_OFF); LAS bf16* KT = (LAS bf16*)(set + HK_OFF); LAS bf16* KHT = (LAS bf16*)(set + HKH_OFF); LAS bf16* VT = (LAS bf16*)(set + HV_OFF);
        LAS float* OS = (LAS float*)(lds + HOS_OFF + cs * HOS_SZ); LAS float* DEC = (LAS float*)(lds + HDEC_OFF) + cs * 128;
        if (FULL) {
            f32x4 p00 = (f32x4){0.f, 0.f, 0.f, 0.f}, p01 = p00, p11 = p00;
#pragma unroll
            for (int ks = 0; ks < 4; ++ks) {
                const bf16x8 k0 = *(const LAS bf16x8*)(KT + fr * 136 + 32 * ks + 8 * fq), k1 = *(const LAS bf16x8*)(KT + (16 + fr) * 136 + 32 * ks + 8 * fq);
                const bf16x8 q0 = *(const LAS bf16x8*)(QT + fr * 136 + 32 * ks + 8 * fq), q1 = *(const LAS bf16x8*)(QT + (16 + fr) * 136 + 32 * ks + 8 * fq);
                p00 = mfma16(k0, q0, p00); p01 = mfma16(k0, q1, p01); p11 = mfma16(k1, q1, p11); }
#pragma unroll
            for (int i = 0; i < 4; ++i) { const bool keep = 4 * fq + i <= fr; p00[i] = keep ? p00[i] : 0.f; p11[i] = keep ? p11[i] : 0.f; }
            const bf16x8 pf0 = __builtin_bit_cast(bf16x8, (u32x4){pk2(p00[0], p00[1]), pk2(p00[2], p00[3]), 0u, 0u});
            const bf16x8 pf1 = __builtin_bit_cast(bf16x8, (u32x4){pk2(p01[0], p01[1]), pk2(p01[2], p01[3]), pk2(p11[0], p11[1]), pk2(p11[2], p11[3])});
            f32x4 o0 = (f32x4){0.f, 0.f, 0.f, 0.f}, o1 = o0;
#pragma unroll
            for (int ks = 0; ks < 4; ++ks) {
                const bf16x8 sa = __builtin_bit_cast(bf16x8, (u32x4){pk2(S[2 * ks][0], S[2 * ks][1]), pk2(S[2 * ks][2], S[2 * ks][3]), pk2(S[2 * ks + 1][0], S[2 * ks + 1][1]), pk2(S[2 * ks + 1][2], S[2 * ks + 1][3])});
                const u32x2 a0 = *(const LAS u32x2*)(QT + fr * 136 + 32 * ks + 4 * fq), a1 = *(const LAS u32x2*)(QT + fr * 136 + 32 * ks + 16 + 4 * fq);
                const u32x2 c0 = *(const LAS u32x2*)(QT + (16 + fr) * 136 + 32 * ks + 4 * fq), c1 = *(const LAS u32x2*)(QT + (16 + fr) * 136 + 32 * ks + 16 + 4 * fq);
                o0 = mfma16(sa, __builtin_bit_cast(bf16x8, (u32x4){a0.x, a0.y, a1.x, a1.y}), o0);
                o1 = mfma16(sa, __builtin_bit_cast(bf16x8, (u32x4){c0.x, c0.y, c1.x, c1.y}), o1); }
            { const u32x2 v0 = *(const LAS u32x2*)(VT + (16 * w + fr) * 40 + 4 * fq), v1 = *(const LAS u32x2*)(VT + (16 * w + fr) * 40 + 16 + 4 * fq);
              const bf16x8 va = __builtin_bit_cast(bf16x8, (u32x4){v0.x, v0.y, v1.x, v1.y});
              o0 = mfma16(va, pf0, o0); o1 = mfma16(va, pf1, o1); }
            *(LAS f32x4*)(OS + fr * 132 + 16 * w + 4 * fq) = o0; *(LAS f32x4*)(OS + (16 + fr) * 132 + 16 * w + 4 * fq) = o1;
        }
        { const bf16x8 vfr = *(const LAS bf16x8*)(VT + (16 * w + fr) * 40 + 8 * fq);
#pragma unroll
          for (int i = 0; i < 8; ++i) { const f32x4 dv4 = *(const LAS f32x4*)(DEC + 16 * i + 4 * fq); S[i] = S[i] * dv4;
              S[i] = mfma16(*(const LAS bf16x8*)(KHT + (16 * i + fr) * 40 + 8 * fq), vfr, S[i]); } }
        if (PROBE_SEL == 14) PT_ACC(lds, PT_NOW() - tk0);
        } }
        if (PROBE_SEL == 15) tk0 = PT_NOW();
        WG_BAR();
        if (PROBE_SEL == 15) PT_ACC(lds, PT_NOW() - tk0);
        if (FULL) {
            LAS float* OS = (LAS float*)(lds + HOS_OFF + cs * HOS_SZ);
            f32x4 o0 = *(const LAS f32x4*)(OS + fc * 132 + 8 * dvg), o1 = *(const LAS f32x4*)(OS + fc * 132 + 8 * dvg + 4);
            if (!SECOND) { *(f32x4*)op = o0; *(f32x4*)(op + 4) = o1; }
            else { o0 = o0 + op0; o1 = o1 + op1;
                float sq = (o0[0] * o0[0] + o0[1] * o0[1]) + (o0[2] * o0[2] + o0[3] * o0[3]) + (o1[0] * o1[0] + o1[1] * o1[1]) + (o1[2] * o1[2] + o1[3] * o1[3]);
                sq += __shfl_xor(sq, 1); sq += __shfl_xor(sq, 2); sq += __shfl_xor(sq, 4); sq += __shfl_xor(sq, 8);
                const float rs = __builtin_amdgcn_rsqf(sq * (1.f / 128.f) + EPS);
                u32x4 ow; ow.x = pk2(o0[0] * rs * ng0[0] * bflo(gw4.x), o0[1] * rs * ng0[1] * bfhi(gw4.x));
                ow.y = pk2(o0[2] * rs * ng0[2] * bflo(gw4.y), o0[3] * rs * ng0[3] * bfhi(gw4.y));
                ow.z = pk2(o1[0] * rs * ng1[0] * bflo(gw4.z), o1[1] * rs * ng1[1] * bfhi(gw4.z));
                ow.w = pk2(o1[2] * rs * ng1[2] * bflo(gw4.w), o1[3] * rs * ng1[3] * bfhi(gw4.w));
                *(u32x4*)(MIXED + (size_t)(b * SEQ + ftok) * DM + h * 128 + 8 * dvg) = ow; }
        }
    }
    WG_BAR();
#undef HG_LOAD
#undef HG_PREP
}
__device__ __forceinline__ float hg_lb(const float* hg_lb_all, int layer, int dir, int ch) {
    if (layer == 0) return 0.f;
    const float a0 = hg_lb_all[(0 * 2 + dir) * 512 + ch], a1 = hg_lb_all[(1 * 2 + dir) * 512 + ch], mx = fmaxf(a0, a1), e0 = __expf(a0 - mx), e1 = __expf(a1 - mx);
    return e1 / (e0 + e1);
}
__device__ __forceinline__ void hg_passA_item(LAS unsigned char* lds, const Params& p, int layer, int item) {
    const int dir = item & 1, seg = (item >> 1) & (NSEG - 1), h = (item >> 4) & 3, b = item >> 6;
    if ((dir == 0 && seg == NSEG - 1) || (dir == 1 && seg == 0)) return;
    int tid_ = threadIdx.x; asm volatile("" : "+v"(tid_)); const int tid = tid_, w = __builtin_amdgcn_readfirstlane(tid >> 6), lane = tid & 63;
    const float lb = hg_lb(p.hg_lb, layer, dir, h * 128 + 16 * w + (lane & 15));
    f32x4 S[8];
#pragma unroll
    for (int i = 0; i < 8; ++i) S[i] = (f32x4){0.f, 0.f, 0.f, 0.f};
    float bsum = 1.f;
    hg_segment<false, false>(lds, (const bf16*)(p.ws + WS_P), b, h, dir, seg, lb, S, bsum, nullptr, nullptr, nullptr);
    u32x2* sl = (u32x2*)(p.ws + WS_SLOC) + (size_t)item * 4096;
#pragma unroll
    for (int i = 0; i < 8; ++i) sl[(w * 8 + i) * 64 + lane] = (u32x2){pk2(S[i][0], S[i][1]), pk2(S[i][2], S[i][3])};
    if (lane < 16) ((float*)(p.ws + WS_DSEG))[(size_t)item * 128 + 16 * w + (lane & 15)] = bsum;
    __syncthreads();
}
__device__ __forceinline__ unsigned long long hg_passB_item(LAS unsigned char* lds, const Params& p, int layer, int item) {
    unsigned long long tsub = 0, t0_ = 0;
    const int seg = item & (NSEG - 1), h = (item >> 3) & 3, b = item >> 5;
    int tid_ = threadIdx.x; asm volatile("" : "+v"(tid_)); const int tid = tid_, w = __builtin_amdgcn_readfirstlane(tid >> 6), lane = tid & 63, fr = lane & 15, fq = lane >> 4;
    const u32x2* slb = (const u32x2*)(p.ws + WS_SLOC); const float* dsg = (const float*)(p.ws + WS_DSEG);
    float* OP = p.out;   bf16* MIXED = (bf16*)(p.ws + WS_MIX); const bf16* P = (const bf16*)(p.ws + WS_P);
#pragma unroll 1
    for (int dir = 0; dir < 2; ++dir) {
        const float lb = hg_lb(p.hg_lb, layer, dir, h * 128 + 16 * w + (lane & 15));
        f32x4 S[8];
#pragma unroll
        for (int i = 0; i < 8; ++i) S[i] = (f32x4){0.f, 0.f, 0.f, 0.f};
        const int nprev = dir == 0 ? seg : (NSEG - 1 - seg);
        if (PROBE_SEL == 11) t0_ = PT_NOW();
#pragma unroll 1
        for (int q = 0; q < nprev; q += 2) {
            const bool two = q + 1 < nprev; const int sA = dir == 0 ? q : (NSEG - 1 - q), sB = two ? (dir == 0 ? q + 1 : (NSEG - 2 - q)) : sA;
            const int itA = ((b * 4 + h) * NSEG + sA) * 2 + dir, itB = ((b * 4 + h) * NSEG + sB) * 2 + dir;
            const u32x2* slA = slb + (size_t)itA * 4096; const float* dcA = dsg + (size_t)itA * 128; const u32x2* slB = slb + (size_t)itB * 4096; const float* dcB = dsg + (size_t)itB * 128;
            f32x4 dvA[8], dvB[8]; u32x2 svA[8], svB[8];
#pragma unroll
            for (int i = 0; i < 8; ++i) { dvA[i] = *(const f32x4*)(dcA + 16 * i + 4 * fq); svA[i] = slA[(w * 8 + i) * 64 + lane]; dvB[i] = *(const f32x4*)(dcB + 16 * i + 4 * fq); svB[i] = slB[(w * 8 + i) * 64 + lane]; }
            __builtin_amdgcn_sched_barrier(0);
#pragma unroll
            for (int i = 0; i < 8; ++i) { S[i] = S[i] * dvA[i] + (f32x4){bflo(svA[i].x), bfhi(svA[i].x), bflo(svA[i].y), bfhi(svA[i].y)};
                if (two) S[i] = S[i] * dvB[i] + (f32x4){bflo(svB[i].x), bfhi(svB[i].x), bflo(svB[i].y), bfhi(svB[i].y)}; } }
        if (PROBE_SEL == 11) PT_ACC(lds, PT_NOW() - t0_);
        if (PROBE_SEL == 10) t0_ = PT_NOW();
        float bsum = 1.f;
        if (dir == 0) hg_segment<true, false>(lds, P, b, h, 0, seg, lb, S, bsum, OP, MIXED, p.hg_ng + layer * 128);
        else hg_segment<true, true>(lds, P, b, h, 1, seg, lb, S, bsum, OP, MIXED, p.hg_ng + layer * 128);
        if (PROBE_SEL == 10) PT_ACC(lds, PT_NOW() - t0_);
        if (PROBE_SEL == 12) t0_ = PT_NOW();
        __syncthreads();
        if (PROBE_SEL == 12) PT_ACC(lds, PT_NOW() - t0_);
    }
    return tsub;
}

constexpr int NA_KS = 584, NA_RPB_OFF = 64 * NA_KS * 2;
__device__ __forceinline__ int clampi(int v, int lo, int hi) { return v < lo ? lo : (v > hi ? hi : v); }
__device__ __forceinline__ void na_item(LAS unsigned char* lds, const Params& p, int layer, int item) {
    const int rp = item & 15, h = (item >> 4) & 3, b = item >> 6, r0 = 2 * rp, kbase = clampi(r0 - 4, 0, 24);
    int tid_ = threadIdx.x; asm volatile("" : "+v"(tid_)); const int tid = tid_, w = __builtin_amdgcn_readfirstlane(tid >> 6), lane = tid & 63, fr = lane & 15, fq = lane >> 4;
    const bf16* P = (const bf16*)(p.ws + WS_P); bf16* MIXED = (bf16*)(p.ws + WS_MIX);
    LAS bf16* VT = (LAS bf16*)lds; LAS float* RPB = (LAS float*)(lds + NA_RPB_OFF);
    const int rl = w >> 2, j = w & 3, r = r0 + rl, kr0 = clampi(r - 4, 0, 24), kc0 = clampi(16 * j - 8, 0, 32);
    const size_t qtok = (size_t)b * SEQ + r * 64 + 16 * j + fr;
    unsigned long long tn0_ = 0; if (PROBE_SEL >= 20 && PROBE_SEL <= 24) tn0_ = PT_NOW();
    const float rpbv = tid < 465 ? p.rpb[(size_t)(layer * 4 + h) * 465 + tid] : 0.f;
    u32x4 vbuf[9];
#pragma unroll
    for (int it = 0; it < 9; ++it) { const int key = it * 64 + w * 8 + (lane >> 3), dg = lane & 7; int trow = kbase * 64 + key; trow = trow > SEQ - 1 ? SEQ - 1 : trow;
        vbuf[it] = *(const u32x4*)(P + (size_t)(b * SEQ + trow) * DIN + C_NV + h * 64 + 8 * dg); }
    bf16x8 qf[2], kfa[16], kfb[16];
#pragma unroll
    for (int ks = 0; ks < 2; ++ks) qf[ks] = *(const bf16x8*)(P + qtok * DIN + C_NQ + h * 64 + 32 * ks + 8 * fq);
#define NA_KLOAD(dst, hh) do { _Pragma("unroll") for (int k8 = 0; k8 < 8; ++k8) { const int kt = (hh) * 8 + k8, krl = kt >> 1, half = kt & 1; \
        const size_t ktok = (size_t)b * SEQ + (kr0 + krl) * 64 + kc0 + 16 * half + fr; \
        _Pragma("unroll") for (int ks = 0; ks < 2; ++ks) dst[k8 * 2 + ks] = *(const bf16x8*)(P + ktok * DIN + C_NK + h * 64 + 32 * ks + 8 * fq); } } while (0)
    NA_KLOAD(kfa, 0);
    __builtin_amdgcn_sched_barrier(0);
#pragma unroll
    for (int it = 0; it < 9; ++it) { const int key = it * 64 + w * 8 + (lane >> 3), dg = lane & 7; const u32x4 v = vbuf[it];
        LAS bf16* dst = VT + (8 * dg) * NA_KS + (key ^ (dg << 3));
        dst[0 * NA_KS] = (bf16)(v.x & 0xffffu); dst[1 * NA_KS] = (bf16)(v.x >> 16); dst[2 * NA_KS] = (bf16)(v.y & 0xffffu); dst[3 * NA_KS] = (bf16)(v.y >> 16);
        dst[4 * NA_KS] = (bf16)(v.z & 0xffffu); dst[5 * NA_KS] = (bf16)(v.z >> 16); dst[6 * NA_KS] = (bf16)(v.w & 0xffffu); dst[7 * NA_KS] = (bf16)(v.w >> 16); }
    if (tid < 465) RPB[tid] = rpbv;
    if (PROBE_SEL == 20) { LDS_WAIT(); PT_ACC(lds, PT_NOW() - tn0_); } if (PROBE_SEL == 21) tn0_ = PT_NOW();
    NA_KLOAD(kfb, 1);
    __builtin_amdgcn_sched_barrier(0);
    WG_BAR();
    if (PROBE_SEL == 21) PT_ACC(lds, PT_NOW() - tn0_); if (PROBE_SEL == 22) tn0_ = PT_NOW();
    f32x4 s[16];
#pragma unroll
    for (int k8 = 0; k8 < 8; ++k8) { f32x4 a = (f32x4){0.f, 0.f, 0.f, 0.f};
#pragma unroll
        for (int ks = 0; ks < 2; ++ks) a = mfma16(kfa[k8 * 2 + ks], qf[ks], a);
        s[k8] = a; }
#pragma unroll
    for (int k8 = 0; k8 < 8; ++k8) { f32x4 a = (f32x4){0.f, 0.f, 0.f, 0.f};
#pragma unroll
        for (int ks = 0; ks < 2; ++ks) a = mfma16(kfb[k8 * 2 + ks], qf[ks], a);
        s[8 + k8] = a; }
#undef NA_KLOAD
    if (PROBE_SEL == 22) { asm volatile("" :: "v"(s[15][0]), "v"(s[7][0])); PT_ACC(lds, PT_NOW() - tn0_); } if (PROBE_SEL == 23) tn0_ = PT_NOW();
    const int qc = 16 * j + fr, qs = clampi(qc - 8, 0, 48);
    float mx = -1e30f;
#pragma unroll
    for (int kt = 0; kt < 16; ++kt) { const int krl = kt >> 1, half = kt & 1; const int ridx = kr0 + krl - r + 7;
        float bz[4];
#pragma unroll
        for (int i = 0; i < 4; ++i) { const int kc = kc0 + 16 * half + 4 * fq + i; bz[i] = RPB[ridx * 31 + clampi(kc - qc + 15, 0, 30)]; }
#pragma unroll
        for (int i = 0; i < 4; ++i) { const int kc = kc0 + 16 * half + 4 * fq + i; const bool valid = kc >= qs && kc < qs + 16;
            const float v = valid ? s[kt][i] * 0.125f + bz[i] : -1e30f; s[kt][i] = v; mx = fmaxf(mx, v); } }
    mx = fmaxf(mx, __shfl_xor(mx, 16)); mx = fmaxf(mx, __shfl_xor(mx, 32));
    float sum = 0.f;
#pragma unroll
    for (int kt = 0; kt < 16; ++kt)
#pragma unroll
        for (int i = 0; i < 4; ++i) { const float e = __expf(s[kt][i] - mx); s[kt][i] = e; sum += e; }
    sum += __shfl_xor(sum, 16); sum += __shfl_xor(sum, 32);
    if (PROBE_SEL == 23) { asm volatile("" :: "v"(sum)); PT_ACC(lds, PT_NOW() - tn0_); } if (PROBE_SEL == 24) tn0_ = PT_NOW();
    f32x4 o[4];
#pragma unroll
    for (int dt = 0; dt < 4; ++dt) o[dt] = (f32x4){0.f, 0.f, 0.f, 0.f};
#pragma unroll
    for (int kk = 0; kk < 8; ++kk) {
        const u32x4 pw = (u32x4){pk2(s[2 * kk][0], s[2 * kk][1]), pk2(s[2 * kk][2], s[2 * kk][3]), pk2(s[2 * kk + 1][0], s[2 * kk + 1][1]), pk2(s[2 * kk + 1][2], s[2 * kk + 1][3])};
        const bf16x8 pf = __builtin_bit_cast(bf16x8, pw);
        const int keyoff = (kr0 + kk - kbase) * 64 + kc0 + 4 * fq;
#pragma unroll
        for (int dt = 0; dt < 4; ++dt) { const int sw = (2 * dt + (fr >> 3)) << 3;
            const u32x2 lo = *(const LAS u32x2*)(VT + (16 * dt + fr) * NA_KS + (keyoff ^ sw)), hi = *(const LAS u32x2*)(VT + (16 * dt + fr) * NA_KS + ((keyoff + 16) ^ sw));
            const bf16x8 vf = __builtin_bit_cast(bf16x8, (u32x4){lo.x, lo.y, hi.x, hi.y});
            o[dt] = mfma16(vf, pf, o[dt]); } }
    const float inv = 1.f / sum;
#pragma unroll
    for (int dt = 0; dt < 4; ++dt) *(u32x2*)(MIXED + qtok * DM + 512 + h * 64 + 16 * dt + 4 * fq) = (u32x2){pk2(o[dt][0] * inv, o[dt][1] * inv), pk2(o[dt][2] * inv, o[dt][3] * inv)};
    WG_BAR();
    if (PROBE_SEL == 24) PT_ACC(lds, PT_NOW() - tn0_);
}

__device__ __forceinline__ void conv_item(LAS unsigned char* lds, const Params& p, int layer, int item) {
    const int b = item >> 6, t0 = (item & 63) * 32;
    int tid_ = threadIdx.x; asm volatile("" : "+v"(tid_)); const int tid = tid_, w = __builtin_amdgcn_readfirstlane(tid >> 6), lane = tid & 63;
    const bf16* P = (const bf16*)(p.ws + WS_P); bf16* MIXED = (bf16*)(p.ws + WS_MIX);
    LAS float* U = (LAS float*)lds; LAS float* CO = U + 62 * 256;
    u32x4 ca4[4], cg4[4];
#pragma unroll
    for (int it = 0; it < 4; ++it) { const int u = it * NTHR + tid, tt = u >> 5, c8 = u & 31, t = t0 - 15 + tt; ca4[it] = (u32x4){0u, 0u, 0u, 0u}; cg4[it] = ca4[it];
        if (u < 62 * 32 && t >= 0 && t < SEQ) { const bf16* rp = P + (size_t)(b * SEQ + t) * DIN; ca4[it] = *(const u32x4*)(rp + C_CA + 8 * c8); cg4[it] = *(const u32x4*)(rp + C_CG + 8 * c8); } }
    const int c = tid & 255, half = tid >> 8;
    float wk[31];
#pragma unroll
    for (int k = 0; k < 31; ++k) wk[k] = p.cw[(size_t)(layer * 31 + k) * 256 + c];
    const float bias = p.cb[layer * 256 + c];
    __builtin_amdgcn_sched_barrier(0);
#pragma unroll
    for (int it = 0; it < 4; ++it) { const int u = it * NTHR + tid, tt = u >> 5, c8 = u & 31; const u32x4 a = ca4[it], g = cg4[it];
        if (u < 62 * 32) {
            const f32x4 u0 = (f32x4){bflo(a.x) * sigm(bflo(g.x)), bfhi(a.x) * sigm(bfhi(g.x)), bflo(a.y) * sigm(bflo(g.y)), bfhi(a.y) * sigm(bfhi(g.y))};
            const f32x4 u1 = (f32x4){bflo(a.z) * sigm(bflo(g.z)), bfhi(a.z) * sigm(bfhi(g.z)), bflo(a.w) * sigm(bflo(g.w)), bfhi(a.w) * sigm(bfhi(g.w))};
            *(LAS f32x4*)(U + tt * 256 + 8 * c8) = u0; *(LAS f32x4*)(U + tt * 256 + 8 * c8 + 4) = u1; } }
    WG_BAR();
#pragma unroll 1
    for (int g = 0; g < 2; ++g) { const int base = 16 * half + 8 * g; float win[38];
#pragma unroll
        for (int i = 0; i < 38; ++i) win[i] = U[(base + i) * 256 + c];
#pragma unroll
        for (int o = 0; o < 8; ++o) { float a = bias;
#pragma unroll
            for (int k = 0; k < 31; ++k) a += wk[k] * win[o + k];
            CO[(base + o) * 256 + c] = a; } }
    __syncthreads();
    const f32x4 lg = *(const f32x4*)(p.lng + layer * 256 + 4 * lane), lbv = *(const f32x4*)(p.lnb + layer * 256 + 4 * lane);
#pragma unroll
    for (int q = 0; q < 4; ++q) { const int tl = 4 * w + q; const f32x4 v = *(const LAS f32x4*)(CO + tl * 256 + 4 * lane);
        const float mean = wave_sum((v.x + v.y) + (v.z + v.w)) * (1.f / 256.f); const f32x4 dd = v - mean;
        const float var = wave_sum((dd.x * dd.x + dd.y * dd.y) + (dd.z * dd.z + dd.w * dd.w)) * (1.f / 256.f); const float rs = __builtin_amdgcn_rsqf(var + EPS);
        f32x4 y = dd * rs * lg + lbv; y = (f32x4){silu_f0(y.x), silu_f0(y.y), silu_f0(y.z), silu_f0(y.w)};
        *(u32x2*)(MIXED + (size_t)(b * SEQ + t0 + tl) * DM + 768 + 4 * lane) = (u32x2){pk2(y.x, y.y), pk2(y.z, y.w)}; }
    __syncthreads();
}

#define XB_TMO      128
#define XB_XCNT(j)  (256  + 64 * (j))
#define XB_XSUB(j)  (1280 + 64 * (j))
#define XB_XGEN(j)  (2304 + 64 * (j))
#define XB_TOP      3328
#define XB_TOPGEN   3392
#define XCD_BAR_WORDS 3456
#define XB_SPIN_CAP (1u << 18)

__device__ __forceinline__ unsigned xb_ld(unsigned* p)              { return __hip_atomic_load(p, __ATOMIC_RELAXED, __HIP_MEMORY_SCOPE_AGENT); }
__device__ __forceinline__ unsigned xb_add(unsigned* p, unsigned v) { return __hip_atomic_fetch_add(p, v, __ATOMIC_RELAXED, __HIP_MEMORY_SCOPE_AGENT); }
__device__ __forceinline__ unsigned xb_xcc_id() { return (unsigned)__builtin_amdgcn_s_getreg((3 << 11) | 20) & 0xFu; }
#define XB_SPIN(cond, bar) do { unsigned _sp = 0; while (cond) { __builtin_amdgcn_s_sleep(1); \
    if ((++_sp & 255u) == 0u) { if (xb_ld(&(bar)[XB_TMO])) break; if (_sp > XB_SPIN_CAP) { atomicAdd(&(bar)[XB_TMO], 1u); break; } } } } while (0)

struct XcdBarrier {
    unsigned* bar; unsigned x;
    volatile LAS unsigned* st;
};

__device__ __forceinline__ XcdBarrier xcd_barrier_post(unsigned* bar, volatile LAS unsigned* st) {
    XcdBarrier b; b.bar = bar; b.x = xb_xcc_id(); b.st = st;
    if (threadIdx.x == 0) (void)xb_add(&bar[XB_XCNT(b.x)], 1u);
    return b;
}
__device__ __forceinline__ void xcd_barrier_complete(unsigned* bar, unsigned x, unsigned& nloc, unsigned& nx) {
    const unsigned G = gridDim.x * gridDim.y * gridDim.z;
    unsigned sum, cnt, mine, sp = 0u;
    for (;;) {
        sum = 0u; cnt = 0u; mine = 0u;
#pragma unroll
        for (unsigned j = 0; j < 16; ++j) { const unsigned c = xb_ld(&bar[XB_XCNT(j)]); sum += c; cnt += (c > 0u) ? 1u : 0u; mine = (j == x) ? c : mine; }
        if (sum == G) break;
        __builtin_amdgcn_s_sleep(1);
        if ((++sp & 255u) == 0u) { if (xb_ld(&bar[XB_TMO])) break; if (sp > XB_SPIN_CAP) { atomicAdd(&bar[XB_TMO], 1u); break; } }
    }
    nloc = mine > 0u ? mine : 1u; nx = cnt > 0u ? cnt : 1u;
}

__device__ __forceinline__ void xcd_barrier(const XcdBarrier& b) {
    asm volatile("s_waitcnt vmcnt(0)" ::: "memory");
    __syncthreads();
    if (threadIdx.x == 0) {
        unsigned* bar = b.bar;
        __builtin_amdgcn_s_waitcnt(0);
        unsigned nloc = b.st[0], nx = b.st[1];
        if (nloc == 0u) { xcd_barrier_complete(bar, b.x, nloc, nx); b.st[0] = nloc; b.st[1] = nx; }
        const unsigned old = xb_add(&bar[XB_XSUB(b.x)], 1u);
        const unsigned gen = old / nloc;
        if (old + 1u == (gen + 1u) * nloc) {
            __builtin_amdgcn_fence(__ATOMIC_RELEASE, "agent");
            asm volatile("s_waitcnt vmcnt(0)" ::: "memory");
            const unsigned og = xb_add(&bar[XB_TOP], 1u);
            const unsigned tg = og / nx;
            if (og + 1u == (tg + 1u) * nx) xb_add(&bar[XB_TOPGEN], 1u);
            else XB_SPIN(xb_ld(&bar[XB_TOPGEN]) == tg, bar);
            __builtin_amdgcn_fence(__ATOMIC_ACQUIRE, "agent");
            xb_add(&bar[XB_XGEN(b.x)], 1u);
            asm volatile("s_waitcnt vmcnt(0)" ::: "memory");
        } else {
            XB_SPIN(xb_ld(&bar[XB_XGEN(b.x)]) == gen, bar);
            __builtin_amdgcn_fence(__ATOMIC_ACQUIRE, "agent");
            asm volatile("s_waitcnt vmcnt(0)" ::: "memory");
        }
    }
    __syncthreads();
}

#if 0
#define PROBE_SEL_UNUSED (-1)
#endif
#ifndef REP_HA
#define REP_HA 1
#endif
#ifndef REP_NA
#define REP_NA 1
#endif
#ifndef REP_CV
#define REP_CV 1
#endif
#ifndef REP_F
#define REP_F 1
#endif
#ifndef REP_B
#define REP_B 1
#endif
#define GRID_BAR() do { XcdBarrier xb_; xb_.bar = (unsigned*)(ws + WS_BAR); xb_.x = xb_xcc_id(); xb_.st = (volatile LAS unsigned*)(lds + XB_ST_OFF); xcd_barrier(xb_); } while (0)
#define PHASE_END(kind) do { GRID_BAR(); if (PROBE_SEL >= 0 && PROBE_SEL < 10 && threadIdx.x == 0) { volatile LAS unsigned long long* pv_ = (volatile LAS unsigned long long*)(lds + PT_WORDS_OFF + 8); const unsigned long long t_ = PT_NOW(); if ((kind) == PROBE_SEL || PROBE_SEL == 9) PT_ACC(lds, t_ - pv_[0]); pv_[0] = t_; } } while (0)
constexpr size_t WS_BAR = 4096, WS_CTL_BYTES = 65536;
constexpr int XB_ST_OFF = 140288;
constexpr int RS_OFF = 131072;
constexpr int LDS_BYTES = 147456;
#define KARGS(q_) const Params& q_ = p_unused;
__global__ void __launch_bounds__(NTHR, 2) fwd_megakernel(Params p_unused) {
    extern __shared__ __attribute__((aligned(16))) unsigned char lds_raw[];
    LAS unsigned char* lds = (LAS unsigned char*)lds_raw;
    int tid_ = threadIdx.x; asm volatile("" : "+v"(tid_)); const int tid = tid_, lane = tid & 63, wave = __builtin_amdgcn_readfirstlane(tid >> 6);
    const int G = gridDim.x, bid = blockIdx.x, gw = bid * NWAVES + wave, NGW = G * NWAVES;
    unsigned char* ws; { KARGS(q0); ws = q0.ws; }

    if (tid < 2) ((volatile LAS unsigned*)(lds + XB_ST_OFF))[tid] = 0u;
    __syncthreads();
    if (ws == nullptr) cg::this_grid().sync();
    (void)xcd_barrier_post((unsigned*)(ws + WS_BAR), (volatile LAS unsigned*)(lds + XB_ST_OFF));
    if (PROBE_SEL >= 0 && threadIdx.x == 0) { ((volatile LAS unsigned*)(lds + PT_WORDS_OFF))[0] = 0u; *(volatile LAS unsigned long long*)(lds + PT_WORDS_OFF + 8) = PT_NOW(); }
    { KARGS(q); prologue(q, lds, gw, NGW, wave, lane); }
    PHASE_END(0);
    if (PROBE_SEL == 8) { PHASE_END(9); PHASE_END(8); }
#pragma unroll 1
    for (int l = 0; l < DEPTH; ++l) {
        unsigned char* wsl; { KARGS(ql); wsl = ql.ws; }
        float* ssq = (float*)(wsl + WS_SSQ); bf16* XB = (bf16*)(wsl + WS_XB); bf16* PB = (bf16*)(wsl + WS_P); bf16* MIXED = (bf16*)(wsl + WS_MIX);
        {
            pg8::Gemm g{XB, (const bf16*)(wsl + WS_WIN + l * WS_WIN_L), M, DIN, DM}; pg8::StaticOrder S; S.init(M, DIN, G, bid);
            pg8::rstd_table((LAS float*)(lds + RS_OFF), ssq, S); pg8::EpiScale E{PB, DIN, (LAS float*)(lds + RS_OFF), 0x303u};
            pg8::gemm_phase<pg8::EpiScale, pg8::StaticOrder, true, true>(lds, g, S, E);
            {
                KARGS(qc); const int nfull = (M / 256) * (DIN / 256) % G, first = nfull ? nfull : 0, nidle = G - first;
                if (bid >= first) { int tc_ = threadIdx.x; asm volatile("" : "+v"(tc_)); const int wv_ = __builtin_amdgcn_readfirstlane(tc_ >> 6); convert_weights(qc, lds, l * I_L + I_IN, l * I_L + I_IN + I_OUT + I_GU, (bid - first) * NWAVES + wv_, nidle * NWAVES, wv_, tc_ & 63); }
            }
        }
        PHASE_END(1);
#pragma unroll 1
        for (int rep = 0; rep < REP_HA; ++rep)
        { KARGS(q); for (int it = bid; it < BATCH * 4 * NSEG * 2; it += G) hg_passA_item(lds, q, l, it); }
#pragma unroll 1
        for (int rep = 0; rep < REP_NA; ++rep)
        { KARGS(q); for (int it = bid; it < BATCH * 4 * 16; it += G) na_item(lds, q, l, it); }
#pragma unroll 1
        for (int rep = 0; rep < REP_CV; ++rep)
        { KARGS(q); for (int it = bid; it < BATCH * 64; it += G) conv_item(lds, q, l, it); }
        PHASE_END(2);
#pragma unroll 1
        for (int rep = 0; rep < REP_B; ++rep)
        { KARGS(q); for (int it = bid; it < BATCH * 4 * NSEG; it += G) (void)hg_passB_item(lds, q, l, it); }
        PHASE_END(3);
        {
            pg8::Gemm g{MIXED, (const bf16*)(wsl + WS_WOUT + l * WS_WOUT_L), M, DM, DM}; pg8::StaticOrder S; S.init(M, DM, G, bid);
            pg8::EpiRes E{XB, ssq};
            pg8::gemm_phase<pg8::EpiRes, pg8::StaticOrder, true, true>(lds, g, S, E);
        }
        PHASE_END(4);
        {
            pg8::Gemm g{XB, (const bf16*)(wsl + WS_WGU + l * WS_WGU_L), M, 2 * FFN, DM}; pg8::StaticOrder S; S.init(M, 2 * FFN, G, bid);
            pg8::rstd_table((LAS float*)(lds + RS_OFF), ssq, S); pg8::EpiSwiGLU E{PB, FFN, (LAS float*)(lds + RS_OFF)};
            pg8::gemm_phase<pg8::EpiSwiGLU, pg8::StaticOrder, true, true>(lds, g, S, E);
            {
                KARGS(qc); const int nfull = (M / 256) * (2 * FFN / 256) % G, first = nfull ? nfull : 0, nidle = G - first;
                if (bid >= first) { int tc_ = threadIdx.x; asm volatile("" : "+v"(tc_)); const int wv_ = __builtin_amdgcn_readfirstlane(tc_ >> 6); convert_weights(qc, lds, l * I_L + I_IN + I_OUT + I_GU, (l + 1 < DEPTH) ? (l + 1) * I_L + I_IN : (l + 1) * I_L, (bid - first) * NWAVES + wv_, nidle * NWAVES, wv_, tc_ & 63); }
            }
        }
        PHASE_END(5);
        {
            pg8::Gemm g{PB, (const bf16*)(wsl + WS_WDN + l * WS_WDN_L), M, DM, FFN}; pg8::StaticOrder S; S.init(M, DM, G, bid);
            pg8::EpiRes E{XB, ssq};
            pg8::gemm_phase<pg8::EpiRes, pg8::StaticOrder, true, true>(lds, g, S, E);
        }
        PHASE_END(6);
    }
    float pdelta = 0.f;
    int tf_ = threadIdx.x; asm volatile("" : "+v"(tf_)); const int lanef = tf_ & 63, gwf = bid * NWAVES + __builtin_amdgcn_readfirstlane(tf_ >> 6);
    KARGS(qf); unsigned char* wsf = qf.ws; const float* ssq = (const float*)(wsf + WS_SSQ); const bf16* XB = (const bf16*)(wsf + WS_XB);
    if (PROBE_SEL >= 0) {
        unsigned* tw = (unsigned*)(wsf + 64);
        if (bid == 0 && threadIdx.x == 0) __hip_atomic_store(tw, ((volatile LAS unsigned*)(lds + PT_WORDS_OFF))[0], __ATOMIC_RELAXED, __HIP_MEMORY_SCOPE_AGENT);
        GRID_BAR();
        pdelta = (float)__hip_atomic_load(tw, __ATOMIC_RELAXED, __HIP_MEMORY_SCOPE_AGENT) * (PROBE_SEL == 9 ? 0.5e-6f : 1e-6f);
    }
#pragma unroll 1
    for (int rep = 0; rep < REP_F; ++rep)
    for (int m = gwf; m < M; m += 2 * NGW) {
        const int m2 = (m + NGW < M) ? m + NGW : m;
        float pa = lanef < 16 ? ssq[(size_t)(lanef & 15) * M + m] : 0.f, pc = lanef < 16 ? ssq[(size_t)(lanef & 15) * M + m2] : 0.f;
        const u32x4* xa = (const u32x4*)(XB + (size_t)m * DM) + lanef; const u32x4* xc = (const u32x4*)(XB + (size_t)m2 * DM) + lanef;
        u32x4 va[2], vc[2]; f32x4 gg[4];
#pragma unroll
        for (int j = 0; j < 2; ++j) { va[j] = xa[64 * j]; vc[j] = xc[64 * j]; gg[2 * j] = *(const f32x4*)(qf.fin_g + 512 * j + 8 * lanef); gg[2 * j + 1] = *(const f32x4*)(qf.fin_g + 512 * j + 8 * lanef + 4); }
        __builtin_amdgcn_sched_barrier(0);
        pa = wave_sum(pa); pc = wave_sum(pc);
        const float ra = __builtin_amdgcn_rsqf(pa * (1.f / DM) + EPS), rc = __builtin_amdgcn_rsqf(pc * (1.f / DM) + EPS);
        const f32x4 pd = (PROBE_SEL >= 0) ? (f32x4){pdelta, -pdelta, pdelta, -pdelta} : (f32x4){0.f, 0.f, 0.f, 0.f};
#pragma unroll
        for (int j = 0; j < 2; ++j) {
            { const u32x4 r = va[j]; float* o = qf.out + (size_t)m * DM + 512 * j + 8 * lanef;
              f32x4 v0 = (f32x4){bflo(r.x), bfhi(r.x), bflo(r.y), bfhi(r.y)} * ra * gg[2 * j], v1 = (f32x4){bflo(r.z), bfhi(r.z), bflo(r.w), bfhi(r.w)} * ra * gg[2 * j + 1];
              if (PROBE_SEL >= 0 && m < 256) { v0 = v0 + pd; v1 = v1 + pd; }
              *(f32x4*)o = v0; *(f32x4*)(o + 4) = v1; }
            if (m2 != m) { const u32x4 r = vc[j]; float* o = qf.out + (size_t)m2 * DM + 512 * j + 8 * lanef;
              f32x4 v0 = (f32x4){bflo(r.x), bfhi(r.x), bflo(r.y), bfhi(r.y)} * rc * gg[2 * j], v1 = (f32x4){bflo(r.z), bfhi(r.z), bflo(r.w), bfhi(r.w)} * rc * gg[2 * j + 1];
              if (PROBE_SEL >= 0 && m2 < 256) { v0 = v0 + pd; v1 = v1 + pd; }
              *(f32x4*)o = v0; *(f32x4*)(o + 4) = v1; } }
    }
}

extern "C" void kernel_launch(void* const* d_in, const int* in_sizes, int n_in, void* d_out, int out_size, void* d_ws, size_t ws_size, hipStream_t stream) {
    static int grid_blocks = 0;
    if (grid_blocks == 0) {
        if (n_in != 15 || out_size != M * DM || ws_size < WS_END) { fprintf(stderr, "kernel_launch: unexpected shapes (n_in %d out %d ws %zu)\n", n_in, out_size, ws_size); grid_blocks = -1; return; }
        int dev = 0, cus = 0, per_cu = 0;
        hipGetDevice(&dev); hipDeviceGetAttribute(&cus, hipDeviceAttributeMultiprocessorCount, dev);
        hipFuncSetAttribute((const void*)fwd_megakernel, hipFuncAttributeMaxDynamicSharedMemorySize, LDS_BYTES);
        hipOccupancyMaxActiveBlocksPerMultiprocessor(&per_cu, (const void*)fwd_megakernel, NTHR, LDS_BYTES);
        if (per_cu < 1) { fprintf(stderr, "kernel_launch: occupancy query says %d blocks per CU\n", per_cu); per_cu = 1; }
        (void)hipGetLastError();
        grid_blocks = cus * 1;
    }
    if (grid_blocks < 0) return;
    Params p{};
    p.x = (const float*)d_in[0]; p.mix_g = (const float*)d_in[1]; p.w_in = (const float*)d_in[2]; p.hg_lb = (const float*)d_in[3]; p.hg_ng = (const float*)d_in[4];
    p.rpb = (const float*)d_in[5]; p.cw = (const float*)d_in[6]; p.cb = (const float*)d_in[7]; p.lng = (const float*)d_in[8]; p.lnb = (const float*)d_in[9];
    p.w_out = (const float*)d_in[10]; p.ffn_g = (const float*)d_in[11]; p.w_gu = (const float*)d_in[12]; p.w_dn = (const float*)d_in[13]; p.fin_g = (const float*)d_in[14];
    p.out = (float*)d_out; p.ws = (unsigned char*)d_ws;
    if (hipMemsetAsync(d_ws, 0, WS_CTL_BYTES, stream) != hipSuccess) { fprintf(stderr, "kernel_launch: hipMemsetAsync failed\n"); return; }
    void* args[] = {&p};
    hipError_t e = hipLaunchCooperativeKernel((const void*)fwd_megakernel, dim3(grid_blocks), dim3(NTHR), args, LDS_BYTES, stream);
    if (e != hipSuccess) fprintf(stderr, "cooperative launch failed: %s (grid %d)\n", hipGetErrorString(e), grid_blocks);
}
```

```cpp
#include <hip/hip_runtime.h>
#include <hip/hip_cooperative_groups.h>
#include <cstdio>
#include <cstdint>
namespace cg = cooperative_groups;

namespace pg8 {
#define PG8_LAS __attribute__((address_space(3)))
typedef unsigned short bf16_t;
typedef short bf16x8 __attribute__((ext_vector_type(8)));
typedef float f32x4 __attribute__((ext_vector_type(4)));
typedef unsigned u32x4 __attribute__((ext_vector_type(4)));
constexpr int BM = 256, BK = 64, HALF = 128, HTB = HALF * BK * 2  , STAGE_BYTES = 8 * HTB, NXCD = 8, WGM = 8;

__host__ __device__ __forceinline__ int lds_byte(int r, int c) { const int st = (r >> 4) * 2 + (c >> 5), rr = r & 15, cc = c & 31, ob = rr * 64 + cc * 2; return st * 1024 + (ob ^ (((ob >> 9) & 1) << 5)); }
__host__ __device__ __forceinline__ void stage_rc(int b, int& R, int& C) { const int st = b / 1024, sb = b % 1024, swz = sb ^ (((sb >> 9) & 1) << 5); R = (st >> 1) * 16 + swz / 64; C = (st & 1) * 32 + (swz % 64) / 2; }
__host__ __device__ __forceinline__ int perm32(int rho) { const int n = rho >> 4, i = rho & 15; return 8 * (i >> 2) + 4 * n + (i & 3); }

struct Unit { int pm, pn; };
struct Gemm { const bf16_t* A; const bf16_t* Bt; int M, N, K; };

struct StaticOrder {
    int nM, nN, nwg, G, c;
    __host__ __device__ void init(int M, int N, int G_, int c_) { nM = M / BM; nN = N / BM; nwg = nM * nN; G = G_; c = c_; }
    __host__ __device__ bool next(int i, Unit& u) const {
        const long L = (long)i * G + c; if (L >= nwg) return false;
        int wgid = (int)L; { const int q = nwg / NXCD, r = nwg % NXCD, xcd = wgid % NXCD, off = wgid / NXCD; wgid = (xcd < r ? xcd * (q + 1) : r * (q + 1) + (xcd - r) * q) + off; }
        const int nig = WGM * nN, gid = wgid / nig, fm = gid * WGM, gsz = (nM - fm) < WGM ? (nM - fm) : WGM;
        u.pm = fm + ((wgid % nig) % gsz); u.pn = (wgid % nig) / gsz; return true;
    }
    __device__ __forceinline__ void a_ready(const Unit&) const {}
    __device__ __forceinline__ void done(const Unit&) const {}
};
__device__ __forceinline__ unsigned cvt_pk_bf16(float lo, float hi) { unsigned r; asm volatile("v_cvt_pk_bf16_f32 %0, %1, %2" : "=v"(r) : "v"(lo), "v"(hi)); return r; }
typedef float f32x2 __attribute__((ext_vector_type(2)));
constexpr int MROWS = 16384, DMODEL = 1024, NPART = 16;
constexpr float NORM_EPS = 1e-6f;
__device__ __forceinline__ float row_rstd(const float* ssq, int row) {
    float s = 0.f;
#pragma unroll
    for (int p = 0; p < NPART; ++p) s += ssq[(size_t)p * MROWS + row];
    return __builtin_amdgcn_rsqf(s * (1.f / DMODEL) + NORM_EPS);
}
__device__ __forceinline__ float silu_f(float x) { return x * __builtin_amdgcn_rcpf(1.f + __expf(-x)); }

struct EpiScale {
    static constexpr bool PERM = true, AFTER_DRAIN = false;
    bf16_t* O; int ldc; const PG8_LAS float* RS; unsigned silu_mask;
    __device__ __forceinline__ void operator()(const f32x4 (&acc)[2][2][4][2], const Unit& u, int ui, int wr, int wc, int fr, int fq) const {
        const int row0 = u.pm * BM + wr * 64 + fr, col0 = u.pn * BM + wc * 32 + 8 * fq; const bool act = (silu_mask >> u.pn) & 1u;
#pragma unroll
        for (int ai = 0; ai < 2; ++ai)
#pragma unroll
            for (int m = 0; m < 4; ++m) { const int row = row0 + ai * HALF + m * 16; const float rs = RS[ui * BM + wr * 64 + fr + ai * HALF + m * 16]; bf16_t* rowp = O + (size_t)row * ldc + col0;
#pragma unroll
                for (int bj = 0; bj < 2; ++bj) { f32x4 v0 = acc[ai][bj][m][0] * rs, v1 = acc[ai][bj][m][1] * rs;
                    if (act) { v0 = (f32x4){silu_f(v0[0]), silu_f(v0[1]), silu_f(v0[2]), silu_f(v0[3])}; v1 = (f32x4){silu_f(v1[0]), silu_f(v1[1]), silu_f(v1[2]), silu_f(v1[3])}; }
                    u32x4 w; w.x = cvt_pk_bf16(v0[0], v0[1]); w.y = cvt_pk_bf16(v0[2], v0[3]); w.z = cvt_pk_bf16(v1[0], v1[1]); w.w = cvt_pk_bf16(v1[2], v1[3]);
                    *(u32x4*)(rowp + bj * HALF) = w; } __builtin_amdgcn_sched_barrier(0); }
    }
};
struct EpiRes {
    static constexpr bool PERM = true, AFTER_DRAIN = false;
    bf16_t* XB; float* ssq;
    __device__ __forceinline__ void operator()(const f32x4 (&acc)[2][2][4][2], const Unit& u, int ui, int wr, int wc, int fr, int fq) const {
        const int row0 = u.pm * BM + wr * 64 + fr, col0 = u.pn * BM + wc * 32 + 8 * fq;
#pragma unroll
        for (int ai = 0; ai < 2; ++ai)
#pragma unroll
            for (int mm = 0; mm < 4; mm += 2) {
                u32x4 rr[2][2];
#pragma unroll
                for (int q = 0; q < 2; ++q)
#pragma unroll
                    for (int bj = 0; bj < 2; ++bj) rr[q][bj] = *(const u32x4*)(XB + (size_t)(row0 + ai * HALF + (mm + q) * 16) * DMODEL + col0 + bj * HALF);
                __builtin_amdgcn_sched_barrier(0);
#pragma unroll
                for (int q = 0; q < 2; ++q) { const int m = mm + q, row = row0 + ai * HALF + m * 16; const size_t o = (size_t)row * DMODEL + col0; float sq = 0.f;
#pragma unroll
                    for (int bj = 0; bj < 2; ++bj) { const u32x4 r = rr[q][bj];
                        const f32x4 r0 = (f32x4){__builtin_bit_cast(float, r.x << 16), __builtin_bit_cast(float, r.x & 0xffff0000u), __builtin_bit_cast(float, r.y << 16), __builtin_bit_cast(float, r.y & 0xffff0000u)};
                        const f32x4 r1 = (f32x4){__builtin_bit_cast(float, r.z << 16), __builtin_bit_cast(float, r.z & 0xffff0000u), __builtin_bit_cast(float, r.w << 16), __builtin_bit_cast(float, r.w & 0xffff0000u)};
                        const f32x4 v0 = acc[ai][bj][m][0] + r0, v1 = acc[ai][bj][m][1] + r1;
                        u32x4 w; w.x = cvt_pk_bf16(v0[0], v0[1]); w.y = cvt_pk_bf16(v0[2], v0[3]); w.z = cvt_pk_bf16(v1[0], v1[1]); w.w = cvt_pk_bf16(v1[2], v1[3]);
                        *(u32x4*)(XB + o + bj * HALF) = w;
                        sq += (v0[0] * v0[0] + v0[1] * v0[1]) + (v0[2] * v0[2] + v0[3] * v0[3]) + (v1[0] * v1[0] + v1[1] * v1[1]) + (v1[2] * v1[2] + v1[3] * v1[3]); }
                    sq += __shfl_xor(sq, 16); sq += __shfl_xor(sq, 32);
                    if (fq == 0) ssq[(size_t)(u.pn * 4 + wc) * MROWS + row] = sq; }
                __builtin_amdgcn_sched_barrier(0); }
    }
};
struct EpiSwiGLU {
    static constexpr bool PERM = true, AFTER_DRAIN = false;
    bf16_t* O; int ldc; const PG8_LAS float* RS;
    __device__ __forceinline__ void operator()(const f32x4 (&acc)[2][2][4][2], const Unit& u, int ui, int wr, int wc, int fr, int fq) const {
        const int row0 = u.pm * BM + wr * 64 + fr, col0 = u.pn * HALF + wc * 32 + 8 * fq;
#pragma unroll
        for (int ai = 0; ai < 2; ++ai)
#pragma unroll
            for (int m = 0; m < 4; ++m) { const int row = row0 + ai * HALF + m * 16; const float rs = RS[ui * BM + wr * 64 + fr + ai * HALF + m * 16];
                const f32x4 g0 = acc[ai][0][m][0] * rs, g1 = acc[ai][0][m][1] * rs, u0 = acc[ai][1][m][0] * rs, u1 = acc[ai][1][m][1] * rs;
                u32x4 w; w.x = cvt_pk_bf16(silu_f(g0[0]) * u0[0], silu_f(g0[1]) * u0[1]); w.y = cvt_pk_bf16(silu_f(g0[2]) * u0[2], silu_f(g0[3]) * u0[3]);
                w.z = cvt_pk_bf16(silu_f(g1[0]) * u1[0], silu_f(g1[1]) * u1[1]); w.w = cvt_pk_bf16(silu_f(g1[2]) * u1[2], silu_f(g1[3]) * u1[3]);
                *(u32x4*)(O + (size_t)row * ldc + col0) = w; __builtin_amdgcn_sched_barrier(0); }
    }
};
template <class Sched> __device__ __forceinline__ void rstd_table(PG8_LAS float* RS, const float* ssq, const Sched& S) {
    int tx_ = threadIdx.x; asm volatile("" : "+v"(tx_));
    Unit u; const int t = tx_ & (BM - 1);
    for (int i = __builtin_amdgcn_readfirstlane(tx_ >> 8); S.next(i, u); i += 2) {
        float v[NPART];
#pragma unroll
        for (int p = 0; p < NPART; ++p) v[p] = ssq[(size_t)p * MROWS + u.pm * BM + t];
        __builtin_amdgcn_sched_barrier(0);
        const float s = (((v[0] + v[1]) + (v[2] + v[3])) + ((v[4] + v[5]) + (v[6] + v[7]))) + (((v[8] + v[9]) + (v[10] + v[11])) + ((v[12] + v[13]) + (v[14] + v[15])));
        RS[i * BM + t] = __builtin_amdgcn_rsqf(s * (1.f / DMODEL) + NORM_EPS);
    }
    __syncthreads();
}
template <class Epi, class Sched, bool ALIGN_EPI = false, bool SP2 = false>
__device__ __forceinline__ void gemm_phase(PG8_LAS unsigned char* lds, const Gemm g, const Sched& S, const Epi& E) {
    int tid_ = threadIdx.x; asm volatile("" : "+v"(tid_));
    const int tid = tid_, wid = __builtin_amdgcn_readfirstlane(tid >> 6), lane = tid & 63, wr = wid >> 2, wc = wid & 3, fr = lane & 15, fq = lane >> 4;
    const int K = g.K, nt = K / BK;
    unsigned voffA[2], voffB[2];
#pragma unroll
    for (int i = 0; i < 2; ++i) { int R, C; stage_rc(tid * 16 + i * 8192, R, C); const int Rb = Epi::PERM ? ((R & ~31) + perm32(R & 31)) : R;
        voffA[i] = (unsigned)(R * K + C) * 2u; voffB[i] = (unsigned)(Rb * K + C) * 2u; }
    const size_t kstep = (size_t)(BK * 2);
    const size_t hstep = (size_t)HALF * K * 2;
    const size_t tstep = 2 * hstep;
    const unsigned ldsw = (unsigned)wid * 1024u;
    const int aoff = lds_byte(wr * 64 + fr, fq * 8), boff = lds_byte(wc * 32 + fr, fq * 8);
#define PG8_SA(b, h) (((b) * 2 + (h)) * HTB)
#define PG8_SB(b, h) ((4 + (b) * 2 + (h)) * HTB)
#define PG8_STAGE(bufoff, gbase, voff) do { _Pragma("unroll") for (int _i = 0; _i < 2; ++_i) \
        __builtin_amdgcn_global_load_lds((const unsigned*)((const char*)(gbase) + (voff)[_i]), (PG8_LAS unsigned*)(lds + (bufoff) + ldsw + _i * 8192), 16, 0, 0); } while (0)
#define PG8_LDA(dst, b, h) do { _Pragma("unroll") for (int m = 0; m < 4; ++m) _Pragma("unroll") for (int k = 0; k < 2; ++k) dst[m][k] = *(const PG8_LAS bf16x8*)(lds + PG8_SA(b, h) + aoff + m * 2048 + k * 1024); } while (0)
#define PG8_LDB(dst, b, h) do { _Pragma("unroll") for (int n = 0; n < 2; ++n) _Pragma("unroll") for (int k = 0; k < 2; ++k) dst[n][k] = *(const PG8_LAS bf16x8*)(lds + PG8_SB(b, h) + boff + n * 2048 + k * 1024); } while (0)
#define PG8_MMA(ai, bj, At, Bt) do { __builtin_amdgcn_s_setprio(1); _Pragma("unroll") for (int m = 0; m < 4; ++m) _Pragma("unroll") for (int n = 0; n < 2; ++n) _Pragma("unroll") for (int k = 0; k < 2; ++k) \
        acc[ai][bj][m][n] = __builtin_amdgcn_mfma_f32_16x16x32_bf16(Bt[n][k], At[m][k], acc[ai][bj][m][n], 0, 0, 0); __builtin_amdgcn_s_setprio(0); } while (0)
#define PG8_WAIT_V(n) asm volatile("s_waitcnt vmcnt(" #n ")" ::: "memory")
#define PG8_WAIT_L(n) asm volatile("s_waitcnt lgkmcnt(" #n ")" ::: "memory")
#define PG8_BAR __builtin_amdgcn_s_barrier()
#define PG8_SCHED __builtin_amdgcn_sched_barrier(0)
    Unit cur, nxt; int ui = 0;
    if (!S.next(0, cur)) return;
    f32x4 acc[2][2][4][2];
#pragma unroll
    for (int a = 0; a < 2; ++a)
#pragma unroll
        for (int b = 0; b < 2; ++b)
#pragma unroll
            for (int m = 0; m < 4; ++m)
#pragma unroll
                for (int n = 0; n < 2; ++n) acc[a][b][m][n] = (f32x4){0.f, 0.f, 0.f, 0.f};
    bf16x8 At[4][2], B0[2][2], B1[2][2];
    const char* cA = (const char*)g.A + (size_t)cur.pm * tstep; const char* cB = (const char*)g.Bt + (size_t)cur.pn * tstep;
    S.a_ready(cur);
    if constexpr (SP2) {
        PG8_STAGE(PG8_SB(0, 0), cB, voffB); PG8_STAGE(PG8_SB(0, 1), cB + hstep, voffB); PG8_STAGE(PG8_SA(0, 0), cA, voffA); PG8_STAGE(PG8_SA(0, 1), cA + hstep, voffA);
        if (wr == 1) PG8_BAR;
        PG8_WAIT_V(2); PG8_BAR;
        PG8_STAGE(PG8_SB(1, 0), cB + kstep, voffB); PG8_STAGE(PG8_SA(1, 0), cA + kstep, voffA); PG8_STAGE(PG8_SB(1, 1), cB + hstep + kstep, voffB);
        PG8_WAIT_V(6); PG8_BAR;
    } else {
        PG8_STAGE(PG8_SB(0, 0), cB, voffB); PG8_STAGE(PG8_SA(0, 0), cA, voffA); PG8_STAGE(PG8_SB(0, 1), cB + hstep, voffB); PG8_STAGE(PG8_SA(0, 1), cA + hstep, voffA);
        if (wr == 1) PG8_BAR;
        PG8_WAIT_V(4); PG8_BAR;
        PG8_STAGE(PG8_SB(1, 0), cB + kstep, voffB); PG8_STAGE(PG8_SA(1, 0), cA + kstep, voffA); PG8_STAGE(PG8_SB(1, 1), cB + hstep + kstep, voffB);
        PG8_WAIT_V(6); PG8_BAR;
    }
    for (;;) {
        const bool has_next = S.next(ui + 1, nxt);
        const char* nA = has_next ? (const char*)g.A + (size_t)nxt.pm * tstep : cA; const char* nB = has_next ? (const char*)g.Bt + (size_t)nxt.pn * tstep : cB;
        for (int t = 0; t < nt; t += 2) {
            const bool last = (t == nt - 2);
            const char* a1 = cA + (size_t)(t + 1) * kstep;
            const char* a2 = last ? nA : cA + (size_t)(t + 2) * kstep; const char* b2 = last ? nB : cB + (size_t)(t + 2) * kstep;
            const char* a3 = a2 + kstep; const char* b3 = b2 + kstep;
            if (last && has_next) S.a_ready(nxt);
            if constexpr (SP2) {
            PG8_LDB(B0, 0, 0); PG8_LDB(B1, 0, 1); PG8_SCHED; PG8_LDA(At, 0, 0); PG8_STAGE(PG8_SA(1, 1), a1 + hstep, voffA);
            PG8_WAIT_V(8); PG8_WAIT_L(0); PG8_BAR; PG8_MMA(0, 0, At, B0); PG8_MMA(0, 1, At, B1); PG8_BAR; PG8_SCHED;
            PG8_LDA(At, 0, 1); PG8_STAGE(PG8_SB(0, 0), b2, voffB); PG8_STAGE(PG8_SB(0, 1), b2 + hstep, voffB); PG8_STAGE(PG8_SA(0, 0), a2, voffA);
            PG8_WAIT_V(8); PG8_WAIT_L(0); PG8_BAR; PG8_MMA(1, 0, At, B0); PG8_MMA(1, 1, At, B1); PG8_BAR; PG8_SCHED;
            PG8_LDB(B0, 1, 0); PG8_LDB(B1, 1, 1); PG8_SCHED; PG8_LDA(At, 1, 0); PG8_STAGE(PG8_SA(0, 1), a2 + hstep, voffA);
            PG8_WAIT_V(8); PG8_WAIT_L(0); PG8_BAR; PG8_MMA(0, 0, At, B0); PG8_MMA(0, 1, At, B1); PG8_BAR; PG8_SCHED;
            PG8_LDA(At, 1, 1); PG8_STAGE(PG8_SB(1, 0), b3, voffB); PG8_STAGE(PG8_SB(1, 1), b3 + hstep, voffB); PG8_STAGE(PG8_SA(1, 0), a3, voffA);
            PG8_WAIT_V(8); PG8_WAIT_L(0); PG8_BAR; PG8_MMA(1, 0, At, B0); PG8_MMA(1, 1, At, B1); PG8_BAR; PG8_SCHED;
            } else {
            PG8_LDB(B0, 0, 0); PG8_SCHED; PG8_LDA(At, 0, 0); PG8_STAGE(PG8_SA(1, 1), a1 + hstep, voffA);
            PG8_WAIT_L(8); PG8_BAR; PG8_WAIT_L(0); PG8_MMA(0, 0, At, B0); PG8_BAR; PG8_SCHED;
            PG8_LDB(B1, 0, 1); PG8_STAGE(PG8_SB(0, 0), b2, voffB);
            PG8_BAR; PG8_WAIT_L(0); PG8_MMA(0, 1, At, B1); PG8_BAR;
            PG8_LDA(At, 0, 1); PG8_STAGE(PG8_SA(0, 0), a2, voffA);
            PG8_BAR; PG8_WAIT_L(0); PG8_MMA(1, 0, At, B0); PG8_BAR; PG8_SCHED;
            PG8_STAGE(PG8_SB(0, 1), b2 + hstep, voffB);
            PG8_WAIT_V(6); PG8_BAR; PG8_MMA(1, 1, At, B1); PG8_BAR;
            PG8_LDB(B0, 1, 0); PG8_SCHED; PG8_LDA(At, 1, 0); PG8_STAGE(PG8_SA(0, 1), a2 + hstep, voffA);
            PG8_WAIT_L(8); PG8_BAR; PG8_WAIT_L(0); PG8_MMA(0, 0, At, B0); PG8_BAR; PG8_SCHED;
            PG8_LDB(B1, 1, 1); PG8_STAGE(PG8_SB(1, 0), b3, voffB);
            PG8_BAR; PG8_WAIT_L(0); PG8_MMA(0, 1, At, B1); PG8_BAR;
            PG8_LDA(At, 1, 1); PG8_STAGE(PG8_SA(1, 0), a3, voffA);
            PG8_BAR; PG8_WAIT_L(0); PG8_MMA(1, 0, At, B0); PG8_BAR; PG8_SCHED;
            PG8_STAGE(PG8_SB(1, 1), b3 + hstep, voffB);
            PG8_WAIT_V(6); PG8_BAR; PG8_MMA(1, 1, At, B1); PG8_BAR;
            }
        }
        if constexpr (ALIGN_EPI) { if (wr == 0) PG8_BAR; }
        if constexpr (!Epi::AFTER_DRAIN) { E(acc, cur, ui, wr, wc, fr, fq); S.done(cur); }
        if (!has_next) break;
#pragma unroll
        for (int a = 0; a < 2; ++a)
#pragma unroll
            for (int b = 0; b < 2; ++b)
#pragma unroll
                for (int m = 0; m < 4; ++m)
#pragma unroll
                    for (int n = 0; n < 2; ++n) acc[a][b][m][n] = (f32x4){0.f, 0.f, 0.f, 0.f};
        cur = nxt; cA = nA; cB = nB; ++ui;
        if constexpr (ALIGN_EPI) { if (wr == 1) PG8_BAR; }
    }
    PG8_WAIT_V(0);
    if constexpr (!ALIGN_EPI) { if (wr == 0) PG8_BAR; }
    PG8_BAR;
    if constexpr (Epi::AFTER_DRAIN) { E.fused(acc, cur, wr, wc, fr, fq, lds, wid, lane); S.done(cur); }
#undef PG8_SA
#undef PG8_SB
#undef PG8_STAGE
#undef PG8_LDA
#undef PG8_LDB
#undef PG8_MMA
#undef PG8_WAIT_V
#undef PG8_WAIT_L
#undef PG8_BAR
#undef PG8_SCHED
}
}
#ifndef PROBE_SEL
#define PROBE_SEL (-1)
#endif
#define PT_NOW() __builtin_amdgcn_s_memrealtime()
#define PT_WORDS_OFF 140304
#define PT_ACC(lds_, dt_) do { if (threadIdx.x == 0) { volatile __attribute__((address_space(3))) unsigned* a_ = (volatile __attribute__((address_space(3))) unsigned*)((lds_) + PT_WORDS_OFF); a_[0] = a_[0] + (unsigned)(dt_); } } while (0)
#define LAS __attribute__((address_space(3)))
typedef unsigned short bf16;
typedef float f32x4 __attribute__((ext_vector_type(4)));
typedef short bf16x8 __attribute__((ext_vector_type(8)));
typedef unsigned u32x4 __attribute__((ext_vector_type(4)));
typedef unsigned u32x2 __attribute__((ext_vector_type(2)));
constexpr int NWAVES = 8, NTHR = 512;
constexpr int BATCH = 8, SEQ = 2048, DM = 1024, M = BATCH * SEQ, DIN = 3840, FFN = 2816, DEPTH = 2;
constexpr int C_HQ = 0, C_HFF = 512, C_HI = 1536, C_HG = 2048, C_NQ = 2560, C_NK = 2816, C_NV = 3072, C_CA = 3328, C_CG = 3584;
constexpr int NSEG = 8, SEGLEN = SEQ / NSEG, CHS = SEGLEN / 32;
constexpr float EPS = 1e-6f;
constexpr size_t MiB = 1u << 20;
constexpr size_t WS_SSQ = 1 * MiB;
constexpr size_t WS_WIN = 2 * MiB, WS_WIN_L = (size_t)DIN * DM * 2;
constexpr size_t WS_WOUT = 17 * MiB, WS_WOUT_L = (size_t)DM * DM * 2;
constexpr size_t WS_WGU = 21 * MiB, WS_WGU_L = (size_t)2 * FFN * DM * 2;
constexpr size_t WS_WDN = 43 * MiB, WS_WDN_L = (size_t)DM * FFN * 2;
constexpr size_t WS_P = 54 * MiB;
constexpr size_t WS_MIX = 174 * MiB;
constexpr size_t WS_XB = 206 * MiB;
constexpr size_t WS_SLOC = 238 * MiB;
constexpr size_t WS_DSEG = 254 * MiB;
constexpr size_t WS_END = 255 * MiB;

__device__ __forceinline__ float bf2f(unsigned short h) { return __builtin_bit_cast(float, (unsigned)h << 16); }
__device__ __forceinline__ float bflo(unsigned w) { return __builtin_bit_cast(float, w << 16); }
__device__ __forceinline__ float bfhi(unsigned w) { return __builtin_bit_cast(float, w & 0xffff0000u); }
typedef float f32x2_t __attribute__((ext_vector_type(2)));
typedef __bf16 bf16x2_t __attribute__((ext_vector_type(2)));
__device__ __forceinline__ unsigned pk2(float lo, float hi) { const f32x2_t v = {lo, hi}; const bf16x2_t b = __builtin_convertvector(v, bf16x2_t); return __builtin_bit_cast(unsigned, b); }
__device__ __forceinline__ unsigned short f2bf(float v) { return (unsigned short)(pk2(v, 0.f) & 0xffffu); }
__device__ __forceinline__ float wave_sum(float v) {
#pragma unroll
    for (int o = 1; o < 64; o <<= 1) v += __shfl_xor(v, o);
    return v;
}
__device__ __forceinline__ float sigm(float x) { return __builtin_amdgcn_rcpf(1.f + __expf(-x)); }
__device__ __forceinline__ float silu_f0(float x) { return x * sigm(x); }
__device__ __forceinline__ f32x4 mfma16(bf16x8 a, bf16x8 b, f32x4 c) { return __builtin_amdgcn_mfma_f32_16x16x32_bf16(a, b, c, 0, 0, 0); }
#define LDS_WAIT() asm volatile("s_waitcnt lgkmcnt(0)" ::: "memory")

struct Params {
    const float *x, *mix_g, *w_in, *hg_lb, *hg_ng, *rpb, *cw, *cb, *lng, *lnb, *w_out, *ffn_g, *w_gu, *w_dn, *fin_g;
    float* out; unsigned char* ws;
};

__device__ __forceinline__ void transpose_item(const float* W, int K, int N, bf16* WT, const float* gk, bool gu, LAS float* scr, int item, int lane) {
    const int nblk = N / 64, kb = item / nblk, nb = item % nblk, k0 = 64 * kb, n0 = 64 * nb;
    const float gs = gk ? gk[k0 + lane] : 1.f;
    const float* src = W + (size_t)k0 * N + n0 + lane;
#pragma unroll
    for (int hh = 0; hh < 2; ++hh) {
        float wv[32];
#pragma unroll
        for (int i = 0; i < 32; ++i) wv[i] = __builtin_nontemporal_load(src + (size_t)(32 * hh + i) * N);
        __builtin_amdgcn_sched_barrier(0);
#pragma unroll
        for (int i = 0; i < 32; ++i) scr[(32 * hh + i) * 65 + lane] = wv[i] * __shfl(gs, 32 * hh + i);
    }
    LDS_WAIT(); asm volatile("" ::: "memory");
    const int c = lane & 7;
    int r0 = n0;
    if (gu) { const int up = n0 >= FFN ? 1 : 0, cc = n0 - up * FFN; r0 = 256 * (cc >> 7) + (cc & 127) + up * 128; }
#pragma unroll
    for (int j = 0; j < 8; ++j) { const int n = (lane >> 3) + 8 * j; const LAS float* s = scr + (8 * c) * 65 + n;
        u32x4 o; o.x = pk2(s[0 * 65], s[1 * 65]); o.y = pk2(s[2 * 65], s[3 * 65]); o.z = pk2(s[4 * 65], s[5 * 65]); o.w = pk2(s[6 * 65], s[7 * 65]);
        *(u32x4*)(WT + (size_t)(r0 + n) * K + k0 + 8 * c) = o; }
    LDS_WAIT(); asm volatile("" ::: "memory");
}
constexpr int I_IN = (DM / 64) * (DIN / 64), I_OUT = (DM / 64) * (DM / 64), I_GU = (DM / 64) * (2 * FFN / 64), I_DN = (FFN / 64) * (DM / 64), I_L = I_IN + I_OUT + I_GU + I_DN;
__device__ __forceinline__ void convert_weights(const Params& p, LAS unsigned char* lds, int lo, int hi, int w0, int nw, int wave, int lane) {
    LAS float* scr = (LAS float*)(lds + wave * 16640);
    for (int it = lo + w0; it < hi; it += nw) {
        const int l = it / I_L; int r = it % I_L;
        if (r < I_IN) { transpose_item(p.w_in + (size_t)l * DM * DIN, DM, DIN, (bf16*)(p.ws + WS_WIN + l * WS_WIN_L), p.mix_g + l * DM, false, scr, r, lane); continue; } r -= I_IN;
        if (r < I_OUT) { transpose_item(p.w_out + (size_t)l * DM * DM, DM, DM, (bf16*)(p.ws + WS_WOUT + l * WS_WOUT_L), nullptr, false, scr, r, lane); continue; } r -= I_OUT;
        if (r < I_GU) { transpose_item(p.w_gu + (size_t)l * DM * 2 * FFN, DM, 2 * FFN, (bf16*)(p.ws + WS_WGU + l * WS_WGU_L), p.ffn_g + l * DM, true, scr, r, lane); continue; } r -= I_GU;
        transpose_item(p.w_dn + (size_t)l * FFN * DM, FFN, DM, (bf16*)(p.ws + WS_WDN + l * WS_WDN_L), nullptr, false, scr, r, lane);
    }
}
__device__ __forceinline__ void prologue(const Params& p, LAS unsigned char* lds, int gw, int NGW, int wave, int lane) {
    convert_weights(p, lds, 0, I_IN, gw, NGW, wave, lane);
    bf16* XB = (bf16*)(p.ws + WS_XB); float* ssq = (float*)(p.ws + WS_SSQ);
    for (int m = gw; m < M; m += 2 * NGW) {
        const int m2 = m + NGW;
        const f32x4* xa = (const f32x4*)(p.x + (size_t)m * DM) + lane; const f32x4* xc = (const f32x4*)(p.x + (size_t)(m2 < M ? m2 : m) * DM) + lane;
        f32x4 va[4], vc[4];
#pragma unroll
        for (int j = 0; j < 4; ++j) { va[j] = __builtin_nontemporal_load(xa + 64 * j); vc[j] = __builtin_nontemporal_load(xc + 64 * j); }
        __builtin_amdgcn_sched_barrier(0);
        float sa = 0.f, sc = 0.f;
        unsigned long long* oa = (unsigned long long*)(XB + (size_t)m * DM) + lane; unsigned long long* oc = (unsigned long long*)(XB + (size_t)m2 * DM) + lane;
#pragma unroll
        for (int j = 0; j < 4; ++j) { sa += (va[j].x * va[j].x + va[j].y * va[j].y) + (va[j].z * va[j].z + va[j].w * va[j].w); sc += (vc[j].x * vc[j].x + vc[j].y * vc[j].y) + (vc[j].z * vc[j].z + vc[j].w * vc[j].w);
            oa[64 * j] = (unsigned long long)pk2(va[j].x, va[j].y) | ((unsigned long long)pk2(va[j].z, va[j].w) << 32);
            if (m2 < M) oc[64 * j] = (unsigned long long)pk2(vc[j].x, vc[j].y) | ((unsigned long long)pk2(vc[j].z, vc[j].w) << 32); }
        sa = wave_sum(sa); sc = wave_sum(sc);
        if (lane < 16) { ssq[(size_t)lane * M + m] = lane == 0 ? sa : 0.f; if (m2 < M) ssq[(size_t)lane * M + m2] = lane == 0 ? sc : 0.f; }
    }
}

constexpr int HS_SET = 37888, HQ_OFF = 0, HK_OFF = 8704, HKH_OFF = 17408, HV_OFF = 27648;
constexpr int HOS_OFF = 2 * HS_SET, HOS_SZ = 16896, HDEC_OFF = HOS_OFF + 2 * HOS_SZ;
#define WG_BAR() asm volatile("s_waitcnt lgkmcnt(0)\n\ts_barrier" ::: "memory")
template <bool FULL, bool SECOND>
__device__ __forceinline__ void hg_segment(LAS unsigned char* lds, const bf16* P, int b, int h, int dir, int seg, float lb, f32x4 (&S)[8], float& bsum,
                                           float* OP, bf16* MIXED, const float* norm_g) {
    int tid_ = threadIdx.x; asm volatile("" : "+v"(tid_)); const int tid = tid_, w = __builtin_amdgcn_readfirstlane(tid >> 6), lane = tid & 63, fr = lane & 15, fq = lane >> 4;
    unsigned long long tk0 = 0;
    const int d = 16 * w + (lane & 15), grp = lane >> 4;
    const int zcol = C_HFF + dir * 512 + h * 128 + d, qcol = C_HQ + h * 128 + d, vcol = C_HI + h * 128 + d;
    const float oml = 1.f - lb;
    const int ts = dir == 0 ? 1 : -1, tb0 = dir == 0 ? seg * SEGLEN : (seg * SEGLEN + SEGLEN - 1);
    const long rstep = (long)ts * DIN;
    const int fc = tid >> 4, dvg = tid & 15;
    f32x4 ng0 = (f32x4){0.f, 0.f, 0.f, 0.f}, ng1 = ng0;
    if (FULL && SECOND) { ng0 = *(const f32x4*)(norm_g + 8 * dvg); ng1 = *(const f32x4*)(norm_g + 8 * dvg + 4); }
    unsigned short zn[8], qn[8], vn[8];
#define HG_LOAD(n_) do { const bf16* rowp_ = P + (size_t)(b * SEQ + tb0 + ts * (32 * (n_) + 8 * grp)) * DIN; \
        _Pragma("unroll") for (int e = 0; e < 8; ++e) { const bf16* r_ = rowp_ + rstep * e; zn[e] = r_[zcol]; if (FULL) qn[e] = r_[qcol]; else qn[e] = 0; vn[e] = r_[vcol]; } } while (0)
#define HG_PREP(s_) do { LAS unsigned char* set_ = lds + (s_) * HS_SET; LAS bf16* QT_ = (LAS bf16*)(set_ + HQ_OFF); LAS bf16* KT_ = (LAS bf16*)(set_ + HK_OFF); \
        f32x2_t Ev[4], kvv[4]; float run = 1.f;                                     \
        _Pragma("unroll") for (int e2 = 0; e2 < 4; ++e2) { \
            f32x2_t z = {__builtin_amdgcn_fmed3f(bf2f(zn[2 * e2]), -40.f, 40.f), __builtin_amdgcn_fmed3f(bf2f(zn[2 * e2 + 1]), -40.f, 40.f)}; \
            const f32x2_t t = z * (-1.4426950408889634f); const f32x2_t den = (f32x2_t){__builtin_amdgcn_exp2f(t.x), __builtin_amdgcn_exp2f(t.y)} + 1.0f; \
            const f32x2_t inv = {__builtin_amdgcn_rcpf(den.x), __builtin_amdgcn_rcpf(den.y)};              \
            const f32x2_t fv = inv * oml + lb; kvv[e2] = inv * (-oml) + oml;                                  \
            run *= fv.x; Ev[e2].x = run; run *= fv.y; Ev[e2].y = run; } \
        float pre = 1.f, tot = 1.f; \
        _Pragma("unroll") for (int g2 = 0; g2 < 4; ++g2) { const float t = __shfl(run, (g2 << 4) | (lane & 15)); tot *= t; if (g2 < grp) pre *= t; } \
        unsigned khp[4], vvp[4]; \
        _Pragma("unroll") for (int e2 = 0; e2 < 4; ++e2) { const f32x2_t E = Ev[e2] * pre; const f32x2_t r = {__builtin_amdgcn_rcpf(E.x), __builtin_amdgcn_rcpf(E.y)}; const f32x2_t kt = kvv[e2] * r; \
            if (FULL) { const int c0 = 8 * grp + 2 * e2; const f32x2_t qs = (f32x2_t){bf2f(qn[2 * e2]), bf2f(qn[2 * e2 + 1])} * E; const unsigned qw = pk2(qs.x, qs.y), kw = pk2(kt.x, kt.y); \
                QT_[c0 * 136 + d] = (bf16)(qw & 0xffffu); QT_[(c0 + 1) * 136 + d] = (bf16)(qw >> 16); KT_[c0 * 136 + d] = (bf16)(kw & 0xffffu); KT_[(c0 + 1) * 136 + d] = (bf16)(kw >> 16); } \
            const f32x2_t kh = kt * tot; khp[e2] = pk2(kh.x, kh.y); vvp[e2] = (unsigned)vn[2 * e2] | ((unsigned)vn[2 * e2 + 1] << 16); } \
        *(LAS u32x4*)((LAS bf16*)(set_ + HKH_OFF) + d * 40 + 8 * grp) = (u32x4){khp[0], khp[1], khp[2], khp[3]}; \
        *(LAS u32x4*)((LAS bf16*)(set_ + HV_OFF) + d * 40 + 8 * grp) = (u32x4){vvp[0], vvp[1], vvp[2], vvp[3]}; \
        if (grp == 0) { ((LAS float*)(lds + HDEC_OFF))[(s_) * 128 + d] = tot; bsum *= tot; } } while (0)
    HG_LOAD(0);
    __builtin_amdgcn_sched_barrier(0);
    HG_PREP(0);
    __builtin_amdgcn_sched_barrier(0);
    if (CHS > 1) HG_LOAD(1);
    WG_BAR();
#pragma unroll 1
    for (int n = 0; n < CHS; ++n) {
        const int tb = tb0 + ts * 32 * n, cs = n & 1;
        const int ftok = tb + ts * fc;
        f32x4 op0 = (f32x4){0.f, 0.f, 0.f, 0.f}, op1 = op0; u32x4 gw4 = (u32x4){0u, 0u, 0u, 0u};
        float* op = OP + ((size_t)((b * 4 + h) * SEQ + ftok)) * 128 + 8 * dvg;
        if (FULL && SECOND) { op0 = *(const f32x4*)op; op1 = *(const f32x4*)(op + 4); gw4 = *(const u32x4*)(P + (size_t)(b * SEQ + ftok) * DIN + C_HG + h * 128 + 8 * dvg); }
        __builtin_amdgcn_sched_barrier(0);
#pragma unroll 1
        for (int ph = 0; ph < 2; ++ph) {
        if ((ph == 0) == (w < 4)) { if (PROBE_SEL == 13) tk0 = PT_NOW(); if (n + 1 < CHS) { HG_PREP(cs ^ 1); __builtin_amdgcn_sched_barrier(0); if (n + 2 < CHS) HG_LOAD(n + 2); } if (PROBE_SEL == 13) PT_ACC(lds, PT_NOW() - tk0); }
        else {
        if (PROBE_SEL == 14) tk0 = PT_NOW();
        LAS unsigned char* set = lds + cs * HS_SET;
        LAS bf16* QT = (LAS bf16*)(set + HQ_OFF); LAS bf16* KT = (LAS bf16*)(set + HK_OFF); LAS bf16* KHT = (LAS bf16*)(set + HKH_OFF); LAS bf16* VT = (LAS bf16*)(set + HV_OFF);
        LAS float* OS = (LAS float*)(lds + HOS_OFF + cs * HOS_SZ); LAS float* DEC = (LAS float*)(lds + HDEC_OFF) + cs * 128;
        if (FULL) {
            f32x4 p00 = (f32x4){0.f, 0.f, 0.f, 0.f}, p01 = p00, p11 = p00;
#pragma unroll
            for (int ks = 0; ks < 4; ++ks) {
                const bf16x8 k0 = *(const LAS bf16x8*)(KT + fr * 136 + 32 * ks + 8 * fq), k1 = *(const LAS bf16x8*)(KT + (16 + fr) * 136 + 32 * ks + 8 * fq);
                const bf16x8 q0 = *(const LAS bf16x8*)(QT + fr * 136 + 32 * ks + 8 * fq), q1 = *(const LAS bf16x8*)(QT + (16 + fr) * 136 + 32 * ks + 8 * fq);
                p00 = mfma16(k0, q0, p00); p01 = mfma16(k0, q1, p01); p11 = mfma16(k1, q1, p11); }
#pragma unroll
            for (int i = 0; i < 4; ++i) { const bool keep = 4 * fq + i <= fr; p00[i] = keep ? p00[i] : 0.f; p11[i] = keep ? p11[i] : 0.f; }
            const bf16x8 pf0 = __builtin_bit_cast(bf16x8, (u32x4){pk2(p00[0], p00[1]), pk2(p00[2], p00[3]), 0u, 0u});
            const bf16x8 pf1 = __builtin_bit_cast(bf16x8, (u32x4){pk2(p01[0], p01[1]), pk2(p01[2], p01[3]), pk2(p11[0], p11[1]), pk2(p11[2], p11[3])});
            f32x4 o0 = (f32x4){0.f, 0.f, 0.f, 0.f}, o1 = o0;
#pragma unroll
            for (int ks = 0; ks < 4; ++ks) {
                const bf16x8 sa = __builtin_bit_cast(bf16x8, (u32x4){pk2(S[2 * ks][0], S[2 * ks][1]), pk2(S[2 * ks][2], S[2 * ks][3]), pk2(S[2 * ks + 1][0], S[2 * ks + 1][1]), pk2(S[2 * ks + 1][2], S[2 * ks + 1][3])});
                const u32x2 a0 = *(const LAS u32x2*)(QT + fr * 136 + 32 * ks + 4 * fq), a1 = *(const LAS u32x2*)(QT + fr * 136 + 32 * ks + 16 + 4 * fq);
                const u32x2 c0 = *(const LAS u32x2*)(QT + (16 + fr) * 136 + 32 * ks + 4 * fq), c1 = *(const LAS u32x2*)(QT + (16 + fr) * 136 + 32 * ks + 16 + 4 * fq);
                o0 = mfma16(sa, __builtin_bit_cast(bf16x8, (u32x4){a0.x, a0.y, a1.x, a1.y}), o0);
                o1 = mfma16(sa, __builtin_bit_cast(bf16x8, (u32x4){c0.x, c0.y, c1.x, c1.y}), o1); }
            { const u32x2 v0 = *(const LAS u32x2*)(VT + (16 * w + fr) * 40 + 4 * fq), v1 = *(const LAS u32x2*)(VT + (16 * w + fr) * 40 + 16 + 4 * fq);
              const bf16x8 va = __builtin_bit_cast(bf16x8, (u32x4){v0.x, v0.y, v1.x, v1.y});
              o0 = mfma16(va, pf0, o0); o1 = mfma16(va, pf1, o1); }
            *(LAS f32x4*)(OS + fr * 132 + 16 * w + 4 * fq) = o0; *(LAS f32x4*)(OS + (16 + fr) * 132 + 16 * w + 4 * fq) = o1;
        }
        { const bf16x8 vfr = *(const LAS bf16x8*)(VT + (16 * w + fr) * 40 + 8 * fq);
#pragma unroll
          for (int i = 0; i < 8; ++i) { const f32x4 dv4 = *(const LAS f32x4*)(DEC + 16 * i + 4 * fq); S[i] = S[i] * dv4;
              S[i] = mfma16(*(const LAS bf16x8*)(KHT + (16 * i + fr) * 40 + 8 * fq), vfr, S[i]); } }
        if (PROBE_SEL == 14) PT_ACC(lds, PT_NOW() - tk0);
        } }
        if (PROBE_SEL == 15) tk0 = PT_NOW();
        WG_BAR();
        if (PROBE_SEL == 15) PT_ACC(lds, PT_NOW() - tk0);
        if (FULL) {
            LAS float* OS = (LAS float*)(lds + HOS_OFF + cs * HOS_SZ);
            f32x4 o0 = *(const LAS f32x4*)(OS + fc * 132 + 8 * dvg), o1 = *(const LAS f32x4*)(OS + fc * 132 + 8 * dvg + 4);
            if (!SECOND) { *(f32x4*)op = o0; *(f32x4*)(op + 4) = o1; }
            else { o0 = o0 + op0; o1 = o1 + op1;
                float sq = (o0[0] * o0[0] + o0[1] * o0[1]) + (o0[2] * o0[2] + o0[3] * o0[3]) + (o1[0] * o1[0] + o1[1] * o1[1]) + (o1[2] * o1[2] + o1[3] * o1[3]);
                sq += __shfl_xor(sq, 1); sq += __shfl_xor(sq, 2); sq += __shfl_xor(sq, 4); sq += __shfl_xor(sq, 8);
                const float rs = __builtin_amdgcn_rsqf(sq * (1.f / 128.f) + EPS);
                u32x4 ow; ow.x = pk2(o0[0] * rs * ng0[0] * bflo(gw4.x), o0[1] * rs * ng0[1] * bfhi(gw4.x));
                ow.y = pk2(o0[2] * rs * ng0[2] * bflo(gw4.y), o0[3] * rs * ng0[3] * bfhi(gw4.y));
                ow.z = pk2(o1[0] * rs * ng1[0] * bflo(gw4.z), o1[1] * rs * ng1[1] * bfhi(gw4.z));
                ow.w = pk2(o1[2] * rs * ng1[2] * bflo(gw4.w), o1[3] * rs * ng1[3] * bfhi(gw4.w));
                *(u32x4*)(MIXED + (size_t)(b * SEQ + ftok) * DM + h * 128 + 8 * dvg) = ow; }
        }
    }
    WG_BAR();
#undef HG_LOAD
#undef HG_PREP
}
__device__ __forceinline__ float hg_lb(const float* hg_lb_all, int layer, int dir, int ch) {
    if (layer == 0) return 0.f;
    const float a0 = hg_lb_all[(0 * 2 + dir) * 512 + ch], a1 = hg_lb_all[(1 * 2 + dir) * 512 + ch], mx = fmaxf(a0, a1), e0 = __expf(a0 - mx), e1 = __expf(a1 - mx);
    return e1 / (e0 + e1);
}
__device__ __forceinline__ void hg_passA_item(LAS unsigned char* lds, const Params& p, int layer, int item) {
    const int dir = item & 1, seg = (item >> 1) & (NSEG - 1), h = (item >> 4) & 3, b = item >> 6;
    if ((dir == 0 && seg == NSEG - 1) || (dir == 1 && seg == 0)) return;
    int tid_ = threadIdx.x; asm volatile("" : "+v"(tid_)); const int tid = tid_, w = __builtin_amdgcn_readfirstlane(tid >> 6), lane = tid & 63;
    const float lb = hg_lb(p.hg_lb, layer, dir, h * 128 + 16 * w + (lane & 15));
    f32x4 S[8];
#pragma unroll
    for (int i = 0; i < 8; ++i) S[i] = (f32x4){0.f, 0.f, 0.f, 0.f};
    float bsum = 1.f;
    hg_segment<false, false>(lds, (const bf16*)(p.ws + WS_P), b, h, dir, seg, lb, S, bsum, nullptr, nullptr, nullptr);
    u32x2* sl = (u32x2*)(p.ws + WS_SLOC) + (size_t)item * 4096;
#pragma unroll
    for (int i = 0; i < 8; ++i) sl[(w * 8 + i) * 64 + lane] = (u32x2){pk2(S[i][0], S[i][1]), pk2(S[i][2], S[i][3])};
    if (lane < 16) ((float*)(p.ws + WS_DSEG))[(size_t)item * 128 + 16 * w + (lane & 15)] = bsum;
    __syncthreads();
}
__device__ __forceinline__ unsigned long long hg_passB_item(LAS unsigned char* lds, const Params& p, int layer, int item) {
    unsigned long long tsub = 0, t0_ = 0;
    const int seg = item & (NSEG - 1), h = (item >> 3) & 3, b = item >> 5;
    int tid_ = threadIdx.x; asm volatile("" : "+v"(tid_)); const int tid = tid_, w = __builtin_amdgcn_readfirstlane(tid >> 6), lane = tid & 63, fr = lane & 15, fq = lane >> 4;
    const u32x2* slb = (const u32x2*)(p.ws + WS_SLOC); const float* dsg = (const float*)(p.ws + WS_DSEG);
    float* OP = p.out;   bf16* MIXED = (bf16*)(p.ws + WS_MIX); const bf16* P = (const bf16*)(p.ws + WS_P);
#pragma unroll 1
    for (int dir = 0; dir < 2; ++dir) {
        const float lb = hg_lb(p.hg_lb, layer, dir, h * 128 + 16 * w + (lane & 15));
        f32x4 S[8];
#pragma unroll
        for (int i = 0; i < 8; ++i) S[i] = (f32x4){0.f, 0.f, 0.f, 0.f};
        const int nprev = dir == 0 ? seg : (NSEG - 1 - seg);
        if (PROBE_SEL == 11) t0_ = PT_NOW();
#pragma unroll 1
        for (int q = 0; q < nprev; q += 2) {
            const bool two = q + 1 < nprev; const int sA = dir == 0 ? q : (NSEG - 1 - q), sB = two ? (dir == 0 ? q + 1 : (NSEG - 2 - q)) : sA;
            const int itA = ((b * 4 + h) * NSEG + sA) * 2 + dir, itB = ((b * 4 + h) * NSEG + sB) * 2 + dir;
            const u32x2* slA = slb + (size_t)itA * 4096; const float* dcA = dsg + (size_t)itA * 128; const u32x2* slB = slb + (size_t)itB * 4096; const float* dcB = dsg + (size_t)itB * 128;
            f32x4 dvA[8], dvB[8]; u32x2 svA[8], svB[8];
#pragma unroll
            for (int i = 0; i < 8; ++i) { dvA[i] = *(const f32x4*)(dcA + 16 * i + 4 * fq); svA[i] = slA[(w * 8 + i) * 64 + lane]; dvB[i] = *(const f32x4*)(dcB + 16 * i + 4 * fq); svB[i] = slB[(w * 8 + i) * 64 + lane]; }
            __builtin_amdgcn_sched_barrier(0);
#pragma unroll
            for (int i = 0; i < 8; ++i) { S[i] = S[i] * dvA[i] + (f32x4){bflo(svA[i].x), bfhi(svA[i].x), bflo(svA[i].y), bfhi(svA[i].y)};
                if (two) S[i] = S[i] * dvB[i] + (f32x4){bflo(svB[i].x), bfhi(svB[i].x), bflo(svB[i].y), bfhi(svB[i].y)}; } }
        if (PROBE_SEL == 11) PT_ACC(lds, PT_NOW() - t0_);
        if (PROBE_SEL == 10) t0_ = PT_NOW();
        float bsum = 1.f;
        if (dir == 0) hg_segment<true, false>(lds, P, b, h, 0, seg, lb, S, bsum, OP, MIXED, p.hg_ng + layer * 128);
        else hg_segment<true, true>(lds, P, b, h, 1, seg, lb, S, bsum, OP, MIXED, p.hg_ng + layer * 128);
        if (PROBE_SEL == 10) PT_ACC(lds, PT_NOW() - t0_);
        if (PROBE_SEL == 12) t0_ = PT_NOW();
        __syncthreads();
        if (PROBE_SEL == 12) PT_ACC(lds, PT_NOW() - t0_);
    }
    return tsub;
}

constexpr int NA_KS = 584, NA_RPB_OFF = 64 * NA_KS * 2;
__device__ __forceinline__ int clampi(int v, int lo, int hi) { return v < lo ? lo : (v > hi ? hi : v); }
__device__ __forceinline__ void na_item(LAS unsigned char* lds, const Params& p, int layer, int item) {
    const int rp = item & 15, h = (item >> 4) & 3, b = item >> 6, r0 = 2 * rp, kbase = clampi(r0 - 4, 0, 24);
    int tid_ = threadIdx.x; asm volatile("" : "+v"(tid_)); const int tid = tid_, w = __builtin_amdgcn_readfirstlane(tid >> 6), lane = tid & 63, fr = lane & 15, fq = lane >> 4;
    const bf16* P = (const bf16*)(p.ws + WS_P); bf16* MIXED = (bf16*)(p.ws + WS_MIX);
    LAS bf16* VT = (LAS bf16*)lds; LAS float* RPB = (LAS float*)(lds + NA_RPB_OFF);
    const int rl = w >> 2, j = w & 3, r = r0 + rl, kr0 = clampi(r - 4, 0, 24), kc0 = clampi(16 * j - 8, 0, 32);
    const size_t qtok = (size_t)b * SEQ + r * 64 + 16 * j + fr;
    unsigned long long tn0_ = 0; if (PROBE_SEL >= 20 && PROBE_SEL <= 24) tn0_ = PT_NOW();
    const float rpbv = tid < 465 ? p.rpb[(size_t)(layer * 4 + h) * 465 + tid] : 0.f;
    u32x4 vbuf[9];
#pragma unroll
    for (int it = 0; it < 9; ++it) { const int key = it * 64 + w * 8 + (lane >> 3), dg = lane & 7; int trow = kbase * 64 + key; trow = trow > SEQ - 1 ? SEQ - 1 : trow;
        vbuf[it] = *(const u32x4*)(P + (size_t)(b * SEQ + trow) * DIN + C_NV + h * 64 + 8 * dg); }
    bf16x8 qf[2], kfa[16], kfb[16];
#pragma unroll
    for (int ks = 0; ks < 2; ++ks) qf[ks] = *(const bf16x8*)(P + qtok * DIN + C_NQ + h * 64 + 32 * ks + 8 * fq);
#define NA_KLOAD(dst, hh) do { _Pragma("unroll") for (int k8 = 0; k8 < 8; ++k8) { const int kt = (hh) * 8 + k8, krl = kt >> 1, half = kt & 1; \
        const size_t ktok = (size_t)b * SEQ + (kr0 + krl) * 64 + kc0 + 16 * half + fr; \
        _Pragma("unroll") for (int ks = 0; ks < 2; ++ks) dst[k8 * 2 + ks] = *(const bf16x8*)(P + ktok * DIN + C_NK + h * 64 + 32 * ks + 8 * fq); } } while (0)
    NA_KLOAD(kfa, 0);
    __builtin_amdgcn_sched_barrier(0);
#pragma unroll
    for (int it = 0; it < 9; ++it) { const int key = it * 64 + w * 8 + (lane >> 3), dg = lane & 7; const u32x4 v = vbuf[it];
        LAS bf16* dst = VT + (8 * dg) * NA_KS + (key ^ (dg << 3));
        dst[0 * NA_KS] = (bf16)(v.x & 0xffffu); dst[1 * NA_KS] = (bf16)(v.x >> 16); dst[2 * NA_KS] = (bf16)(v.y & 0xffffu); dst[3 * NA_KS] = (bf16)(v.y >> 16);
        dst[4 * NA_KS] = (bf16)(v.z & 0xffffu); dst[5 * NA_KS] = (bf16)(v.z >> 16); dst[6 * NA_KS] = (bf16)(v.w & 0xffffu); dst[7 * NA_KS] = (bf16)(v.w >> 16); }
    if (tid < 465) RPB[tid] = rpbv;
    if (PROBE_SEL == 20) { LDS_WAIT(); PT_ACC(lds, PT_NOW() - tn0_); } if (PROBE_SEL == 21) tn0_ = PT_NOW();
    NA_KLOAD(kfb, 1);
    __builtin_amdgcn_sched_barrier(0);
    WG_BAR();
    if (PROBE_SEL == 21) PT_ACC(lds, PT_NOW() - tn0_); if (PROBE_SEL == 22) tn0_ = PT_NOW();
    f32x4 s[16];
#pragma unroll
    for (int k8 = 0; k8 < 8; ++k8) { f32x4 a = (f32x4){0.f, 0.f, 0.f, 0.f};
#pragma unroll
        for (int ks = 0; ks < 2; ++ks) a = mfma16(kfa[k8 * 2 + ks], qf[ks], a);
        s[k8] = a; }
#pragma unroll
    for (int k8 = 0; k8 < 8; ++k8) { f32x4 a = (f32x4){0.f, 0.f, 0.f, 0.f};
#pragma unroll
        for (int ks = 0; ks < 2; ++ks) a = mfma16(kfb[k8 * 2 + ks], qf[ks], a);
        s[8 + k8] = a; }
#undef NA_KLOAD
    if (PROBE_SEL == 22) { asm volatile("" :: "v"(s[15][0]), "v"(s[7][0])); PT_ACC(lds, PT_NOW() - tn0_); } if (PROBE_SEL == 23) tn0_ = PT_NOW();
    const int qc = 16 * j + fr, qs = clampi(qc - 8, 0, 48);
    float mx = -1e30f;
#pragma unroll
    for (int kt = 0; kt < 16; ++kt) { const int krl = kt >> 1, half = kt & 1; const int ridx = kr0 + krl - r + 7;
        float bz[4];
#pragma unroll
        for (int i = 0; i < 4; ++i) { const int kc = kc0 + 16 * half + 4 * fq + i; bz[i] = RPB[ridx * 31 + clampi(kc - qc + 15, 0, 30)]; }
#pragma unroll
        for (int i = 0; i < 4; ++i) { const int kc = kc0 + 16 * half + 4 * fq + i; const bool valid = kc >= qs && kc < qs + 16;
            const float v = valid ? s[kt][i] * 0.125f + bz[i] : -1e30f; s[kt][i] = v; mx = fmaxf(mx, v); } }
    mx = fmaxf(mx, __shfl_xor(mx, 16)); mx = fmaxf(mx, __shfl_xor(mx, 32));
    float sum = 0.f;
#pragma unroll
    for (int kt = 0; kt < 16; ++kt)
#pragma unroll
        for (int i = 0; i < 4; ++i) { const float e = __expf(s[kt][i] - mx); s[kt][i] = e; sum += e; }
    sum += __shfl_xor(sum, 16); sum += __shfl_xor(sum, 32);
    if (PROBE_SEL == 23) { asm volatile("" :: "v"(sum)); PT_ACC(lds, PT_NOW() - tn0_); } if (PROBE_SEL == 24) tn0_ = PT_NOW();
    f32x4 o[4];
#pragma unroll
    for (int dt = 0; dt < 4; ++dt) o[dt] = (f32x4){0.f, 0.f, 0.f, 0.f};
#pragma unroll
    for (int kk = 0; kk < 8; ++kk) {
        const u32x4 pw = (u32x4){pk2(s[2 * kk][0], s[2 * kk][1]), pk2(s[2 * kk][2], s[2 * kk][3]), pk2(s[2 * kk + 1][0], s[2 * kk + 1][1]), pk2(s[2 * kk + 1][2], s[2 * kk + 1][3])};
        const bf16x8 pf = __builtin_bit_cast(bf16x8, pw);
        const int keyoff = (kr0 + kk - kbase) * 64 + kc0 + 4 * fq;
#pragma unroll
        for (int dt = 0; dt < 4; ++dt) { const int sw = (2 * dt + (fr >> 3)) << 3;
            const u32x2 lo = *(const LAS u32x2*)(VT + (16 * dt + fr) * NA_KS + (keyoff ^ sw)), hi = *(const LAS u32x2*)(VT + (16 * dt + fr) * NA_KS + ((keyoff + 16) ^ sw));
            const bf16x8 vf = __builtin_bit_cast(bf16x8, (u32x4){lo.x, lo.y, hi.x, hi.y});
            o[dt] = mfma16(vf, pf, o[dt]); } }
    const float inv = 1.f / sum;
#pragma unroll
    for (int dt = 0; dt < 4; ++dt) *(u32x2*)(MIXED + qtok * DM + 512 + h * 64 + 16 * dt + 4 * fq) = (u32x2){pk2(o[dt][0] * inv, o[dt][1] * inv), pk2(o[dt][2] * inv, o[dt][3] * inv)};
    WG_BAR();
    if (PROBE_SEL == 24) PT_ACC(lds, PT_NOW() - tn0_);
}

__device__ __forceinline__ void conv_item(LAS unsigned char* lds, const Params& p, int layer, int item) {
    const int b = item >> 6, t0 = (item & 63) * 32;
    int tid_ = threadIdx.x; asm volatile("" : "+v"(tid_)); const int tid = tid_, w = __builtin_amdgcn_readfirstlane(tid >> 6), lane = tid & 63;
    const bf16* P = (const bf16*)(p.ws + WS_P); bf16* MIXED = (bf16*)(p.ws + WS_MIX);
    LAS float* U = (LAS float*)lds; LAS float* CO = U + 62 * 256;
    u32x4 ca4[4], cg4[4];
#pragma unroll
    for (int it = 0; it < 4; ++it) { const int u = it * NTHR + tid, tt = u >> 5, c8 = u & 31, t = t0 - 15 + tt; ca4[it] = (u32x4){0u, 0u, 0u, 0u}; cg4[it] = ca4[it];
        if (u < 62 * 32 && t >= 0 && t < SEQ) { const bf16* rp = P + (size_t)(b * SEQ + t) * DIN; ca4[it] = *(const u32x4*)(rp + C_CA + 8 * c8); cg4[it] = *(const u32x4*)(rp + C_CG + 8 * c8); } }
    const int c = tid & 255, half = tid >> 8;
    float wk[31];
#pragma unroll
    for (int k = 0; k < 31; ++k) wk[k] = p.cw[(size_t)(layer * 31 + k) * 256 + c];
    const float bias = p.cb[layer * 256 + c];
    __builtin_amdgcn_sched_barrier(0);
#pragma unroll
    for (int it = 0; it < 4; ++it) { const int u = it * NTHR + tid, tt = u >> 5, c8 = u & 31; const u32x4 a = ca4[it], g = cg4[it];
        if (u < 62 * 32) {
            const f32x4 u0 = (f32x4){bflo(a.x) * sigm(bflo(g.x)), bfhi(a.x) * sigm(bfhi(g.x)), bflo(a.y) * sigm(bflo(g.y)), bfhi(a.y) * sigm(bfhi(g.y))};
            const f32x4 u1 = (f32x4){bflo(a.z) * sigm(bflo(g.z)), bfhi(a.z) * sigm(bfhi(g.z)), bflo(a.w) * sigm(bflo(g.w)), bfhi(a.w) * sigm(bfhi(g.w))};
            *(LAS f32x4*)(U + tt * 256 + 8 * c8) = u0; *(LAS f32x4*)(U + tt * 256 + 8 * c8 + 4) = u1; } }
    WG_BAR();
#pragma unroll 1
    for (int g = 0; g < 2; ++g) { const int base = 16 * half + 8 * g; float win[38];
#pragma unroll
        for (int i = 0; i < 38; ++i) win[i] = U[(base + i) * 256 + c];
#pragma unroll
        for (int o = 0; o < 8; ++o) { float a = bias;
#pragma unroll
            for (int k = 0; k < 31; ++k) a += wk[k] * win[o + k];
            CO[(base + o) * 256 + c] = a; } }
    __syncthreads();
    const f32x4 lg = *(const f32x4*)(p.lng + layer * 256 + 4 * lane), lbv = *(const f32x4*)(p.lnb + layer * 256 + 4 * lane);
#pragma unroll
    for (int q = 0; q < 4; ++q) { const int tl = 4 * w + q; const f32x4 v = *(const LAS f32x4*)(CO + tl * 256 + 4 * lane);
        const float mean = wave_sum((v.x + v.y) + (v.z + v.w)) * (1.f / 256.f); const f32x4 dd = v - mean;
        const float var = wave_sum((dd.x * dd.x + dd.y * dd.y) + (dd.z * dd.z + dd.w * dd.w)) * (1.f / 256.f); const float rs = __builtin_amdgcn_rsqf(var + EPS);
        f32x4 y = dd * rs * lg + lbv; y = (f32x4){silu_f0(y.x), silu_f0(y.y), silu_f0(y.z), silu_f0(y.w)};
        *(u32x2*)(MIXED + (size_t)(b * SEQ + t0 + tl) * DM + 768 + 4 * lane) = (u32x2){pk2(y.x, y.y), pk2(y.z, y.w)}; }
    __syncthreads();
}

#define XB_TMO      128
#define XB_XCNT(j)  (256  + 64 * (j))
#define XB_XSUB(j)  (1280 + 64 * (j))
#define XB_XGEN(j)  (2304 + 64 * (j))
#define XB_TOP      3328
#define XB_TOPGEN   3392
#define XCD_BAR_WORDS 3456
#define XB_SPIN_CAP (1u << 18)

__device__ __forceinline__ unsigned xb_ld(unsigned* p)              { return __hip_atomic_load(p, __ATOMIC_RELAXED, __HIP_MEMORY_SCOPE_AGENT); }
__device__ __forceinline__ unsigned xb_add(unsigned* p, unsigned v) { return __hip_atomic_fetch_add(p, v, __ATOMIC_RELAXED, __HIP_MEMORY_SCOPE_AGENT); }
__device__ __forceinline__ unsigned xb_xcc_id() { return (unsigned)__builtin_amdgcn_s_getreg((3 << 11) | 20) & 0xFu; }
#define XB_SPIN(cond, bar) do { unsigned _sp = 0; while (cond) { __builtin_amdgcn_s_sleep(1); \
    if ((++_sp & 255u) == 0u) { if (xb_ld(&(bar)[XB_TMO])) break; if (_sp > XB_SPIN_CAP) { atomicAdd(&(bar)[XB_TMO], 1u); break; } } } } while (0)

struct XcdBarrier {
    unsigned* bar; unsigned x;
    volatile LAS unsigned* st;
};

__device__ __forceinline__ XcdBarrier xcd_barrier_post(unsigned* bar, volatile LAS unsigned* st) {
    XcdBarrier b; b.bar = bar; b.x = xb_xcc_id(); b.st = st;
    if (threadIdx.x == 0) (void)xb_add(&bar[XB_XCNT(b.x)], 1u);
    return b;
}
__device__ __forceinline__ void xcd_barrier_complete(unsigned* bar, unsigned x, unsigned& nloc, unsigned& nx) {
    const unsigned G = gridDim.x * gridDim.y * gridDim.z;
    unsigned sum, cnt, mine, sp = 0u;
    for (;;) {
        sum = 0u; cnt = 0u; mine = 0u;
#pragma unroll
        for (unsigned j = 0; j < 16; ++j) { const unsigned c = xb_ld(&bar[XB_XCNT(j)]); sum += c; cnt += (c > 0u) ? 1u : 0u; mine = (j == x) ? c : mine; }
        if (sum == G) break;
        __builtin_amdgcn_s_sleep(1);
        if ((++sp & 255u) == 0u) { if (xb_ld(&bar[XB_TMO])) break; if (sp > XB_SPIN_CAP) { atomicAdd(&bar[XB_TMO], 1u); break; } }
    }
    nloc = mine > 0u ? mine : 1u; nx = cnt > 0u ? cnt : 1u;
}

__device__ __forceinline__ void xcd_barrier(const XcdBarrier& b) {
    asm volatile("s_waitcnt vmcnt(0)" ::: "memory");
    __syncthreads();
    if (threadIdx.x == 0) {
        unsigned* bar = b.bar;
        __builtin_amdgcn_s_waitcnt(0);
        unsigned nloc = b.st[0], nx = b.st[1];
        if (nloc == 0u) { xcd_barrier_complete(bar, b.x, nloc, nx); b.st[0] = nloc; b.st[1] = nx; }
        const unsigned old = xb_add(&bar[XB_XSUB(b.x)], 1u);
        const unsigned gen = old / nloc;
        if (old + 1u == (gen + 1u) * nloc) {
            __builtin_amdgcn_fence(__ATOMIC_RELEASE, "agent");
            asm volatile("s_waitcnt vmcnt(0)" ::: "memory");
            const unsigned og = xb_add(&bar[XB_TOP], 1u);
            const unsigned tg = og / nx;
            if (og + 1u == (tg + 1u) * nx) xb_add(&bar[XB_TOPGEN], 1u);
            else XB_SPIN(xb_ld(&bar[XB_TOPGEN]) == tg, bar);
            __builtin_amdgcn_fence(__ATOMIC_ACQUIRE, "agent");
            xb_add(&bar[XB_XGEN(b.x)], 1u);
            asm volatile("s_waitcnt vmcnt(0)" ::: "memory");
        } else {
            XB_SPIN(xb_ld(&bar[XB_XGEN(b.x)]) == gen, bar);
            __builtin_amdgcn_fence(__ATOMIC_ACQUIRE, "agent");
            asm volatile("s_waitcnt vmcnt(0)" ::: "memory");
        }
    }
    __syncthreads();
}

#if 0
#define PROBE_SEL_UNUSED (-1)
#endif
#ifndef REP_HA
#define REP_HA 1
#endif
#ifndef REP_NA
#define REP_NA 1
#endif
#ifndef REP_CV
#define REP_CV 1
#endif
#ifndef REP_F
#define REP_F 1
#endif
#ifndef REP_B
#define REP_B 1
#endif
#define GRID_BAR() do { XcdBarrier xb_; xb_.bar = (unsigned*)(ws + WS_BAR); xb_.x = xb_xcc_id(); xb_.st = (volatile LAS unsigned*)(lds + XB_ST_OFF); xcd_barrier(xb_); } while (0)
#define PHASE_END(kind) do { GRID_BAR(); if (PROBE_SEL >= 0 && PROBE_SEL < 10 && threadIdx.x == 0) { volatile LAS unsigned long long* pv_ = (volatile LAS unsigned long long*)(lds + PT_WORDS_OFF + 8); const unsigned long long t_ = PT_NOW(); if ((kind) == PROBE_SEL || PROBE_SEL == 9) PT_ACC(lds, t_ - pv_[0]); pv_[0] = t_; } } while (0)
constexpr size_t WS_BAR = 4096, WS_CTL_BYTES = 65536;
constexpr int XB_ST_OFF = 140288;
constexpr int RS_OFF = 131072;
constexpr int LDS_BYTES = 147456;
#define KARGS(q_) const Params& q_ = p_unused;
__global__ void __launch_bounds__(NTHR, 2) fwd_megakernel(Params p_unused) {
    extern __shared__ __attribute__((aligned(16))) unsigned char lds_raw[];
    LAS unsigned char* lds = (LAS unsigned char*)lds_raw;
    int tid_ = threadIdx.x; asm volatile("" : "+v"(tid_)); const int tid = tid_, lane = tid & 63, wave = __builtin_amdgcn_readfirstlane(tid >> 6);
    const int G = gridDim.x, bid = blockIdx.x, gw = bid * NWAVES + wave, NGW = G * NWAVES;
    unsigned char* ws; { KARGS(q0); ws = q0.ws; }

    if (tid < 2) ((volatile LAS unsigned*)(lds + XB_ST_OFF))[tid] = 0u;
    __syncthreads();
    if (ws == nullptr) cg::this_grid().sync();
    (void)xcd_barrier_post((unsigned*)(ws + WS_BAR), (volatile LAS unsigned*)(lds + XB_ST_OFF));
    if (PROBE_SEL >= 0 && threadIdx.x == 0) { ((volatile LAS unsigned*)(lds + PT_WORDS_OFF))[0] = 0u; *(volatile LAS unsigned long long*)(lds + PT_WORDS_OFF + 8) = PT_NOW(); }
    { KARGS(q); prologue(q, lds, gw, NGW, wave, lane); }
    PHASE_END(0);
    if (PROBE_SEL == 8) { PHASE_END(9); PHASE_END(8); }
#pragma unroll 1
    for (int l = 0; l < DEPTH; ++l) {
        unsigned char* wsl; { KARGS(ql); wsl = ql.ws; }
        float* ssq = (float*)(wsl + WS_SSQ); bf16* XB = (bf16*)(wsl + WS_XB); bf16* PB = (bf16*)(wsl + WS_P); bf16* MIXED = (bf16*)(wsl + WS_MIX);
        {
            pg8::Gemm g{XB, (const bf16*)(wsl + WS_WIN + l * WS_WIN_L), M, DIN, DM}; pg8::StaticOrder S; S.init(M, DIN, G, bid);
            pg8::rstd_table((LAS float*)(lds + RS_OFF), ssq, S); pg8::EpiScale E{PB, DIN, (LAS float*)(lds + RS_OFF), 0x303u};
            pg8::gemm_phase<pg8::EpiScale, pg8::StaticOrder, true, true>(lds, g, S, E);
            {
                KARGS(qc); const int nfull = (M / 256) * (DIN / 256) % G, first = nfull ? nfull : 0, nidle = G - first;
                if (bid >= first) { int tc_ = threadIdx.x; asm volatile("" : "+v"(tc_)); const int wv_ = __builtin_amdgcn_readfirstlane(tc_ >> 6); convert_weights(qc, lds, l * I_L + I_IN, l * I_L + I_IN + I_OUT + I_GU, (bid - first) * NWAVES + wv_, nidle * NWAVES, wv_, tc_ & 63); }
            }
        }
        PHASE_END(1);
#pragma unroll 1
        for (int rep = 0; rep < REP_HA; ++rep)
        { KARGS(q); for (int it = bid; it < BATCH * 4 * NSEG * 2; it += G) hg_passA_item(lds, q, l, it); }
#pragma unroll 1
        for (int rep = 0; rep < REP_NA; ++rep)
        { KARGS(q); for (int it = bid; it < BATCH * 4 * 16; it += G) na_item(lds, q, l, it); }
#pragma unroll 1
        for (int rep = 0; rep < REP_CV; ++rep)
        { KARGS(q); for (int it = bid; it < BATCH * 64; it += G) conv_item(lds, q, l, it); }
        PHASE_END(2);
#pragma unroll 1
        for (int rep = 0; rep < REP_B; ++rep)
        { KARGS(q); for (int it = bid; it < BATCH * 4 * NSEG; it += G) (void)hg_passB_item(lds, q, l, it); }
        PHASE_END(3);
        {
            pg8::Gemm g{MIXED, (const bf16*)(wsl + WS_WOUT + l * WS_WOUT_L), M, DM, DM}; pg8::StaticOrder S; S.init(M, DM, G, bid);
            pg8::EpiRes E{XB, ssq};
            pg8::gemm_phase<pg8::EpiRes, pg8::StaticOrder, true, true>(lds, g, S, E);
        }
        PHASE_END(4);
        {
            pg8::Gemm g{XB, (const bf16*)(wsl + WS_WGU + l * WS_WGU_L), M, 2 * FFN, DM}; pg8::StaticOrder S; S.init(M, 2 * FFN, G, bid);
            pg8::rstd_table((LAS float*)(lds + RS_OFF), ssq, S); pg8::EpiSwiGLU E{PB, FFN, (LAS float*)(lds + RS_OFF)};
            pg8::gemm_phase<pg8::EpiSwiGLU, pg8::StaticOrder, true, true>(lds, g, S, E);
            {
                KARGS(qc); const int nfull = (M / 256) * (2 * FFN / 256) % G, first = nfull ? nfull : 0, nidle = G - first;
                if (bid >= first) { int tc_ = threadIdx.x; asm volatile("" : "+v"(tc_)); const int wv_ = __builtin_amdgcn_readfirstlane(tc_ >> 6); convert_weights(qc, lds, l * I_L + I_IN + I_OUT + I_GU, (l + 1 < DEPTH) ? (l + 1) * I_L + I_IN : (l + 1) * I_L, (bid - first) * NWAVES + wv_, nidle * NWAVES, wv_, tc_ & 63); }
            }
        }
        PHASE_END(5);
        {
            pg8::Gemm g{PB, (const bf16*)(wsl + WS_WDN + l * WS_WDN_L), M, DM, FFN}; pg8::StaticOrder S; S.init(M, DM, G, bid);
            pg8::EpiRes E{XB, ssq};
            pg8::gemm_phase<pg8::EpiRes, pg8::StaticOrder, true, true>(lds, g, S, E);
        }
        PHASE_END(6);
    }
    float pdelta = 0.f;
    int tf_ = threadIdx.x; asm volatile("" : "+v"(tf_)); const int lanef = tf_ & 63, gwf = bid * NWAVES + __builtin_amdgcn_readfirstlane(tf_ >> 6);
    KARGS(qf); unsigned char* wsf = qf.ws; const float* ssq = (const float*)(wsf + WS_SSQ); const bf16* XB = (const bf16*)(wsf + WS_XB);
    if (PROBE_SEL >= 0) {
        unsigned* tw = (unsigned*)(wsf + 64);
        if (bid == 0 && threadIdx.x == 0) __hip_atomic_store(tw, ((volatile LAS unsigned*)(lds + PT_WORDS_OFF))[0], __ATOMIC_RELAXED, __HIP_MEMORY_SCOPE_AGENT);
        GRID_BAR();
        pdelta = (float)__hip_atomic_load(tw, __ATOMIC_RELAXED, __HIP_MEMORY_SCOPE_AGENT) * (PROBE_SEL == 9 ? 0.5e-6f : 1e-6f);
    }
#pragma unroll 1
    for (int rep = 0; rep < REP_F; ++rep)
    for (int m = gwf; m < M; m += 2 * NGW) {
        const int m2 = (m + NGW < M) ? m + NGW : m;
        float pa = lanef < 16 ? ssq[(size_t)(lanef & 15) * M + m] : 0.f, pc = lanef < 16 ? ssq[(size_t)(lanef & 15) * M + m2] : 0.f;
        const u32x4* xa = (const u32x4*)(XB + (size_t)m * DM) + lanef; const u32x4* xc = (const u32x4*)(XB + (size_t)m2 * DM) + lanef;
        u32x4 va[2], vc[2]; f32x4 gg[4];
#pragma unroll
        for (int j = 0; j < 2; ++j) { va[j] = __builtin_nontemporal_load(xa + 64 * j); vc[j] = __builtin_nontemporal_load(xc + 64 * j); gg[2 * j] = *(const f32x4*)(qf.fin_g + 512 * j + 8 * lanef); gg[2 * j + 1] = *(const f32x4*)(qf.fin_g + 512 * j + 8 * lanef + 4); }
        __builtin_amdgcn_sched_barrier(0);
        pa = wave_sum(pa); pc = wave_sum(pc);
        const float ra = __builtin_amdgcn_rsqf(pa * (1.f / DM) + EPS), rc = __builtin_amdgcn_rsqf(pc * (1.f / DM) + EPS);
        const f32x4 pd = (PROBE_SEL >= 0) ? (f32x4){pdelta, -pdelta, pdelta, -pdelta} : (f32x4){0.f, 0.f, 0.f, 0.f};
#pragma unroll
        for (int j = 0; j < 2; ++j) {
            { const u32x4 r = va[j]; float* o = qf.out + (size_t)m * DM + 512 * j + 8 * lanef;
              f32x4 v0 = (f32x4){bflo(r.x), bfhi(r.x), bflo(r.y), bfhi(r.y)} * ra * gg[2 * j], v1 = (f32x4){bflo(r.z), bfhi(r.z), bflo(r.w), bfhi(r.w)} * ra * gg[2 * j + 1];
              if (PROBE_SEL >= 0 && m < 256) { v0 = v0 + pd; v1 = v1 + pd; }
              __builtin_nontemporal_store(v0, (f32x4*)o); __builtin_nontemporal_store(v1, (f32x4*)(o + 4)); }
            if (m2 != m) { const u32x4 r = vc[j]; float* o = qf.out + (size_t)m2 * DM + 512 * j + 8 * lanef;
              f32x4 v0 = (f32x4){bflo(r.x), bfhi(r.x), bflo(r.y), bfhi(r.y)} * rc * gg[2 * j], v1 = (f32x4){bflo(r.z), bfhi(r.z), bflo(r.w), bfhi(r.w)} * rc * gg[2 * j + 1];
              if (PROBE_SEL >= 0 && m2 < 256) { v0 = v0 + pd; v1 = v1 + pd; }
              __builtin_nontemporal_store(v0, (f32x4*)o); __builtin_nontemporal_store(v1, (f32x4*)(o + 4)); } }
    }
}

extern "C" void kernel_launch(void* const* d_in, const int* in_sizes, int n_in, void* d_out, int out_size, void* d_ws, size_t ws_size, hipStream_t stream) {
    static int grid_blocks = 0;
    if (grid_blocks == 0) {
        if (n_in != 15 || out_size != M * DM || ws_size < WS_END) { fprintf(stderr, "kernel_launch: unexpected shapes (n_in %d out %d ws %zu)\n", n_in, out_size, ws_size); grid_blocks = -1; return; }
        int dev = 0, cus = 0, per_cu = 0;
        hipGetDevice(&dev); hipDeviceGetAttribute(&cus, hipDeviceAttributeMultiprocessorCount, dev);
        hipFuncSetAttribute((const void*)fwd_megakernel, hipFuncAttributeMaxDynamicSharedMemorySize, LDS_BYTES);
        hipOccupancyMaxActiveBlocksPerMultiprocessor(&per_cu, (const void*)fwd_megakernel, NTHR, LDS_BYTES);
        if (per_cu < 1) { fprintf(stderr, "kernel_launch: occupancy query says %d blocks per CU\n", per_cu); per_cu = 1; }
        (void)hipGetLastError();
        grid_blocks = cus * 1;
    }
    if (grid_blocks < 0) return;
    Params p{};
    p.x = (const float*)d_in[0]; p.mix_g = (const float*)d_in[1]; p.w_in = (const float*)d_in[2]; p.hg_lb = (const float*)d_in[3]; p.hg_ng = (const float*)d_in[4];
    p.rpb = (const float*)d_in[5]; p.cw = (const float*)d_in[6]; p.cb = (const float*)d_in[7]; p.lng = (const float*)d_in[8]; p.lnb = (const float*)d_in[9];
    p.w_out = (const float*)d_in[10]; p.ffn_g = (const float*)d_in[11]; p.w_gu = (const float*)d_in[12]; p.w_dn = (const float*)d_in[13]; p.fin_g = (const float*)d_in[14];
    p.out = (float*)d_out; p.ws = (unsigned char*)d_ws;
    if (hipMemsetAsync(d_ws, 0, WS_CTL_BYTES, stream) != hipSuccess) { fprintf(stderr, "kernel_launch: hipMemsetAsync failed\n"); return; }
    void* args[] = {&p};
    hipError_t e = hipLaunchCooperativeKernel((const void*)fwd_megakernel, dim3(grid_blocks), dim3(NTHR), args, LDS_BYTES, stream);
    if (e != hipSuccess) fprintf(stderr, "cooperative launch failed: %s (grid %d)\n", hipGetErrorString(e), grid_blocks);
}
```

```cpp
#include <hip/hip_runtime.h>
#include <hip/hip_cooperative_groups.h>
#include <cstdio>
#include <cstdint>
namespace cg = cooperative_groups;

namespace pg8 {
#define PG8_LAS __attribute__((address_space(3)))
typedef unsigned short bf16_t;
typedef short bf16x8 __attribute__((ext_vector_type(8)));
typedef float f32x4 __attribute__((ext_vector_type(4)));
typedef unsigned u32x4 __attribute__((ext_vector_type(4)));
constexpr int BM = 256, BK = 64, HALF = 128, HTB = HALF * BK * 2  , STAGE_BYTES = 8 * HTB, NXCD = 8, WGM = 8;

__host__ __device__ __forceinline__ int lds_byte(int r, int c) { const int st = (r >> 4) * 2 + (c >> 5), rr = r & 15, cc = c & 31, ob = rr * 64 + cc * 2; return st * 1024 + (ob ^ (((ob >> 9) & 1) << 5)); }
__host__ __device__ __forceinline__ void stage_rc(int b, int& R, int& C) { const int st = b / 1024, sb = b % 1024, swz = sb ^ (((sb >> 9) & 1) << 5); R = (st >> 1) * 16 + swz / 64; C = (st & 1) * 32 + (swz % 64) / 2; }
__host__ __device__ __forceinline__ int perm32(int rho) { const int n = rho >> 4, i = rho & 15; return 8 * (i >> 2) + 4 * n + (i & 3); }

struct Unit { int pm, pn; };
struct Gemm { const bf16_t* A; const bf16_t* Bt; int M, N, K; };

struct StaticOrder {
    int nM, nN, nwg, G, c;
    __host__ __device__ void init(int M, int N, int G_, int c_) { nM = M / BM; nN = N / BM; nwg = nM * nN; G = G_; c = c_; }
    __host__ __device__ bool next(int i, Unit& u) const {
        const long L = (long)i * G + c; if (L >= nwg) return false;
        int wgid = (int)L; { const int q = nwg / NXCD, r = nwg % NXCD, xcd = wgid % NXCD, off = wgid / NXCD; wgid = (xcd < r ? xcd * (q + 1) : r * (q + 1) + (xcd - r) * q) + off; }
        const int nig = WGM * nN, gid = wgid / nig, fm = gid * WGM, gsz = (nM - fm) < WGM ? (nM - fm) : WGM;
        u.pm = fm + ((wgid % nig) % gsz); u.pn = (wgid % nig) / gsz; return true;
    }
    __device__ __forceinline__ void a_ready(const Unit&) const {}
    __device__ __forceinline__ void done(const Unit&) const {}
};
__device__ __forceinline__ unsigned cvt_pk_bf16(float lo, float hi) { unsigned r; asm volatile("v_cvt_pk_bf16_f32 %0, %1, %2" : "=v"(r) : "v"(lo), "v"(hi)); return r; }
typedef float f32x2 __attribute__((ext_vector_type(2)));
constexpr int MROWS = 16384, DMODEL = 1024, NPART = 16;
constexpr float NORM_EPS = 1e-6f;
__device__ __forceinline__ float row_rstd(const float* ssq, int row) {
    float s = 0.f;
#pragma unroll
    for (int p = 0; p < NPART; ++p) s += ssq[(size_t)p * MROWS + row];
    return __builtin_amdgcn_rsqf(s * (1.f / DMODEL) + NORM_EPS);
}
__device__ __forceinline__ float silu_f(float x) { return x * __builtin_amdgcn_rcpf(1.f + __expf(-x)); }

struct EpiScale {
    static constexpr bool PERM = true, AFTER_DRAIN = false;
    bf16_t* O; int ldc; const PG8_LAS float* RS; unsigned silu_mask;
    __device__ __forceinline__ void operator()(const f32x4 (&acc)[2][2][4][2], const Unit& u, int ui, int wr, int wc, int fr, int fq) const {
        const int row0 = u.pm * BM + wr * 64 + fr, col0 = u.pn * BM + wc * 32 + 8 * fq; const bool act = (silu_mask >> u.pn) & 1u;
#pragma unroll
        for (int ai = 0; ai < 2; ++ai)
#pragma unroll
            for (int m = 0; m < 4; ++m) { const int row = row0 + ai * HALF + m * 16; const float rs = RS[ui * BM + wr * 64 + fr + ai * HALF + m * 16]; bf16_t* rowp = O + (size_t)row * ldc + col0;
#pragma unroll
                for (int bj = 0; bj < 2; ++bj) { f32x4 v0 = acc[ai][bj][m][0] * rs, v1 = acc[ai][bj][m][1] * rs;
                    if (act) { v0 = (f32x4){silu_f(v0[0]), silu_f(v0[1]), silu_f(v0[2]), silu_f(v0[3])}; v1 = (f32x4){silu_f(v1[0]), silu_f(v1[1]), silu_f(v1[2]), silu_f(v1[3])}; }
                    u32x4 w; w.x = cvt_pk_bf16(v0[0], v0[1]); w.y = cvt_pk_bf16(v0[2], v0[3]); w.z = cvt_pk_bf16(v1[0], v1[1]); w.w = cvt_pk_bf16(v1[2], v1[3]);
                    *(u32x4*)(rowp + bj * HALF) = w; } __builtin_amdgcn_sched_barrier(0); }
    }
};
struct EpiRes {
    static constexpr bool PERM = true, AFTER_DRAIN = false;
    bf16_t* XB; float* ssq;
    __device__ __forceinline__ void operator()(const f32x4 (&acc)[2][2][4][2], const Unit& u, int ui, int wr, int wc, int fr, int fq) const {
        const int row0 = u.pm * BM + wr * 64 + fr, col0 = u.pn * BM + wc * 32 + 8 * fq;
#pragma unroll
        for (int ai = 0; ai < 2; ++ai)
#pragma unroll
            for (int mm = 0; mm < 4; mm += 2) {
                u32x4 rr[2][2];
#pragma unroll
                for (int q = 0; q < 2; ++q)
#pragma unroll
                    for (int bj = 0; bj < 2; ++bj) rr[q][bj] = *(const u32x4*)(XB + (size_t)(row0 + ai * HALF + (mm + q) * 16) * DMODEL + col0 + bj * HALF);
                __builtin_amdgcn_sched_barrier(0);
#pragma unroll
                for (int q = 0; q < 2; ++q) { const int m = mm + q, row = row0 + ai * HALF + m * 16; const size_t o = (size_t)row * DMODEL + col0; float sq = 0.f;
#pragma unroll
                    for (int bj = 0; bj < 2; ++bj) { const u32x4 r = rr[q][bj];
                        const f32x4 r0 = (f32x4){__builtin_bit_cast(float, r.x << 16), __builtin_bit_cast(float, r.x & 0xffff0000u), __builtin_bit_cast(float, r.y << 16), __builtin_bit_cast(float, r.y & 0xffff0000u)};
                        const f32x4 r1 = (f32x4){__builtin_bit_cast(float, r.z << 16), __builtin_bit_cast(float, r.z & 0xffff0000u), __builtin_bit_cast(float, r.w << 16), __builtin_bit_cast(float, r.w & 0xffff0000u)};
                        const f32x4 v0 = acc[ai][bj][m][0] + r0, v1 = acc[ai][bj][m][1] + r1;
                        u32x4 w; w.x = cvt_pk_bf16(v0[0], v0[1]); w.y = cvt_pk_bf16(v0[2], v0[3]); w.z = cvt_pk_bf16(v1[0], v1[1]); w.w = cvt_pk_bf16(v1[2], v1[3]);
                        *(u32x4*)(XB + o + bj * HALF) = w;
                        sq += (v0[0] * v0[0] + v0[1] * v0[1]) + (v0[2] * v0[2] + v0[3] * v0[3]) + (v1[0] * v1[0] + v1[1] * v1[1]) + (v1[2] * v1[2] + v1[3] * v1[3]); }
                    sq += __shfl_xor(sq, 16); sq += __shfl_xor(sq, 32);
                    if (fq == 0) ssq[(size_t)(u.pn * 4 + wc) * MROWS + row] = sq; }
                __builtin_amdgcn_sched_barrier(0); }
    }
};
struct EpiSwiGLU {
    static constexpr bool PERM = true, AFTER_DRAIN = false;
    bf16_t* O; int ldc; const PG8_LAS float* RS;
    __device__ __forceinline__ void operator()(const f32x4 (&acc)[2][2][4][2], const Unit& u, int ui, int wr, int wc, int fr, int fq) const {
        const int row0 = u.pm * BM + wr * 64 + fr, col0 = u.pn * HALF + wc * 32 + 8 * fq;
#pragma unroll
        for (int ai = 0; ai < 2; ++ai)
#pragma unroll
            for (int m = 0; m < 4; ++m) { const int row = row0 + ai * HALF + m * 16; const float rs = RS[ui * BM + wr * 64 + fr + ai * HALF + m * 16];
                const f32x4 g0 = acc[ai][0][m][0] * rs, g1 = acc[ai][0][m][1] * rs, u0 = acc[ai][1][m][0] * rs, u1 = acc[ai][1][m][1] * rs;
                u32x4 w; w.x = cvt_pk_bf16(silu_f(g0[0]) * u0[0], silu_f(g0[1]) * u0[1]); w.y = cvt_pk_bf16(silu_f(g0[2]) * u0[2], silu_f(g0[3]) * u0[3]);
                w.z = cvt_pk_bf16(silu_f(g1[0]) * u1[0], silu_f(g1[1]) * u1[1]); w.w = cvt_pk_bf16(silu_f(g1[2]) * u1[2], silu_f(g1[3]) * u1[3]);
                *(u32x4*)(O + (size_t)row * ldc + col0) = w; __builtin_amdgcn_sched_barrier(0); }
    }
};
template <class Sched> __device__ __forceinline__ void rstd_table(PG8_LAS float* RS, const float* ssq, const Sched& S) {
    int tx_ = threadIdx.x; asm volatile("" : "+v"(tx_));
    Unit u; const int t = tx_ & (BM - 1);
    for (int i = __builtin_amdgcn_readfirstlane(tx_ >> 8); S.next(i, u); i += 2) {
        float v[NPART];
#pragma unroll
        for (int p = 0; p < NPART; ++p) v[p] = ssq[(size_t)p * MROWS + u.pm * BM + t];
        __builtin_amdgcn_sched_barrier(0);
        const float s = (((v[0] + v[1]) + (v[2] + v[3])) + ((v[4] + v[5]) + (v[6] + v[7]))) + (((v[8] + v[9]) + (v[10] + v[11])) + ((v[12] + v[13]) + (v[14] + v[15])));
        RS[i * BM + t] = __builtin_amdgcn_rsqf(s * (1.f / DMODEL) + NORM_EPS);
    }
    __syncthreads();
}
template <class Epi, class Sched, bool ALIGN_EPI = false, bool SP2 = false>
__device__ __forceinline__ void gemm_phase(PG8_LAS unsigned char* lds, const Gemm g, const Sched& S, const Epi& E) {
    int tid_ = threadIdx.x; asm volatile("" : "+v"(tid_));
    const int tid = tid_, wid = __builtin_amdgcn_readfirstlane(tid >> 6), lane = tid & 63, wr = wid >> 2, wc = wid & 3, fr = lane & 15, fq = lane >> 4;
    const int K = g.K, nt = K / BK;
    unsigned voffA[2], voffB[2];
#pragma unroll
    for (int i = 0; i < 2; ++i) { int R, C; stage_rc(tid * 16 + i * 8192, R, C); const int Rb = Epi::PERM ? ((R & ~31) + perm32(R & 31)) : R;
        voffA[i] = (unsigned)(R * K + C) * 2u; voffB[i] = (unsigned)(Rb * K + C) * 2u; }
    const size_t kstep = (size_t)(BK * 2);
    const size_t hstep = (size_t)HALF * K * 2;
    const size_t tstep = 2 * hstep;
    const unsigned ldsw = (unsigned)wid * 1024u;
    const int aoff = lds_byte(wr * 64 + fr, fq * 8), boff = lds_byte(wc * 32 + fr, fq * 8);
#define PG8_SA(b, h) (((b) * 2 + (h)) * HTB)
#define PG8_SB(b, h) ((4 + (b) * 2 + (h)) * HTB)
#define PG8_STAGE(bufoff, gbase, voff) do { _Pragma("unroll") for (int _i = 0; _i < 2; ++_i) \
        __builtin_amdgcn_global_load_lds((const unsigned*)((const char*)(gbase) + (voff)[_i]), (PG8_LAS unsigned*)(lds + (bufoff) + ldsw + _i * 8192), 16, 0, 0); } while (0)
#define PG8_LDA(dst, b, h) do { _Pragma("unroll") for (int m = 0; m < 4; ++m) _Pragma("unroll") for (int k = 0; k < 2; ++k) dst[m][k] = *(const PG8_LAS bf16x8*)(lds + PG8_SA(b, h) + aoff + m * 2048 + k * 1024); } while (0)
#define PG8_LDB(dst, b, h) do { _Pragma("unroll") for (int n = 0; n < 2; ++n) _Pragma("unroll") for (int k = 0; k < 2; ++k) dst[n][k] = *(const PG8_LAS bf16x8*)(lds + PG8_SB(b, h) + boff + n * 2048 + k * 1024); } while (0)
#define PG8_MMA(ai, bj, At, Bt) do { __builtin_amdgcn_s_setprio(1); _Pragma("unroll") for (int m = 0; m < 4; ++m) _Pragma("unroll") for (int n = 0; n < 2; ++n) _Pragma("unroll") for (int k = 0; k < 2; ++k) \
        acc[ai][bj][m][n] = __builtin_amdgcn_mfma_f32_16x16x32_bf16(Bt[n][k], At[m][k], acc[ai][bj][m][n], 0, 0, 0); __builtin_amdgcn_s_setprio(0); } while (0)
#define PG8_WAIT_V(n) asm volatile("s_waitcnt vmcnt(" #n ")" ::: "memory")
#define PG8_WAIT_L(n) asm volatile("s_waitcnt lgkmcnt(" #n ")" ::: "memory")
#define PG8_BAR __builtin_amdgcn_s_barrier()
#define PG8_SCHED __builtin_amdgcn_sched_barrier(0)
    Unit cur, nxt; int ui = 0;
    if (!S.next(0, cur)) return;
    f32x4 acc[2][2][4][2];
#pragma unroll
    for (int a = 0; a < 2; ++a)
#pragma unroll
        for (int b = 0; b < 2; ++b)
#pragma unroll
            for (int m = 0; m < 4; ++m)
#pragma unroll
                for (int n = 0; n < 2; ++n) acc[a][b][m][n] = (f32x4){0.f, 0.f, 0.f, 0.f};
    bf16x8 At[4][2], B0[2][2], B1[2][2];
    const char* cA = (const char*)g.A + (size_t)cur.pm * tstep; const char* cB = (const char*)g.Bt + (size_t)cur.pn * tstep;
    S.a_ready(cur);
    if constexpr (SP2) {
        PG8_STAGE(PG8_SB(0, 0), cB, voffB); PG8_STAGE(PG8_SB(0, 1), cB + hstep, voffB); PG8_STAGE(PG8_SA(0, 0), cA, voffA); PG8_STAGE(PG8_SA(0, 1), cA + hstep, voffA);
        if (wr == 1) PG8_BAR;
        PG8_WAIT_V(2); PG8_BAR;
        PG8_STAGE(PG8_SB(1, 0), cB + kstep, voffB); PG8_STAGE(PG8_SA(1, 0), cA + kstep, voffA); PG8_STAGE(PG8_SB(1, 1), cB + hstep + kstep, voffB);
        PG8_WAIT_V(6); PG8_BAR;
    } else {
        PG8_STAGE(PG8_SB(0, 0), cB, voffB); PG8_STAGE(PG8_SA(0, 0), cA, voffA); PG8_STAGE(PG8_SB(0, 1), cB + hstep, voffB); PG8_STAGE(PG8_SA(0, 1), cA + hstep, voffA);
        if (wr == 1) PG8_BAR;
        PG8_WAIT_V(4); PG8_BAR;
        PG8_STAGE(PG8_SB(1, 0), cB + kstep, voffB); PG8_STAGE(PG8_SA(1, 0), cA + kstep, voffA); PG8_STAGE(PG8_SB(1, 1), cB + hstep + kstep, voffB);
        PG8_WAIT_V(6); PG8_BAR;
    }
    for (;;) {
        const bool has_next = S.next(ui + 1, nxt);
        const char* nA = has_next ? (const char*)g.A + (size_t)nxt.pm * tstep : cA; const char* nB = has_next ? (const char*)g.Bt + (size_t)nxt.pn * tstep : cB;
        for (int t = 0; t < nt; t += 2) {
            const bool last = (t == nt - 2);
            const char* a1 = cA + (size_t)(t + 1) * kstep;
            const char* a2 = last ? nA : cA + (size_t)(t + 2) * kstep; const char* b2 = last ? nB : cB + (size_t)(t + 2) * kstep;
            const char* a3 = a2 + kstep; const char* b3 = b2 + kstep;
            if (last && has_next) S.a_ready(nxt);
            if constexpr (SP2) {
            PG8_LDB(B0, 0, 0); PG8_LDB(B1, 0, 1); PG8_SCHED; PG8_LDA(At, 0, 0); PG8_STAGE(PG8_SA(1, 1), a1 + hstep, voffA);
            PG8_WAIT_V(8); PG8_WAIT_L(0); PG8_BAR; PG8_MMA(0, 0, At, B0); PG8_MMA(0, 1, At, B1); PG8_BAR; PG8_SCHED;
            PG8_LDA(At, 0, 1); PG8_STAGE(PG8_SB(0, 0), b2, voffB); PG8_STAGE(PG8_SB(0, 1), b2 + hstep, voffB); PG8_STAGE(PG8_SA(0, 0), a2, voffA);
            PG8_WAIT_V(8); PG8_WAIT_L(0); PG8_BAR; PG8_MMA(1, 0, At, B0); PG8_MMA(1, 1, At, B1); PG8_BAR; PG8_SCHED;
            PG8_LDB(B0, 1, 0); PG8_LDB(B1, 1, 1); PG8_SCHED; PG8_LDA(At, 1, 0); PG8_STAGE(PG8_SA(0, 1), a2 + hstep, voffA);
            PG8_WAIT_V(8); PG8_WAIT_L(0); PG8_BAR; PG8_MMA(0, 0, At, B0); PG8_MMA(0, 1, At, B1); PG8_BAR; PG8_SCHED;
            PG8_LDA(At, 1, 1); PG8_STAGE(PG8_SB(1, 0), b3, voffB); PG8_STAGE(PG8_SB(1, 1), b3 + hstep, voffB); PG8_STAGE(PG8_SA(1, 0), a3, voffA);
            PG8_WAIT_V(8); PG8_WAIT_L(0); PG8_BAR; PG8_MMA(1, 0, At, B0); PG8_MMA(1, 1, At, B1); PG8_BAR; PG8_SCHED;
            } else {
            PG8_LDB(B0, 0, 0); PG8_SCHED; PG8_LDA(At, 0, 0); PG8_STAGE(PG8_SA(1, 1), a1 + hstep, voffA);
            PG8_WAIT_L(8); PG8_BAR; PG8_WAIT_L(0); PG8_MMA(0, 0, At, B0); PG8_BAR; PG8_SCHED;
            PG8_LDB(B1, 0, 1); PG8_STAGE(PG8_SB(0, 0), b2, voffB);
            PG8_BAR; PG8_WAIT_L(0); PG8_MMA(0, 1, At, B1); PG8_BAR;
            PG8_LDA(At, 0, 1); PG8_STAGE(PG8_SA(0, 0), a2, voffA);
            PG8_BAR; PG8_WAIT_L(0); PG8_MMA(1, 0, At, B0); PG8_BAR; PG8_SCHED;
            PG8_STAGE(PG8_SB(0, 1), b2 + hstep, voffB);
            PG8_WAIT_V(6); PG8_BAR; PG8_MMA(1, 1, At, B1); PG8_BAR;
            PG8_LDB(B0, 1, 0); PG8_SCHED; PG8_LDA(At, 1, 0); PG8_STAGE(PG8_SA(0, 1), a2 + hstep, voffA);
            PG8_WAIT_L(8); PG8_BAR; PG8_WAIT_L(0); PG8_MMA(0, 0, At, B0); PG8_BAR; PG8_SCHED;
            PG8_LDB(B1, 1, 1); PG8_STAGE(PG8_SB(1, 0), b3, voffB);
            PG8_BAR; PG8_WAIT_L(0); PG8_MMA(0, 1, At, B1); PG8_BAR;
            PG8_LDA(At, 1, 1); PG8_STAGE(PG8_SA(1, 0), a3, voffA);
            PG8_BAR; PG8_WAIT_L(0); PG8_MMA(1, 0, At, B0); PG8_BAR; PG8_SCHED;
            PG8_STAGE(PG8_SB(1, 1), b3 + hstep, voffB);
            PG8_WAIT_V(6); PG8_BAR; PG8_MMA(1, 1, At, B1); PG8_BAR;
            }
        }
        if constexpr (ALIGN_EPI) { if (wr == 0) PG8_BAR; }
        if constexpr (!Epi::AFTER_DRAIN) { E(acc, cur, ui, wr, wc, fr, fq); S.done(cur); }
        if (!has_next) break;
#pragma unroll
        for (int a = 0; a < 2; ++a)
#pragma unroll
            for (int b = 0; b < 2; ++b)
#pragma unroll
                for (int m = 0; m < 4; ++m)
#pragma unroll
                    for (int n = 0; n < 2; ++n) acc[a][b][m][n] = (f32x4){0.f, 0.f, 0.f, 0.f};
        cur = nxt; cA = nA; cB = nB; ++ui;
        if constexpr (ALIGN_EPI) { if (wr == 1) PG8_BAR; }
    }
    PG8_WAIT_V(0);
    if constexpr (!ALIGN_EPI) { if (wr == 0) PG8_BAR; }
    PG8_BAR;
    if constexpr (Epi::AFTER_DRAIN) { E.fused(acc, cur, wr, wc, fr, fq, lds, wid, lane); S.done(cur); }
#undef PG8_SA
#undef PG8_SB
#undef PG8_STAGE
#undef PG8_LDA
#undef PG8_LDB
#undef PG8_MMA
#undef PG8_WAIT_V
#undef PG8_WAIT_L
#undef PG8_BAR
#undef PG8_SCHED
}
}
#ifndef PROBE_SEL
#define PROBE_SEL (-1)
#endif
#define PT_NOW() __builtin_amdgcn_s_memrealtime()
#define PT_WORDS_OFF 140304
#define PT_ACC(lds_, dt_) do { if (threadIdx.x == 0) { volatile __attribute__((address_space(3))) unsigned* a_ = (volatile __attribute__((address_space(3))) unsigned*)((lds_) + PT_WORDS_OFF); a_[0] = a_[0] + (unsigned)(dt_); } } while (0)
#define LAS __attribute__((address_space(3)))
typedef unsigned short bf16;
typedef float f32x4 __attribute__((ext_vector_type(4)));
typedef short bf16x8 __attribute__((ext_vector_type(8)));
typedef unsigned u32x4 __attribute__((ext_vector_type(4)));
typedef unsigned u32x2 __attribute__((ext_vector_type(2)));
constexpr int NWAVES = 8, NTHR = 512;
constexpr int BATCH = 8, SEQ = 2048, DM = 1024, M = BATCH * SEQ, DIN = 3840, FFN = 2816, DEPTH = 2;
constexpr int C_HQ = 0, C_HFF = 512, C_HI = 1536, C_HG = 2048, C_NQ = 2560, C_NK = 2816, C_NV = 3072, C_CA = 3328, C_CG = 3584;
constexpr int NSEG = 8, SEGLEN = SEQ / NSEG, CHS = SEGLEN / 32;
constexpr float EPS = 1e-6f;
constexpr size_t MiB = 1u << 20;
constexpr size_t WS_SSQ = 1 * MiB;
constexpr size_t WS_WIN = 2 * MiB, WS_WIN_L = (size_t)DIN * DM * 2;
constexpr size_t WS_WOUT = 17 * MiB, WS_WOUT_L = (size_t)DM * DM * 2;
constexpr size_t WS_WGU = 21 * MiB, WS_WGU_L = (size_t)2 * FFN * DM * 2;
constexpr size_t WS_WDN = 43 * MiB, WS_WDN_L = (size_t)DM * FFN * 2;
constexpr size_t WS_P = 54 * MiB;
constexpr size_t WS_MIX = 174 * MiB;
constexpr size_t WS_XB = 206 * MiB;
constexpr size_t WS_SLOC = 238 * MiB;
constexpr size_t WS_DSEG = 254 * MiB;
constexpr size_t WS_END = 255 * MiB;

__device__ __forceinline__ float bf2f(unsigned short h) { return __builtin_bit_cast(float, (unsigned)h << 16); }
__device__ __forceinline__ float bflo(unsigned w) { return __builtin_bit_cast(float, w << 16); }
__device__ __forceinline__ float bfhi(unsigned w) { return __builtin_bit_cast(float, w & 0xffff0000u); }
typedef float f32x2_t __attribute__((ext_vector_type(2)));
typedef __bf16 bf16x2_t __attribute__((ext_vector_type(2)));
__device__ __forceinline__ unsigned pk2(float lo, float hi) { const f32x2_t v = {lo, hi}; const bf16x2_t b = __builtin_convertvector(v, bf16x2_t); return __builtin_bit_cast(unsigned, b); }
__device__ __forceinline__ unsigned short f2bf(float v) { return (unsigned short)(pk2(v, 0.f) & 0xffffu); }
__device__ __forceinline__ float wave_sum(float v) {
#pragma unroll
    for (int o = 1; o < 64; o <<= 1) v += __shfl_xor(v, o);
    return v;
}
__device__ __forceinline__ float sigm(float x) { return __builtin_amdgcn_rcpf(1.f + __expf(-x)); }
__device__ __forceinline__ float silu_f0(float x) { return x * sigm(x); }
__device__ __forceinline__ f32x4 mfma16(bf16x8 a, bf16x8 b, f32x4 c) { return __builtin_amdgcn_mfma_f32_16x16x32_bf16(a, b, c, 0, 0, 0); }
#define LDS_WAIT() asm volatile("s_waitcnt lgkmcnt(0)" ::: "memory")

struct Params {
    const float *x, *mix_g, *w_in, *hg_lb, *hg_ng, *rpb, *cw, *cb, *lng, *lnb, *w_out, *ffn_g, *w_gu, *w_dn, *fin_g;
    float* out; unsigned char* ws;
};

__device__ __forceinline__ void transpose_item(const float* W, int K, int N, bf16* WT, const float* gk, bool gu, LAS float* scr, int item, int lane) {
    const int nblk = N / 64, kb = item / nblk, nb = item % nblk, k0 = 64 * kb, n0 = 64 * nb;
    const float gs = gk ? gk[k0 + lane] : 1.f;
    const float* src = W + (size_t)k0 * N + n0 + lane;
#pragma unroll
    for (int hh = 0; hh < 2; ++hh) {
        float wv[32];
#pragma unroll
        for (int i = 0; i < 32; ++i) wv[i] = __builtin_nontemporal_load(src + (size_t)(32 * hh + i) * N);
        __builtin_amdgcn_sched_barrier(0);
#pragma unroll
        for (int i = 0; i < 32; ++i) scr[(32 * hh + i) * 65 + lane] = wv[i] * __shfl(gs, 32 * hh + i);
    }
    LDS_WAIT(); asm volatile("" ::: "memory");
    const int c = lane & 7;
    int r0 = n0;
    if (gu) { const int up = n0 >= FFN ? 1 : 0, cc = n0 - up * FFN; r0 = 256 * (cc >> 7) + (cc & 127) + up * 128; }
#pragma unroll
    for (int j = 0; j < 8; ++j) { const int n = (lane >> 3) + 8 * j; const LAS float* s = scr + (8 * c) * 65 + n;
        u32x4 o; o.x = pk2(s[0 * 65], s[1 * 65]); o.y = pk2(s[2 * 65], s[3 * 65]); o.z = pk2(s[4 * 65], s[5 * 65]); o.w = pk2(s[6 * 65], s[7 * 65]);
        *(u32x4*)(WT + (size_t)(r0 + n) * K + k0 + 8 * c) = o; }
    LDS_WAIT(); asm volatile("" ::: "memory");
}
constexpr int I_IN = (DM / 64) * (DIN / 64), I_OUT = (DM / 64) * (DM / 64), I_GU = (DM / 64) * (2 * FFN / 64), I_DN = (FFN / 64) * (DM / 64), I_L = I_IN + I_OUT + I_GU + I_DN;
__device__ __forceinline__ void convert_weights(const Params& p, LAS unsigned char* lds, int lo, int hi, int w0, int nw, int wave, int lane) {
    LAS float* scr = (LAS float*)(lds + wave * 16640);
    for (int it = lo + w0; it < hi; it += nw) {
        const int l = it / I_L; int r = it % I_L;
        if (r < I_IN) { transpose_item(p.w_in + (size_t)l * DM * DIN, DM, DIN, (bf16*)(p.ws + WS_WIN + l * WS_WIN_L), p.mix_g + l * DM, false, scr, r, lane); continue; } r -= I_IN;
        if (r < I_OUT) { transpose_item(p.w_out + (size_t)l * DM * DM, DM, DM, (bf16*)(p.ws + WS_WOUT + l * WS_WOUT_L), nullptr, false, scr, r, lane); continue; } r -= I_OUT;
        if (r < I_GU) { transpose_item(p.w_gu + (size_t)l * DM * 2 * FFN, DM, 2 * FFN, (bf16*)(p.ws + WS_WGU + l * WS_WGU_L), p.ffn_g + l * DM, true, scr, r, lane); continue; } r -= I_GU;
        transpose_item(p.w_dn + (size_t)l * FFN * DM, FFN, DM, (bf16*)(p.ws + WS_WDN + l * WS_WDN_L), nullptr, false, scr, r, lane);
    }
}
__device__ __forceinline__ void prologue(const Params& p, LAS unsigned char* lds, int gw, int NGW, int wave, int lane) {
    convert_weights(p, lds, 0, I_IN, gw, NGW, wave, lane);
    bf16* XB = (bf16*)(p.ws + WS_XB); float* ssq = (float*)(p.ws + WS_SSQ);
    for (int m = gw; m < M; m += 2 * NGW) {
        const int m2 = m + NGW;
        const f32x4* xa = (const f32x4*)(p.x + (size_t)m * DM) + lane; const f32x4* xc = (const f32x4*)(p.x + (size_t)(m2 < M ? m2 : m) * DM) + lane;
        f32x4 va[4], vc[4];
#pragma unroll
        for (int j = 0; j < 4; ++j) { va[j] = __builtin_nontemporal_load(xa + 64 * j); vc[j] = __builtin_nontemporal_load(xc + 64 * j); }
        __builtin_amdgcn_sched_barrier(0);
        float sa = 0.f, sc = 0.f;
        unsigned long long* oa = (unsigned long long*)(XB + (size_t)m * DM) + lane; unsigned long long* oc = (unsigned long long*)(XB + (size_t)m2 * DM) + lane;
#pragma unroll
        for (int j = 0; j < 4; ++j) { sa += (va[j].x * va[j].x + va[j].y * va[j].y) + (va[j].z * va[j].z + va[j].w * va[j].w); sc += (vc[j].x * vc[j].x + vc[j].y * vc[j].y) + (vc[j].z * vc[j].z + vc[j].w * vc[j].w);
            oa[64 * j] = (unsigned long long)pk2(va[j].x, va[j].y) | ((unsigned long long)pk2(va[j].z, va[j].w) << 32);
            if (m2 < M) oc[64 * j] = (unsigned long long)pk2(vc[j].x, vc[j].y) | ((unsigned long long)pk2(vc[j].z, vc[j].w) << 32); }
        sa = wave_sum(sa); sc = wave_sum(sc);
        if (lane < 16) { ssq[(size_t)lane * M + m] = lane == 0 ? sa : 0.f; if (m2 < M) ssq[(size_t)lane * M + m2] = lane == 0 ? sc : 0.f; }
    }
}

constexpr int HS_SET = 37888, HQ_OFF = 0, HK_OFF = 8704, HKH_OFF = 17408, HV_OFF = 27648;
constexpr int HOS_OFF = 2 * HS_SET, HOS_SZ = 16896, HDEC_OFF = HOS_OFF + 2 * HOS_SZ;
#define WG_BAR() asm volatile("s_waitcnt lgkmcnt(0)\n\ts_barrier" ::: "memory")
template <bool FULL, bool SECOND>
__device__ __forceinline__ void hg_segment(LAS unsigned char* lds, const bf16* P, int b, int h, int dir, int seg, float lb, f32x4 (&S)[8], float& bsum,
                                           float* OP, bf16* MIXED, const float* norm_g) {
    int tid_ = threadIdx.x; asm volatile("" : "+v"(tid_)); const int tid = tid_, w = __builtin_amdgcn_readfirstlane(tid >> 6), lane = tid & 63, fr = lane & 15, fq = lane >> 4;
    unsigned long long tk0 = 0;
    const int d = 16 * w + (lane & 15), grp = lane >> 4;
    const int zcol = C_HFF + dir * 512 + h * 128 + d, qcol = C_HQ + h * 128 + d, vcol = C_HI + h * 128 + d;
    const float oml = 1.f - lb;
    const int ts = dir == 0 ? 1 : -1, tb0 = dir == 0 ? seg * SEGLEN : (seg * SEGLEN + SEGLEN - 1);
    const long rstep = (long)ts * DIN;
    const int fc = tid >> 4, dvg = tid & 15;
    f32x4 ng0 = (f32x4){0.f, 0.f, 0.f, 0.f}, ng1 = ng0;
    if (FULL && SECOND) { ng0 = *(const f32x4*)(norm_g + 8 * dvg); ng1 = *(const f32x4*)(norm_g + 8 * dvg + 4); }
    unsigned short zn[8], qn[8], vn[8];
#define HG_LOAD(n_) do { const bf16* rowp_ = P + (size_t)(b * SEQ + tb0 + ts * (32 * (n_) + 8 * grp)) * DIN; \
        _Pragma("unroll") for (int e = 0; e < 8; ++e) { const bf16* r_ = rowp_ + rstep * e; zn[e] = r_[zcol]; if (FULL) qn[e] = r_[qcol]; else qn[e] = 0; vn[e] = r_[vcol]; } } while (0)
#define HG_PREP(s_) do { LAS unsigned char* set_ = lds + (s_) * HS_SET; LAS bf16* QT_ = (LAS bf16*)(set_ + HQ_OFF); LAS bf16* KT_ = (LAS bf16*)(set_ + HK_OFF); \
        f32x2_t Ev[4], kvv[4]; float run = 1.f;                                     \
        _Pragma("unroll") for (int e2 = 0; e2 < 4; ++e2) { \
            f32x2_t z = {__builtin_amdgcn_fmed3f(bf2f(zn[2 * e2]), -40.f, 40.f), __builtin_amdgcn_fmed3f(bf2f(zn[2 * e2 + 1]), -40.f, 40.f)}; \
            const f32x2_t t = z * (-1.4426950408889634f); const f32x2_t den = (f32x2_t){__builtin_amdgcn_exp2f(t.x), __builtin_amdgcn_exp2f(t.y)} + 1.0f; \
            const f32x2_t inv = {__builtin_amdgcn_rcpf(den.x), __builtin_amdgcn_rcpf(den.y)};              \
            const f32x2_t fv = inv * oml + lb; kvv[e2] = inv * (-oml) + oml;                                  \
            run *= fv.x; Ev[e2].x = run; run *= fv.y; Ev[e2].y = run; } \
        float pre = 1.f, tot = 1.f; \
        _Pragma("unroll") for (int g2 = 0; g2 < 4; ++g2) { const float t = __shfl(run, (g2 << 4) | (lane & 15)); tot *= t; if (g2 < grp) pre *= t; } \
        unsigned khp[4], vvp[4]; \
        _Pragma("unroll") for (int e2 = 0; e2 < 4; ++e2) { const f32x2_t E = Ev[e2] * pre; const f32x2_t r = {__builtin_amdgcn_rcpf(E.x), __builtin_amdgcn_rcpf(E.y)}; const f32x2_t kt = kvv[e2] * r; \
            if (FULL) { const int c0 = 8 * grp + 2 * e2; const f32x2_t qs = (f32x2_t){bf2f(qn[2 * e2]), bf2f(qn[2 * e2 + 1])} * E; const unsigned qw = pk2(qs.x, qs.y), kw = pk2(kt.x, kt.y); \
                QT_[c0 * 136 + d] = (bf16)(qw & 0xffffu); QT_[(c0 + 1) * 136 + d] = (bf16)(qw >> 16); KT_[c0 * 136 + d] = (bf16)(kw & 0xffffu); KT_[(c0 + 1) * 136 + d] = (bf16)(kw >> 16); } \
            const f32x2_t kh = kt * tot; khp[e2] = pk2(kh.x, kh.y); vvp[e2] = (unsigned)vn[2 * e2] | ((unsigned)vn[2 * e2 + 1] << 16); } \
        *(LAS u32x4*)((LAS bf16*)(set_ + HKH_OFF) + d * 40 + 8 * grp) = (u32x4){khp[0], khp[1], khp[2], khp[3]}; \
        *(LAS u32x4*)((LAS bf16*)(set_ + HV_OFF) + d * 40 + 8 * grp) = (u32x4){vvp[0], vvp[1], vvp[2], vvp[3]}; \
        if (grp == 0) { ((LAS float*)(lds + HDEC_OFF))[(s_) * 128 + d] = tot; bsum *= tot; } } while (0)
    HG_LOAD(0);
    __builtin_amdgcn_sched_barrier(0);
    HG_PREP(0);
    __builtin_amdgcn_sched_barrier(0);
    if (CHS > 1) HG_LOAD(1);
    WG_BAR();
#pragma unroll 1
    for (int n = 0; n < CHS; ++n) {
        const int tb = tb0 + ts * 32 * n, cs = n & 1;
        const int ftok = tb + ts * fc;
        f32x4 op0 = (f32x4){0.f, 0.f, 0.f, 0.f}, op1 = op0; u32x4 gw4 = (u32x4){0u, 0u, 0u, 0u};
        float* op = OP + ((size_t)((b * 4 + h) * SEQ + ftok)) * 128 + 8 * dvg;
        if (FULL && SECOND) { op0 = *(const f32x4*)op; op1 = *(const f32x4*)(op + 4); gw4 = *(const u32x4*)(P + (size_t)(b * SEQ + ftok) * DIN + C_HG + h * 128 + 8 * dvg); }
        __builtin_amdgcn_sched_barrier(0);
#pragma unroll 1
        for (int ph = 0; ph < 2; ++ph) {
        if ((ph == 0) == (w < 4)) { if (PROBE_SEL == 13) tk0 = PT_NOW(); if (n + 1 < CHS) { HG_PREP(cs ^ 1); __builtin_amdgcn_sched_barrier(0); if (n + 2 < CHS) HG_LOAD(n + 2); } if (PROBE_SEL == 13) PT_ACC(lds, PT_NOW() - tk0); }
        else {
        if (PROBE_SEL == 14) tk0 = PT_NOW();
        LAS unsigned char* set = lds + cs * HS_SET;
        LAS bf16* QT = (LAS bf16*)(set + HQ_OFF); LAS bf16* KT = (LAS bf16*)(set + HK_OFF); LAS bf16* KHT = (LAS bf16*)(set + HKH_OFF); LAS bf16* VT = (LAS bf16*)(set + HV_OFF);
        LAS float* OS = (LAS float*)(lds + HOS_OFF + cs * HOS_SZ); LAS float* DEC = (LAS float*)(lds + HDEC_OFF) + cs * 128;
        if (FULL) {
            f32x4 p00 = (f32x4){0.f, 0.f, 0.f, 0.f}, p01 = p00, p11 = p00;
#pragma unroll
            for (int ks = 0; ks < 4; ++ks) {
                const bf16x8 k0 = *(const LAS bf16x8*)(KT + fr * 136 + 32 * ks + 8 * fq), k1 = *(const LAS bf16x8*)(KT + (16 + fr) * 136 + 32 * ks + 8 * fq);
                const bf16x8 q0 = *(const LAS bf16x8*)(QT + fr * 136 + 32 * ks + 8 * fq), q1 = *(const LAS bf16x8*)(QT + (16 + fr) * 136 + 32 * ks + 8 * fq);
                p00 = mfma16(k0, q0, p00); p01 = mfma16(k0, q1, p01); p11 = mfma16(k1, q1, p11); }
#pragma unroll
            for (int i = 0; i < 4; ++i) { const bool keep = 4 * fq + i <= fr; p00[i] = keep ? p00[i] : 0.f; p11[i] = keep ? p11[i] : 0.f; }
            const bf16x8 pf0 = __builtin_bit_cast(bf16x8, (u32x4){pk2(p00[0], p00[1]), pk2(p00[2], p00[3]), 0u, 0u});
            const bf16x8 pf1 = __builtin_bit_cast(bf16x8, (u32x4){pk2(p01[0], p01[1]), pk2(p01[2], p01[3]), pk2(p11[0], p11[1]), pk2(p11[2], p11[3])});
            f32x4 o0 = (f32x4){0.f, 0.f, 0.f, 0.f}, o1 = o0;
#pragma unroll
            for (int ks = 0; ks < 4; ++ks) {
                const bf16x8 sa = __builtin_bit_cast(bf16x8, (u32x4){pk2(S[2 * ks][0], S[2 * ks][1]), pk2(S[2 * ks][2], S[2 * ks][3]), pk2(S[2 * ks + 1][0], S[2 * ks + 1][1]), pk2(S[2 * ks + 1][2], S[2 * ks + 1][3])});
                const u32x2 a0 = *(const LAS u32x2*)(QT + fr * 136 + 32 * ks + 4 * fq), a1 = *(const LAS u32x2*)(QT + fr * 136 + 32 * ks + 16 + 4 * fq);
                const u32x2 c0 = *(const LAS u32x2*)(QT + (16 + fr) * 136 + 32 * ks + 4 * fq), c1 = *(const LAS u32x2*)(QT + (16 + fr) * 136 + 32 * ks + 16 + 4 * fq);
                o0 = mfma16(sa, __builtin_bit_cast(bf16x8, (u32x4){a0.x, a0.y, a1.x, a1.y}), o0);
                o1 = mfma16(sa, __builtin_bit_cast(bf16x8, (u32x4){c0.x, c0.y, c1.x, c1.y}), o1); }
            { const u32x2 v0 = *(const LAS u32x2*)(VT + (16 * w + fr) * 40 + 4 * fq), v1 = *(const LAS u32x2*)(VT + (16 * w + fr) * 40 + 16 + 4 * fq);
              const bf16x8 va = __builtin_bit_cast(bf16x8, (u32x4){v0.x, v0.y, v1.x, v1.y});
              o0 = mfma16(va, pf0, o0); o1 = mfma16(va, pf1, o1); }
            *(LAS f32x4*)(OS + fr * 132 + 16 * w + 4 * fq) = o0; *(LAS f32x4*)(OS + (16 + fr) * 132 + 16 * w + 4 * fq) = o1;
        }
        { const bf16x8 vfr = *(const LAS bf16x8*)(VT + (16 * w + fr) * 40 + 8 * fq);
#pragma unroll
          for (int i = 0; i < 8; ++i) { const f32x4 dv4 = *(const LAS f32x4*)(DEC + 16 * i + 4 * fq); S[i] = S[i] * dv4;
              S[i] = mfma16(*(const LAS bf16x8*)(KHT + (16 * i + fr) * 40 + 8 * fq), vfr, S[i]); } }
        if (PROBE_SEL == 14) PT_ACC(lds, PT_NOW() - tk0);
        } }
        if (PROBE_SEL == 15) tk0 = PT_NOW();
        WG_BAR();
        if (PROBE_SEL == 15) PT_ACC(lds, PT_NOW() - tk0);
        if (FULL) {
            LAS float* OS = (LAS float*)(lds + HOS_OFF + cs * HOS_SZ);
            f32x4 o0 = *(const LAS f32x4*)(OS + fc * 132 + 8 * dvg), o1 = *(const LAS f32x4*)(OS + fc * 132 + 8 * dvg + 4);
            if (!SECOND) { *(f32x4*)op = o0; *(f32x4*)(op + 4) = o1; }
            else { o0 = o0 + op0; o1 = o1 + op1;
                float sq = (o0[0] * o0[0] + o0[1] * o0[1]) + (o0[2] * o0[2] + o0[3] * o0[3]) + (o1[0] * o1[0] + o1[1] * o1[1]) + (o1[2] * o1[2] + o1[3] * o1[3]);
                sq += __shfl_xor(sq, 1); sq += __shfl_xor(sq, 2); sq += __shfl_xor(sq, 4); sq += __shfl_xor(sq, 8);
                const float rs = __builtin_amdgcn_rsqf(sq * (1.f / 128.f) + EPS);
                u32x4 ow; ow.x = pk2(o0[0] * rs * ng0[0] * bflo(gw4.x), o0[1] * rs * ng0[1] * bfhi(gw4.x));
                ow.y = pk2(o0[2] * rs * ng0[2] * bflo(gw4.y), o0[3] * rs * ng0[3] * bfhi(gw4.y));
                ow.z = pk2(o1[0] * rs * ng1[0] * bflo(gw4.z), o1[1] * rs * ng1[1] * bfhi(gw4.z));
                ow.w = pk2(o1[2] * rs * ng1[2] * bflo(gw4.w), o1[3] * rs * ng1[3] * bfhi(gw4.w));
                *(u32x4*)(MIXED + (size_t)(b * SEQ + ftok) * DM + h * 128 + 8 * dvg) = ow; }
        }
    }
    WG_BAR();
#undef HG_LOAD
#undef HG_PREP
}
__device__ __forceinline__ float hg_lb(const float* hg_lb_all, int layer, int dir, int ch) {
    if (layer == 0) return 0.f;
    const float a0 = hg_lb_all[(0 * 2 + dir) * 512 + ch], a1 = hg_lb_all[(1 * 2 + dir) * 512 + ch], mx = fmaxf(a0, a1), e0 = __expf(a0 - mx), e1 = __expf(a1 - mx);
    return e1 / (e0 + e1);
}
__device__ __forceinline__ void hg_passA_item(LAS unsigned char* lds, const Params& p, int layer, int item) {
    const int dir = item & 1, seg = (item >> 1) & (NSEG - 1), h = (item >> 4) & 3, b = item >> 6;
    if ((dir == 0 && seg == NSEG - 1) || (dir == 1 && seg == 0)) return;
    int tid_ = threadIdx.x; asm volatile("" : "+v"(tid_)); const int tid = tid_, w = __builtin_amdgcn_readfirstlane(tid >> 6), lane = tid & 63;
    const float lb = hg_lb(p.hg_lb, layer, dir, h * 128 + 16 * w + (lane & 15));
    f32x4 S[8];
#pragma unroll
    for (int i = 0; i < 8; ++i) S[i] = (f32x4){0.f, 0.f, 0.f, 0.f};
    float bsum = 1.f;
    hg_segment<false, false>(lds, (const bf16*)(p.ws + WS_P), b, h, dir, seg, lb, S, bsum, nullptr, nullptr, nullptr);
    u32x2* sl = (u32x2*)(p.ws + WS_SLOC) + (size_t)item * 4096;
#pragma unroll
    for (int i = 0; i < 8; ++i) sl[(w * 8 + i) * 64 + lane] = (u32x2){pk2(S[i][0], S[i][1]), pk2(S[i][2], S[i][3])};
    if (lane < 16) ((float*)(p.ws + WS_DSEG))[(size_t)item * 128 + 16 * w + (lane & 15)] = bsum;
    __syncthreads();
}
__device__ __forceinline__ unsigned long long hg_passB_item(LAS unsigned char* lds, const Params& p, int layer, int item) {
    unsigned long long tsub = 0, t0_ = 0;
    const int seg = item & (NSEG - 1), h = (item >> 3) & 3, b = item >> 5;
    int tid_ = threadIdx.x; asm volatile("" : "+v"(tid_)); const int tid = tid_, w = __builtin_amdgcn_readfirstlane(tid >> 6), lane = tid & 63, fr = lane & 15, fq = lane >> 4;
    const u32x2* slb = (const u32x2*)(p.ws + WS_SLOC); const float* dsg = (const float*)(p.ws + WS_DSEG);
    float* OP = p.out;   bf16* MIXED = (bf16*)(p.ws + WS_MIX); const bf16* P = (const bf16*)(p.ws + WS_P);
#pragma unroll 1
    for (int dir = 0; dir < 2; ++dir) {
        const float lb = hg_lb(p.hg_lb, layer, dir, h * 128 + 16 * w + (lane & 15));
        f32x4 S[8];
#pragma unroll
        for (int i = 0; i < 8; ++i) S[i] = (f32x4){0.f, 0.f, 0.f, 0.f};
        const int nprev = dir == 0 ? seg : (NSEG - 1 - seg);
        if (PROBE_SEL == 11) t0_ = PT_NOW();
#pragma unroll 1
        for (int q = 0; q < nprev; q += 2) {
            const bool two = q + 1 < nprev; const int sA = dir == 0 ? q : (NSEG - 1 - q), sB = two ? (dir == 0 ? q + 1 : (NSEG - 2 - q)) : sA;
            const int itA = ((b * 4 + h) * NSEG + sA) * 2 + dir, itB = ((b * 4 + h) * NSEG + sB) * 2 + dir;
            const u32x2* slA = slb + (size_t)itA * 4096; const float* dcA = dsg + (size_t)itA * 128; const u32x2* slB = slb + (size_t)itB * 4096; const float* dcB = dsg + (size_t)itB * 128;
            f32x4 dvA[8], dvB[8]; u32x2 svA[8], svB[8];
#pragma unroll
            for (int i = 0; i < 8; ++i) { dvA[i] = *(const f32x4*)(dcA + 16 * i + 4 * fq); svA[i] = slA[(w * 8 + i) * 64 + lane]; dvB[i] = *(const f32x4*)(dcB + 16 * i + 4 * fq); svB[i] = slB[(w * 8 + i) * 64 + lane]; }
            __builtin_amdgcn_sched_barrier(0);
#pragma unroll
            for (int i = 0; i < 8; ++i) { S[i] = S[i] * dvA[i] + (f32x4){bflo(svA[i].x), bfhi(svA[i].x), bflo(svA[i].y), bfhi(svA[i].y)};
                if (two) S[i] = S[i] * dvB[i] + (f32x4){bflo(svB[i].x), bfhi(svB[i].x), bflo(svB[i].y), bfhi(svB[i].y)}; } }
        if (PROBE_SEL == 11) PT_ACC(lds, PT_NOW() - t0_);
        if (PROBE_SEL == 10) t0_ = PT_NOW();
        float bsum = 1.f;
        if (dir == 0) hg_segment<true, false>(lds, P, b, h, 0, seg, lb, S, bsum, OP, MIXED, p.hg_ng + layer * 128);
        else hg_segment<true, true>(lds, P, b, h, 1, seg, lb, S, bsum, OP, MIXED, p.hg_ng + layer * 128);
        if (PROBE_SEL == 10) PT_ACC(lds, PT_NOW() - t0_);
        if (PROBE_SEL == 12) t0_ = PT_NOW();
        __syncthreads();
        if (PROBE_SEL == 12) PT_ACC(lds, PT_NOW() - t0_);
    }
    return tsub;
}

constexpr int NA_KS = 584, NA_RPB_OFF = 64 * NA_KS * 2;
__device__ __forceinline__ int clampi(int v, int lo, int hi) { return v < lo ? lo : (v > hi ? hi : v); }
__device__ __forceinline__ void na_item(LAS unsigned char* lds, const Params& p, int layer, int item) {
    const int rp = item & 15, h = (item >> 4) & 3, b = item >> 6, r0 = 2 * rp, kbase = clampi(r0 - 4, 0, 24);
    int tid_ = threadIdx.x; asm volatile("" : "+v"(tid_)); const int tid = tid_, w = __builtin_amdgcn_readfirstlane(tid >> 6), lane = tid & 63, fr = lane & 15, fq = lane >> 4;
    const bf16* P = (const bf16*)(p.ws + WS_P); bf16* MIXED = (bf16*)(p.ws + WS_MIX);
    LAS bf16* VT = (LAS bf16*)lds; LAS float* RPB = (LAS float*)(lds + NA_RPB_OFF);
    const int rl = w >> 2, j = w & 3, r = r0 + rl, kr0 = clampi(r - 4, 0, 24), kc0 = clampi(16 * j - 8, 0, 32);
    const size_t qtok = (size_t)b * SEQ + r * 64 + 16 * j + fr;
    unsigned long long tn0_ = 0; if (PROBE_SEL >= 20 && PROBE_SEL <= 24) tn0_ = PT_NOW();
    const float rpbv = tid < 465 ? p.rpb[(size_t)(layer * 4 + h) * 465 + tid] : 0.f;
    u32x4 vbuf[9];
#pragma unroll
    for (int it = 0; it < 9; ++it) { const int key = it * 64 + w * 8 + (lane >> 3), dg = lane & 7; int trow = kbase * 64 + key; trow = trow > SEQ - 1 ? SEQ - 1 : trow;
        vbuf[it] = *(const u32x4*)(P + (size_t)(b * SEQ + trow) * DIN + C_NV + h * 64 + 8 * dg); }
    bf16x8 qf[2], kfa[16], kfb[16];
#pragma unroll
    for (int ks = 0; ks < 2; ++ks) qf[ks] = *(const bf16x8*)(P + qtok * DIN + C_NQ + h * 64 + 32 * ks + 8 * fq);
#define NA_KLOAD(dst, hh) do { _Pragma("unroll") for (int k8 = 0; k8 < 8; ++k8) { const int kt = (hh) * 8 + k8, krl = kt >> 1, half = kt & 1; \
        const size_t ktok = (size_t)b * SEQ + (kr0 + krl) * 64 + kc0 + 16 * half + fr; \
        _Pragma("unroll") for (int ks = 0; ks < 2; ++ks) dst[k8 * 2 + ks] = *(const bf16x8*)(P + ktok * DIN + C_NK + h * 64 + 32 * ks + 8 * fq); } } while (0)
    NA_KLOAD(kfa, 0);
    __builtin_amdgcn_sched_barrier(0);
#pragma unroll
    for (int it = 0; it < 9; ++it) { const int key = it * 64 + w * 8 + (lane >> 3), dg = lane & 7; const u32x4 v = vbuf[it];
        LAS bf16* dst = VT + (8 * dg) * NA_KS + (key ^ (dg << 3));
        dst[0 * NA_KS] = (bf16)(v.x & 0xffffu); dst[1 * NA_KS] = (bf16)(v.x >> 16); dst[2 * NA_KS] = (bf16)(v.y & 0xffffu); dst[3 * NA_KS] = (bf16)(v.y >> 16);
        dst[4 * NA_KS] = (bf16)(v.z & 0xffffu); dst[5 * NA_KS] = (bf16)(v.z >> 16); dst[6 * NA_KS] = (bf16)(v.w & 0xffffu); dst[7 * NA_KS] = (bf16)(v.w >> 16); }
    if (tid < 465) RPB[tid] = rpbv;
    if (PROBE_SEL == 20) { LDS_WAIT(); PT_ACC(lds, PT_NOW() - tn0_); } if (PROBE_SEL == 21) tn0_ = PT_NOW();
    NA_KLOAD(kfb, 1);
    __builtin_amdgcn_sched_barrier(0);
    WG_BAR();
    if (PROBE_SEL == 21) PT_ACC(lds, PT_NOW() - tn0_); if (PROBE_SEL == 22) tn0_ = PT_NOW();
    f32x4 s[16];
#pragma unroll
    for (int k8 = 0; k8 < 8; ++k8) { f32x4 a = (f32x4){0.f, 0.f, 0.f, 0.f};
#pragma unroll
        for (int ks = 0; ks < 2; ++ks) a = mfma16(kfa[k8 * 2 + ks], qf[ks], a);
        s[k8] = a; }
#pragma unroll
    for (int k8 = 0; k8 < 8; ++k8) { f32x4 a = (f32x4){0.f, 0.f, 0.f, 0.f};
#pragma unroll
        for (int ks = 0; ks < 2; ++ks) a = mfma16(kfb[k8 * 2 + ks], qf[ks], a);
        s[8 + k8] = a; }
#undef NA_KLOAD
    if (PROBE_SEL == 22) { asm volatile("" :: "v"(s[15][0]), "v"(s[7][0])); PT_ACC(lds, PT_NOW() - tn0_); } if (PROBE_SEL == 23) tn0_ = PT_NOW();
    const int qc = 16 * j + fr, qs = clampi(qc - 8, 0, 48);
    float mx = -1e30f;
#pragma unroll
    for (int kt = 0; kt < 16; ++kt) { const int krl = kt >> 1, half = kt & 1; const int ridx = kr0 + krl - r + 7;
        float bz[4];
#pragma unroll
        for (int i = 0; i < 4; ++i) { const int kc = kc0 + 16 * half + 4 * fq + i; bz[i] = RPB[ridx * 31 + clampi(kc - qc + 15, 0, 30)]; }
#pragma unroll
        for (int i = 0; i < 4; ++i) { const int kc = kc0 + 16 * half + 4 * fq + i; const bool valid = kc >= qs && kc < qs + 16;
            const float v = valid ? s[kt][i] * 0.125f + bz[i] : -1e30f; s[kt][i] = v; mx = fmaxf(mx, v); } }
    mx = fmaxf(mx, __shfl_xor(mx, 16)); mx = fmaxf(mx, __shfl_xor(mx, 32));
    float sum = 0.f;
#pragma unroll
    for (int kt = 0; kt < 16; ++kt)
#pragma unroll
        for (int i = 0; i < 4; ++i) { const float e = __expf(s[kt][i] - mx); s[kt][i] = e; sum += e; }
    sum += __shfl_xor(sum, 16); sum += __shfl_xor(sum, 32);
    if (PROBE_SEL == 23) { asm volatile("" :: "v"(sum)); PT_ACC(lds, PT_NOW() - tn0_); } if (PROBE_SEL == 24) tn0_ = PT_NOW();
    f32x4 o[4];
#pragma unroll
    for (int dt = 0; dt < 4; ++dt) o[dt] = (f32x4){0.f, 0.f, 0.f, 0.f};
#pragma unroll
    for (int kk = 0; kk < 8; ++kk) {
        const u32x4 pw = (u32x4){pk2(s[2 * kk][0], s[2 * kk][1]), pk2(s[2 * kk][2], s[2 * kk][3]), pk2(s[2 * kk + 1][0], s[2 * kk + 1][1]), pk2(s[2 * kk + 1][2], s[2 * kk + 1][3])};
        const bf16x8 pf = __builtin_bit_cast(bf16x8, pw);
        const int keyoff = (kr0 + kk - kbase) * 64 + kc0 + 4 * fq;
#pragma unroll
        for (int dt = 0; dt < 4; ++dt) { const int sw = (2 * dt + (fr >> 3)) << 3;
            const u32x2 lo = *(const LAS u32x2*)(VT + (16 * dt + fr) * NA_KS + (keyoff ^ sw)), hi = *(const LAS u32x2*)(VT + (16 * dt + fr) * NA_KS + ((keyoff + 16) ^ sw));
            const bf16x8 vf = __builtin_bit_cast(bf16x8, (u32x4){lo.x, lo.y, hi.x, hi.y});
            o[dt] = mfma16(vf, pf, o[dt]); } }
    const float inv = 1.f / sum;
#pragma unroll
    for (int dt = 0; dt < 4; ++dt) *(u32x2*)(MIXED + qtok * DM + 512 + h * 64 + 16 * dt + 4 * fq) = (u32x2){pk2(o[dt][0] * inv, o[dt][1] * inv), pk2(o[dt][2] * inv, o[dt][3] * inv)};
    WG_BAR();
    if (PROBE_SEL == 24) PT_ACC(lds, PT_NOW() - tn0_);
}

__device__ __forceinline__ void conv_item(LAS unsigned char* lds, const Params& p, int layer, int item) {
    const int b = item >> 6, t0 = (item & 63) * 32;
    int tid_ = threadIdx.x; asm volatile("" : "+v"(tid_)); const int tid = tid_, w = __builtin_amdgcn_readfirstlane(tid >> 6), lane = tid & 63;
    const bf16* P = (const bf16*)(p.ws + WS_P); bf16* MIXED = (bf16*)(p.ws + WS_MIX);
    LAS float* U = (LAS float*)lds; LAS float* CO = U + 62 * 256;
    u32x4 ca4[4], cg4[4];
#pragma unroll
    for (int it = 0; it < 4; ++it) { const int u = it * NTHR + tid, tt = u >> 5, c8 = u & 31, t = t0 - 15 + tt; ca4[it] = (u32x4){0u, 0u, 0u, 0u}; cg4[it] = ca4[it];
        if (u < 62 * 32 && t >= 0 && t < SEQ) { const bf16* rp = P + (size_t)(b * SEQ + t) * DIN; ca4[it] = *(const u32x4*)(rp + C_CA + 8 * c8); cg4[it] = *(const u32x4*)(rp + C_CG + 8 * c8); } }
    const int c = tid & 255, half = tid >> 8;
    float wk[31];
#pragma unroll
    for (int k = 0; k < 31; ++k) wk[k] = p.cw[(size_t)(layer * 31 + k) * 256 + c];
    const float bias = p.cb[layer * 256 + c];
    __builtin_amdgcn_sched_barrier(0);
#pragma unroll
    for (int it = 0; it < 4; ++it) { const int u = it * NTHR + tid, tt = u >> 5, c8 = u & 31; const u32x4 a = ca4[it], g = cg4[it];
        if (u < 62 * 32) {
            const f32x4 u0 = (f32x4){bflo(a.x) * sigm(bflo(g.x)), bfhi(a.x) * sigm(bfhi(g.x)), bflo(a.y) * sigm(bflo(g.y)), bfhi(a.y) * sigm(bfhi(g.y))};
            const f32x4 u1 = (f32x4){bflo(a.z) * sigm(bflo(g.z)), bfhi(a.z) * sigm(bfhi(g.z)), bflo(a.w) * sigm(bflo(g.w)), bfhi(a.w) * sigm(bfhi(g.w))};
            *(LAS f32x4*)(U + tt * 256 + 8 * c8) = u0; *(LAS f32x4*)(U + tt * 256 + 8 * c8 + 4) = u1; } }
    WG_BAR();
#pragma unroll 1
    for (int g = 0; g < 2; ++g) { const int base = 16 * half + 8 * g; float win[38];
#pragma unroll
        for (int i = 0; i < 38; ++i) win[i] = U[(base + i) * 256 + c];
#pragma unroll
        for (int o = 0; o < 8; ++o) { float a = bias;
#pragma unroll
            for (int k = 0; k < 31; ++k) a += wk[k] * win[o + k];
            CO[(base + o) * 256 + c] = a; } }
    __syncthreads();
    const f32x4 lg = *(const f32x4*)(p.lng + layer * 256 + 4 * lane), lbv = *(const f32x4*)(p.lnb + layer * 256 + 4 * lane);
#pragma unroll
    for (int q = 0; q < 4; ++q) { const int tl = 4 * w + q; const f32x4 v = *(const LAS f32x4*)(CO + tl * 256 + 4 * lane);
        const float mean = wave_sum((v.x + v.y) + (v.z + v.w)) * (1.f / 256.f); const f32x4 dd = v - mean;
        const float var = wave_sum((dd.x * dd.x + dd.y * dd.y) + (dd.z * dd.z + dd.w * dd.w)) * (1.f / 256.f); const float rs = __builtin_amdgcn_rsqf(var + EPS);
        f32x4 y = dd * rs * lg + lbv; y = (f32x4){silu_f0(y.x), silu_f0(y.y), silu_f0(y.z), silu_f0(y.w)};
        *(u32x2*)(MIXED + (size_t)(b * SEQ + t0 + tl) * DM + 768 + 4 * lane) = (u32x2){pk2(y.x, y.y), pk2(y.z, y.w)}; }
    __syncthreads();
}

#define XB_TMO      128
#define XB_XCNT(j)  (256  + 64 * (j))
#define XB_XSUB(j)  (1280 + 64 * (j))
#define XB_XGEN(j)  (2304 + 64 * (j))
#define XB_TOP      3328
#define XB_TOPGEN   3392
#define XCD_BAR_WORDS 3456
#define XB_SPIN_CAP (1u << 18)

__device__ __forceinline__ unsigned xb_ld(unsigned* p)              { return __hip_atomic_load(p, __ATOMIC_RELAXED, __HIP_MEMORY_SCOPE_AGENT); }
__device__ __forceinline__ unsigned xb_add(unsigned* p, unsigned v) { return __hip_atomic_fetch_add(p, v, __ATOMIC_RELAXED, __HIP_MEMORY_SCOPE_AGENT); }
__device__ __forceinline__ unsigned xb_xcc_id() { return (unsigned)__builtin_amdgcn_s_getreg((3 << 11) | 20) & 0xFu; }
#define XB_SPIN(cond, bar) do { unsigned _sp = 0; while (cond) { __builtin_amdgcn_s_sleep(1); \
    if ((++_sp & 255u) == 0u) { if (xb_ld(&(bar)[XB_TMO])) break; if (_sp > XB_SPIN_CAP) { atomicAdd(&(bar)[XB_TMO], 1u); break; } } } } while (0)

struct XcdBarrier {
    unsigned* bar; unsigned x;
    volatile LAS unsigned* st;
};

__device__ __forceinline__ XcdBarrier xcd_barrier_post(unsigned* bar, volatile LAS unsigned* st) {
    XcdBarrier b; b.bar = bar; b.x = xb_xcc_id(); b.st = st;
    if (threadIdx.x == 0) (void)xb_add(&bar[XB_XCNT(b.x)], 1u);
    return b;
}
__device__ __forceinline__ void xcd_barrier_complete(unsigned* bar, unsigned x, unsigned& nloc, unsigned& nx) {
    const unsigned G = gridDim.x * gridDim.y * gridDim.z;
    unsigned sum, cnt, mine, sp = 0u;
    for (;;) {
        sum = 0u; cnt = 0u; mine = 0u;
#pragma unroll
        for (unsigned j = 0; j < 16; ++j) { const unsigned c = xb_ld(&bar[XB_XCNT(j)]); sum += c; cnt += (c > 0u) ? 1u : 0u; mine = (j == x) ? c : mine; }
        if (sum == G) break;
        __builtin_amdgcn_s_sleep(1);
        if ((++sp & 255u) == 0u) { if (xb_ld(&bar[XB_TMO])) break; if (sp > XB_SPIN_CAP) { atomicAdd(&bar[XB_TMO], 1u); break; } }
    }
    nloc = mine > 0u ? mine : 1u; nx = cnt > 0u ? cnt : 1u;
}

__device__ __forceinline__ void xcd_barrier(const XcdBarrier& b) {
    asm volatile("s_waitcnt vmcnt(0)" ::: "memory");
    __syncthreads();
    if (threadIdx.x == 0) {
        unsigned* bar = b.bar;
        __builtin_amdgcn_s_waitcnt(0);
        unsigned nloc = b.st[0], nx = b.st[1];
        if (nloc == 0u) { xcd_barrier_complete(bar, b.x, nloc, nx); b.st[0] = nloc; b.st[1] = nx; }
        const unsigned old = xb_add(&bar[XB_XSUB(b.x)], 1u);
        const unsigned gen = old / nloc;
        if (old + 1u == (gen + 1u) * nloc) {
            __builtin_amdgcn_fence(__ATOMIC_RELEASE, "agent");
            asm volatile("s_waitcnt vmcnt(0)" ::: "memory");
            const unsigned og = xb_add(&bar[XB_TOP], 1u);
            const unsigned tg = og / nx;
            if (og + 1u == (tg + 1u) * nx) xb_add(&bar[XB_TOPGEN], 1u);
            else XB_SPIN(xb_ld(&bar[XB_TOPGEN]) == tg, bar);
            __builtin_amdgcn_fence(__ATOMIC_ACQUIRE, "agent");
            xb_add(&bar[XB_XGEN(b.x)], 1u);
            asm volatile("s_waitcnt vmcnt(0)" ::: "memory");
        } else {
            XB_SPIN(xb_ld(&bar[XB_XGEN(b.x)]) == gen, bar);
            __builtin_amdgcn_fence(__ATOMIC_ACQUIRE, "agent");
            asm volatile("s_waitcnt vmcnt(0)" ::: "memory");
        }
    }
    __syncthreads();
}

#if 0
#define PROBE_SEL_UNUSED (-1)
#endif
#ifndef REP_HA
#define REP_HA 1
#endif
#ifndef REP_NA
#define REP_NA 1
#endif
#ifndef REP_CV
#define REP_CV 1
#endif
#ifndef REP_F
#define REP_F 1
#endif
#ifndef REP_B
#define REP_B 1
#endif
#define GRID_BAR() do { XcdBarrier xb_; xb_.bar = (unsigned*)(ws + WS_BAR); xb_.x = xb_xcc_id(); xb_.st = (volatile LAS unsigned*)(lds + XB_ST_OFF); xcd_barrier(xb_); } while (0)
#define PHASE_END(kind) do { GRID_BAR(); if (PROBE_SEL >= 0 && PROBE_SEL < 10 && threadIdx.x == 0) { volatile LAS unsigned long long* pv_ = (volatile LAS unsigned long long*)(lds + PT_WORDS_OFF + 8); const unsigned long long t_ = PT_NOW(); if ((kind) == PROBE_SEL || PROBE_SEL == 9) PT_ACC(lds, t_ - pv_[0]); pv_[0] = t_; } } while (0)
constexpr size_t WS_BAR = 4096, WS_CTL_BYTES = 65536;
constexpr int XB_ST_OFF = 140288;
constexpr int RS_OFF = 131072;
constexpr int LDS_BYTES = 147456;
#define KARGS(q_) const Params& q_ = p_unused;
__global__ void __launch_bounds__(NTHR, 2) fwd_megakernel(Params p_unused) {
    extern __shared__ __attribute__((aligned(16))) unsigned char lds_raw[];
    LAS unsigned char* lds = (LAS unsigned char*)lds_raw;
    int tid_ = threadIdx.x; asm volatile("" : "+v"(tid_)); const int tid = tid_, lane = tid & 63, wave = __builtin_amdgcn_readfirstlane(tid >> 6);
    const int G = gridDim.x, bid = blockIdx.x, gw = bid * NWAVES + wave, NGW = G * NWAVES;
    const int vcu = (G % 8 == 0) ? (bid % 8) * (G / 8) + bid / 8 : bid;
    unsigned char* ws; { KARGS(q0); ws = q0.ws; }

    if (tid < 2) ((volatile LAS unsigned*)(lds + XB_ST_OFF))[tid] = 0u;
    __syncthreads();
    if (ws == nullptr) cg::this_grid().sync();
    (void)xcd_barrier_post((unsigned*)(ws + WS_BAR), (volatile LAS unsigned*)(lds + XB_ST_OFF));
    if (PROBE_SEL >= 0 && threadIdx.x == 0) { ((volatile LAS unsigned*)(lds + PT_WORDS_OFF))[0] = 0u; *(volatile LAS unsigned long long*)(lds + PT_WORDS_OFF + 8) = PT_NOW(); }
    { KARGS(q); prologue(q, lds, gw, NGW, wave, lane); }
    PHASE_END(0);
    if (PROBE_SEL == 8) { PHASE_END(9); PHASE_END(8); }
#pragma unroll 1
    for (int l = 0; l < DEPTH; ++l) {
        unsigned char* wsl; { KARGS(ql); wsl = ql.ws; }
        float* ssq = (float*)(wsl + WS_SSQ); bf16* XB = (bf16*)(wsl + WS_XB); bf16* PB = (bf16*)(wsl + WS_P); bf16* MIXED = (bf16*)(wsl + WS_MIX);
        {
            pg8::Gemm g{XB, (const bf16*)(wsl + WS_WIN + l * WS_WIN_L), M, DIN, DM}; pg8::StaticOrder S; S.init(M, DIN, G, bid);
            pg8::rstd_table((LAS float*)(lds + RS_OFF), ssq, S); pg8::EpiScale E{PB, DIN, (LAS float*)(lds + RS_OFF), 0x303u};
            pg8::gemm_phase<pg8::EpiScale, pg8::StaticOrder, true, true>(lds, g, S, E);
            {
                KARGS(qc); const int nfull = (M / 256) * (DIN / 256) % G, first = nfull ? nfull : 0, nidle = G - first;
                if (bid >= first) { int tc_ = threadIdx.x; asm volatile("" : "+v"(tc_)); const int wv_ = __builtin_amdgcn_readfirstlane(tc_ >> 6); convert_weights(qc, lds, l * I_L + I_IN, l * I_L + I_IN + I_OUT + I_GU, (bid - first) * NWAVES + wv_, nidle * NWAVES, wv_, tc_ & 63); }
            }
        }
        PHASE_END(1);
#pragma unroll 1
        for (int rep = 0; rep < REP_HA; ++rep)
        { KARGS(q); constexpr int NI = BATCH * 4 * NSEG * 2; const int R = (NI + G - 1) / G; for (int k = 0; k < R; ++k) { const int it = vcu * R + k; if (it < NI) hg_passA_item(lds, q, l, it); } }
#pragma unroll 1
        for (int rep = 0; rep < REP_NA; ++rep)
        { KARGS(q); constexpr int NI = BATCH * 4 * 16; const int R = (NI + G - 1) / G; for (int k = 0; k < R; ++k) { const int it = vcu * R + k; if (it < NI) na_item(lds, q, l, it); } }
#pragma unroll 1
        for (int rep = 0; rep < REP_CV; ++rep)
        { KARGS(q); constexpr int NI = BATCH * 64; const int R = (NI + G - 1) / G; for (int k = 0; k < R; ++k) { const int it = vcu * R + k; if (it < NI) conv_item(lds, q, l, it); } }
        PHASE_END(2);
#pragma unroll 1
        for (int rep = 0; rep < REP_B; ++rep)
        { KARGS(q); constexpr int NI = BATCH * 4 * NSEG; const int R = (NI + G - 1) / G; for (int k = 0; k < R; ++k) { const int it = vcu * R + k; if (it < NI) (void)hg_passB_item(lds, q, l, it); } }
        PHASE_END(3);
        {
            pg8::Gemm g{MIXED, (const bf16*)(wsl + WS_WOUT + l * WS_WOUT_L), M, DM, DM}; pg8::StaticOrder S; S.init(M, DM, G, bid);
            pg8::EpiRes E{XB, ssq};
            pg8::gemm_phase<pg8::EpiRes, pg8::StaticOrder, true, true>(lds, g, S, E);
        }
        PHASE_END(4);
        {
            pg8::Gemm g{XB, (const bf16*)(wsl + WS_WGU + l * WS_WGU_L), M, 2 * FFN, DM}; pg8::StaticOrder S; S.init(M, 2 * FFN, G, bid);
            pg8::rstd_table((LAS float*)(lds + RS_OFF), ssq, S); pg8::EpiSwiGLU E{PB, FFN, (LAS float*)(lds + RS_OFF)};
            pg8::gemm_phase<pg8::EpiSwiGLU, pg8::StaticOrder, true, true>(lds, g, S, E);
            {
                KARGS(qc); const int nfull = (M / 256) * (2 * FFN / 256) % G, first = nfull ? nfull : 0, nidle = G - first;
                if (bid >= first) { int tc_ = threadIdx.x; asm volatile("" : "+v"(tc_)); const int wv_ = __builtin_amdgcn_readfirstlane(tc_ >> 6); convert_weights(qc, lds, l * I_L + I_IN + I_OUT + I_GU, (l + 1 < DEPTH) ? (l + 1) * I_L + I_IN : (l + 1) * I_L, (bid - first) * NWAVES + wv_, nidle * NWAVES, wv_, tc_ & 63); }
            }
        }
        PHASE_END(5);
        {
            pg8::Gemm g{PB, (const bf16*)(wsl + WS_WDN + l * WS_WDN_L), M, DM, FFN}; pg8::StaticOrder S; S.init(M, DM, G, bid);
            pg8::EpiRes E{XB, ssq};
            pg8::gemm_phase<pg8::EpiRes, pg8::StaticOrder, true, true>(lds, g, S, E);
        }
        PHASE_END(6);
    }
    float pdelta = 0.f;
    int tf_ = threadIdx.x; asm volatile("" : "+v"(tf_)); const int lanef = tf_ & 63, gwf = bid * NWAVES + __builtin_amdgcn_readfirstlane(tf_ >> 6);
    KARGS(qf); unsigned char* wsf = qf.ws; const float* ssq = (const float*)(wsf + WS_SSQ); const bf16* XB = (const bf16*)(wsf + WS_XB);
    if (PROBE_SEL >= 0) {
        unsigned* tw = (unsigned*)(wsf + 64);
        if (bid == 0 && threadIdx.x == 0) __hip_atomic_store(tw, ((volatile LAS unsigned*)(lds + PT_WORDS_OFF))[0], __ATOMIC_RELAXED, __HIP_MEMORY_SCOPE_AGENT);
        GRID_BAR();
        pdelta = (float)__hip_atomic_load(tw, __ATOMIC_RELAXED, __HIP_MEMORY_SCOPE_AGENT) * (PROBE_SEL == 9 ? 0.5e-6f : 1e-6f);
    }
#pragma unroll 1
    for (int rep = 0; rep < REP_F; ++rep)
    for (int m = gwf; m < M; m += 2 * NGW) {
        const int m2 = (m + NGW < M) ? m + NGW : m;
        float pa = lanef < 16 ? ssq[(size_t)(lanef & 15) * M + m] : 0.f, pc = lanef < 16 ? ssq[(size_t)(lanef & 15) * M + m2] : 0.f;
        const u32x4* xa = (const u32x4*)(XB + (size_t)m * DM) + lanef; const u32x4* xc = (const u32x4*)(XB + (size_t)m2 * DM) + lanef;
        u32x4 va[2], vc[2]; f32x4 gg[4];
#pragma unroll
        for (int j = 0; j < 2; ++j) { va[j] = __builtin_nontemporal_load(xa + 64 * j); vc[j] = __builtin_nontemporal_load(xc + 64 * j); gg[2 * j] = *(const f32x4*)(qf.fin_g + 512 * j + 8 * lanef); gg[2 * j + 1] = *(const f32x4*)(qf.fin_g + 512 * j + 8 * lanef + 4); }
        __builtin_amdgcn_sched_barrier(0);
        pa = wave_sum(pa); pc = wave_sum(pc);
        const float ra = __builtin_amdgcn_rsqf(pa * (1.f / DM) + EPS), rc = __builtin_amdgcn_rsqf(pc * (1.f / DM) + EPS);
        const f32x4 pd = (PROBE_SEL >= 0) ? (f32x4){pdelta, -pdelta, pdelta, -pdelta} : (f32x4){0.f, 0.f, 0.f, 0.f};
#pragma unroll
        for (int j = 0; j < 2; ++j) {
            { const u32x4 r = va[j]; float* o = qf.out + (size_t)m * DM + 512 * j + 8 * lanef;
              f32x4 v0 = (f32x4){bflo(r.x), bfhi(r.x), bflo(r.y), bfhi(r.y)} * ra * gg[2 * j], v1 = (f32x4){bflo(r.z), bfhi(r.z), bflo(r.w), bfhi(r.w)} * ra * gg[2 * j + 1];
              if (PROBE_SEL >= 0 && m < 256) { v0 = v0 + pd; v1 = v1 + pd; }
              __builtin_nontemporal_store(v0, (f32x4*)o); __builtin_nontemporal_store(v1, (f32x4*)(o + 4)); }
            if (m2 != m) { const u32x4 r = vc[j]; float* o = qf.out + (size_t)m2 * DM + 512 * j + 8 * lanef;
              f32x4 v0 = (f32x4){bflo(r.x), bfhi(r.x), bflo(r.y), bfhi(r.y)} * rc * gg[2 * j], v1 = (f32x4){bflo(r.z), bfhi(r.z), bflo(r.w), bfhi(r.w)} * rc * gg[2 * j + 1];
              if (PROBE_SEL >= 0 && m2 < 256) { v0 = v0 + pd; v1 = v1 + pd; }
              __builtin_nontemporal_store(v0, (f32x4*)o); __builtin_nontemporal_store(v1, (f32x4*)(o + 4)); } }
    }
}

extern "C" void kernel_launch(void* const* d_in, const int* in_sizes, int n_in, void* d_out, int out_size, void* d_ws, size_t ws_size, hipStream_t stream) {
    static int grid_blocks = 0;
    if (grid_blocks == 0) {
        if (n_in != 15 || out_size != M * DM || ws_size < WS_END) { fprintf(stderr, "kernel_launch: unexpected shapes (n_in %d out %d ws %zu)\n", n_in, out_size, ws_size); grid_blocks = -1; return; }
        int dev = 0, cus = 0, per_cu = 0;
        hipGetDevice(&dev); hipDeviceGetAttribute(&cus, hipDeviceAttributeMultiprocessorCount, dev);
        hipFuncSetAttribute((const void*)fwd_megakernel, hipFuncAttributeMaxDynamicSharedMemorySize, LDS_BYTES);
        hipOccupancyMaxActiveBlocksPerMultiprocessor(&per_cu, (const void*)fwd_megakernel, NTHR, LDS_BYTES);
        if (per_cu < 1) { fprintf(stderr, "kernel_launch: occupancy query says %d blocks per CU\n", per_cu); per_cu = 1; }
        (void)hipGetLastError();
        grid_blocks = cus * 1;
    }
    if (grid_blocks < 0) return;
    Params p{};
    p.x = (const float*)d_in[0]; p.mix_g = (const float*)d_in[1]; p.w_in = (const float*)d_in[2]; p.hg_lb = (const float*)d_in[3]; p.hg_ng = (const float*)d_in[4];
    p.rpb = (const float*)d_in[5]; p.cw = (const float*)d_in[6]; p.cb = (const float*)d_in[7]; p.lng = (const float*)d_in[8]; p.lnb = (const float*)d_in[9];
    p.w_out = (const float*)d_in[10]; p.ffn_g = (const float*)d_in[11]; p.w_gu = (const float*)d_in[12]; p.w_dn = (const float*)d_in[13]; p.fin_g = (const float*)d_in[14];
    p.out = (float*)d_out; p.ws = (unsigned char*)d_ws;
    if (hipMemsetAsync(d_ws, 0, WS_CTL_BYTES, stream) != hipSuccess) { fprintf(stderr, "kernel_launch: hipMemsetAsync failed\n"); return; }
    void* args[] = {&p};
    hipError_t e = hipLaunchCooperativeKernel((const void*)fwd_megakernel, dim3(grid_blocks), dim3(NTHR), args, LDS_BYTES, stream);
    if (e != hipSuccess) fprintf(stderr, "cooperative launch failed: %s (grid %d)\n", hipGetErrorString(e), grid_blocks);
}
```
